# Optimizing an MI355X kernel written in HIP

```python
import math
import jax, jax.numpy as jnp
from jax import lax
import numpy as np

D_MODEL = 4096
BATCH = 4
SEQ = 4096
DEPTH = 1
DEC_BATCH = 2
DEC_SEQ = 8192
PAST_LEN = 128

H_DIFF = D_MODEL // 256
DH_DIFF = 64
V_DIFF = 2 * DH_DIFF
H_MLA = D_MODEL // 256
Q_LORA = 1024
KV_LORA = 512
QK_NOPE = 128
QK_ROPE = 64
V_MLA = 128
ROPE_THETA = 10000.0
N_BUCKETS = 32
MAX_DISTANCE = 128
D_FF = 11008
CONV_WIDTH = 3
Q_BLOCK = 128
EPS = 1e-6

DIFF_Q_COLS = H_DIFF * 2 * DH_DIFF
DIFF_K_COLS = H_DIFF * 2 * DH_DIFF
DIFF_V_COLS = H_DIFF * V_DIFF
MLA_V_COLS = H_MLA * V_MLA
GATE_COLS = 2 * D_MODEL
IN_COLS = DIFF_Q_COLS + DIFF_K_COLS + DIFF_V_COLS + Q_LORA + KV_LORA + QK_ROPE + GATE_COLS
IN_SPLITS = (
    DIFF_Q_COLS,
    DIFF_Q_COLS + DIFF_K_COLS,
    DIFF_Q_COLS + DIFF_K_COLS + DIFF_V_COLS,
    DIFF_Q_COLS + DIFF_K_COLS + DIFF_V_COLS + Q_LORA,
    DIFF_Q_COLS + DIFF_K_COLS + DIFF_V_COLS + Q_LORA + KV_LORA,
    DIFF_Q_COLS + DIFF_K_COLS + DIFF_V_COLS + Q_LORA + KV_LORA + QK_ROPE,
)

kernel_name = 'hybrid_diffattn_mla_convffn_encoder'


def rmsnorm(x, g):
    xf = x.astype(jnp.float32)
    y = xf * lax.rsqrt(jnp.mean(xf * xf, axis=-1, keepdims=True) + EPS) * g.astype(jnp.float32)
    return y.astype(x.dtype)


def t5_bucket(rel):
    nb = N_BUCKETS // 2
    max_exact = nb // 2
    ret = (rel > 0).astype(jnp.int32) * nb
    n = jnp.abs(rel)
    nf = jnp.maximum(n, max_exact).astype(jnp.float32)
    large = max_exact + (jnp.log(nf / max_exact) / math.log(MAX_DISTANCE / max_exact)
                         * (nb - max_exact)).astype(jnp.int32)
    large = jnp.minimum(large, nb - 1)
    return ret + jnp.where(n < max_exact, n, large)


def to_blocks(t):
    b, s = t.shape[0], t.shape[1]
    return t.reshape((b, s // Q_BLOCK, Q_BLOCK) + t.shape[2:]).swapaxes(0, 1)


def from_blocks(t):
    n, b, q = t.shape[0], t.shape[1], t.shape[2]
    return t.swapaxes(0, 1).reshape((b, n * q) + t.shape[3:])


def rope(x, cos, sin):
    xf = x.astype(jnp.float32)
    x1, x2 = jnp.split(xf, 2, axis=-1)
    return jnp.concatenate([x1 * cos - x2 * sin, x1 * sin + x2 * cos], axis=-1).astype(x.dtype)


def diff_attention(q, k, v, lam, rel_bias):
    s_len = k.shape[1]
    scale = DH_DIFF ** -0.5
    kpos = jnp.arange(s_len, dtype=jnp.int32)
    qb = to_blocks(q)
    nblk = qb.shape[0]

    def one(args):
        qi, bi = args
        qpos = bi * Q_BLOCK + jnp.arange(Q_BLOCK, dtype=jnp.int32)
        bias = rel_bias[t5_bucket(kpos[None, :] - qpos[:, None])]
        bias = bias.astype(jnp.float32).transpose(2, 0, 1)
        s = jnp.einsum('bqhcd,bkhcd->bhcqk', qi, k).astype(jnp.float32) * scale
        p = jax.nn.softmax(s + bias[None, :, None], axis=-1)
        a = p[:, :, 0] - lam * p[:, :, 1]
        return jnp.einsum('bhqk,bkhe->bqhe', a.astype(v.dtype), v)

    out = lax.map(one, (qb, jnp.arange(nblk, dtype=jnp.int32)))
    return from_blocks(out)


def mla_attention(q_nope, q_pe, k_nope, k_pe, v):
    scale = (QK_NOPE + QK_ROPE) ** -0.5

    def one(args):
        qn, qp = args
        s = (jnp.einsum('bqhd,bkhd->bhqk', qn, k_nope)
             + jnp.einsum('bqhr,bkr->bhqk', qp, k_pe)).astype(jnp.float32) * scale
        p = jax.nn.softmax(s, axis=-1)
        return jnp.einsum('bhqk,bkhe->bqhe', p.astype(v.dtype), v)

    out = lax.map(one, (to_blocks(q_nope), to_blocks(q_pe)))
    return from_blocks(out)


def depthwise_conv3(h, w, b):
    hp = jnp.pad(h, ((0, 0), (1, 1), (0, 0)))
    return hp[:, :-2] * w[0] + hp[:, 1:-1] * w[1] + hp[:, 2:] * w[2] + b


def encoder_layer(x, layer_idx, rel_bias, rms_attn_g, w_in, lambda_q1, lambda_k1, lambda_q2,
                  lambda_k2, diff_subln_g, mla_q_norm_g, w_mla_q_up, mla_kv_norm_g, w_mla_kv_up,
                  w_branch_a, w_branch_b, w_out, rms_ffn_g, w_ffn_up, conv_w, conv_b, w_ffn_down):
    b, s_len, _ = x.shape
    h = rmsnorm(x, rms_attn_g)
    proj = h @ w_in
    dq, dk, dv, q_lat, kv_lat, k_pe, gates = jnp.split(proj, IN_SPLITS, axis=-1)

    lambda_init = 0.8 - 0.6 * math.exp(-0.3 * layer_idx)
    f32 = jnp.float32
    lam = (jnp.exp(jnp.sum(lambda_q1.astype(f32) * lambda_k1.astype(f32)))
           - jnp.exp(jnp.sum(lambda_q2.astype(f32) * lambda_k2.astype(f32))) + lambda_init)
    a_out = diff_attention(dq.reshape(b, s_len, H_DIFF, 2, DH_DIFF),
                           dk.reshape(b, s_len, H_DIFF, 2, DH_DIFF),
                           dv.reshape(b, s_len, H_DIFF, V_DIFF), lam, rel_bias)
    a_out = rmsnorm(a_out, diff_subln_g) * (1.0 - lambda_init)
    a_out = a_out.astype(x.dtype).reshape(b, s_len, DIFF_V_COLS)

    q = (rmsnorm(q_lat, mla_q_norm_g) @ w_mla_q_up).reshape(b, s_len, H_MLA, QK_NOPE + QK_ROPE)
    q_nope, q_pe = q[..., :QK_NOPE], q[..., QK_NOPE:]
    kv = (rmsnorm(kv_lat, mla_kv_norm_g) @ w_mla_kv_up).reshape(b, s_len, H_MLA, QK_NOPE + V_MLA)
    k_nope, v_mla = kv[..., :QK_NOPE], kv[..., QK_NOPE:]
    pos = jnp.arange(s_len, dtype=jnp.float32)
    inv_freq = ROPE_THETA ** (-jnp.arange(0, QK_ROPE, 2, dtype=jnp.float32) / QK_ROPE)
    ang = pos[:, None] * inv_freq[None, :]
    cos, sin = jnp.cos(ang), jnp.sin(ang)
    q_pe = rope(q_pe, cos[None, :, None, :], sin[None, :, None, :])
    k_pe = rope(k_pe, cos[None], sin[None])
    b_out = mla_attention(q_nope, q_pe, k_nope, k_pe, v_mla).reshape(b, s_len, MLA_V_COLS)

    g_a, g_b = jnp.split(gates, 2, axis=-1)
    merged = jax.nn.sigmoid(g_a) * (a_out @ w_branch_a) + jax.nn.sigmoid(g_b) * (b_out @ w_branch_b)
    x = x + merged @ w_out

    h2 = rmsnorm(x, rms_ffn_g)
    u = depthwise_conv3(h2 @ w_ffn_up, conv_w, conv_b)
    gate, up = jnp.split(u, 2, axis=-1)
    x = x + (jax.nn.silu(gate) * up) @ w_ffn_down
    return x


def setup_inputs(seed: int = 0) -> dict:
    key = jax.random.key(seed)
    ks = jax.random.split(key, 24)
    f32 = jnp.float32
    L = DEPTH

    def nrm(k, shape, fan_in):
        return jax.random.normal(k, shape, f32) * (fan_in ** -0.5)

    def gain(k, shape):
        return 1.0 + 0.02 * jax.random.normal(k, shape, f32)

    return {
        'x_prompt': jax.random.normal(ks[0], (BATCH, SEQ, D_MODEL), f32),
        'x_sample': jax.random.normal(ks[1], (DEC_BATCH, DEC_SEQ, D_MODEL), f32),
        'rel_bias': 0.5 * jax.random.normal(ks[2], (N_BUCKETS, H_DIFF), f32),
        'final_norm_g': gain(ks[3], (D_MODEL,)),
        'rms_attn_g': gain(ks[4], (L, D_MODEL)),
        'w_in': nrm(ks[5], (L, D_MODEL, IN_COLS), D_MODEL),
        'lambda_q1': 0.1 * jax.random.normal(ks[6], (L, DH_DIFF), f32),
        'lambda_k1': 0.1 * jax.random.normal(ks[7], (L, DH_DIFF), f32),
        'lambda_q2': 0.1 * jax.random.normal(ks[8], (L, DH_DIFF), f32),
        'lambda_k2': 0.1 * jax.random.normal(ks[9], (L, DH_DIFF), f32),
        'diff_subln_g': gain(ks[10], (L, V_DIFF)),
        'mla_q_norm_g': gain(ks[11], (L, Q_LORA)),
        'w_mla_q_up': nrm(ks[12], (L, Q_LORA, H_MLA * (QK_NOPE + QK_ROPE)), Q_LORA),
        'mla_kv_norm_g': gain(ks[13], (L, KV_LORA)),
        'w_mla_kv_up': nrm(ks[14], (L, KV_LORA, H_MLA * (QK_NOPE + V_MLA)), KV_LORA),
        'w_branch_a': nrm(ks[15], (L, DIFF_V_COLS, D_MODEL), DIFF_V_COLS),
        'w_branch_b': nrm(ks[16], (L, MLA_V_COLS, D_MODEL), MLA_V_COLS),
        'w_out': nrm(ks[17], (L, D_MODEL, D_MODEL), D_MODEL),
        'rms_ffn_g': gain(ks[18], (L, D_MODEL)),
        'w_ffn_up': nrm(ks[19], (L, D_MODEL, 2 * D_FF), D_MODEL),
        'conv_w': nrm(ks[20], (L, CONV_WIDTH, 2 * D_FF), CONV_WIDTH),
        'conv_b': 0.02 * jax.random.normal(ks[21], (L, 2 * D_FF), f32),
        'w_ffn_down': nrm(ks[22], (L, D_FF, D_MODEL), D_FF),
    }


def reference(x_prompt, x_sample, rel_bias, final_norm_g, rms_attn_g, w_in, lambda_q1, lambda_k1,
              lambda_q2, lambda_k2, diff_subln_g, mla_q_norm_g, w_mla_q_up, mla_kv_norm_g,
              w_mla_kv_up, w_branch_a, w_branch_b, w_out, rms_ffn_g, w_ffn_up, conv_w, conv_b,
              w_ffn_down):
    def trunk(x):
        for l in range(DEPTH):
            x = encoder_layer(x, l, rel_bias, rms_attn_g[l], w_in[l], lambda_q1[l], lambda_k1[l],
                              lambda_q2[l], lambda_k2[l], diff_subln_g[l], mla_q_norm_g[l],
                              w_mla_q_up[l], mla_kv_norm_g[l], w_mla_kv_up[l], w_branch_a[l],
                              w_branch_b[l], w_out[l], rms_ffn_g[l], w_ffn_up[l], conv_w[l],
                              conv_b[l], w_ffn_down[l])
        return rmsnorm(x, final_norm_g)

    y_prompt = trunk(x_prompt)
    y_sample = trunk(x_sample)
    return (y_prompt, y_sample)
```

```cpp
#include <hip/hip_runtime.h>
#include <cstdio>
#include <cstdint>
#include <cmath>

#ifndef I8_IN
#define I8_IN 1
#endif
#ifndef ATT_CINIT
#define ATT_CINIT 1
#endif
constexpr float CS_DIFF = 0.125f * 1.4426950408889634f;
#ifndef CONV_FUSE
#define CONV_FUSE 0
#endif
#ifndef I8_MID
#define I8_MID 1
#endif
#ifndef I8_UP
#define I8_UP 1
#endif
#ifndef FP8_DOWN
#define FP8_DOWN 0
#endif
constexpr float S_WD = 1024.f, S_ACT8 = 8.f;
#ifndef REP_GEMM
#define REP_GEMM 1
#endif
#ifndef REP_DIFF
#define REP_DIFF 1
#endif
#ifndef REP_MLA
#define REP_MLA 1
#endif
#if REP_GEMM == 1
#define REP_LOOP_GEMM
#else
#define REP_LOOP_GEMM _Pragma("unroll 1") for (int rep = 0; rep < REP_GEMM; ++rep)
#endif
#ifndef MK_PER_STEP_LAUNCH
#define MK_PER_STEP_LAUNCH 0
#endif

typedef unsigned short bf16;
typedef short bf16x8 __attribute__((ext_vector_type(8)));
typedef short s16x4 __attribute__((ext_vector_type(4)));
typedef float f32x4 __attribute__((ext_vector_type(4)));
typedef float f32x2 __attribute__((ext_vector_type(2)));
typedef float f32x16 __attribute__((ext_vector_type(16)));
typedef unsigned u32x4 __attribute__((ext_vector_type(4)));
typedef unsigned u32x2 __attribute__((ext_vector_type(2)));
typedef int i32x4 __attribute__((ext_vector_type(4)));
typedef int i32x8 __attribute__((ext_vector_type(8)));
#define LAS __attribute__((address_space(3)))

__device__ __forceinline__ unsigned cvt_pk_bf16(float lo, float hi) { unsigned r; asm volatile("v_cvt_pk_bf16_f32 %0, %1, %2" : "=v"(r) : "v"(lo), "v"(hi)); return r; }
__device__ __forceinline__ float bf_lo(unsigned w) { return __uint_as_float(w << 16); }
__device__ __forceinline__ float bf_hi(unsigned w) { return __uint_as_float(w & 0xffff0000u); }
__device__ __forceinline__ float clamp448(float x) { return __builtin_fminf(__builtin_fmaxf(x, -448.f), 448.f); }
__device__ __forceinline__ unsigned pack4_fp8(float a, float b, float c, float d) { int w = 0; w = __builtin_amdgcn_cvt_pk_fp8_f32(clamp448(a), clamp448(b), w, false); w = __builtin_amdgcn_cvt_pk_fp8_f32(clamp448(c), clamp448(d), w, true); return (unsigned)w; }
__device__ __forceinline__ unsigned pack4_i8(float a, float b, float c, float d) { const int ia = (int)__builtin_rintf(a), ib = (int)__builtin_rintf(b), ic = (int)__builtin_rintf(c), id = (int)__builtin_rintf(d);
    return (unsigned)(ia & 255) | ((unsigned)(ib & 255) << 8) | ((unsigned)(ic & 255) << 16) | ((unsigned)id << 24); }
__device__ __forceinline__ float fast_sigmoid(float x) { return __builtin_amdgcn_rcpf(1.0f + __builtin_amdgcn_exp2f(-1.4426950408889634f * x)); }

__device__ __forceinline__ int lane_id_fresh() { unsigned ones = ~0u; asm volatile("" : "+s"(ones)); return (int)__builtin_amdgcn_mbcnt_hi(ones, __builtin_amdgcn_mbcnt_lo(ones, 0u)); }

constexpr int DM = 4096, NTOK = 32768, TG = 8192, NGRP = 4;
constexpr int NIN = 16128;
constexpr int C_DQ = 0, C_DK = 2048, C_DV = 4096, C_QLAT = 6144, C_KVLAT = 7168, C_GATE = 7680, C_KPE = 15872;
constexpr int DFF = 11008, NUP = 22016, NQ = 3072, NKV = 4096;
constexpr float EPS = 1e-6f;

constexpr size_t MiB = 1u << 20;
constexpr size_t WS_CTL = 0, CTL_ZERO_BYTES = 1 * MiB;
constexpr size_t WS_COS = 1 * MiB, WS_SIN = 2 * MiB, WS_BIAS = 3 * MiB, WS_LAM = 3 * MiB + 32768;
constexpr size_t WS_CSIN = 3 * MiB + 65536, WS_CSUP = 3 * MiB + 131072, WS_RSH = 3 * MiB + 262144;
constexpr size_t WS_CSQ = 3 * MiB + 320 * 1024, WS_CSKV = 3 * MiB + 336 * 1024, WS_CSA = 3 * MiB + 352 * 1024, WS_CSB = 3 * MiB + 368 * 1024, WS_CSO = 3 * MiB + 384 * 1024;
constexpr size_t WS_RSQL = 3 * MiB + 400 * 1024, WS_RSKVL = 3 * MiB + 432 * 1024, WS_RSA = 3 * MiB + 464 * 1024, WS_RSB = 3 * MiB + 496 * 1024, WS_RSM = 3 * MiB + 528 * 1024;
constexpr int CW_CMAX_IN = 16384, CW_CMAX_UP = 32768, CW_CMAX_Q = 57344, CW_CMAX_KV = 61440, CW_CMAX_A = 65536, CW_CMAX_B = 69632, CW_CMAX_O = 73728;
constexpr size_t WS_WIN = 4 * MiB, WS_WQ = 130 * MiB, WS_WKV = 136 * MiB, WS_WA = 140 * MiB, WS_WB = 156 * MiB, WS_WO = 172 * MiB, WS_WUP = 204 * MiB, WS_WD = 376 * MiB;
constexpr size_t WS_ACT = 462 * MiB;
constexpr size_t WS_H = WS_ACT, WS_P = WS_ACT + 64 * MiB, WS_Q = WS_ACT + 316 * MiB, WS_KV = WS_ACT + 364 * MiB, WS_AO = WS_ACT + 428 * MiB, WS_BO = WS_ACT + 460 * MiB, WS_MG = WS_ACT + 492 * MiB, WS_STASH = WS_ACT + 556 * MiB;
constexpr size_t WS_Y = WS_ACT + 64 * MiB, WS_ACTV = WS_ACT + 408 * MiB;
constexpr size_t WS_QL8 = WS_ACT + 588 * MiB, WS_KVL8 = WS_ACT + 596 * MiB, WS_AO8 = WS_ACT + 600 * MiB, WS_BO8 = WS_ACT + 616 * MiB, WS_MG8 = WS_ACT + 632 * MiB;
constexpr size_t WS_X1 = WS_ACT + 664 * MiB;
constexpr size_t WS_END = WS_ACT + 728 * MiB;
static_assert(WS_WIN + (size_t)NIN * DM * 2 <= WS_WQ && WS_WUP + (size_t)NUP * DM * 2 <= WS_WD && WS_WD + (size_t)DM * DFF * 2 <= WS_ACT, "weight map");
static_assert(WS_P + (size_t)TG * NIN * 2 <= WS_Q && WS_Y + (size_t)TG * NUP * 2 <= WS_ACTV && WS_ACTV + (size_t)TG * DFF * 2 <= WS_STASH + 32 * MiB, "activation map");

namespace pg8 {
constexpr int BM = 256, BK = 64, HALF = 128, HTB = HALF * BK * 2, STAGE_BYTES = 8 * HTB, NXCD = 8, WGM = 8;
__host__ __device__ __forceinline__ int lds_byte(int r, int c) { const int st = (r >> 4) * 2 + (c >> 5), rr = r & 15, cc = c & 31, ob = rr * 64 + cc * 2; return st * 1024 + (ob ^ (((ob >> 9) & 1) << 5)); }
__host__ __device__ __forceinline__ void stage_rc(int b, int& R, int& C) { const int st = b / 1024, sb = b % 1024, swz = sb ^ (((sb >> 9) & 1) << 5); R = (st >> 1) * 16 + swz / 64; C = (st & 1) * 32 + (swz % 64) / 2; }
__host__ __device__ __forceinline__ int perm32(int rho) { const int n = rho >> 4, i = rho & 15; return 8 * (i >> 2) + 4 * n + (i & 3); }

struct Unit { int pm, pn; };
struct Gemm { const bf16* A; int lda; const bf16* Bt; int M, N, K; };

struct StaticOrder {
    int nM, nN, nwg, G, c;
    __device__ void init(int M, int N, int G_, int c_) { nM = M / BM; nN = N / BM; nwg = nM * nN; G = G_; c = c_; }
    __device__ bool next(int i, Unit& u) const {
        const long L = (long)i * G + c; if (L >= nwg) return false;
        int wgid = (int)L; { const int q = nwg / NXCD, r = nwg % NXCD, xcd = wgid % NXCD, off = wgid / NXCD; wgid = (xcd < r ? xcd * (q + 1) : r * (q + 1) + (xcd - r) * q) + off; }
        const int nig = WGM * nN, gid = wgid / nig, fm = gid * WGM, gsz = (nM - fm) < WGM ? (nM - fm) : WGM;
        u.pm = fm + ((wgid % nig) % gsz); u.pn = (wgid % nig) / gsz; return true;
    }
};

template <int MODE> struct AccSel { typedef f32x4 T; }; template <> struct AccSel<2> { typedef i32x4 T; };
__device__ __forceinline__ f32x4 tof(f32x4 v) { return v; }
__device__ __forceinline__ f32x4 tof(i32x4 v) { return __builtin_convertvector(v, f32x4); }

template <class Epi, int MODE = 0>
__device__ __forceinline__ void gemm_phase(LAS unsigned char* lds, const Gemm g, const StaticOrder& S, const Epi& E, int tid_in) {
    int tid = tid_in; asm volatile("" : "+v"(tid));
    const int wid = __builtin_amdgcn_readfirstlane(tid >> 6), lane = tid & 63, wr = wid >> 2, wc = wid & 3, fr = lane & 15, fq = lane >> 4;
    int K = g.K, lda = g.lda; asm volatile("" : "+s"(K), "+s"(lda));
    const int nt = K / BK;
    unsigned voffA[2], voffB[2];
#pragma unroll
    for (int i = 0; i < 2; ++i) { int R, C; stage_rc(tid * 16 + i * 8192, R, C); const int Rb = (R & ~31) + perm32(R & 31);
        voffA[i] = (unsigned)(R * lda + C) * 2u; voffB[i] = (unsigned)(Rb * K + C) * 2u; }
    const size_t kstep = (size_t)(BK * 2);
    const size_t hstepA = (size_t)HALF * lda * 2, hstepB = (size_t)HALF * K * 2;
    const size_t tstepA = 2 * hstepA, tstepB = 2 * hstepB;
    const unsigned ldsw = (unsigned)wid * 1024u;
    const int aoff = lds_byte(wr * 64 + fr, fq * 8), boff = lds_byte(wc * 32 + fr, fq * 8);
#define PG8_SA(b, h) (((b) * 2 + (h)) * HTB)
#define PG8_SB(b, h) ((4 + (b) * 2 + (h)) * HTB)
#define PG8_STAGE(bufoff, gbase, voff) do { _Pragma("unroll") for (int _i = 0; _i < 2; ++_i) \
        __builtin_amdgcn_global_load_lds((const unsigned*)((const char*)(gbase) + (voff)[_i]), (LAS unsigned*)(lds + (bufoff) + ldsw + _i * 8192), 16, 0, 0); } while (0)
#define PG8_CAT(x, y) __builtin_shufflevector(__builtin_bit_cast(i32x4, x), __builtin_bit_cast(i32x4, y), 0, 1, 2, 3, 4, 5, 6, 7)
#define PG8_LDA(dst, b, h) do { _Pragma("unroll") for (int m = 0; m < 4; ++m) dst[m] = PG8_CAT(*(const LAS bf16x8*)(lds + PG8_SA(b, h) + aoff + m * 2048), *(const LAS bf16x8*)(lds + PG8_SA(b, h) + aoff + m * 2048 + 1024)); } while (0)
#define PG8_LDB(dst, b, h) do { _Pragma("unroll") for (int n = 0; n < 2; ++n) dst[n] = PG8_CAT(*(const LAS bf16x8*)(lds + PG8_SB(b, h) + boff + n * 2048), *(const LAS bf16x8*)(lds + PG8_SB(b, h) + boff + n * 2048 + 1024)); } while (0)
#define PG8_LO4(v) __builtin_shufflevector(v, v, 0, 1, 2, 3)
#define PG8_HI4(v) __builtin_shufflevector(v, v, 4, 5, 6, 7)
#define PG8_LO(v) __builtin_bit_cast(bf16x8, __builtin_shufflevector(v, v, 0, 1, 2, 3))
#define PG8_HI(v) __builtin_bit_cast(bf16x8, __builtin_shufflevector(v, v, 4, 5, 6, 7))
#define PG8_MMA(ai, bj, At, Bt) do { __builtin_amdgcn_s_setprio(1); _Pragma("unroll") for (int m = 0; m < 4; ++m) _Pragma("unroll") for (int n = 0; n < 2; ++n) { \
        if constexpr (F8) asm volatile("v_mfma_f32_16x16x128_f8f6f4 %0, %1, %2, %0" : "+v"(acc[ai][bj][m][n]) : "v"(Bt[n]), "v"(At[m]));   \
        else if constexpr (MODE == 2) { acc[ai][bj][m][n] = __builtin_amdgcn_mfma_i32_16x16x64_i8(PG8_LO4(Bt[n]), PG8_LO4(At[m]), acc[ai][bj][m][n], 0, 0, 0); \
               acc[ai][bj][m][n] = __builtin_amdgcn_mfma_i32_16x16x64_i8(PG8_HI4(Bt[n]), PG8_HI4(At[m]), acc[ai][bj][m][n], 0, 0, 0); } \
        else { acc[ai][bj][m][n] = __builtin_amdgcn_mfma_f32_16x16x32_bf16(PG8_LO(Bt[n]), PG8_LO(At[m]), acc[ai][bj][m][n], 0, 0, 0); \
               acc[ai][bj][m][n] = __builtin_amdgcn_mfma_f32_16x16x32_bf16(PG8_HI(Bt[n]), PG8_HI(At[m]), acc[ai][bj][m][n], 0, 0, 0); } } __builtin_amdgcn_s_setprio(0); } while (0)
#define PG8_WAIT_V(n) asm volatile("s_waitcnt vmcnt(" #n ")" ::: "memory")
#define PG8_WAIT_L(n) asm volatile("s_waitcnt lgkmcnt(" #n ")" ::: "memory")
#define PG8_BAR __builtin_amdgcn_s_barrier()
#define PG8_SCHED __builtin_amdgcn_sched_barrier(0)
    Unit cur, nxt; int ui = 0;
    if (!S.next(0, cur)) return;
    constexpr bool F8 = (MODE == 1); typedef typename AccSel<MODE>::T AccT; AccT acc[2][2][4][2];
#pragma unroll
    for (int a = 0; a < 2; ++a)
#pragma unroll
        for (int b = 0; b < 2; ++b)
#pragma unroll
            for (int m = 0; m < 4; ++m)
#pragma unroll
                for (int n = 0; n < 2; ++n) acc[a][b][m][n] = AccT{};
    i32x8 At[4], B0[2], B1[2];
    const char* cA = (const char*)g.A + (size_t)cur.pm * tstepA; const char* cB = (const char*)g.Bt + (size_t)cur.pn * tstepB;
    PG8_STAGE(PG8_SB(0, 0), cB, voffB); PG8_STAGE(PG8_SB(0, 1), cB + hstepB, voffB); PG8_STAGE(PG8_SA(0, 0), cA, voffA); PG8_STAGE(PG8_SA(0, 1), cA + hstepA, voffA);
    if (wr == 1) PG8_BAR;
    PG8_WAIT_V(2); PG8_BAR;
    PG8_STAGE(PG8_SB(1, 0), cB + kstep, voffB); PG8_STAGE(PG8_SA(1, 0), cA + kstep, voffA); PG8_STAGE(PG8_SB(1, 1), cB + hstepB + kstep, voffB);
    PG8_WAIT_V(6); PG8_BAR;
    for (;;) {
        const bool has_next = S.next(ui + 1, nxt);
        const char* nA = has_next ? (const char*)g.A + (size_t)nxt.pm * tstepA : cA; const char* nB = has_next ? (const char*)g.Bt + (size_t)nxt.pn * tstepB : cB;
        for (int t = 0; t < nt; t += 2) {
            const bool last = (t == nt - 2);
            const char* a1 = cA + (size_t)(t + 1) * kstep;
            const char* a2 = last ? nA : cA + (size_t)(t + 2) * kstep; const char* b2 = last ? nB : cB + (size_t)(t + 2) * kstep;
            const char* a3 = a2 + kstep; const char* b3 = b2 + kstep;
            PG8_LDB(B0, 0, 0); PG8_LDB(B1, 0, 1); PG8_SCHED; PG8_LDA(At, 0, 0); PG8_STAGE(PG8_SA(1, 1), a1 + hstepA, voffA);
            PG8_WAIT_V(8); PG8_WAIT_L(0); PG8_BAR; PG8_MMA(0, 0, At, B0); PG8_MMA(0, 1, At, B1); PG8_BAR; PG8_SCHED;
            PG8_LDA(At, 0, 1); PG8_STAGE(PG8_SB(0, 0), b2, voffB); PG8_STAGE(PG8_SB(0, 1), b2 + hstepB, voffB); PG8_STAGE(PG8_SA(0, 0), a2, voffA);
            PG8_WAIT_V(8); PG8_WAIT_L(0); PG8_BAR; PG8_MMA(1, 0, At, B0); PG8_MMA(1, 1, At, B1); PG8_BAR; PG8_SCHED;
            PG8_LDB(B0, 1, 0); PG8_LDB(B1, 1, 1); PG8_SCHED; PG8_LDA(At, 1, 0); PG8_STAGE(PG8_SA(0, 1), a2 + hstepA, voffA);
            PG8_WAIT_V(8); PG8_WAIT_L(0); PG8_BAR; PG8_MMA(0, 0, At, B0); PG8_MMA(0, 1, At, B1); PG8_BAR; PG8_SCHED;
            PG8_LDA(At, 1, 1); PG8_STAGE(PG8_SB(1, 0), b3, voffB); PG8_STAGE(PG8_SB(1, 1), b3 + hstepB, voffB); PG8_STAGE(PG8_SA(1, 0), a3, voffA);
            PG8_WAIT_V(8); PG8_WAIT_L(0); PG8_BAR; PG8_MMA(1, 0, At, B0); PG8_MMA(1, 1, At, B1); PG8_BAR; PG8_SCHED;
        }
        if (wr == 0) PG8_BAR;
        if constexpr (F8) asm volatile("s_nop 15\n\ts_nop 15" ::: "memory");
        { int l3_ = lane_id_fresh(); asm volatile("" : "+v"(l3_)); E(acc, cur, wr, wc, l3_ & 15, l3_ >> 4); }
        if (!has_next) break;
#pragma unroll
        for (int a = 0; a < 2; ++a)
#pragma unroll
            for (int b = 0; b < 2; ++b)
#pragma unroll
                for (int m = 0; m < 4; ++m)
#pragma unroll
                    for (int n = 0; n < 2; ++n) acc[a][b][m][n] = AccT{};
        cur = nxt; cA = nA; cB = nB; ++ui;
        if (wr == 1) PG8_BAR;
    }
    PG8_WAIT_V(0);
    PG8_BAR;
#undef PG8_SA
#undef PG8_SB
#undef PG8_STAGE
#undef PG8_LDA
#undef PG8_LDB
#undef PG8_MMA
#undef PG8_CAT
#undef PG8_LO
#undef PG8_LO4
#undef PG8_HI4
#undef PG8_HI
#undef PG8_WAIT_V
#undef PG8_WAIT_L
#undef PG8_BAR
#undef PG8_SCHED
}

template <bool SC, size_t RSOFF = 0, size_t CSOFF = 0> struct EpiStoreT {
    bf16* O; int ldc; int sig_lo, sig_hi; float scale; const unsigned char* wsb;
    template <class AccT> __device__ __forceinline__ void operator()(const AccT (&acc)[2][2][4][2], const Unit& u, int wr, int wc, int fr, int fq) const {
        const bool sig = (u.pn >= sig_lo && u.pn < sig_hi);
        const int row0 = u.pm * BM + wr * 64 + fr, col0 = u.pn * BM + wc * 32 + 8 * fq;
        const float* rs = (const float*)(wsb + RSOFF); const float* cs = (const float*)(wsb + CSOFF);
        const float tsc = (u.pn < 8) ? scale : 1.f;
        f32x4 cv[2][2];
#pragma unroll
        for (int bj = 0; bj < 2; ++bj) { if constexpr (SC) { cv[bj][0] = *(const f32x4*)(cs + col0 + bj * HALF) * tsc; cv[bj][1] = *(const f32x4*)(cs + col0 + bj * HALF + 4) * tsc; } else { cv[bj][0] = (f32x4){tsc, tsc, tsc, tsc}; cv[bj][1] = cv[bj][0]; } }
#pragma unroll
        for (int ai = 0; ai < 2; ++ai)
#pragma unroll
            for (int m = 0; m < 4; ++m) { bf16* rowp = O + (size_t)(row0 + ai * HALF + m * 16) * ldc + col0; float rsv = 1.f; if constexpr (SC) rsv = rs[row0 + ai * HALF + m * 16];
#pragma unroll
                for (int bj = 0; bj < 2; ++bj) { f32x4 v0 = tof(acc[ai][bj][m][0]) * (cv[bj][0] * rsv), v1 = tof(acc[ai][bj][m][1]) * (cv[bj][1] * rsv);
                    if (sig) {
#pragma unroll
                        for (int j = 0; j < 4; ++j) { v0[j] = fast_sigmoid(v0[j]); v1[j] = fast_sigmoid(v1[j]); } }
                    u32x4 w; w.x = cvt_pk_bf16(v0[0], v0[1]); w.y = cvt_pk_bf16(v0[2], v0[3]); w.z = cvt_pk_bf16(v1[0], v1[1]); w.w = cvt_pk_bf16(v1[2], v1[3]);
                    *(u32x4*)(rowp + bj * HALF) = w; }
                asm volatile("" ::: "memory"); }
    }
};
template <bool SC> struct EpiQT {
    bf16* O; int ldc; const unsigned char* wsb; int posmask;
    template <class AccT> __device__ __forceinline__ void operator()(const AccT (&acc)[2][2][4][2], const Unit& u, int wr, int wc, int fr, int fq) const {
        const bool rope = (u.pn >= 8);
        const int row0 = u.pm * BM + wr * 64 + fr, col0 = u.pn * BM + wc * 32 + 8 * fq;
        const float* cosT = (const float*)(wsb + WS_COS); const float* sinT = (const float*)(wsb + WS_SIN); const float* rs = (const float*)(wsb + WS_RSQL); const float* cs = (const float*)(wsb + WS_CSQ);
        f32x4 cv[2][2];
#pragma unroll
        for (int bj = 0; bj < 2; ++bj) { if constexpr (SC) { cv[bj][0] = *(const f32x4*)(cs + col0 + bj * HALF); cv[bj][1] = *(const f32x4*)(cs + col0 + bj * HALF + 4); } else { cv[bj][0] = (f32x4){1.f, 1.f, 1.f, 1.f}; cv[bj][1] = cv[bj][0]; } }
#pragma unroll
        for (int ai = 0; ai < 2; ++ai)
#pragma unroll
            for (int m = 0; m < 4; ++m) { const int row = row0 + ai * HALF + m * 16; bf16* rowp = O + (size_t)row * ldc + col0; const int pos = row & posmask; float rsv = 1.f; if constexpr (SC) rsv = rs[row];
#pragma unroll
                for (int bj = 0; bj < 2; ++bj) { f32x4 v0 = tof(acc[ai][bj][m][0]) * (cv[bj][0] * rsv), v1 = tof(acc[ai][bj][m][1]) * (cv[bj][1] * rsv);
                    if (rope) { const int i0 = (((col0 + bj * HALF) & 63) >> 1);
                        const f32x4 c = *(const f32x4*)(cosT + (size_t)pos * 32 + i0), s = *(const f32x4*)(sinT + (size_t)pos * 32 + i0);
                        f32x4 a, b;
                        a[0] = v0[0] * c[0] - v0[1] * s[0]; a[1] = v0[0] * s[0] + v0[1] * c[0]; a[2] = v0[2] * c[1] - v0[3] * s[1]; a[3] = v0[2] * s[1] + v0[3] * c[1];
                        b[0] = v1[0] * c[2] - v1[1] * s[2]; b[1] = v1[0] * s[2] + v1[1] * c[2]; b[2] = v1[2] * c[3] - v1[3] * s[3]; b[3] = v1[2] * s[3] + v1[3] * c[3];
                        v0 = a; v1 = b; }
                    u32x4 w; w.x = cvt_pk_bf16(v0[0], v0[1]); w.y = cvt_pk_bf16(v0[2], v0[3]); w.z = cvt_pk_bf16(v1[0], v1[1]); w.w = cvt_pk_bf16(v1[2], v1[3]);
                    *(u32x4*)(rowp + bj * HALF) = w; } }
    }
};
template <bool SC> struct EpiGateAT {
    bf16* part; int ldp; const bf16* gate; int ldg; const unsigned char* wsb;
    template <class AccT> __device__ __forceinline__ void operator()(const AccT (&acc)[2][2][4][2], const Unit& u, int wr, int wc, int fr, int fq) const {
        const int row0 = u.pm * BM + wr * 64 + fr, col0 = u.pn * BM + wc * 32 + 8 * fq;
        const float* rs = (const float*)(wsb + WS_RSA); const float* cs = (const float*)(wsb + WS_CSA);
        f32x4 cv[2][2];
#pragma unroll
        for (int bj = 0; bj < 2; ++bj) { if constexpr (SC) { cv[bj][0] = *(const f32x4*)(cs + col0 + bj * HALF); cv[bj][1] = *(const f32x4*)(cs + col0 + bj * HALF + 4); } else { cv[bj][0] = (f32x4){1.f, 1.f, 1.f, 1.f}; cv[bj][1] = cv[bj][0]; } }
#pragma unroll
        for (int ai = 0; ai < 2; ++ai) {
            u32x4 gw[4][2]; float rsv[4];
#pragma unroll
            for (int m = 0; m < 4; ++m) { const size_t row = (size_t)(row0 + ai * HALF + m * 16); rsv[m] = 1.f; if constexpr (SC) rsv[m] = rs[row];
#pragma unroll
                for (int bj = 0; bj < 2; ++bj) gw[m][bj] = *(const u32x4*)(gate + row * ldg + col0 + bj * HALF); }
#pragma unroll
            for (int m = 0; m < 4; ++m) { const size_t row = (size_t)(row0 + ai * HALF + m * 16);
#pragma unroll
                for (int bj = 0; bj < 2; ++bj) { const f32x4 v0 = tof(acc[ai][bj][m][0]) * (cv[bj][0] * rsv[m]), v1 = tof(acc[ai][bj][m][1]) * (cv[bj][1] * rsv[m]); const u32x4 g = gw[m][bj];
                    u32x4 w; w.x = cvt_pk_bf16(v0[0] * bf_lo(g.x), v0[1] * bf_hi(g.x)); w.y = cvt_pk_bf16(v0[2] * bf_lo(g.y), v0[3] * bf_hi(g.y)); w.z = cvt_pk_bf16(v1[0] * bf_lo(g.z), v1[1] * bf_hi(g.z)); w.w = cvt_pk_bf16(v1[2] * bf_lo(g.w), v1[3] * bf_hi(g.w));
                    *(u32x4*)(part + row * ldp + col0 + bj * HALF) = w; } }
            asm volatile("" ::: "memory");
        }
    }
};
template <bool SC> struct EpiGateBT {
    const bf16* part; int ldp; const bf16* gate; int ldg; bf16* O; int ldc; const unsigned char* wsb;
    template <class AccT> __device__ __forceinline__ void operator()(const AccT (&acc)[2][2][4][2], const Unit& u, int wr, int wc, int fr, int fq) const {
        const int row0 = u.pm * BM + wr * 64 + fr, col0 = u.pn * BM + wc * 32 + 8 * fq;
        const float* rs = (const float*)(wsb + WS_RSB); const float* cs = (const float*)(wsb + WS_CSB);
        f32x4 cv[2][2];
#pragma unroll
        for (int bj = 0; bj < 2; ++bj) { if constexpr (SC) { cv[bj][0] = *(const f32x4*)(cs + col0 + bj * HALF); cv[bj][1] = *(const f32x4*)(cs + col0 + bj * HALF + 4); } else { cv[bj][0] = (f32x4){1.f, 1.f, 1.f, 1.f}; cv[bj][1] = cv[bj][0]; } }
#pragma unroll
        for (int ai = 0; ai < 2; ++ai) {
            u32x4 gw[4][2], pw[4][2]; float rsv[4];
#pragma unroll
            for (int m = 0; m < 4; ++m) { const size_t row = (size_t)(row0 + ai * HALF + m * 16); rsv[m] = 1.f; if constexpr (SC) rsv[m] = rs[row];
#pragma unroll
                for (int bj = 0; bj < 2; ++bj) { gw[m][bj] = *(const u32x4*)(gate + row * ldg + col0 + bj * HALF); pw[m][bj] = *(const u32x4*)(part + row * ldp + col0 + bj * HALF); } }
#pragma unroll
            for (int m = 0; m < 4; ++m) { const size_t row = (size_t)(row0 + ai * HALF + m * 16);
#pragma unroll
                for (int bj = 0; bj < 2; ++bj) { const f32x4 v0 = tof(acc[ai][bj][m][0]) * (cv[bj][0] * rsv[m]), v1 = tof(acc[ai][bj][m][1]) * (cv[bj][1] * rsv[m]); const u32x4 g = gw[m][bj], p = pw[m][bj];
                    u32x4 w; w.x = cvt_pk_bf16(bf_lo(p.x) + v0[0] * bf_lo(g.x), bf_hi(p.x) + v0[1] * bf_hi(g.x)); w.y = cvt_pk_bf16(bf_lo(p.y) + v0[2] * bf_lo(g.y), bf_hi(p.y) + v0[3] * bf_hi(g.y));
                    w.z = cvt_pk_bf16(bf_lo(p.z) + v1[0] * bf_lo(g.z), bf_hi(p.z) + v1[1] * bf_hi(g.z)); w.w = cvt_pk_bf16(bf_lo(p.w) + v1[2] * bf_lo(g.w), bf_hi(p.w) + v1[3] * bf_hi(g.w));
                    *(u32x4*)(O + row * ldc + col0 + bj * HALF) = w; } }
            asm volatile("" ::: "memory");
        }
    }
};
template <bool SC, bool SRCB> struct EpiResT {
    const void* src; bf16* dst; int ld; float scale; const unsigned char* wsb;
    template <class AccT> __device__ __forceinline__ void operator()(const AccT (&acc)[2][2][4][2], const Unit& u, int wr, int wc, int fr, int fq) const {
        const int row0 = u.pm * BM + wr * 64 + fr, col0 = u.pn * BM + wc * 32 + 8 * fq;
        const float* rs = (const float*)(wsb + WS_RSM); const float* cs = (const float*)(wsb + WS_CSO);
        f32x4 cv[2][2];
#pragma unroll
        for (int bj = 0; bj < 2; ++bj) { if constexpr (SC) { cv[bj][0] = *(const f32x4*)(cs + col0 + bj * HALF); cv[bj][1] = *(const f32x4*)(cs + col0 + bj * HALF + 4); } else { cv[bj][0] = (f32x4){scale, scale, scale, scale}; cv[bj][1] = cv[bj][0]; } }
#pragma unroll
        for (int ai = 0; ai < 2; ++ai)
#pragma unroll
            for (int mh = 0; mh < 2; ++mh) {
                f32x4 sv[2][2][2]; float rsv[2];
#pragma unroll
                for (int mm = 0; mm < 2; ++mm) { const int m = 2 * mh + mm; const size_t off = (size_t)(row0 + ai * HALF + m * 16) * ld + col0; rsv[mm] = 1.f; if constexpr (SC) rsv[mm] = rs[row0 + ai * HALF + m * 16];
#pragma unroll
                    for (int bj = 0; bj < 2; ++bj) {
                        if constexpr (SRCB) { const u32x4 w = *(const u32x4*)((const bf16*)src + off + bj * HALF); sv[mm][bj][0] = (f32x4){bf_lo(w.x), bf_hi(w.x), bf_lo(w.y), bf_hi(w.y)}; sv[mm][bj][1] = (f32x4){bf_lo(w.z), bf_hi(w.z), bf_lo(w.w), bf_hi(w.w)}; }
                        else { const float* sp = (const float*)src + off + bj * HALF; sv[mm][bj][0] = *(const f32x4*)sp; sv[mm][bj][1] = *(const f32x4*)(sp + 4); } } }
#pragma unroll
                for (int mm = 0; mm < 2; ++mm) { const int m = 2 * mh + mm; const size_t off = (size_t)(row0 + ai * HALF + m * 16) * ld + col0;
#pragma unroll
                    for (int bj = 0; bj < 2; ++bj) { const f32x4 o0 = sv[mm][bj][0] + tof(acc[ai][bj][m][0]) * (cv[bj][0] * rsv[mm]), o1 = sv[mm][bj][1] + tof(acc[ai][bj][m][1]) * (cv[bj][1] * rsv[mm]);
                        u32x4 w; w.x = cvt_pk_bf16(o0[0], o0[1]); w.y = cvt_pk_bf16(o0[2], o0[3]); w.z = cvt_pk_bf16(o1[0], o1[1]); w.w = cvt_pk_bf16(o1[2], o1[3]); *(u32x4*)(dst + off + bj * HALF) = w; } }
                asm volatile("" ::: "memory");
            }
    }
};

__device__ __forceinline__ float dpp_from_prev_lane(float v) { return __builtin_bit_cast(float, __builtin_amdgcn_update_dpp(0, __builtin_bit_cast(int, v), 0x121, 0xF, 0xF, false)); }
__device__ __forceinline__ float dpp_from_next_lane(float v) { return __builtin_bit_cast(float, __builtin_amdgcn_update_dpp(0, __builtin_bit_cast(int, v), 0x12F, 0xF, 0xF, false)); }
struct EpiConv {
    unsigned char* act; bf16* yb; const float* cw; const float* cb; const unsigned char* wsb; float oscale;
    template <class AccT> __device__ __forceinline__ void operator()(const AccT (&acc)[2][2][4][2], const Unit& u, int wr, int wc, int fr, int fq) const {
        const float* rs = (const float*)(wsb + WS_RSH); const float* cs = (const float*)(wsb + WS_CSUP);
#pragma unroll
        for (int n = 0; n < 2; ++n) {
            const int ch0 = wc * 32 + 8 * fq + 4 * n, cg = u.pn * 128 + ch0, colg = u.pn * BM + ch0;
            const f32x4 csg = *(const f32x4*)(cs + colg), csu = *(const f32x4*)(cs + colg + HALF), bg = *(const f32x4*)(cb + cg), bu = *(const f32x4*)(cb + DFF + cg);
            f32x4 wg[3], wu[3];
#pragma unroll
            for (int t = 0; t < 3; ++t) { wg[t] = *(const f32x4*)(cw + t * NUP + cg); wu[t] = *(const f32x4*)(cw + t * NUP + DFF + cg); }
#pragma unroll
            for (int ai = 0; ai < 2; ++ai) {
                const int rowb = u.pm * BM + ai * HALF + wr * 64;
                f32x4 yg[4], yu[4];
#pragma unroll
                for (int m = 0; m < 4; ++m) { const float rsv = rs[rowb + 16 * m + fr]; yg[m] = tof(acc[ai][0][m][n]) * (csg * rsv); yu[m] = tof(acc[ai][1][m][n]) * (csu * rsv); }
                if (fr < 2 || fr >= 14) { const bool lo = fr < 2; bf16* yr = yb + ((size_t)(rowb >> 6) * 4 + (lo ? fr : fr - 12)) * NUP + colg;
                    const f32x4 a0 = lo ? yg[0] : yg[3], b0 = lo ? yu[0] : yu[3];
                    u32x2 w; w.x = cvt_pk_bf16(a0[0], a0[1]); w.y = cvt_pk_bf16(a0[2], a0[3]); *(u32x2*)yr = w;
                    w.x = cvt_pk_bf16(b0[0], b0[1]); w.y = cvt_pk_bf16(b0[2], b0[3]); *(u32x2*)(yr + HALF) = w; }
#pragma unroll
                for (int m = 0; m < 4; ++m) {
                    float o[4];
#pragma unroll
                    for (int e = 0; e < 4; ++e) {
                        const float gc = yg[m][e], uc = yu[m][e];
                        const float gsp = (m > 0 && fr == 15) ? yg[m > 0 ? m - 1 : 0][e] : gc, usp = (m > 0 && fr == 15) ? yu[m > 0 ? m - 1 : 0][e] : uc;
                        const float gsn = (m < 3 && fr == 0) ? yg[m < 3 ? m + 1 : 3][e] : gc, usn = (m < 3 && fr == 0) ? yu[m < 3 ? m + 1 : 3][e] : uc;
                        const float gp = dpp_from_prev_lane(gsp), up = dpp_from_prev_lane(usp), gn = dpp_from_next_lane(gsn), un = dpp_from_next_lane(usn);
                        const float ug = wg[0][e] * gp + wg[1][e] * gc + wg[2][e] * gn + bg[e];
                        const float uu = wu[0][e] * up + wu[1][e] * uc + wu[2][e] * un + bu[e];
                        o[e] = ug * fast_sigmoid(ug) * uu * oscale; }
                    const bool edge = (m == 0 && fr == 0) || (m == 3 && fr == 15);
                    if (!edge) { const size_t row = (size_t)(rowb + 16 * m + fr);
                        if (FP8_DOWN) *(unsigned*)(act + row * DFF + cg) = pack4_fp8(o[0], o[1], o[2], o[3]);
                        else { u32x2 w; w.x = cvt_pk_bf16(o[0], o[1]); w.y = cvt_pk_bf16(o[2], o[3]); *(u32x2*)((bf16*)act + row * DFF + cg) = w; } }
                }
                asm volatile("" ::: "memory");
            }
        }
    }
};
}

namespace att {
constexpr int OFF_V = 0, SHM_V = 16384, OFF_K = 32768, KROW = 144  , SHM_KP = 64 * KROW, OFF_WS = 32768 + 2 * 3 * SHM_KP, OFF_TBL = OFF_WS + 2048, OFF_QR = OFF_TBL + 1056, LDS_END = OFF_QR + 256 * KROW;
#define SBAR() __builtin_amdgcn_sched_barrier(0)
__device__ __forceinline__ int crow(int r, int hi) { return (r & 3) + 8 * (r >> 2) + 4 * hi; }
__device__ __forceinline__ int kswz(int row, int colB) { return row * KROW + colB; }
__device__ __forceinline__ int v_st(int k, int c) { const int kk = (k & ~0xC) | ((k & 4) << 1) | ((k & 8) >> 1); return ((kk >> 3) * 4 + (c >> 5)) * 512 + ((kk & 7) * 32 + (c & 31)) * 2; }
__device__ __forceinline__ int v_rd_base(int lane) { return ((lane & 3) << 3) | (((lane >> 2) & 3) << 6) | (((lane >> 4) & 1) << 5) | (((lane >> 5) & 1) << 8); }
constexpr int v_rd_off(int d0, int ks, int half) { return d0 * 512 + ks * 4096 + half * 2048; }
template <int OFF> __device__ __forceinline__ s16x4 tr_read(int vb) { s16x4 r; asm volatile("ds_read_b64_tr_b16 %0, %1 offset:%2" : "=&v"(r) : "v"(vb), "i"(OFF) : "memory"); return r; }
template <int D0> __device__ __forceinline__ void pv_one(f32x16& od, int vb, bf16x8 pa0, bf16x8 pa1, bf16x8 pa2, bf16x8 pa3) {
    const s16x4 l0 = tr_read<v_rd_off(D0, 0, 0)>(vb), h0 = tr_read<v_rd_off(D0, 0, 1)>(vb), l1 = tr_read<v_rd_off(D0, 1, 0)>(vb), h1 = tr_read<v_rd_off(D0, 1, 1)>(vb);
    const s16x4 l2 = tr_read<v_rd_off(D0, 2, 0)>(vb), h2 = tr_read<v_rd_off(D0, 2, 1)>(vb), l3 = tr_read<v_rd_off(D0, 3, 0)>(vb), h3 = tr_read<v_rd_off(D0, 3, 1)>(vb);
    asm volatile("s_waitcnt lgkmcnt(0)" ::: "memory"); SBAR();
#define PK(L, H) (bf16x8){L[0], L[1], L[2], L[3], H[0], H[1], H[2], H[3]}
    od = __builtin_amdgcn_mfma_f32_32x32x16_bf16(pa0, PK(l0, h0), od, 0, 0, 0);
    od = __builtin_amdgcn_mfma_f32_32x32x16_bf16(pa1, PK(l1, h1), od, 0, 0, 0);
    od = __builtin_amdgcn_mfma_f32_32x32x16_bf16(pa2, PK(l2, h2), od, 0, 0, 0);
    od = __builtin_amdgcn_mfma_f32_32x32x16_bf16(pa3, PK(l3, h3), od, 0, 0, 0);
#undef PK
}
__device__ __forceinline__ void pv_d0(f32x16* o, int vb, bf16x8 pa0, bf16x8 pa1, bf16x8 pa2, bf16x8 pa3) {
    pv_one<0>(o[0], vb, pa0, pa1, pa2, pa3); pv_one<1>(o[1], vb, pa0, pa1, pa2, pa3); pv_one<2>(o[2], vb, pa0, pa1, pa2, pa3); pv_one<3>(o[3], vb, pa0, pa1, pa2, pa3);
}
__device__ __forceinline__ float fma_s(float a, float s_uniform, float c) { float d; asm("v_fma_f32 %0, %1, %2, %3" : "=v"(d) : "v"(a), "s"(s_uniform), "v"(c)); return d; }
constexpr float THR2 = 8.0f * 1.4426950408889634f;
template <bool BIAS>
__device__ __forceinline__ void partialSM(f32x16& p0, f32x16& p1, float& m_reg, float& mn, float& alpha, float Cs, bool near, float bconst, int relbase, int hi, const LAS float* tbl) {
    float pmax;
    if (BIAS && near) {
#pragma unroll
        for (int r = 0; r < 16; ++r) { const int k = relbase + crow(r, hi);
            const int i0 = min(max(k, 0), 256), i1 = min(max(k + 32, 0), 256);
            p0[r] = fma_s(p0[r], Cs, tbl[i0]); p1[r] = fma_s(p1[r], Cs, tbl[i1]); }
        pmax = p0[0];
#pragma unroll
        for (int r = 1; r < 16; ++r) pmax = fmaxf(pmax, p0[r]);
#pragma unroll
        for (int r = 0; r < 16; ++r) pmax = fmaxf(pmax, p1[r]);
        { auto rr = __builtin_amdgcn_permlane32_swap(__float_as_uint(pmax), __float_as_uint(pmax), false, false); pmax = fmaxf(__uint_as_float(rr[0]), __uint_as_float(rr[1])); }
        if (__builtin_expect(__all(pmax - m_reg <= THR2), 1)) { mn = m_reg; alpha = 1.f; }
        else { mn = fmaxf(m_reg, pmax); alpha = __builtin_amdgcn_exp2f(m_reg - mn); m_reg = mn; }
#pragma unroll
        for (int r = 0; r < 16; ++r) { p0[r] = p0[r] - mn; p1[r] = p1[r] - mn; }
    } else {
        pmax = p0[0];
#pragma unroll
        for (int r = 1; r < 16; ++r) pmax = fmaxf(pmax, p0[r]);
#pragma unroll
        for (int r = 0; r < 16; ++r) pmax = fmaxf(pmax, p1[r]);
        { auto rr = __builtin_amdgcn_permlane32_swap(__float_as_uint(pmax), __float_as_uint(pmax), false, false); pmax = fmaxf(__uint_as_float(rr[0]), __uint_as_float(rr[1])); }
        pmax = fmaf(pmax, Cs, bconst);
        if (__builtin_expect(__all(pmax - m_reg <= THR2), 1)) { mn = m_reg; alpha = 1.f; }
        else { mn = fmaxf(m_reg, pmax); alpha = __builtin_amdgcn_exp2f(m_reg - mn); m_reg = mn; }
        const float off = bconst - mn;
#pragma unroll
        for (int r = 0; r < 16; ++r) { p0[r] = fma_s(p0[r], Cs, off); p1[r] = fma_s(p1[r], Cs, off); }
    }
#pragma unroll
    for (int r = 0; r < 16; ++r) p0[r] = __builtin_amdgcn_exp2f(p0[r]);
}
__device__ __forceinline__ void partialSM_ci(f32x16& p0, f32x16& p1, float& m_reg, float& alpha, f32x16& csp, bool first, bool near, float bcur, int relbase, int hi, const LAS float* tbl) {
    if (near) {
#pragma unroll
        for (int r = 0; r < 16; ++r) { const int k = relbase + crow(r, hi); const int i0 = min(max(k, 0), 256), i1 = min(max(k + 32, 0), 256);
            p0[r] += tbl[i0] - bcur; p1[r] += tbl[i1] - bcur; }
    }
    float pmax = p0[0];
#pragma unroll
    for (int r = 1; r < 16; ++r) pmax = fmaxf(pmax, p0[r]);
#pragma unroll
    for (int r = 0; r < 16; ++r) pmax = fmaxf(pmax, p1[r]);
    { auto rr = __builtin_amdgcn_permlane32_swap(__float_as_uint(pmax), __float_as_uint(pmax), false, false); pmax = fmaxf(__uint_as_float(rr[0]), __uint_as_float(rr[1])); }
    if (__builtin_expect(!first && __all(pmax <= THR2), 1)) { alpha = 1.f; }
    else { const float d = first ? pmax : fmaxf(pmax, 0.f); alpha = __builtin_amdgcn_exp2f(-d); m_reg += d;
#pragma unroll
        for (int r = 0; r < 16; ++r) { p0[r] -= d; p1[r] -= d; csp[r] -= d; } }
#pragma unroll
    for (int r = 0; r < 16; ++r) p0[r] = __builtin_amdgcn_exp2f(p0[r]);
}
__device__ __forceinline__ void finishSM(f32x16& p0, f32x16& p1, float alpha, float& l_reg, bf16x8& pa0, bf16x8& pa1, bf16x8& pa2, bf16x8& pa3) {
#pragma unroll
    for (int r = 0; r < 16; ++r) p1[r] = __builtin_amdgcn_exp2f(p1[r]);
    float ps = 0;
#pragma unroll
    for (int r = 0; r < 16; ++r) ps += p0[r];
#pragma unroll
    for (int r = 0; r < 16; ++r) ps += p1[r];
    { auto rr = __builtin_amdgcn_permlane32_swap(__float_as_uint(ps), __float_as_uint(ps), false, false); ps = __uint_as_float(rr[0]) + __uint_as_float(rr[1]); }
    l_reg = l_reg * alpha + ps;
#define PK4(P, BASE, OUT) do { unsigned a0 = cvt_pk_bf16(P[BASE + 0], P[BASE + 1]), a1 = cvt_pk_bf16(P[BASE + 2], P[BASE + 3]);   \
    unsigned b0 = cvt_pk_bf16(P[BASE + 4], P[BASE + 5]), b1 = cvt_pk_bf16(P[BASE + 6], P[BASE + 7]);                              \
    auto r0 = __builtin_amdgcn_permlane32_swap(a0, b0, false, false); auto r1 = __builtin_amdgcn_permlane32_swap(a1, b1, false, false); \
    u32x4 w = {r0[0], r1[0], r0[1], r1[1]}; OUT = *reinterpret_cast<bf16x8*>(&w); } while (0)
    PK4(p0, 0, pa0); PK4(p0, 8, pa1); PK4(p1, 0, pa2); PK4(p1, 8, pa3);
#undef PK4
}
template <int NP>
__device__ __forceinline__ void qkt(f32x16& p0, f32x16& p1, const LAS char* Ks, const bf16x8* qr, const LAS char* qrl, int r32, int hi, const f32x16& cinit) {
    p0 = cinit; p1 = cinit;
#pragma unroll
    for (int p = 0; p < NP; ++p)
#pragma unroll
        for (int d0 = 0; d0 < 4; ++d0) { const int cb = d0 * 32 + hi * 16;
            bf16x8 b0 = *(const LAS bf16x8*)(Ks + p * SHM_KP + kswz(r32, cb));
            bf16x8 b1 = *(const LAS bf16x8*)(Ks + p * SHM_KP + kswz(32 + r32, cb));
            const bf16x8 qf = (NP == 3 && p == 2) ? *(const LAS bf16x8*)(qrl + d0 * 32) : qr[p * 4 + d0];
            p0 = __builtin_amdgcn_mfma_f32_32x32x16_bf16(b0, qf, p0, 0, 0, 0);
            p1 = __builtin_amdgcn_mfma_f32_32x32x16_bf16(b1, qf, p1, 0, 0, 0); }
}
struct Ptrs { const bf16* q[3]; const bf16* k[3]; const bf16* v; };
struct StrDiff { static constexpr int LDQ = NIN, LDK = NIN, LDK2 = NIN, LDV = NIN; };
struct StrMla { static constexpr int LDQ = NQ, LDK = NKV, LDK2 = NIN, LDV = NKV; };
template <int NP, bool BIAS, int SDEPTH, class STR>
__device__ __forceinline__ void attn_body(const Ptrs& P, int seq, int qpos0, float Cs, LAS char* lds, f32x16 (&o)[4], int tid_in) {
    int tid = tid_in; asm volatile("" : "+v"(tid));
    const int wid = __builtin_amdgcn_readfirstlane(tid >> 6), lane = tid & 63, r32 = lane & 31, hi = lane >> 5;
    LAS char* V_lds = lds + OFF_V; LAS char* K_lds = lds + OFF_K;
    LAS float* wsl = (LAS float*)(lds + OFF_WS) + wid * 64; LAS float* li_l = wsl; LAS float* al_l = wsl + 32;
    const LAS float* tbl = (const LAS float*)(lds + OFF_TBL);
    constexpr int KB = NP * SHM_KP;
    constexpr bool CI = BIAS && (ATT_CINIT != 0);
    float m_reg = CI ? 0.f : -1e30f, l_reg = 0;
#pragma unroll
    for (int d = 0; d < 4; ++d) o[d] = f32x16{};
    constexpr int NPR = (NP == 3) ? 2 : NP;
    bf16x8 qr[NPR * 4];
#pragma unroll
    for (int p = 0; p < NPR; ++p)
#pragma unroll
        for (int d0 = 0; d0 < 4; ++d0) qr[p * 4 + d0] = *reinterpret_cast<const bf16x8*>(P.q[p] + (long)(wid * 32 + r32) * STR::LDQ + hi * 8 + d0 * 16);
    LAS char* qrl = lds + OFF_QR + (wid * 32 + r32) * KROW + hi * 16;
    if constexpr (NP == 3) {
#pragma unroll
        for (int d0 = 0; d0 < 4; ++d0) *(LAS bf16x8*)(qrl + d0 * 32) = *reinterpret_cast<const bf16x8*>(P.q[2] + (long)(wid * 32 + r32) * STR::LDQ + hi * 8 + d0 * 16);
    }
    const int kr = tid >> 3, kc = tid & 7, kst = kswz(kr, kc * 16);
    const int sr = tid >> 4, sc = (tid & 15) * 8, vst0 = v_st(sr, sc), vst1 = v_st(32 + sr, sc);
    const int vb0 = (int)(uintptr_t)V_lds + v_rd_base(lane);
    const int qlo = qpos0 + wid * 32;
    const float bL = BIAS ? tbl[0] : 0.f, bR = BIAS ? tbl[256] : 0.f;
    f32x16 csp = f32x16{}; float bcur = bL;
    if constexpr (CI) {
#pragma unroll
        for (int r = 0; r < 16; ++r) csp[r] = bL; }
    struct { bf16x8 vs0, vs1, ks[NP]; } st_[SDEPTH];
#define SLOAD(i, k0) do { st_[i].vs0 = *reinterpret_cast<const bf16x8*>(P.v + (long)((k0) + sr) * STR::LDV + sc); st_[i].vs1 = *reinterpret_cast<const bf16x8*>(P.v + (long)((k0) + 32 + sr) * STR::LDV + sc); \
    _Pragma("unroll") for (int p_ = 0; p_ < NP; ++p_) st_[i].ks[p_] = *reinterpret_cast<const bf16x8*>(P.k[p_] + (long)((k0) + kr) * (p_ == 2 ? STR::LDK2 : STR::LDK) + kc * 8); } while (0)
#define SWRITE(b, i) do { *(LAS bf16x8*)(V_lds + (b) * SHM_V + vst0) = st_[i].vs0; *(LAS bf16x8*)(V_lds + (b) * SHM_V + vst1) = st_[i].vs1; \
    _Pragma("unroll") for (int p_ = 0; p_ < NP; ++p_) *(LAS bf16x8*)(K_lds + (b) * KB + p_ * SHM_KP + kst) = st_[i].ks[p_]; } while (0)
#define SWAIT() do { if constexpr (SDEPTH == 2) { if constexpr (NP == 1) asm volatile("s_waitcnt vmcnt(3)" ::: "memory"); else asm volatile("s_waitcnt vmcnt(5)" ::: "memory"); } else asm volatile("s_waitcnt vmcnt(0)" ::: "memory"); } while (0)
#define RESC(a) do { if (__any((a) < 1.f)) { if (hi == 0) al_l[r32] = (a); asm volatile("s_waitcnt lgkmcnt(0)" ::: "memory"); \
    _Pragma("unroll") for (int d = 0; d < 4; ++d) _Pragma("unroll") for (int r = 0; r < 16; ++r) o[d][r] *= al_l[crow(r, hi)]; } } while (0)
#define TILEB(j, nearv, bcv, rbv) const int _rh##j = (j) * 64 + 63 - qlo, _rl##j = (j) * 64 - (qlo + 31); \
    const bool nearv = BIAS && (_rh##j > -128) && (_rl##j < 128); const float bcv = (_rh##j <= -128) ? bL : bR; const int rbv = (j) * 64 - (qlo + r32) + 128
#define CLS(nearv, bcv) do { if constexpr (CI) { if (!(nearv) && (bcv) != bcur) { const float _dl = (bcv) - bcur; _Pragma("unroll") for (int r = 0; r < 16; ++r) csp[r] += _dl; bcur = (bcv); } } } while (0)
#define PSM(P0, P1, MN, AL, first, nearv, bcv, rbv) do { if constexpr (CI) { partialSM_ci(P0, P1, m_reg, AL, csp, first, nearv, bcur, rbv, hi, tbl); MN = 0.f; } \
        else partialSM<BIAS>(P0, P1, m_reg, MN, AL, Cs, nearv, bcv, rbv, hi, tbl); } while (0)
    f32x16 pA0, pA1, pB0, pB1; float mnA, mnB, alA, alB; bf16x8 pa0, pa1, pa2, pa3; const int NT = seq / 64;
    constexpr int SE = 0, SO = SDEPTH - 1;
    SLOAD(SE, 0); asm volatile("s_waitcnt vmcnt(0)" ::: "memory"); SWRITE(0, SE); __syncthreads();
    { const int jj = 0; TILEB(jj, nr, bc, rb); CLS(nr, bc); qkt<NP>(pA0, pA1, K_lds, qr, qrl, r32, hi, csp); PSM(pA0, pA1, mnA, alA, true, nr, bc, rb); }
    SLOAD(SO, 64); if constexpr (SDEPTH == 2) { if (2 < NT) SLOAD(SE, 128); }
    SWAIT(); SWRITE(1, SO); __syncthreads();
    for (int j = 1; j + 1 < NT; j += 2) {
        TILEB(j, nrB, bcB, rbB); CLS(nrB, bcB);
        SBAR(); qkt<NP>(pB0, pB1, K_lds + KB, qr, qrl, r32, hi, csp);
        finishSM(pA0, pA1, alA, l_reg, pa0, pa1, pa2, pa3); SBAR();
        SLOAD(SO, (j + SDEPTH) * 64); SBAR();
        pv_d0(o, vb0, pa0, pa1, pa2, pa3);
        PSM(pB0, pB1, mnB, alB, false, nrB, bcB, rbB);
        __syncthreads(); SWAIT(); SWRITE(0, SE);
        RESC(alB); __syncthreads();
        const int j1 = j + 1; TILEB(j1, nrA, bcA, rbA); CLS(nrA, bcA);
        SBAR(); qkt<NP>(pA0, pA1, K_lds, qr, qrl, r32, hi, csp);
        finishSM(pB0, pB1, alB, l_reg, pa0, pa1, pa2, pa3); SBAR();
        if (SDEPTH == 1 || j + 3 < NT) SLOAD(SE, (j + 1 + SDEPTH) * 64); SBAR();
        pv_d0(o, vb0 + SHM_V, pa0, pa1, pa2, pa3);
        PSM(pA0, pA1, mnA, alA, false, nrA, bcA, rbA);
        __syncthreads(); SWAIT(); SWRITE(1, SO);
        RESC(alA); __syncthreads();
    }
    const int jl = NT - 1; TILEB(jl, nrL, bcL, rbL); CLS(nrL, bcL);
    SBAR(); qkt<NP>(pB0, pB1, K_lds + KB, qr, qrl, r32, hi, csp);
    finishSM(pA0, pA1, alA, l_reg, pa0, pa1, pa2, pa3); SBAR();
    pv_d0(o, vb0, pa0, pa1, pa2, pa3);
    PSM(pB0, pB1, mnB, alB, false, nrL, bcL, rbL);
    __syncthreads(); RESC(alB);
    finishSM(pB0, pB1, alB, l_reg, pa0, pa1, pa2, pa3); SBAR();
    pv_d0(o, vb0 + SHM_V, pa0, pa1, pa2, pa3);
    if (hi == 0) li_l[r32] = l_reg; asm volatile("s_waitcnt lgkmcnt(0)" ::: "memory");
#pragma unroll
    for (int r = 0; r < 16; ++r) { const float rl = __builtin_amdgcn_rcpf(li_l[crow(r, hi)]);
#pragma unroll
        for (int d = 0; d < 4; ++d) o[d][r] *= rl; }
    __syncthreads();
#undef SLOAD
#undef SWRITE
#undef SWAIT
#undef RESC
#undef TILEB
#undef CLS
#undef PSM
}
}

constexpr int NWAVES = 8;
constexpr int CW_BAR = 4096;
constexpr int RING_BYTES = 131072, MISC_OFF = RING_BYTES + 320, LDS_BYTES = 147456;
static_assert(att::LDS_END <= RING_BYTES, "attention LDS");

#define XB_TMO      128
#define XB_XCNT(j)  (256  + 64 * (j))
#define XB_XSUB(j)  (1280 + 64 * (j))
#define XB_XGEN(j)  (2304 + 64 * (j))
#define XB_TOP      3328
#define XB_TOPGEN   3392
#define XCD_BAR_WORDS 3456
#define XB_SPIN_CAP (1u << 21)
__device__ __forceinline__ unsigned xb_ld(unsigned* p)              { return __hip_atomic_load(p, __ATOMIC_RELAXED, __HIP_MEMORY_SCOPE_AGENT); }
__device__ __forceinline__ unsigned xb_add(unsigned* p, unsigned v) { return __hip_atomic_fetch_add(p, v, __ATOMIC_RELAXED, __HIP_MEMORY_SCOPE_AGENT); }
__device__ __forceinline__ unsigned xb_xcc_id() { return (unsigned)__builtin_amdgcn_s_getreg((3 << 11) | 20) & 0xFu; }
#define XB_SPIN(cond, bar) do { unsigned _sp = 0; while (cond) { __builtin_amdgcn_s_sleep(1); \
    if ((++_sp & 255u) == 0u) { if (xb_ld(&(bar)[XB_TMO])) break; if (_sp > XB_SPIN_CAP) { atomicAdd(&(bar)[XB_TMO], 1u); break; } } } } while (0)
struct XcdBarrier { unsigned* bar; unsigned x; volatile LAS unsigned* st; };
__device__ __forceinline__ XcdBarrier xcd_barrier_post(unsigned* bar, volatile LAS unsigned* st, bool leader) {
    XcdBarrier b; b.bar = bar; b.x = xb_xcc_id(); b.st = st;
    if (leader) (void)xb_add(&bar[XB_XCNT(b.x)], 1u);
    return b;
}
__device__ __forceinline__ void xcd_barrier_complete(unsigned* bar, unsigned x, unsigned& nloc, unsigned& nx) {
    const unsigned G = gridDim.x * gridDim.y * gridDim.z;
    unsigned sum, cnt, mine, sp = 0u;
    for (;;) {
        sum = 0u; cnt = 0u; mine = 0u;
#pragma unroll
        for (unsigned j = 0; j < 16; ++j) { const unsigned c = xb_ld(&bar[XB_XCNT(j)]); sum += c; cnt += (c > 0u) ? 1u : 0u; mine = (j == x) ? c : mine; }
        if (sum == G) break;
        __builtin_amdgcn_s_sleep(1);
        if ((++sp & 255u) == 0u) { if (xb_ld(&bar[XB_TMO])) break; if (sp > XB_SPIN_CAP) { atomicAdd(&bar[XB_TMO], 1u); break; } }
    }
    nloc = mine > 0u ? mine : 1u; nx = cnt > 0u ? cnt : 1u;
}
__device__ __forceinline__ void xcd_barrier(const XcdBarrier& b, bool leader) {
    asm volatile("s_waitcnt vmcnt(0)" ::: "memory");
    __syncthreads();
    if (leader) {
        unsigned* bar = b.bar;
        __builtin_amdgcn_s_waitcnt(0);
        unsigned nloc = b.st[0], nx = b.st[1];
        if (nloc == 0u) { xcd_barrier_complete(bar, b.x, nloc, nx); b.st[0] = nloc; b.st[1] = nx; }
        const unsigned old = xb_add(&bar[XB_XSUB(b.x)], 1u);
        const unsigned gen = old / nloc;
        if (old + 1u == (gen + 1u) * nloc) {
            __builtin_amdgcn_fence(__ATOMIC_RELEASE, "agent");
            asm volatile("s_waitcnt vmcnt(0)" ::: "memory");
            const unsigned og = xb_add(&bar[XB_TOP], 1u);
            const unsigned tg = og / nx;
            if (og + 1u == (tg + 1u) * nx) xb_add(&bar[XB_TOPGEN], 1u);
            else XB_SPIN(xb_ld(&bar[XB_TOPGEN]) == tg, bar);
            __builtin_amdgcn_fence(__ATOMIC_ACQUIRE, "agent");
            xb_add(&bar[XB_XGEN(b.x)], 1u);
            asm volatile("s_waitcnt vmcnt(0)" ::: "memory");
        } else {
            XB_SPIN(xb_ld(&bar[XB_XGEN(b.x)]) == gen, bar);
            __builtin_amdgcn_fence(__ATOMIC_ACQUIRE, "agent");
            asm volatile("s_waitcnt vmcnt(0)" ::: "memory");
        }
    }
    __syncthreads();
}

#define LDS_WAIT() asm volatile("s_waitcnt lgkmcnt(0)" ::: "memory")
template <int X> __device__ __forceinline__ float swz_xor(float v) { return __int_as_float(__builtin_amdgcn_ds_swizzle(__float_as_int(v), (X << 10) | 0x1f)); }
__device__ __forceinline__ float half_sum(float v) { v += swz_xor<1>(v); v += swz_xor<2>(v); v += swz_xor<4>(v); v += swz_xor<8>(v); v += swz_xor<16>(v); return v; }
__device__ __forceinline__ float wave_max(float v) {
    v = __builtin_fmaxf(v, swz_xor<1>(v)); v = __builtin_fmaxf(v, swz_xor<2>(v)); v = __builtin_fmaxf(v, swz_xor<4>(v)); v = __builtin_fmaxf(v, swz_xor<8>(v)); v = __builtin_fmaxf(v, swz_xor<16>(v));
    auto rr = __builtin_amdgcn_permlane32_swap(__float_as_uint(v), __float_as_uint(v), false, false);
    return __builtin_fmaxf(__uint_as_float(rr[0]), __uint_as_float(rr[1]));
}
__device__ __forceinline__ float wave_sum(float v) {
    v = half_sum(v);
    auto rr = __builtin_amdgcn_permlane32_swap(__float_as_uint(v), __float_as_uint(v), false, false);
    return __uint_as_float(rr[0]) + __uint_as_float(rr[1]);
}

template <class SrcFn>
__device__ __forceinline__ void transpose_item(const float* W, int K, int N, bf16* WT, int nblk, LAS float* scr, int item, int lane, SrcFn src) {
    const int kb = item / nblk, nb = item % nblk, k0 = 64 * kb, n0 = 32 * nb;
    const int scol = src(n0 + (lane & 31));
#pragma unroll 8
    for (int i = 0; i < 32; ++i) { const int kk = 2 * i + (lane >> 5); scr[kk * 33 + (lane & 31)] = scol >= 0 ? W[(size_t)(k0 + kk) * N + scol] : 0.f; }
    LDS_WAIT(); asm volatile("" ::: "memory");
    const int c = lane & 7;
#pragma unroll
    for (int j = 0; j < 4; ++j) { const int n = (lane >> 3) + 8 * j; const LAS float* s = scr + (8 * c) * 33 + n;
        u32x4 o; o.x = cvt_pk_bf16(s[0 * 33], s[1 * 33]); o.y = cvt_pk_bf16(s[2 * 33], s[3 * 33]); o.z = cvt_pk_bf16(s[4 * 33], s[5 * 33]); o.w = cvt_pk_bf16(s[6 * 33], s[7 * 33]);
        *(u32x4*)(WT + (size_t)(n0 + n) * K + k0 + 8 * c) = o; }
    LDS_WAIT(); asm volatile("" ::: "memory");
}
__device__ __forceinline__ void transpose_item_f8(const float* W, int K, int N, unsigned char* WT8, int nblk, LAS float* scr, int item, int lane, float scale) {
    const int kb = item / nblk, nb = item % nblk, k0 = 64 * kb, n0 = 32 * nb;
#pragma unroll 8
    for (int i = 0; i < 32; ++i) { const int kk = 2 * i + (lane >> 5); scr[kk * 33 + (lane & 31)] = W[(size_t)(k0 + kk) * N + n0 + (lane & 31)] * scale; }
    LDS_WAIT(); asm volatile("" ::: "memory");
    const int c = lane & 3;
#pragma unroll
    for (int j = 0; j < 2; ++j) { const int n = (lane >> 2) + 16 * j; const LAS float* s = scr + (16 * c) * 33 + n;
        u32x4 o; o.x = pack4_fp8(s[0 * 33], s[1 * 33], s[2 * 33], s[3 * 33]); o.y = pack4_fp8(s[4 * 33], s[5 * 33], s[6 * 33], s[7 * 33]);
        o.z = pack4_fp8(s[8 * 33], s[9 * 33], s[10 * 33], s[11 * 33]); o.w = pack4_fp8(s[12 * 33], s[13 * 33], s[14 * 33], s[15 * 33]);
        *(u32x4*)(WT8 + (size_t)(n0 + n) * K + k0 + 16 * c) = o; }
    LDS_WAIT(); asm volatile("" ::: "memory");
}
template <class SrcFn>
__device__ __forceinline__ void transpose_item_i8(const float* W, int K, int N, unsigned char* WT8, int nblk, LAS float* scr, int item, int lane, const unsigned* cmax, float* cs, SrcFn src) {
    const int kb = item / nblk, nb = item % nblk, k0 = 64 * kb, n0 = 32 * nb;
    const int scol = src(n0 + (lane & 31));
    const float cm = scol >= 0 ? __uint_as_float(cmax[scol]) : 0.f, inv = cm > 0.f ? 127.f / cm : 0.f;
    if (kb == 0 && lane < 32) cs[n0 + lane] = cm * (1.f / 127.f);
#pragma unroll 8
    for (int i = 0; i < 32; ++i) { const int kk = 2 * i + (lane >> 5); scr[kk * 33 + (lane & 31)] = scol >= 0 ? W[(size_t)(k0 + kk) * N + scol] * inv : 0.f; }
    LDS_WAIT(); asm volatile("" ::: "memory");
    const int c = lane & 3;
#pragma unroll
    for (int j = 0; j < 2; ++j) { const int n = (lane >> 2) + 16 * j; const LAS float* s = scr + (16 * c) * 33 + n;
        u32x4 o; o.x = pack4_i8(s[0 * 33], s[1 * 33], s[2 * 33], s[3 * 33]); o.y = pack4_i8(s[4 * 33], s[5 * 33], s[6 * 33], s[7 * 33]);
        o.z = pack4_i8(s[8 * 33], s[9 * 33], s[10 * 33], s[11 * 33]); o.w = pack4_i8(s[12 * 33], s[13 * 33], s[14 * 33], s[15 * 33]);
        *(u32x4*)(WT8 + (size_t)(n0 + n) * K + k0 + 16 * c) = o; }
    LDS_WAIT(); asm volatile("" ::: "memory");
}
__device__ __forceinline__ void absmax_item(const float* W, int N, unsigned* cmax, int item, int lane) {
    const int ncb = N / 64, kb = item / ncb, cb = item % ncb; const float* p = W + (size_t)(kb * 64) * N + cb * 64 + lane; float mx = 0.f;
#pragma unroll 16
    for (int i = 0; i < 64; ++i) mx = __builtin_fmaxf(mx, __builtin_fabsf(p[(size_t)i * N]));
    atomicMax(cmax + cb * 64 + lane, __float_as_uint(mx));
}
constexpr int NWAVES_ = 8;
template <int MODE, class SrcFn>
__device__ __forceinline__ void convert_strip(const float* W, int K, int N, unsigned char* WT, float* cs, int n0, float fscale, LAS float* lmax, int wave, int lane, SrcFn src) {
    const int rg = lane >> 3, cq = lane & 7, nchunk = K >> 7;
    int sc[4];
#pragma unroll
    for (int j = 0; j < 4; ++j) sc[j] = src(n0 + 4 * cq + j);
    const bool contig = __all(sc[0] >= 0 && (sc[0] & 3) == 0 && sc[1] == sc[0] + 1 && sc[2] == sc[0] + 2 && sc[3] == sc[0] + 3);
    auto ldrow = [&](int row) -> f32x4 {
        if (contig) return *(const f32x4*)(W + (size_t)row * N + sc[0]);
        f32x4 v;
#pragma unroll
        for (int j = 0; j < 4; ++j) v[j] = sc[j] >= 0 ? W[(size_t)row * N + sc[j]] : 0.f;
        return v; };
    f32x4 inv = (f32x4){fscale, fscale, fscale, fscale};
    if constexpr (MODE == 2) {
        f32x4 mx = (f32x4){0.f, 0.f, 0.f, 0.f};
        for (int c = wave; c < nchunk; c += NWAVES_) { f32x4 v[16];
#pragma unroll
            for (int i = 0; i < 16; ++i) v[i] = ldrow(c * 128 + 16 * rg + i);
#pragma unroll
            for (int i = 0; i < 16; ++i)
#pragma unroll
                for (int j = 0; j < 4; ++j) mx[j] = __builtin_fmaxf(mx[j], __builtin_fabsf(v[i][j])); }
#pragma unroll
        for (int j = 0; j < 4; ++j) { float m = mx[j]; m = __builtin_fmaxf(m, swz_xor<8>(m)); m = __builtin_fmaxf(m, swz_xor<16>(m));
            auto rr = __builtin_amdgcn_permlane32_swap(__float_as_uint(m), __float_as_uint(m), false, false); mx[j] = __builtin_fmaxf(__uint_as_float(rr[0]), __uint_as_float(rr[1])); }
        __syncthreads();
        if (lane < 8) *(LAS f32x4*)(lmax + wave * 32 + 4 * lane) = mx;
        __syncthreads();
        f32x4 cm = *(const LAS f32x4*)(lmax + 4 * cq);
#pragma unroll
        for (int w = 1; w < NWAVES_; ++w) { const f32x4 o = *(const LAS f32x4*)(lmax + w * 32 + 4 * cq);
#pragma unroll
            for (int j = 0; j < 4; ++j) cm[j] = __builtin_fmaxf(cm[j], o[j]); }
#pragma unroll
        for (int j = 0; j < 4; ++j) inv[j] = cm[j] > 0.f ? 127.f / cm[j] : 0.f;
        if (wave == 0 && lane < 8) *(f32x4*)(cs + n0 + 4 * lane) = cm * (1.f / 127.f);
    }
    constexpr int EB = (MODE == 0) ? 2 : 1; const size_t rowb = (size_t)K * EB;
    for (int c = wave; c < nchunk; c += NWAVES_) { f32x4 v[16];
#pragma unroll
        for (int i = 0; i < 16; ++i) v[i] = ldrow(c * 128 + 16 * rg + i) * inv;
#pragma unroll
        for (int j = 0; j < 4; ++j) { unsigned char* dst = WT + (size_t)(n0 + 4 * cq + j) * rowb + (size_t)(c * 128 + 16 * rg) * EB;
            if constexpr (MODE == 2) { u32x4 o; o.x = pack4_i8(v[0][j], v[1][j], v[2][j], v[3][j]); o.y = pack4_i8(v[4][j], v[5][j], v[6][j], v[7][j]); o.z = pack4_i8(v[8][j], v[9][j], v[10][j], v[11][j]); o.w = pack4_i8(v[12][j], v[13][j], v[14][j], v[15][j]); *(u32x4*)dst = o; }
            else if constexpr (MODE == 1) { u32x4 o; o.x = pack4_fp8(v[0][j], v[1][j], v[2][j], v[3][j]); o.y = pack4_fp8(v[4][j], v[5][j], v[6][j], v[7][j]); o.z = pack4_fp8(v[8][j], v[9][j], v[10][j], v[11][j]); o.w = pack4_fp8(v[12][j], v[13][j], v[14][j], v[15][j]); *(u32x4*)dst = o; }
            else { u32x4 o; o.x = cvt_pk_bf16(v[0][j], v[1][j]); o.y = cvt_pk_bf16(v[2][j], v[3][j]); o.z = cvt_pk_bf16(v[4][j], v[5][j]); o.w = cvt_pk_bf16(v[6][j], v[7][j]); *(u32x4*)dst = o;
                   o.x = cvt_pk_bf16(v[8][j], v[9][j]); o.y = cvt_pk_bf16(v[10][j], v[11][j]); o.z = cvt_pk_bf16(v[12][j], v[13][j]); o.w = cvt_pk_bf16(v[14][j], v[15][j]); *(u32x4*)(dst + 16) = o; } }
    }
}
__device__ __forceinline__ int t5_bucket(int rel) {
    const int ret = rel > 0 ? 16 : 0; const int n = rel < 0 ? -rel : rel;
    if (n < 8) return ret + n;
    int large = 2 + (31 - __builtin_clz((unsigned)(n * n)));
    large = large < 15 ? large : 15;
    return ret + large;
}
__device__ __forceinline__ void sincos_f32arg(float ang, float& c, float& s) {
    const double a = (double)ang; const double kq = __builtin_rint(a * 0.63661977236758134);
    double r = __builtin_fma(-kq, 1.5707963267948966, a); r = __builtin_fma(-kq, 6.123233995736766e-17, r);
    const int q = ((int)kq) & 3; const double r2 = r * r;
    const double sp = r * (1.0 + r2 * (-1.0 / 6 + r2 * (1.0 / 120 + r2 * (-1.0 / 5040 + r2 * (1.0 / 362880 + r2 * (-1.0 / 39916800))))));
    const double cp = 1.0 + r2 * (-0.5 + r2 * (1.0 / 24 + r2 * (-1.0 / 720 + r2 * (1.0 / 40320 + r2 * (-1.0 / 3628800 + r2 * (1.0 / 479001600))))));
    const double sv = (q == 0) ? sp : (q == 1) ? cp : (q == 2) ? -sp : -cp;
    const double cv = (q == 0) ? cp : (q == 1) ? -sp : (q == 2) ? -cp : sp;
    c = (float)cv; s = (float)sv;
}

struct Args { const float* in[23]; float* out; unsigned char* ws; float invf[32]; int lo, hi; };
typedef const __attribute__((address_space(4))) Args* ArgsP;

enum { I_XP = 0, I_XS, I_RELB, I_FNG, I_RAG, I_WIN, I_LQ1, I_LK1, I_LQ2, I_LK2, I_SUBG, I_QNG, I_WQUP, I_KVNG, I_WKVUP, I_WA, I_WB, I_WO, I_RFG, I_WUP, I_CW, I_CB, I_WD };

#define P_WINT ((bf16*)(ws + WS_WIN))
#define P_WQT ((bf16*)(ws + WS_WQ))
#define P_WKVT ((bf16*)(ws + WS_WKV))
#define P_WAT ((bf16*)(ws + WS_WA))
#define P_WBT ((bf16*)(ws + WS_WB))
#define P_WOT ((bf16*)(ws + WS_WO))
#define P_WUPT ((bf16*)(ws + WS_WUP))
#define P_WDT ((bf16*)(ws + WS_WD))
#define P_COS ((float*)(ws + WS_COS))
#define P_SIN ((float*)(ws + WS_SIN))
#define P_BIAS2 ((float*)(ws + WS_BIAS))
#define P_LAM ((float*)(ws + WS_LAM))
#define P_CSIN ((float*)(ws + WS_CSIN))
#define P_CSUP ((float*)(ws + WS_CSUP))
#define P_RSH ((float*)(ws + WS_RSH))
#define P_QL8 ((unsigned char*)(ws + WS_QL8))
#define P_KVL8 ((unsigned char*)(ws + WS_KVL8))
#define P_AO8 ((unsigned char*)(ws + WS_AO8))
#define P_BO8 ((unsigned char*)(ws + WS_BO8))
#define P_MG8 ((unsigned char*)(ws + WS_MG8))
#define P_X1 ((bf16*)(ws + WS_X1))
#define P_H ((bf16*)(ws + WS_H))
#define P_P ((bf16*)(ws + WS_P))
#define P_Q ((bf16*)(ws + WS_Q))
#define P_KV ((bf16*)(ws + WS_KV))
#define P_AO ((bf16*)(ws + WS_AO))
#define P_BO ((bf16*)(ws + WS_BO))
#define P_MG ((bf16*)(ws + WS_MG))
#define P_STASH ((float*)(ws + WS_STASH))
#define P_Y ((bf16*)(ws + WS_Y))
#define P_ACT ((bf16*)(ws + WS_ACTV))
#define XG() ((g < 2) ? A->in[I_XP] + (size_t)g * TG * DM : A->in[I_XS] + (size_t)(g - 2) * TG * DM)
#define OG() (A->out + (size_t)g * TG * DM)
constexpr int NSTEP_PER_GROUP = I8_MID ? 14 : 12, NSTEPS = 1 + NGRP * NSTEP_PER_GROUP;

__global__ void __launch_bounds__(NWAVES * 64, 2) enc_fwd(Args args) {
    extern __shared__ __attribute__((aligned(16))) unsigned char lds[];
    LAS unsigned char* ldsL = (LAS unsigned char*)lds;
    volatile LAS unsigned* MISC = (volatile LAS unsigned*)(ldsL + MISC_OFF);
    const int wave = __builtin_amdgcn_readfirstlane((int)threadIdx.x >> 6);
    const int G = gridDim.x; const int bx = blockIdx.x; const int vcu0 = (G % 8 == 0) ? (bx % 8) * (G / 8) + bx / 8 : bx;
    unsigned char* ws = args.ws;
    unsigned* ctl = (unsigned*)(ws + WS_CTL);
    { const int tid0 = wave * 64 + lane_id_fresh(); for (int u = tid0; u < (LDS_BYTES - RING_BYTES) / 4; u += NWAVES * 64) ((LAS unsigned*)(ldsL + RING_BYTES))[u] = 0u; }
    __syncthreads();
    XcdBarrier bar; bar.bar = ctl + CW_BAR; bar.x = 0; bar.st = nullptr;
#if !MK_PER_STEP_LAUNCH
    bar = xcd_barrier_post(ctl + CW_BAR, MISC + 8, (wave * 64 + lane_id_fresh()) == 0);
#endif
    const int lo = args.lo, hi = args.hi;
    int step = 0;
#ifndef EN_MASK
#define EN_MASK 0xFFFFFF
#endif
#define EN(k) (((EN_MASK) >> (k)) & 1)
#define RUN() (step >= lo && step < hi)
#define LOCAL_TID() ArgsP A = (ArgsP)__builtin_amdgcn_kernarg_segment_ptr(); asm volatile("" : "+s"(A)); unsigned char* const ws = A->ws; (void)ws; int lane_ = lane_id_fresh(); asm volatile("" : "+v"(lane_)); const int lane = lane_; const int tid = wave * 64 + lane; (void)tid; int gw = gw0, vcu = vcu0; asm volatile("" : "+s"(gw), "+s"(vcu)); (void)gw; (void)vcu
#if MK_PER_STEP_LAUNCH
#define SEAM() do { ++step; } while (0)
#else
#define SEAM() do { if (RUN() && step + 1 < hi) xcd_barrier(bar, (wave * 64 + lane_id_fresh()) == 0); ++step; } while (0)
#endif
    const int gw0 = vcu0 * NWAVES + wave, NGW = G * NWAVES;

    if (RUN() && EN(0)) { LOCAL_TID();
        LAS float* lmax = (LAS float*)ldsL;
        auto ident = [](int n) -> int { return n; };
        auto srcIn = [](int n) -> int { if (n < C_GATE) return n; if (n < C_KPE) return n + 64; if (n < C_KPE + 64) { const int j = n - C_KPE; return 7680 + ((j & 1) ? 32 + (j >> 1) : (j >> 1)); } return -1; };
        auto srcQ = [](int n) -> int { if (n < 2048) return (n >> 7) * 192 + (n & 127); const int j = n - 2048, hh = j >> 6, jj = j & 63; return hh * 192 + 128 + ((jj & 1) ? 32 + (jj >> 1) : (jj >> 1)); };
        auto srcUp = [](int n) -> int { return CONV_FUSE ? ((n & 128) ? DFF : 0) + (n >> 8) * 128 + (n & 127) : n; };
        constexpr int T0 = DM / 32, T1 = T0 + NIN / 32, T2 = T1 + NUP / 32, T3 = T2 + DM / 32, T4 = T3 + DM / 32, T5 = T4 + DM / 32, T6 = T5 + NQ / 32, T7 = T6 + NKV / 32;
        for (int s = vcu; s < T7; s += G) {
            if (s < T0) { const int n0 = 32 * s;
                if (FP8_DOWN) convert_strip<1>(A->in[I_WD], DFF, DM, (unsigned char*)P_WDT, nullptr, n0, S_WD, lmax, wave, lane, ident); else convert_strip<0>(A->in[I_WD], DFF, DM, (unsigned char*)P_WDT, nullptr, n0, 1.f, lmax, wave, lane, ident); }
            else if (s < T1) { const int n0 = 32 * (s - T0);
                if (I8_IN) convert_strip<2>(A->in[I_WIN], DM, 15936, (unsigned char*)P_WINT, P_CSIN, n0, 1.f, lmax, wave, lane, srcIn); else convert_strip<0>(A->in[I_WIN], DM, 15936, (unsigned char*)P_WINT, nullptr, n0, 1.f, lmax, wave, lane, srcIn); }
            else if (s < T2) { const int n0 = 32 * (s - T1);
                if (I8_UP) convert_strip<2>(A->in[I_WUP], DM, NUP, (unsigned char*)P_WUPT, P_CSUP, n0, 1.f, lmax, wave, lane, srcUp); else convert_strip<0>(A->in[I_WUP], DM, NUP, (unsigned char*)P_WUPT, nullptr, n0, 1.f, lmax, wave, lane, srcUp); }
            else if (s < T3) { const int n0 = 32 * (s - T2);
                if (I8_MID) convert_strip<2>(A->in[I_WO], DM, DM, (unsigned char*)P_WOT, (float*)(ws + WS_CSO), n0, 1.f, lmax, wave, lane, ident); else convert_strip<0>(A->in[I_WO], DM, DM, (unsigned char*)P_WOT, nullptr, n0, 1.f, lmax, wave, lane, ident); }
            else if (s < T4) { const int n0 = 32 * (s - T3);
                if (I8_MID) convert_strip<2>(A->in[I_WA], 2048, DM, (unsigned char*)P_WAT, (float*)(ws + WS_CSA), n0, 1.f, lmax, wave, lane, ident); else convert_strip<0>(A->in[I_WA], 2048, DM, (unsigned char*)P_WAT, nullptr, n0, 1.f, lmax, wave, lane, ident); }
            else if (s < T5) { const int n0 = 32 * (s - T4);
                if (I8_MID) convert_strip<2>(A->in[I_WB], 2048, DM, (unsigned char*)P_WBT, (float*)(ws + WS_CSB), n0, 1.f, lmax, wave, lane, ident); else convert_strip<0>(A->in[I_WB], 2048, DM, (unsigned char*)P_WBT, nullptr, n0, 1.f, lmax, wave, lane, ident); }
            else if (s < T6) { const int n0 = 32 * (s - T5);
                if (I8_MID) convert_strip<2>(A->in[I_WQUP], 1024, NQ, (unsigned char*)P_WQT, (float*)(ws + WS_CSQ), n0, 1.f, lmax, wave, lane, srcQ); else convert_strip<0>(A->in[I_WQUP], 1024, NQ, (unsigned char*)P_WQT, nullptr, n0, 1.f, lmax, wave, lane, srcQ); }
            else { const int n0 = 32 * (s - T6);
                if (I8_MID) convert_strip<2>(A->in[I_WKVUP], 512, NKV, (unsigned char*)P_WKVT, (float*)(ws + WS_CSKV), n0, 1.f, lmax, wave, lane, ident); else convert_strip<0>(A->in[I_WKVUP], 512, NKV, (unsigned char*)P_WKVT, nullptr, n0, 1.f, lmax, wave, lane, ident); }
        }
        for (int i = bx * (NWAVES * 64) + tid; i < 8192 * 32; i += G * NWAVES * 64) { const int pos = i >> 5, k = i & 31; float c, s; sincos_f32arg((float)pos * A->invf[k], c, s); P_COS[i] = c; P_SIN[i] = s; }
        if (bx == 0) {
            for (int i = tid; i < 16 * 257; i += NWAVES * 64) { const int h = i / 257, j = i % 257; P_BIAS2[h * 260 + j] = A->in[I_RELB][t5_bucket(j - 128) * 16 + h] * 1.4426950408889634f; }
            if (wave == 0) { const float a = wave_sum(A->in[I_LQ1][lane] * A->in[I_LK1][lane]), b = wave_sum(A->in[I_LQ2][lane] * A->in[I_LK2][lane]);
                if (lane == 0) P_LAM[0] = expf(a) - expf(b) + 0.2f; }
        }
    }
    SEAM();

    for (int g = 0; g < NGRP; ++g) {
        const int seqlen = (g < 2) ? 4096 : 8192, posmask = seqlen - 1;

        if (RUN() && EN(1)) { LOCAL_TID();
            const float* gv = A->in[I_RAG];
            for (int m = gw; m < TG; m += NGW) {
                const f32x4* xr = (const f32x4*)(XG() + (size_t)m * DM) + lane; f32x4 v[16]; float s = 0.f;
#pragma unroll
                for (int j = 0; j < 16; ++j) { v[j] = xr[64 * j]; s += (v[j].x * v[j].x + v[j].y * v[j].y) + (v[j].z * v[j].z + v[j].w * v[j].w); }
                const float rstd = 1.0f / sqrtf(wave_sum(s) * (1.f / DM) + EPS);
                if (I8_IN) { float mx = 0.f;
#pragma unroll
                    for (int j = 0; j < 16; ++j) { const f32x4 gg = ((const f32x4*)gv)[64 * j + lane]; v[j] = v[j] * rstd * gg; mx = __builtin_fmaxf(__builtin_fmaxf(mx, __builtin_fmaxf(__builtin_fabsf(v[j].x), __builtin_fabsf(v[j].y))), __builtin_fmaxf(__builtin_fabsf(v[j].z), __builtin_fabsf(v[j].w))); }
                    mx = wave_max(mx); const float inv = mx > 0.f ? 127.f / mx : 0.f; if (lane == 0) P_RSH[m] = mx * (1.f / 127.f);
                    unsigned* o4 = (unsigned*)((unsigned char*)P_H + (size_t)m * DM) + lane;
#pragma unroll
                    for (int j = 0; j < 16; ++j) o4[64 * j] = pack4_i8(v[j].x * inv, v[j].y * inv, v[j].z * inv, v[j].w * inv);
                } else {
                u32x2* o8 = (u32x2*)(P_H + (size_t)m * DM) + lane;
#pragma unroll
                for (int j = 0; j < 16; ++j) { const f32x4 gg = ((const f32x4*)gv)[64 * j + lane]; u32x2 w; w.x = cvt_pk_bf16(v[j].x * rstd * gg.x, v[j].y * rstd * gg.y); w.y = cvt_pk_bf16(v[j].z * rstd * gg.z, v[j].w * rstd * gg.w); o8[64 * j] = w; }
                }
            }
        }
        SEAM();

        if (RUN() && EN(2)) { LOCAL_TID();
            pg8::Gemm gm{P_H, I8_IN ? DM / 2 : DM, P_WINT, TG, NIN, I8_IN ? DM / 2 : DM}; pg8::StaticOrder S; S.init(TG, NIN, G, bx);
            pg8::EpiStoreT<I8_IN != 0, WS_RSH, WS_CSIN> E{P_P, NIN, C_GATE / 256, C_KPE / 256, ATT_CINIT ? CS_DIFF : 1.f, ws};
            REP_LOOP_GEMM { int l2_ = lane_id_fresh(); asm volatile("" : "+v"(l2_)); pg8::gemm_phase<pg8::EpiStoreT<I8_IN != 0, WS_RSH, WS_CSIN>, I8_IN ? 2 : 0>(ldsL, gm, S, E, wave * 64 + l2_); }
        }
        SEAM();

        if (RUN() && EN(3)) { LOCAL_TID();
            const float* gq = A->in[I_QNG]; const float* gkv = A->in[I_KVNG];
            for (int m = gw; m < TG; m += NGW) {
                bf16* prow = P_P + (size_t)m * NIN;
                { u32x4 a = *(const u32x4*)(prow + C_QLAT + lane * 8), b = *(const u32x4*)(prow + C_QLAT + 512 + lane * 8);
                  float x[16] = {bf_lo(a.x), bf_hi(a.x), bf_lo(a.y), bf_hi(a.y), bf_lo(a.z), bf_hi(a.z), bf_lo(a.w), bf_hi(a.w), bf_lo(b.x), bf_hi(b.x), bf_lo(b.y), bf_hi(b.y), bf_lo(b.z), bf_hi(b.z), bf_lo(b.w), bf_hi(b.w)};
                  float s = 0.f;
#pragma unroll
                  for (int j = 0; j < 16; ++j) s += x[j] * x[j];
                  const float rstd = 1.0f / sqrtf(wave_sum(s) * (1.f / 1024) + EPS);
                  const f32x4 g0 = *(const f32x4*)(gq + lane * 8), g1 = *(const f32x4*)(gq + lane * 8 + 4), g2 = *(const f32x4*)(gq + 512 + lane * 8), g3 = *(const f32x4*)(gq + 512 + lane * 8 + 4);
                  u32x4 oa, ob;
                  oa.x = cvt_pk_bf16(x[0] * rstd * g0.x, x[1] * rstd * g0.y); oa.y = cvt_pk_bf16(x[2] * rstd * g0.z, x[3] * rstd * g0.w); oa.z = cvt_pk_bf16(x[4] * rstd * g1.x, x[5] * rstd * g1.y); oa.w = cvt_pk_bf16(x[6] * rstd * g1.z, x[7] * rstd * g1.w);
                  ob.x = cvt_pk_bf16(x[8] * rstd * g2.x, x[9] * rstd * g2.y); ob.y = cvt_pk_bf16(x[10] * rstd * g2.z, x[11] * rstd * g2.w); ob.z = cvt_pk_bf16(x[12] * rstd * g3.x, x[13] * rstd * g3.y); ob.w = cvt_pk_bf16(x[14] * rstd * g3.z, x[15] * rstd * g3.w);
                  if (I8_MID) { float y[16]; float mx = 0.f; const float gg[16] = {g0.x, g0.y, g0.z, g0.w, g1.x, g1.y, g1.z, g1.w, g2.x, g2.y, g2.z, g2.w, g3.x, g3.y, g3.z, g3.w};
#pragma unroll
                      for (int j = 0; j < 16; ++j) { y[j] = x[j] * rstd * gg[j]; mx = __builtin_fmaxf(mx, __builtin_fabsf(y[j])); }
                      mx = wave_max(mx); const float inv = mx > 0.f ? 127.f / mx : 0.f; if (lane == 0) ((float*)(ws + WS_RSQL))[m] = mx * (1.f / 127.f);
                      u32x2 q0, q1; q0.x = pack4_i8(y[0] * inv, y[1] * inv, y[2] * inv, y[3] * inv); q0.y = pack4_i8(y[4] * inv, y[5] * inv, y[6] * inv, y[7] * inv);
                      q1.x = pack4_i8(y[8] * inv, y[9] * inv, y[10] * inv, y[11] * inv); q1.y = pack4_i8(y[12] * inv, y[13] * inv, y[14] * inv, y[15] * inv);
                      *(u32x2*)(P_QL8 + (size_t)m * 1024 + lane * 8) = q0; *(u32x2*)(P_QL8 + (size_t)m * 1024 + 512 + lane * 8) = q1;
                  } else { *(u32x4*)(prow + C_QLAT + lane * 8) = oa; *(u32x4*)(prow + C_QLAT + 512 + lane * 8) = ob; } }
                { u32x4 a = *(const u32x4*)(prow + C_KVLAT + lane * 8);
                  float x[8] = {bf_lo(a.x), bf_hi(a.x), bf_lo(a.y), bf_hi(a.y), bf_lo(a.z), bf_hi(a.z), bf_lo(a.w), bf_hi(a.w)};
                  float s = 0.f;
#pragma unroll
                  for (int j = 0; j < 8; ++j) s += x[j] * x[j];
                  const float rstd = 1.0f / sqrtf(wave_sum(s) * (1.f / 512) + EPS);
                  const f32x4 g0 = *(const f32x4*)(gkv + lane * 8), g1 = *(const f32x4*)(gkv + lane * 8 + 4);
                  u32x4 oa;
                  oa.x = cvt_pk_bf16(x[0] * rstd * g0.x, x[1] * rstd * g0.y); oa.y = cvt_pk_bf16(x[2] * rstd * g0.z, x[3] * rstd * g0.w); oa.z = cvt_pk_bf16(x[4] * rstd * g1.x, x[5] * rstd * g1.y); oa.w = cvt_pk_bf16(x[6] * rstd * g1.z, x[7] * rstd * g1.w);
                  if (I8_MID) { float y[8]; float mx = 0.f; const float gg[8] = {g0.x, g0.y, g0.z, g0.w, g1.x, g1.y, g1.z, g1.w};
#pragma unroll
                      for (int j = 0; j < 8; ++j) { y[j] = x[j] * rstd * gg[j]; mx = __builtin_fmaxf(mx, __builtin_fabsf(y[j])); }
                      mx = wave_max(mx); const float inv = mx > 0.f ? 127.f / mx : 0.f; if (lane == 0) ((float*)(ws + WS_RSKVL))[m] = mx * (1.f / 127.f);
                      u32x2 q0; q0.x = pack4_i8(y[0] * inv, y[1] * inv, y[2] * inv, y[3] * inv); q0.y = pack4_i8(y[4] * inv, y[5] * inv, y[6] * inv, y[7] * inv);
                      *(u32x2*)(P_KVL8 + (size_t)m * 512 + lane * 8) = q0;
                  } else *(u32x4*)(prow + C_KVLAT + lane * 8) = oa; }
                if (lane < 32) { const int pos = m & posmask; unsigned w = *(const unsigned*)(prow + C_KPE + 2 * lane); const float x1 = bf_lo(w), x2 = bf_hi(w);
                  const float c = P_COS[pos * 32 + lane], s = P_SIN[pos * 32 + lane];
                  *(unsigned*)(prow + C_KPE + 2 * lane) = cvt_pk_bf16(x1 * c - x2 * s, x1 * s + x2 * c); }
            }
        }
        SEAM();

        if (RUN() && EN(4)) { LOCAL_TID();
            if (EN(18)) { pg8::Gemm gm{I8_MID ? (const bf16*)P_QL8 : P_P + C_QLAT, I8_MID ? 512 : NIN, P_WQT, TG, NQ, I8_MID ? 512 : 1024}; pg8::StaticOrder S; S.init(TG, NQ, G, bx);
              pg8::EpiQT<I8_MID != 0> E{P_Q, NQ, ws, posmask}; REP_LOOP_GEMM { int l2_ = lane_id_fresh(); asm volatile("" : "+v"(l2_)); pg8::gemm_phase<pg8::EpiQT<I8_MID != 0>, I8_MID ? 2 : 0>(ldsL, gm, S, E, wave * 64 + l2_); } }
            if (EN(19)) { pg8::Gemm gm{I8_MID ? (const bf16*)P_KVL8 : P_P + C_KVLAT, I8_MID ? 256 : NIN, P_WKVT, TG, NKV, I8_MID ? 256 : 512}; pg8::StaticOrder S; S.init(TG, NKV, G, bx);
              pg8::EpiStoreT<I8_MID != 0, WS_RSKVL, WS_CSKV> E{P_KV, NKV, 0, 0, 1.f, ws}; REP_LOOP_GEMM { int l2_ = lane_id_fresh(); asm volatile("" : "+v"(l2_)); pg8::gemm_phase<pg8::EpiStoreT<I8_MID != 0, WS_RSKVL, WS_CSKV>, I8_MID ? 2 : 0>(ldsL, gm, S, E, wave * 64 + l2_); } }
        }
        SEAM();

        if (RUN() && EN(5)) { LOCAL_TID();
            const int wid = wave;
            const float lam = P_LAM[0];
            if (EN(16)) _Pragma("unroll 1") for (int rep = 0; rep < REP_DIFF; ++rep) for (int u = vcu; u < 512; u += G) {
                const int head = u >> 5, rb = u & 31, row0 = rb * 256, kbase = (seqlen == 4096) ? (rb >> 4) * 4096 : 0, qpos0 = row0 - kbase;
                __syncthreads();
                if (tid < 257) ((float*)(lds + att::OFF_TBL))[tid] = P_BIAS2[head * 260 + tid];
                __syncthreads();
#pragma unroll 1
                for (int c = 0; c < 2; ++c) {
                    att::Ptrs P;
                    P.q[0] = P_P + (size_t)row0 * NIN + C_DQ + head * 128 + c * 64; P.q[1] = P.q[0]; P.q[2] = P.q[0];
                    P.k[0] = P_P + (size_t)kbase * NIN + C_DK + head * 128 + c * 64; P.k[1] = P.k[0]; P.k[2] = P.k[0];
                    P.v = P_P + (size_t)kbase * NIN + C_DV + head * 128;
                    f32x16 o[4];
                    att::attn_body<1, true, 2, att::StrDiff>(P, seqlen, qpos0, 0.125f * 1.4426950408889634f, (LAS char*)ldsL, o, tid);
                    int tid_e = tid; asm volatile("" : "+v"(tid_e));
                    const int r32 = tid_e & 31, hh = (tid_e >> 5) & 1;
                    f32x4* myst = (f32x4*)(P_STASH + ((size_t)bx * 512 + tid_e) * 64);
                    if (c == 0) {
#pragma unroll
                        for (int d = 0; d < 4; ++d)
#pragma unroll
                            for (int r4 = 0; r4 < 4; ++r4) myst[d * 4 + r4] = (f32x4){o[d][4 * r4], o[d][4 * r4 + 1], o[d][4 * r4 + 2], o[d][4 * r4 + 3]};
                    } else {
                        float ss[16];
#pragma unroll
                        for (int r = 0; r < 16; ++r) ss[r] = 0.f;
#pragma unroll
                        for (int d = 0; d < 4; ++d)
#pragma unroll
                            for (int r4 = 0; r4 < 4; ++r4) { const f32x4 s0 = myst[d * 4 + r4];
#pragma unroll
                                for (int j = 0; j < 4; ++j) { const float a = s0[j] - lam * o[d][4 * r4 + j]; o[d][4 * r4 + j] = a; ss[4 * r4 + j] += a * a; } }
#pragma unroll
                        for (int r = 0; r < 16; ++r) ss[r] = 0.8f / sqrtf(half_sum(ss[r]) * (1.f / 128) + EPS);
                        const float* sg = A->in[I_SUBG];
                        float gsub[4];
#pragma unroll
                        for (int d = 0; d < 4; ++d) gsub[d] = sg[d * 32 + r32];
#pragma unroll
                        for (int r = 0; r < 16; ++r) { bf16* orow = P_AO + (size_t)(row0 + wid * 32 + att::crow(r, hh)) * 2048 + head * 128 + r32;
#pragma unroll
                            for (int d = 0; d < 4; ++d) orow[d * 32] = (bf16)(cvt_pk_bf16(o[d][r] * ss[r] * gsub[d], 0.f) & 0xffffu); }
                    }
                }
            }
            if (EN(17)) _Pragma("unroll 1") for (int rep = 0; rep < REP_MLA; ++rep) for (int u = vcu; u < 512; u += G) {
                const int head = u >> 5, rb = u & 31, row0 = rb * 256, kbase = (seqlen == 4096) ? (rb >> 4) * 4096 : 0;
                att::Ptrs P;
                P.q[0] = P_Q + (size_t)row0 * NQ + head * 128; P.q[1] = P.q[0] + 64; P.q[2] = P_Q + (size_t)row0 * NQ + 2048 + head * 64;
                P.k[0] = P_KV + (size_t)kbase * NKV + head * 256; P.k[1] = P.k[0] + 64; P.k[2] = P_P + (size_t)kbase * NIN + C_KPE;
                P.v = P_KV + (size_t)kbase * NKV + head * 256 + 128;
                f32x16 o[4];
                att::attn_body<3, false, 1, att::StrMla>(P, seqlen, 0, 0.07216878364870323f * 1.4426950408889634f, (LAS char*)ldsL, o, tid);
                int tid_e = tid; asm volatile("" : "+v"(tid_e));
                const int r32 = tid_e & 31, hh = (tid_e >> 5) & 1;
#pragma unroll
                for (int r = 0; r < 16; ++r) { bf16* orow = P_BO + (size_t)(row0 + wid * 32 + att::crow(r, hh)) * 2048 + head * 128 + r32;
#pragma unroll
                    for (int d = 0; d < 4; ++d) orow[d * 32] = (bf16)(cvt_pk_bf16(o[d][r], 0.f) & 0xffffu); }
            }
        }
        SEAM();

#if I8_MID
        if (RUN()) { LOCAL_TID();
            for (int m = gw; m < 2 * TG; m += NGW) { const int row = m >> 1; const bool isB = m & 1;
                const bf16* srow = (isB ? P_BO : P_AO) + (size_t)row * 2048 + lane * 8; u32x4 a[4]; float mx = 0.f;
#pragma unroll
                for (int j = 0; j < 4; ++j) { a[j] = *(const u32x4*)(srow + 512 * j);
                    mx = __builtin_fmaxf(mx, __builtin_fmaxf(__builtin_fmaxf(__builtin_fmaxf(__builtin_fabsf(bf_lo(a[j].x)), __builtin_fabsf(bf_hi(a[j].x))), __builtin_fmaxf(__builtin_fabsf(bf_lo(a[j].y)), __builtin_fabsf(bf_hi(a[j].y)))),
                                                      __builtin_fmaxf(__builtin_fmaxf(__builtin_fabsf(bf_lo(a[j].z)), __builtin_fabsf(bf_hi(a[j].z))), __builtin_fmaxf(__builtin_fabsf(bf_lo(a[j].w)), __builtin_fabsf(bf_hi(a[j].w)))))); }
                mx = wave_max(mx); const float inv = mx > 0.f ? 127.f / mx : 0.f; if (lane == 0) ((float*)(ws + (isB ? WS_RSB : WS_RSA)))[row] = mx * (1.f / 127.f);
                unsigned char* drow = (isB ? P_BO8 : P_AO8) + (size_t)row * 2048 + lane * 8;
#pragma unroll
                for (int j = 0; j < 4; ++j) { u32x2 q; q.x = pack4_i8(bf_lo(a[j].x) * inv, bf_hi(a[j].x) * inv, bf_lo(a[j].y) * inv, bf_hi(a[j].y) * inv); q.y = pack4_i8(bf_lo(a[j].z) * inv, bf_hi(a[j].z) * inv, bf_lo(a[j].w) * inv, bf_hi(a[j].w) * inv); *(u32x2*)(drow + 512 * j) = q; }
            }
        }
        SEAM();
#endif

        if (RUN() && EN(6)) { LOCAL_TID();
            if (EN(20)) { pg8::Gemm gm{I8_MID ? (const bf16*)P_AO8 : P_AO, I8_MID ? 1024 : 2048, P_WAT, TG, DM, I8_MID ? 1024 : 2048}; pg8::StaticOrder S; S.init(TG, DM, G, bx);
              pg8::EpiGateAT<I8_MID != 0> E{P_MG, DM, P_P + C_GATE, NIN, ws}; REP_LOOP_GEMM { int l2_ = lane_id_fresh(); asm volatile("" : "+v"(l2_)); pg8::gemm_phase<pg8::EpiGateAT<I8_MID != 0>, I8_MID ? 2 : 0>(ldsL, gm, S, E, wave * 64 + l2_); } }
            if (EN(21)) { pg8::Gemm gm{I8_MID ? (const bf16*)P_BO8 : P_BO, I8_MID ? 1024 : 2048, P_WBT, TG, DM, I8_MID ? 1024 : 2048}; pg8::StaticOrder S; S.init(TG, DM, G, bx);
              pg8::EpiGateBT<I8_MID != 0> E{P_MG, DM, P_P + C_GATE + DM, NIN, P_MG, DM, ws}; REP_LOOP_GEMM { int l2_ = lane_id_fresh(); asm volatile("" : "+v"(l2_)); pg8::gemm_phase<pg8::EpiGateBT<I8_MID != 0>, I8_MID ? 2 : 0>(ldsL, gm, S, E, wave * 64 + l2_); } }
        }
        SEAM();

#if I8_MID
        if (RUN()) { LOCAL_TID();
            for (int m = gw; m < TG; m += NGW) {
                const bf16* srow = P_MG + (size_t)m * DM + lane * 8; u32x4 a[8]; float mx = 0.f;
#pragma unroll
                for (int j = 0; j < 8; ++j) { a[j] = *(const u32x4*)(srow + 512 * j);
                    mx = __builtin_fmaxf(mx, __builtin_fmaxf(__builtin_fmaxf(__builtin_fmaxf(__builtin_fabsf(bf_lo(a[j].x)), __builtin_fabsf(bf_hi(a[j].x))), __builtin_fmaxf(__builtin_fabsf(bf_lo(a[j].y)), __builtin_fabsf(bf_hi(a[j].y)))),
                                                      __builtin_fmaxf(__builtin_fmaxf(__builtin_fabsf(bf_lo(a[j].z)), __builtin_fabsf(bf_hi(a[j].z))), __builtin_fmaxf(__builtin_fabsf(bf_lo(a[j].w)), __builtin_fabsf(bf_hi(a[j].w)))))); }
                mx = wave_max(mx); const float inv = mx > 0.f ? 127.f / mx : 0.f; if (lane == 0) ((float*)(ws + WS_RSM))[m] = mx * (1.f / 127.f);
                unsigned char* drow = P_MG8 + (size_t)m * DM + lane * 8;
#pragma unroll
                for (int j = 0; j < 8; ++j) { u32x2 q; q.x = pack4_i8(bf_lo(a[j].x) * inv, bf_hi(a[j].x) * inv, bf_lo(a[j].y) * inv, bf_hi(a[j].y) * inv); q.y = pack4_i8(bf_lo(a[j].z) * inv, bf_hi(a[j].z) * inv, bf_lo(a[j].w) * inv, bf_hi(a[j].w) * inv); *(u32x2*)(drow + 512 * j) = q; }
            }
        }
        SEAM();
#endif

        if (RUN() && EN(7)) { LOCAL_TID();
            pg8::Gemm gm{I8_MID ? (const bf16*)P_MG8 : P_MG, I8_MID ? DM / 2 : DM, P_WOT, TG, DM, I8_MID ? DM / 2 : DM}; pg8::StaticOrder S; S.init(TG, DM, G, bx);
            pg8::EpiResT<I8_MID != 0, false> E{XG(), P_X1, DM, 1.f, ws}; REP_LOOP_GEMM { int l2_ = lane_id_fresh(); asm volatile("" : "+v"(l2_)); pg8::gemm_phase<pg8::EpiResT<I8_MID != 0, false>, I8_MID ? 2 : 0>(ldsL, gm, S, E, wave * 64 + l2_); }
        }
        SEAM();

        if (RUN() && EN(8)) { LOCAL_TID();
            const float* gv = A->in[I_RFG];
            for (int m = gw; m < TG; m += NGW) {
                const u32x2* xr = (const u32x2*)(P_X1 + (size_t)m * DM) + lane; f32x4 v[16]; float s = 0.f;
#pragma unroll
                for (int j = 0; j < 16; ++j) { const u32x2 w = xr[64 * j]; v[j] = (f32x4){bf_lo(w.x), bf_hi(w.x), bf_lo(w.y), bf_hi(w.y)}; s += (v[j].x * v[j].x + v[j].y * v[j].y) + (v[j].z * v[j].z + v[j].w * v[j].w); }
                const float rstd = 1.0f / sqrtf(wave_sum(s) * (1.f / DM) + EPS);
                if (I8_UP) { float mx = 0.f;
#pragma unroll
                    for (int j = 0; j < 16; ++j) { const f32x4 gg = ((const f32x4*)gv)[64 * j + lane]; v[j] = v[j] * rstd * gg; mx = __builtin_fmaxf(__builtin_fmaxf(mx, __builtin_fmaxf(__builtin_fabsf(v[j].x), __builtin_fabsf(v[j].y))), __builtin_fmaxf(__builtin_fabsf(v[j].z), __builtin_fabsf(v[j].w))); }
                    mx = wave_max(mx); const float inv = mx > 0.f ? 127.f / mx : 0.f; if (lane == 0) P_RSH[m] = mx * (1.f / 127.f);
                    unsigned* o4 = (unsigned*)((unsigned char*)P_H + (size_t)m * DM) + lane;
#pragma unroll
                    for (int j = 0; j < 16; ++j) o4[64 * j] = pack4_i8(v[j].x * inv, v[j].y * inv, v[j].z * inv, v[j].w * inv);
                } else {
                u32x2* o8 = (u32x2*)(P_H + (size_t)m * DM) + lane;
#pragma unroll
                for (int j = 0; j < 16; ++j) { const f32x4 gg = ((const f32x4*)gv)[64 * j + lane]; u32x2 w; w.x = cvt_pk_bf16(v[j].x * rstd * gg.x, v[j].y * rstd * gg.y); w.y = cvt_pk_bf16(v[j].z * rstd * gg.z, v[j].w * rstd * gg.w); o8[64 * j] = w; }
                }
            }
        }
        SEAM();

        if (RUN() && EN(9)) { LOCAL_TID();
            pg8::Gemm gm{P_H, I8_UP ? DM / 2 : DM, P_WUPT, TG, NUP, I8_UP ? DM / 2 : DM}; pg8::StaticOrder S; S.init(TG, NUP, G, bx);
#if CONV_FUSE
            static_assert(I8_UP, "CONV_FUSE needs the int8 up GEMM");
            pg8::EpiConv E{(unsigned char*)P_ACT, P_Y, A->in[I_CW], A->in[I_CB], ws, FP8_DOWN ? S_ACT8 : 1.f}; REP_LOOP_GEMM { int l2_ = lane_id_fresh(); asm volatile("" : "+v"(l2_)); pg8::gemm_phase<pg8::EpiConv, 2>(ldsL, gm, S, E, wave * 64 + l2_); }
#else
            pg8::EpiStoreT<I8_UP != 0, WS_RSH, WS_CSUP> E{P_Y, NUP, 0, 0, 1.f, ws}; REP_LOOP_GEMM { int l2_ = lane_id_fresh(); asm volatile("" : "+v"(l2_)); pg8::gemm_phase<pg8::EpiStoreT<I8_UP != 0, WS_RSH, WS_CSUP>, I8_UP ? 2 : 0>(ldsL, gm, S, E, wave * 64 + l2_); }
#endif
        }
        SEAM();

#if CONV_FUSE
        if (RUN() && EN(10)) { LOCAL_TID();
            const float* cw = A->in[I_CW]; const float* cb = A->in[I_CB];
            constexpr int NCB = DFF / 256, NITEM = NCB * (TG / 64) * 2;
            for (int it = gw; it < NITEM; it += NGW) {
                const int cbk = it % NCB, be = it / NCB, b = be >> 1, edge = be & 1, c0 = cbk * 256 + lane * 4, t = b * 64 + (edge ? 63 : 0);
                const int colg = (c0 >> 7) * 256 + (c0 & 127);
                const f32x4 wg0 = *(const f32x4*)(cw + c0), wg1 = *(const f32x4*)(cw + NUP + c0), wg2 = *(const f32x4*)(cw + 2 * NUP + c0), bg = *(const f32x4*)(cb + c0);
                const f32x4 wu0 = *(const f32x4*)(cw + DFF + c0), wu1 = *(const f32x4*)(cw + NUP + DFF + c0), wu2 = *(const f32x4*)(cw + 2 * NUP + DFF + c0), bu = *(const f32x4*)(cb + DFF + c0);
                auto ldyb = [&](int blk, int slot, f32x4& yg, f32x4& yu) {
                    const bf16* p = P_Y + ((size_t)blk * 4 + slot) * NUP + colg; const u32x2 a = *(const u32x2*)p, bb = *(const u32x2*)(p + 128);
                    yg = (f32x4){bf_lo(a.x), bf_hi(a.x), bf_lo(a.y), bf_hi(a.y)}; yu = (f32x4){bf_lo(bb.x), bf_hi(bb.x), bf_lo(bb.y), bf_hi(bb.y)}; };
                const f32x4 z = (f32x4){0.f, 0.f, 0.f, 0.f};
                f32x4 pg = z, pu = z, cg, cu, ng = z, nu = z;
                if (edge == 0) { ldyb(b, 0, cg, cu); ldyb(b, 1, ng, nu); if ((t & posmask) != 0) ldyb(b - 1, 3, pg, pu); }
                else { ldyb(b, 3, cg, cu); ldyb(b, 2, pg, pu); if (((t + 1) & posmask) != 0) ldyb(b + 1, 0, ng, nu); }
                const f32x4 ug = wg0 * pg + wg1 * cg + wg2 * ng + bg, uu = wu0 * pu + wu1 * cu + wu2 * nu + bu;
                float a[4];
#pragma unroll
                for (int j = 0; j < 4; ++j) a[j] = ug[j] * fast_sigmoid(ug[j]) * uu[j];
                if (FP8_DOWN) *(unsigned*)((unsigned char*)P_ACT + (size_t)t * DFF + c0) = pack4_fp8(a[0] * S_ACT8, a[1] * S_ACT8, a[2] * S_ACT8, a[3] * S_ACT8);
                else { u32x2 w; w.x = cvt_pk_bf16(a[0], a[1]); w.y = cvt_pk_bf16(a[2], a[3]); *(u32x2*)(P_ACT + (size_t)t * DFF + c0) = w; }
            }
        }
#else
        if (RUN() && EN(10)) { LOCAL_TID();
            const float* cw = A->in[I_CW]; const float* cb = A->in[I_CB];
            constexpr int RCH = 64, NCB = DFF / 256, NITEM = NCB * (TG / RCH);
            for (int it = gw; it < NITEM; it += NGW) {
                const int cbk = it % NCB, rc = it / NCB, c0 = cbk * 256 + lane * 4, t0 = rc * RCH;
                f32x4 wg0 = *(const f32x4*)(cw + c0), wg1 = *(const f32x4*)(cw + NUP + c0), wg2 = *(const f32x4*)(cw + 2 * NUP + c0), bg = *(const f32x4*)(cb + c0);
                f32x4 wu0 = *(const f32x4*)(cw + DFF + c0), wu1 = *(const f32x4*)(cw + NUP + DFF + c0), wu2 = *(const f32x4*)(cw + 2 * NUP + DFF + c0), bu = *(const f32x4*)(cb + DFF + c0);
                auto ldrow = [&](int t, f32x4& yg, f32x4& yu) {
                    const u32x2 a = *(const u32x2*)(P_Y + (size_t)t * NUP + c0), b = *(const u32x2*)(P_Y + (size_t)t * NUP + DFF + c0);
                    yg = (f32x4){bf_lo(a.x), bf_hi(a.x), bf_lo(a.y), bf_hi(a.y)}; yu = (f32x4){bf_lo(b.x), bf_hi(b.x), bf_lo(b.y), bf_hi(b.y)}; };
                const f32x4 z = (f32x4){0.f, 0.f, 0.f, 0.f};
                f32x4 pg = z, pu = z, cg, cu, ng, nu;
                if ((t0 & posmask) != 0) ldrow(t0 - 1, pg, pu);
                ldrow(t0, cg, cu);
#pragma unroll 4
                for (int t = t0; t < t0 + RCH; ++t) {
                    if (((t + 1) & posmask) != 0) ldrow(t + 1, ng, nu); else { ng = z; nu = z; }
                    const f32x4 ug = wg0 * pg + wg1 * cg + wg2 * ng + bg, uu = wu0 * pu + wu1 * cu + wu2 * nu + bu;
                    float a[4];
#pragma unroll
                    for (int j = 0; j < 4; ++j) a[j] = ug[j] * fast_sigmoid(ug[j]) * uu[j];
                    if (FP8_DOWN) *(unsigned*)((unsigned char*)P_ACT + (size_t)t * DFF + c0) = pack4_fp8(a[0] * S_ACT8, a[1] * S_ACT8, a[2] * S_ACT8, a[3] * S_ACT8);
                    else { u32x2 w; w.x = cvt_pk_bf16(a[0], a[1]); w.y = cvt_pk_bf16(a[2], a[3]); *(u32x2*)(P_ACT + (size_t)t * DFF + c0) = w; }
                    pg = cg; pu = cu; cg = ng; cu = nu;
                }
            }
        }
#endif
        SEAM();

        if (RUN() && EN(11)) { LOCAL_TID();
            pg8::Gemm gm{P_ACT, FP8_DOWN ? DFF / 2 : DFF, P_WDT, TG, DM, FP8_DOWN ? DFF / 2 : DFF}; pg8::StaticOrder S; S.init(TG, DM, G, bx);
            pg8::EpiResT<false, true> E{P_X1, P_X1, DM, FP8_DOWN ? 1.f / (S_WD * S_ACT8) : 1.f, ws}; { int l2_ = lane_id_fresh(); asm volatile("" : "+v"(l2_)); pg8::gemm_phase<pg8::EpiResT<false, true>, FP8_DOWN ? 1 : 0>(ldsL, gm, S, E, wave * 64 + l2_); }
        }
        SEAM();

        if (RUN() && EN(12)) { LOCAL_TID();
            const float* gv = A->in[I_FNG];
            for (int m = gw; m < TG; m += NGW) {
                const u32x2* xr = (const u32x2*)(P_X1 + (size_t)m * DM) + lane; f32x4* orow = (f32x4*)(OG() + (size_t)m * DM) + lane; f32x4 v[16]; float s = 0.f;
#pragma unroll
                for (int j = 0; j < 16; ++j) { const u32x2 w = xr[64 * j]; v[j] = (f32x4){bf_lo(w.x), bf_hi(w.x), bf_lo(w.y), bf_hi(w.y)}; s += (v[j].x * v[j].x + v[j].y * v[j].y) + (v[j].z * v[j].z + v[j].w * v[j].w); }
                const float rstd = 1.0f / sqrtf(wave_sum(s) * (1.f / DM) + EPS);
#pragma unroll
                for (int j = 0; j < 16; ++j) { const f32x4 gg = ((const f32x4*)gv)[64 * j + lane]; orow[64 * j] = v[j] * rstd * gg; }
            }
        }
        SEAM();
    }
#undef RUN
#undef SEAM
}

extern "C" void kernel_launch(void* const* d_in, const int* in_sizes, int n_in, void* d_out, int out_size, void* d_ws, size_t ws_size, hipStream_t stream) {
    static int grid = 0;
    if (grid == 0) {
        if (n_in != 23 || out_size != NTOK * DM || ws_size < WS_END) { fprintf(stderr, "kernel_launch: unexpected shapes: n_in %d out %d ws %zu (need %zu)\n", n_in, out_size, ws_size, (size_t)WS_END); grid = -1; return; }
        int dev = 0, cus = 0, per_cu = 0;
        if (hipGetDevice(&dev) != hipSuccess || hipDeviceGetAttribute(&cus, hipDeviceAttributeMultiprocessorCount, dev) != hipSuccess) { grid = -1; return; }
        if (hipFuncSetAttribute((const void*)enc_fwd, hipFuncAttributeMaxDynamicSharedMemorySize, LDS_BYTES) != hipSuccess) { fprintf(stderr, "kernel_launch: hipFuncSetAttribute failed\n"); grid = -1; return; }
        if (hipOccupancyMaxActiveBlocksPerMultiprocessor(&per_cu, (const void*)enc_fwd, NWAVES * 64, LDS_BYTES) != hipSuccess || per_cu < 1) { fprintf(stderr, "kernel_launch: occupancy query says %d\n", per_cu); per_cu = 1; }
        (void)hipGetLastError();
        grid = cus;
    }
    if (grid < 0) return;
    (void)hipMemsetAsync((char*)d_ws + WS_CTL, 0, CTL_ZERO_BYTES, stream);
    Args a{};
    for (int i = 0; i < 23; ++i) a.in[i] = (const float*)d_in[i];
    a.out = (float*)d_out; a.ws = (unsigned char*)d_ws;
    for (int i = 0; i < 32; ++i) a.invf[i] = powf(10000.0f, -(float)(2 * i) / 64.0f);
#if MK_PER_STEP_LAUNCH
    for (int s = 0; s < NSTEPS; ++s) { a.lo = s; a.hi = s + 1; hipLaunchKernelGGL(enc_fwd, dim3(grid), dim3(NWAVES * 64), LDS_BYTES, stream, a); }
#else
    a.lo = 0; a.hi = NSTEPS;
    hipLaunchKernelGGL(enc_fwd, dim3(grid), dim3(NWAVES * 64), LDS_BYTES, stream, a);
#endif
    const hipError_t le = hipPeekAtLastError();
    if (le != hipSuccess) fprintf(stderr, "kernel_launch: launch failed: %s\n", hipGetErrorName(le));
}
```

```cpp
#include <hip/hip_runtime.h>
#include <cstdio>
#include <cstdint>
#include <cmath>

#ifndef I8_IN
#define I8_IN 1
#endif
#ifndef ATT_CINIT
#define ATT_CINIT 1
#endif
constexpr float CS_DIFF = 0.125f * 1.4426950408889634f;
#ifndef CONV_FUSE
#define CONV_FUSE 1
#endif
#ifndef I8_MID
#define I8_MID 1
#endif
#ifndef I8_UP
#define I8_UP 1
#endif
#ifndef FP8_DOWN
#define FP8_DOWN 1
#endif
constexpr float S_WD = 1024.f, S_ACT8 = 8.f;
#ifndef REP_GEMM
#define REP_GEMM 1
#endif
#ifndef REP_DIFF
#define REP_DIFF 1
#endif
#ifndef REP_MLA
#define REP_MLA 1
#endif
#if REP_GEMM == 1
#define REP_LOOP_GEMM
#else
#define REP_LOOP_GEMM _Pragma("unroll 1") for (int rep = 0; rep < REP_GEMM; ++rep)
#endif
#ifndef MK_PER_STEP_LAUNCH
#define MK_PER_STEP_LAUNCH 0
#endif

typedef unsigned short bf16;
typedef short bf16x8 __attribute__((ext_vector_type(8)));
typedef short s16x4 __attribute__((ext_vector_type(4)));
typedef float f32x4 __attribute__((ext_vector_type(4)));
typedef float f32x2 __attribute__((ext_vector_type(2)));
typedef float f32x16 __attribute__((ext_vector_type(16)));
typedef unsigned u32x4 __attribute__((ext_vector_type(4)));
typedef unsigned u32x2 __attribute__((ext_vector_type(2)));
typedef int i32x4 __attribute__((ext_vector_type(4)));
typedef int i32x8 __attribute__((ext_vector_type(8)));
#define LAS __attribute__((address_space(3)))

__device__ __forceinline__ unsigned cvt_pk_bf16(float lo, float hi) { unsigned r; asm volatile("v_cvt_pk_bf16_f32 %0, %1, %2" : "=v"(r) : "v"(lo), "v"(hi)); return r; }
__device__ __forceinline__ float bf_lo(unsigned w) { return __uint_as_float(w << 16); }
__device__ __forceinline__ float bf_hi(unsigned w) { return __uint_as_float(w & 0xffff0000u); }
__device__ __forceinline__ float clamp448(float x) { return __builtin_fminf(__builtin_fmaxf(x, -448.f), 448.f); }
__device__ __forceinline__ unsigned pack4_fp8(float a, float b, float c, float d) { int w = 0; w = __builtin_amdgcn_cvt_pk_fp8_f32(clamp448(a), clamp448(b), w, false); w = __builtin_amdgcn_cvt_pk_fp8_f32(clamp448(c), clamp448(d), w, true); return (unsigned)w; }
__device__ __forceinline__ unsigned pack4_i8(float a, float b, float c, float d) { const int ia = (int)__builtin_rintf(a), ib = (int)__builtin_rintf(b), ic = (int)__builtin_rintf(c), id = (int)__builtin_rintf(d);
    return (unsigned)(ia & 255) | ((unsigned)(ib & 255) << 8) | ((unsigned)(ic & 255) << 16) | ((unsigned)id << 24); }
__device__ __forceinline__ float fast_sigmoid(float x) { return __builtin_amdgcn_rcpf(1.0f + __builtin_amdgcn_exp2f(-1.4426950408889634f * x)); }

__device__ __forceinline__ int lane_id_fresh() { unsigned ones = ~0u; asm volatile("" : "+s"(ones)); return (int)__builtin_amdgcn_mbcnt_hi(ones, __builtin_amdgcn_mbcnt_lo(ones, 0u)); }

constexpr int DM = 4096, NTOK = 32768, TG = 8192, NGRP = 4;
constexpr int NIN = 16128;
constexpr int C_DQ = 0, C_DK = 2048, C_DV = 4096, C_QLAT = 6144, C_KVLAT = 7168, C_GATE = 7680, C_KPE = 15872;
constexpr int DFF = 11008, NUP = 22016, NQ = 3072, NKV = 4096;
constexpr float EPS = 1e-6f;

constexpr size_t MiB = 1u << 20;
constexpr size_t WS_CTL = 0, CTL_ZERO_BYTES = 1 * MiB;
constexpr size_t WS_COS = 1 * MiB, WS_SIN = 2 * MiB, WS_BIAS = 3 * MiB, WS_LAM = 3 * MiB + 32768;
constexpr size_t WS_CSIN = 3 * MiB + 65536, WS_CSUP = 3 * MiB + 131072, WS_RSH = 3 * MiB + 262144;
constexpr size_t WS_CSQ = 3 * MiB + 320 * 1024, WS_CSKV = 3 * MiB + 336 * 1024, WS_CSA = 3 * MiB + 352 * 1024, WS_CSB = 3 * MiB + 368 * 1024, WS_CSO = 3 * MiB + 384 * 1024;
constexpr size_t WS_RSQL = 3 * MiB + 400 * 1024, WS_RSKVL = 3 * MiB + 432 * 1024, WS_RSA = 3 * MiB + 464 * 1024, WS_RSB = 3 * MiB + 496 * 1024, WS_RSM = 3 * MiB + 528 * 1024;
constexpr int CW_CMAX_IN = 16384, CW_CMAX_UP = 32768, CW_CMAX_Q = 57344, CW_CMAX_KV = 61440, CW_CMAX_A = 65536, CW_CMAX_B = 69632, CW_CMAX_O = 73728;
constexpr size_t WS_WIN = 4 * MiB, WS_WQ = 130 * MiB, WS_WKV = 136 * MiB, WS_WA = 140 * MiB, WS_WB = 156 * MiB, WS_WO = 172 * MiB, WS_WUP = 204 * MiB, WS_WD = 376 * MiB;
constexpr size_t WS_ACT = 462 * MiB;
constexpr size_t WS_H = WS_ACT, WS_P = WS_ACT + 64 * MiB, WS_Q = WS_ACT + 316 * MiB, WS_KV = WS_ACT + 364 * MiB, WS_AO = WS_ACT + 428 * MiB, WS_BO = WS_ACT + 460 * MiB, WS_MG = WS_ACT + 492 * MiB, WS_STASH = WS_ACT + 556 * MiB;
constexpr size_t WS_Y = WS_ACT + 64 * MiB, WS_ACTV = WS_ACT + 408 * MiB;
constexpr size_t WS_QL8 = WS_ACT + 588 * MiB, WS_KVL8 = WS_ACT + 596 * MiB, WS_AO8 = WS_ACT + 600 * MiB, WS_BO8 = WS_ACT + 616 * MiB, WS_MG8 = WS_ACT + 632 * MiB;
constexpr size_t WS_X1 = WS_ACT + 664 * MiB;
constexpr size_t WS_END = WS_ACT + 728 * MiB;
static_assert(WS_WIN + (size_t)NIN * DM * 2 <= WS_WQ && WS_WUP + (size_t)NUP * DM * 2 <= WS_WD && WS_WD + (size_t)DM * DFF * 2 <= WS_ACT, "weight map");
static_assert(WS_P + (size_t)TG * NIN * 2 <= WS_Q && WS_Y + (size_t)TG * NUP * 2 <= WS_ACTV && WS_ACTV + (size_t)TG * DFF * 2 <= WS_STASH + 32 * MiB, "activation map");

namespace pg8 {
constexpr int BM = 256, BK = 64, HALF = 128, HTB = HALF * BK * 2, STAGE_BYTES = 8 * HTB, NXCD = 8, WGM = 8;
__host__ __device__ __forceinline__ int lds_byte(int r, int c) { const int st = (r >> 4) * 2 + (c >> 5), rr = r & 15, cc = c & 31, ob = rr * 64 + cc * 2; return st * 1024 + (ob ^ (((ob >> 9) & 1) << 5)); }
__host__ __device__ __forceinline__ void stage_rc(int b, int& R, int& C) { const int st = b / 1024, sb = b % 1024, swz = sb ^ (((sb >> 9) & 1) << 5); R = (st >> 1) * 16 + swz / 64; C = (st & 1) * 32 + (swz % 64) / 2; }
__host__ __device__ __forceinline__ int perm32(int rho) { const int n = rho >> 4, i = rho & 15; return 8 * (i >> 2) + 4 * n + (i & 3); }

struct Unit { int pm, pn; };
struct Gemm { const bf16* A; int lda; const bf16* Bt; int M, N, K; };

struct StaticOrder {
    int nM, nN, nwg, G, c;
    __device__ void init(int M, int N, int G_, int c_) { nM = M / BM; nN = N / BM; nwg = nM * nN; G = G_; c = c_; }
    __device__ bool next(int i, Unit& u) const {
        const long L = (long)i * G + c; if (L >= nwg) return false;
        int wgid = (int)L; { const int q = nwg / NXCD, r = nwg % NXCD, xcd = wgid % NXCD, off = wgid / NXCD; wgid = (xcd < r ? xcd * (q + 1) : r * (q + 1) + (xcd - r) * q) + off; }
        const int nig = WGM * nN, gid = wgid / nig, fm = gid * WGM, gsz = (nM - fm) < WGM ? (nM - fm) : WGM;
        u.pm = fm + ((wgid % nig) % gsz); u.pn = (wgid % nig) / gsz; return true;
    }
};

template <int MODE> struct AccSel { typedef f32x4 T; }; template <> struct AccSel<2> { typedef i32x4 T; };
__device__ __forceinline__ f32x4 tof(f32x4 v) { return v; }
__device__ __forceinline__ f32x4 tof(i32x4 v) { return __builtin_convertvector(v, f32x4); }

template <class Epi, int MODE = 0>
__device__ __forceinline__ void gemm_phase(LAS unsigned char* lds, const Gemm g, const StaticOrder& S, const Epi& E, int tid_in) {
    int tid = tid_in; asm volatile("" : "+v"(tid));
    const int wid = __builtin_amdgcn_readfirstlane(tid >> 6), lane = tid & 63, wr = wid >> 2, wc = wid & 3, fr = lane & 15, fq = lane >> 4;
    int K = g.K, lda = g.lda; asm volatile("" : "+s"(K), "+s"(lda));
    const int nt = K / BK;
    unsigned voffA[2], voffB[2];
#pragma unroll
    for (int i = 0; i < 2; ++i) { int R, C; stage_rc(tid * 16 + i * 8192, R, C); const int Rb = (R & ~31) + perm32(R & 31);
        voffA[i] = (unsigned)(R * lda + C) * 2u; voffB[i] = (unsigned)(Rb * K + C) * 2u; }
    const size_t kstep = (size_t)(BK * 2);
    const size_t hstepA = (size_t)HALF * lda * 2, hstepB = (size_t)HALF * K * 2;
    const size_t tstepA = 2 * hstepA, tstepB = 2 * hstepB;
    const unsigned ldsw = (unsigned)wid * 1024u;
    const int aoff = lds_byte(wr * 64 + fr, fq * 8), boff = lds_byte(wc * 32 + fr, fq * 8);
#define PG8_SA(b, h) (((b) * 2 + (h)) * HTB)
#define PG8_SB(b, h) ((4 + (b) * 2 + (h)) * HTB)
#define PG8_STAGE(bufoff, gbase, voff) do { _Pragma("unroll") for (int _i = 0; _i < 2; ++_i) \
        __builtin_amdgcn_global_load_lds((const unsigned*)((const char*)(gbase) + (voff)[_i]), (LAS unsigned*)(lds + (bufoff) + ldsw + _i * 8192), 16, 0, 0); } while (0)
#define PG8_CAT(x, y) __builtin_shufflevector(__builtin_bit_cast(i32x4, x), __builtin_bit_cast(i32x4, y), 0, 1, 2, 3, 4, 5, 6, 7)
#define PG8_LDA(dst, b, h) do { _Pragma("unroll") for (int m = 0; m < 4; ++m) dst[m] = PG8_CAT(*(const LAS bf16x8*)(lds + PG8_SA(b, h) + aoff + m * 2048), *(const LAS bf16x8*)(lds + PG8_SA(b, h) + aoff + m * 2048 + 1024)); } while (0)
#define PG8_LDB(dst, b, h) do { _Pragma("unroll") for (int n = 0; n < 2; ++n) dst[n] = PG8_CAT(*(const LAS bf16x8*)(lds + PG8_SB(b, h) + boff + n * 2048), *(const LAS bf16x8*)(lds + PG8_SB(b, h) + boff + n * 2048 + 1024)); } while (0)
#define PG8_LO4(v) __builtin_shufflevector(v, v, 0, 1, 2, 3)
#define PG8_HI4(v) __builtin_shufflevector(v, v, 4, 5, 6, 7)
#define PG8_LO(v) __builtin_bit_cast(bf16x8, __builtin_shufflevector(v, v, 0, 1, 2, 3))
#define PG8_HI(v) __builtin_bit_cast(bf16x8, __builtin_shufflevector(v, v, 4, 5, 6, 7))
#define PG8_MMA(ai, bj, At, Bt) do { __builtin_amdgcn_s_setprio(1); _Pragma("unroll") for (int m = 0; m < 4; ++m) _Pragma("unroll") for (int n = 0; n < 2; ++n) { \
        if constexpr (F8) asm volatile("v_mfma_f32_16x16x128_f8f6f4 %0, %1, %2, %0" : "+v"(acc[ai][bj][m][n]) : "v"(Bt[n]), "v"(At[m]));   \
        else if constexpr (MODE == 2) { acc[ai][bj][m][n] = __builtin_amdgcn_mfma_i32_16x16x64_i8(PG8_LO4(Bt[n]), PG8_LO4(At[m]), acc[ai][bj][m][n], 0, 0, 0); \
               acc[ai][bj][m][n] = __builtin_amdgcn_mfma_i32_16x16x64_i8(PG8_HI4(Bt[n]), PG8_HI4(At[m]), acc[ai][bj][m][n], 0, 0, 0); } \
        else { acc[ai][bj][m][n] = __builtin_amdgcn_mfma_f32_16x16x32_bf16(PG8_LO(Bt[n]), PG8_LO(At[m]), acc[ai][bj][m][n], 0, 0, 0); \
               acc[ai][bj][m][n] = __builtin_amdgcn_mfma_f32_16x16x32_bf16(PG8_HI(Bt[n]), PG8_HI(At[m]), acc[ai][bj][m][n], 0, 0, 0); } } __builtin_amdgcn_s_setprio(0); } while (0)
#define PG8_WAIT_V(n) asm volatile("s_waitcnt vmcnt(" #n ")" ::: "memory")
#define PG8_WAIT_L(n) asm volatile("s_waitcnt lgkmcnt(" #n ")" ::: "memory")
#define PG8_BAR __builtin_amdgcn_s_barrier()
#define PG8_SCHED __builtin_amdgcn_sched_barrier(0)
    Unit cur, nxt; int ui = 0;
    if (!S.next(0, cur)) return;
    constexpr bool F8 = (MODE == 1); typedef typename AccSel<MODE>::T AccT; AccT acc[2][2][4][2];
#pragma unroll
    for (int a = 0; a < 2; ++a)
#pragma unroll
        for (int b = 0; b < 2; ++b)
#pragma unroll
            for (int m = 0; m < 4; ++m)
#pragma unroll
                for (int n = 0; n < 2; ++n) acc[a][b][m][n] = AccT{};
    i32x8 At[4], B0[2], B1[2];
    const char* cA = (const char*)g.A + (size_t)cur.pm * tstepA; const char* cB = (const char*)g.Bt + (size_t)cur.pn * tstepB;
    PG8_STAGE(PG8_SB(0, 0), cB, voffB); PG8_STAGE(PG8_SB(0, 1), cB + hstepB, voffB); PG8_STAGE(PG8_SA(0, 0), cA, voffA); PG8_STAGE(PG8_SA(0, 1), cA + hstepA, voffA);
    if (wr == 1) PG8_BAR;
    PG8_WAIT_V(2); PG8_BAR;
    PG8_STAGE(PG8_SB(1, 0), cB + kstep, voffB); PG8_STAGE(PG8_SA(1, 0), cA + kstep, voffA); PG8_STAGE(PG8_SB(1, 1), cB + hstepB + kstep, voffB);
    PG8_WAIT_V(6); PG8_BAR;
    for (;;) {
        const bool has_next = S.next(ui + 1, nxt);
        const char* nA = has_next ? (const char*)g.A + (size_t)nxt.pm * tstepA : cA; const char* nB = has_next ? (const char*)g.Bt + (size_t)nxt.pn * tstepB : cB;
        for (int t = 0; t < nt; t += 2) {
            const bool last = (t == nt - 2);
            const char* a1 = cA + (size_t)(t + 1) * kstep;
            const char* a2 = last ? nA : cA + (size_t)(t + 2) * kstep; const char* b2 = last ? nB : cB + (size_t)(t + 2) * kstep;
            const char* a3 = a2 + kstep; const char* b3 = b2 + kstep;
            PG8_LDB(B0, 0, 0); PG8_LDB(B1, 0, 1); PG8_SCHED; PG8_LDA(At, 0, 0); PG8_STAGE(PG8_SA(1, 1), a1 + hstepA, voffA);
            PG8_WAIT_V(8); PG8_WAIT_L(0); PG8_BAR; PG8_MMA(0, 0, At, B0); PG8_MMA(0, 1, At, B1); PG8_BAR; PG8_SCHED;
            PG8_LDA(At, 0, 1); PG8_STAGE(PG8_SB(0, 0), b2, voffB); PG8_STAGE(PG8_SB(0, 1), b2 + hstepB, voffB); PG8_STAGE(PG8_SA(0, 0), a2, voffA);
            PG8_WAIT_V(8); PG8_WAIT_L(0); PG8_BAR; PG8_MMA(1, 0, At, B0); PG8_MMA(1, 1, At, B1); PG8_BAR; PG8_SCHED;
            PG8_LDB(B0, 1, 0); PG8_LDB(B1, 1, 1); PG8_SCHED; PG8_LDA(At, 1, 0); PG8_STAGE(PG8_SA(0, 1), a2 + hstepA, voffA);
            PG8_WAIT_V(8); PG8_WAIT_L(0); PG8_BAR; PG8_MMA(0, 0, At, B0); PG8_MMA(0, 1, At, B1); PG8_BAR; PG8_SCHED;
            PG8_LDA(At, 1, 1); PG8_STAGE(PG8_SB(1, 0), b3, voffB); PG8_STAGE(PG8_SB(1, 1), b3 + hstepB, voffB); PG8_STAGE(PG8_SA(1, 0), a3, voffA);
            PG8_WAIT_V(8); PG8_WAIT_L(0); PG8_BAR; PG8_MMA(1, 0, At, B0); PG8_MMA(1, 1, At, B1); PG8_BAR; PG8_SCHED;
        }
        if (wr == 0) PG8_BAR;
        if constexpr (F8) asm volatile("s_nop 15\n\ts_nop 15" ::: "memory");
        { int l3_ = lane_id_fresh(); asm volatile("" : "+v"(l3_)); E(acc, cur, wr, wc, l3_ & 15, l3_ >> 4); }
        if (!has_next) break;
#pragma unroll
        for (int a = 0; a < 2; ++a)
#pragma unroll
            for (int b = 0; b < 2; ++b)
#pragma unroll
                for (int m = 0; m < 4; ++m)
#pragma unroll
                    for (int n = 0; n < 2; ++n) acc[a][b][m][n] = AccT{};
        cur = nxt; cA = nA; cB = nB; ++ui;
        if (wr == 1) PG8_BAR;
    }
    PG8_WAIT_V(0);
    PG8_BAR;
#undef PG8_SA
#undef PG8_SB
#undef PG8_STAGE
#undef PG8_LDA
#undef PG8_LDB
#undef PG8_MMA
#undef PG8_CAT
#undef PG8_LO
#undef PG8_LO4
#undef PG8_HI4
#undef PG8_HI
#undef PG8_WAIT_V
#undef PG8_WAIT_L
#undef PG8_BAR
#undef PG8_SCHED
}

template <bool SC, size_t RSOFF = 0, size_t CSOFF = 0> struct EpiStoreT {
    bf16* O; int ldc; int sig_lo, sig_hi; float scale; const unsigned char* wsb;
    template <class AccT> __device__ __forceinline__ void operator()(const AccT (&acc)[2][2][4][2], const Unit& u, int wr, int wc, int fr, int fq) const {
        const bool sig = (u.pn >= sig_lo && u.pn < sig_hi);
        const int row0 = u.pm * BM + wr * 64 + fr, col0 = u.pn * BM + wc * 32 + 8 * fq;
        const float* rs = (const float*)(wsb + RSOFF); const float* cs = (const float*)(wsb + CSOFF);
        const float tsc = (u.pn < 8) ? scale : 1.f;
        f32x4 cv[2][2];
#pragma unroll
        for (int bj = 0; bj < 2; ++bj) { if constexpr (SC) { cv[bj][0] = *(const f32x4*)(cs + col0 + bj * HALF) * tsc; cv[bj][1] = *(const f32x4*)(cs + col0 + bj * HALF + 4) * tsc; } else { cv[bj][0] = (f32x4){tsc, tsc, tsc, tsc}; cv[bj][1] = cv[bj][0]; } }
#pragma unroll
        for (int ai = 0; ai < 2; ++ai)
#pragma unroll
            for (int m = 0; m < 4; ++m) { bf16* rowp = O + (size_t)(row0 + ai * HALF + m * 16) * ldc + col0; float rsv = 1.f; if constexpr (SC) rsv = rs[row0 + ai * HALF + m * 16];
#pragma unroll
                for (int bj = 0; bj < 2; ++bj) { f32x4 v0 = tof(acc[ai][bj][m][0]) * (cv[bj][0] * rsv), v1 = tof(acc[ai][bj][m][1]) * (cv[bj][1] * rsv);
                    if (sig) {
#pragma unroll
                        for (int j = 0; j < 4; ++j) { v0[j] = fast_sigmoid(v0[j]); v1[j] = fast_sigmoid(v1[j]); } }
                    u32x4 w; w.x = cvt_pk_bf16(v0[0], v0[1]); w.y = cvt_pk_bf16(v0[2], v0[3]); w.z = cvt_pk_bf16(v1[0], v1[1]); w.w = cvt_pk_bf16(v1[2], v1[3]);
                    *(u32x4*)(rowp + bj * HALF) = w; }
                asm volatile("" ::: "memory"); }
    }
};
template <bool SC> struct EpiQT {
    bf16* O; int ldc; const unsigned char* wsb; int posmask;
    template <class AccT> __device__ __forceinline__ void operator()(const AccT (&acc)[2][2][4][2], const Unit& u, int wr, int wc, int fr, int fq) const {
        const bool rope = (u.pn >= 8);
        const int row0 = u.pm * BM + wr * 64 + fr, col0 = u.pn * BM + wc * 32 + 8 * fq;
        const float* cosT = (const float*)(wsb + WS_COS); const float* sinT = (const float*)(wsb + WS_SIN); const float* rs = (const float*)(wsb + WS_RSQL); const float* cs = (const float*)(wsb + WS_CSQ);
        f32x4 cv[2][2];
#pragma unroll
        for (int bj = 0; bj < 2; ++bj) { if constexpr (SC) { cv[bj][0] = *(const f32x4*)(cs + col0 + bj * HALF); cv[bj][1] = *(const f32x4*)(cs + col0 + bj * HALF + 4); } else { cv[bj][0] = (f32x4){1.f, 1.f, 1.f, 1.f}; cv[bj][1] = cv[bj][0]; } }
#pragma unroll
        for (int ai = 0; ai < 2; ++ai)
#pragma unroll
            for (int m = 0; m < 4; ++m) { const int row = row0 + ai * HALF + m * 16; bf16* rowp = O + (size_t)row * ldc + col0; const int pos = row & posmask; float rsv = 1.f; if constexpr (SC) rsv = rs[row];
#pragma unroll
                for (int bj = 0; bj < 2; ++bj) { f32x4 v0 = tof(acc[ai][bj][m][0]) * (cv[bj][0] * rsv), v1 = tof(acc[ai][bj][m][1]) * (cv[bj][1] * rsv);
                    if (rope) { const int i0 = (((col0 + bj * HALF) & 63) >> 1);
                        const f32x4 c = *(const f32x4*)(cosT + (size_t)pos * 32 + i0), s = *(const f32x4*)(sinT + (size_t)pos * 32 + i0);
                        f32x4 a, b;
                        a[0] = v0[0] * c[0] - v0[1] * s[0]; a[1] = v0[0] * s[0] + v0[1] * c[0]; a[2] = v0[2] * c[1] - v0[3] * s[1]; a[3] = v0[2] * s[1] + v0[3] * c[1];
                        b[0] = v1[0] * c[2] - v1[1] * s[2]; b[1] = v1[0] * s[2] + v1[1] * c[2]; b[2] = v1[2] * c[3] - v1[3] * s[3]; b[3] = v1[2] * s[3] + v1[3] * c[3];
                        v0 = a; v1 = b; }
                    u32x4 w; w.x = cvt_pk_bf16(v0[0], v0[1]); w.y = cvt_pk_bf16(v0[2], v0[3]); w.z = cvt_pk_bf16(v1[0], v1[1]); w.w = cvt_pk_bf16(v1[2], v1[3]);
                    *(u32x4*)(rowp + bj * HALF) = w; } }
    }
};
template <bool SC> struct EpiGateAT {
    bf16* part; int ldp; const bf16* gate; int ldg; const unsigned char* wsb;
    template <class AccT> __device__ __forceinline__ void operator()(const AccT (&acc)[2][2][4][2], const Unit& u, int wr, int wc, int fr, int fq) const {
        const int row0 = u.pm * BM + wr * 64 + fr, col0 = u.pn * BM + wc * 32 + 8 * fq;
        const float* rs = (const float*)(wsb + WS_RSA); const float* cs = (const float*)(wsb + WS_CSA);
        f32x4 cv[2][2];
#pragma unroll
        for (int bj = 0; bj < 2; ++bj) { if constexpr (SC) { cv[bj][0] = *(const f32x4*)(cs + col0 + bj * HALF); cv[bj][1] = *(const f32x4*)(cs + col0 + bj * HALF + 4); } else { cv[bj][0] = (f32x4){1.f, 1.f, 1.f, 1.f}; cv[bj][1] = cv[bj][0]; } }
#pragma unroll
        for (int ai = 0; ai < 2; ++ai) {
            u32x4 gw[4][2]; float rsv[4];
#pragma unroll
            for (int m = 0; m < 4; ++m) { const size_t row = (size_t)(row0 + ai * HALF + m * 16); rsv[m] = 1.f; if constexpr (SC) rsv[m] = rs[row];
#pragma unroll
                for (int bj = 0; bj < 2; ++bj) gw[m][bj] = *(const u32x4*)(gate + row * ldg + col0 + bj * HALF); }
#pragma unroll
            for (int m = 0; m < 4; ++m) { const size_t row = (size_t)(row0 + ai * HALF + m * 16);
#pragma unroll
                for (int bj = 0; bj < 2; ++bj) { const f32x4 v0 = tof(acc[ai][bj][m][0]) * (cv[bj][0] * rsv[m]), v1 = tof(acc[ai][bj][m][1]) * (cv[bj][1] * rsv[m]); const u32x4 g = gw[m][bj];
                    u32x4 w; w.x = cvt_pk_bf16(v0[0] * bf_lo(g.x), v0[1] * bf_hi(g.x)); w.y = cvt_pk_bf16(v0[2] * bf_lo(g.y), v0[3] * bf_hi(g.y)); w.z = cvt_pk_bf16(v1[0] * bf_lo(g.z), v1[1] * bf_hi(g.z)); w.w = cvt_pk_bf16(v1[2] * bf_lo(g.w), v1[3] * bf_hi(g.w));
                    *(u32x4*)(part + row * ldp + col0 + bj * HALF) = w; } }
            asm volatile("" ::: "memory");
        }
    }
};
template <bool SC> struct EpiGateBT {
    const bf16* part; int ldp; const bf16* gate; int ldg; bf16* O; int ldc; const unsigned char* wsb;
    template <class AccT> __device__ __forceinline__ void operator()(const AccT (&acc)[2][2][4][2], const Unit& u, int wr, int wc, int fr, int fq) const {
        const int row0 = u.pm * BM + wr * 64 + fr, col0 = u.pn * BM + wc * 32 + 8 * fq;
        const float* rs = (const float*)(wsb + WS_RSB); const float* cs = (const float*)(wsb + WS_CSB);
        f32x4 cv[2][2];
#pragma unroll
        for (int bj = 0; bj < 2; ++bj) { if constexpr (SC) { cv[bj][0] = *(const f32x4*)(cs + col0 + bj * HALF); cv[bj][1] = *(const f32x4*)(cs + col0 + bj * HALF + 4); } else { cv[bj][0] = (f32x4){1.f, 1.f, 1.f, 1.f}; cv[bj][1] = cv[bj][0]; } }
#pragma unroll
        for (int ai = 0; ai < 2; ++ai) {
            u32x4 gw[4][2], pw[4][2]; float rsv[4];
#pragma unroll
            for (int m = 0; m < 4; ++m) { const size_t row = (size_t)(row0 + ai * HALF + m * 16); rsv[m] = 1.f; if constexpr (SC) rsv[m] = rs[row];
#pragma unroll
                for (int bj = 0; bj < 2; ++bj) { gw[m][bj] = *(const u32x4*)(gate + row * ldg + col0 + bj * HALF); pw[m][bj] = *(const u32x4*)(part + row * ldp + col0 + bj * HALF); } }
#pragma unroll
            for (int m = 0; m < 4; ++m) { const size_t row = (size_t)(row0 + ai * HALF + m * 16);
#pragma unroll
                for (int bj = 0; bj < 2; ++bj) { const f32x4 v0 = tof(acc[ai][bj][m][0]) * (cv[bj][0] * rsv[m]), v1 = tof(acc[ai][bj][m][1]) * (cv[bj][1] * rsv[m]); const u32x4 g = gw[m][bj], p = pw[m][bj];
                    u32x4 w; w.x = cvt_pk_bf16(bf_lo(p.x) + v0[0] * bf_lo(g.x), bf_hi(p.x) + v0[1] * bf_hi(g.x)); w.y = cvt_pk_bf16(bf_lo(p.y) + v0[2] * bf_lo(g.y), bf_hi(p.y) + v0[3] * bf_hi(g.y));
                    w.z = cvt_pk_bf16(bf_lo(p.z) + v1[0] * bf_lo(g.z), bf_hi(p.z) + v1[1] * bf_hi(g.z)); w.w = cvt_pk_bf16(bf_lo(p.w) + v1[2] * bf_lo(g.w), bf_hi(p.w) + v1[3] * bf_hi(g.w));
                    *(u32x4*)(O + row * ldc + col0 + bj * HALF) = w; } }
            asm volatile("" ::: "memory");
        }
    }
};
template <bool SC, bool SRCB> struct EpiResT {
    const void* src; bf16* dst; int ld; float scale; const unsigned char* wsb;
    template <class AccT> __device__ __forceinline__ void operator()(const AccT (&acc)[2][2][4][2], const Unit& u, int wr, int wc, int fr, int fq) const {
        const int row0 = u.pm * BM + wr * 64 + fr, col0 = u.pn * BM + wc * 32 + 8 * fq;
        const float* rs = (const float*)(wsb + WS_RSM); const float* cs = (const float*)(wsb + WS_CSO);
        f32x4 cv[2][2];
#pragma unroll
        for (int bj = 0; bj < 2; ++bj) { if constexpr (SC) { cv[bj][0] = *(const f32x4*)(cs + col0 + bj * HALF); cv[bj][1] = *(const f32x4*)(cs + col0 + bj * HALF + 4); } else { cv[bj][0] = (f32x4){scale, scale, scale, scale}; cv[bj][1] = cv[bj][0]; } }
#pragma unroll
        for (int ai = 0; ai < 2; ++ai)
#pragma unroll
            for (int mh = 0; mh < 2; ++mh) {
                f32x4 sv[2][2][2]; float rsv[2];
#pragma unroll
                for (int mm = 0; mm < 2; ++mm) { const int m = 2 * mh + mm; const size_t off = (size_t)(row0 + ai * HALF + m * 16) * ld + col0; rsv[mm] = 1.f; if constexpr (SC) rsv[mm] = rs[row0 + ai * HALF + m * 16];
#pragma unroll
                    for (int bj = 0; bj < 2; ++bj) {
                        if constexpr (SRCB) { const u32x4 w = *(const u32x4*)((const bf16*)src + off + bj * HALF); sv[mm][bj][0] = (f32x4){bf_lo(w.x), bf_hi(w.x), bf_lo(w.y), bf_hi(w.y)}; sv[mm][bj][1] = (f32x4){bf_lo(w.z), bf_hi(w.z), bf_lo(w.w), bf_hi(w.w)}; }
                        else { const float* sp = (const float*)src + off + bj * HALF; sv[mm][bj][0] = *(const f32x4*)sp; sv[mm][bj][1] = *(const f32x4*)(sp + 4); } } }
#pragma unroll
                for (int mm = 0; mm < 2; ++mm) { const int m = 2 * mh + mm; const size_t off = (size_t)(row0 + ai * HALF + m * 16) * ld + col0;
#pragma unroll
                    for (int bj = 0; bj < 2; ++bj) { const f32x4 o0 = sv[mm][bj][0] + tof(acc[ai][bj][m][0]) * (cv[bj][0] * rsv[mm]), o1 = sv[mm][bj][1] + tof(acc[ai][bj][m][1]) * (cv[bj][1] * rsv[mm]);
                        u32x4 w; w.x = cvt_pk_bf16(o0[0], o0[1]); w.y = cvt_pk_bf16(o0[2], o0[3]); w.z = cvt_pk_bf16(o1[0], o1[1]); w.w = cvt_pk_bf16(o1[2], o1[3]); *(u32x4*)(dst + off + bj * HALF) = w; } }
                asm volatile("" ::: "memory");
            }
    }
};

__device__ __forceinline__ float dpp_from_prev_lane(float v) { return __builtin_bit_cast(float, __builtin_amdgcn_update_dpp(0, __builtin_bit_cast(int, v), 0x121, 0xF, 0xF, false)); }
__device__ __forceinline__ float dpp_from_next_lane(float v) { return __builtin_bit_cast(float, __builtin_amdgcn_update_dpp(0, __builtin_bit_cast(int, v), 0x12F, 0xF, 0xF, false)); }
struct EpiConv {
    unsigned char* act; bf16* yb; const float* cw; const float* cb; const unsigned char* wsb; float oscale;
    template <class AccT> __device__ __forceinline__ void operator()(const AccT (&acc)[2][2][4][2], const Unit& u, int wr, int wc, int fr, int fq) const {
        const float* rs = (const float*)(wsb + WS_RSH); const float* cs = (const float*)(wsb + WS_CSUP);
#pragma unroll
        for (int n = 0; n < 2; ++n) {
            const int ch0 = wc * 32 + 8 * fq + 4 * n, cg = u.pn * 128 + ch0, colg = u.pn * BM + ch0;
            const f32x4 csg = *(const f32x4*)(cs + colg), csu = *(const f32x4*)(cs + colg + HALF), bg = *(const f32x4*)(cb + cg), bu = *(const f32x4*)(cb + DFF + cg);
            f32x4 wg[3], wu[3];
#pragma unroll
            for (int t = 0; t < 3; ++t) { wg[t] = *(const f32x4*)(cw + t * NUP + cg); wu[t] = *(const f32x4*)(cw + t * NUP + DFF + cg); }
#pragma unroll
            for (int ai = 0; ai < 2; ++ai) {
                const int rowb = u.pm * BM + ai * HALF + wr * 64;
                f32x4 yg[4], yu[4];
#pragma unroll
                for (int m = 0; m < 4; ++m) { const float rsv = rs[rowb + 16 * m + fr]; yg[m] = tof(acc[ai][0][m][n]) * (csg * rsv); yu[m] = tof(acc[ai][1][m][n]) * (csu * rsv); }
                if (fr < 2 || fr >= 14) { const bool lo = fr < 2; bf16* yr = yb + ((size_t)(rowb >> 6) * 4 + (lo ? fr : fr - 12)) * NUP + colg;
                    const f32x4 a0 = lo ? yg[0] : yg[3], b0 = lo ? yu[0] : yu[3];
                    u32x2 w; w.x = cvt_pk_bf16(a0[0], a0[1]); w.y = cvt_pk_bf16(a0[2], a0[3]); *(u32x2*)yr = w;
                    w.x = cvt_pk_bf16(b0[0], b0[1]); w.y = cvt_pk_bf16(b0[2], b0[3]); *(u32x2*)(yr + HALF) = w; }
#pragma unroll
                for (int m = 0; m < 4; ++m) {
                    float o[4];
#pragma unroll
                    for (int e = 0; e < 4; ++e) {
                        const float gc = yg[m][e], uc = yu[m][e];
                        const float gsp = (m > 0 && fr == 15) ? yg[m > 0 ? m - 1 : 0][e] : gc, usp = (m > 0 && fr == 15) ? yu[m > 0 ? m - 1 : 0][e] : uc;
                        const float gsn = (m < 3 && fr == 0) ? yg[m < 3 ? m + 1 : 3][e] : gc, usn = (m < 3 && fr == 0) ? yu[m < 3 ? m + 1 : 3][e] : uc;
                        const float gp = dpp_from_prev_lane(gsp), up = dpp_from_prev_lane(usp), gn = dpp_from_next_lane(gsn), un = dpp_from_next_lane(usn);
                        const float ug = wg[0][e] * gp + wg[1][e] * gc + wg[2][e] * gn + bg[e];
                        const float uu = wu[0][e] * up + wu[1][e] * uc + wu[2][e] * un + bu[e];
                        o[e] = ug * fast_sigmoid(ug) * uu * oscale; }
                    const bool edge = (m == 0 && fr == 0) || (m == 3 && fr == 15);
                    if (!edge) { const size_t row = (size_t)(rowb + 16 * m + fr);
                        if (FP8_DOWN) *(unsigned*)(act + row * DFF + cg) = pack4_fp8(o[0], o[1], o[2], o[3]);
                        else { u32x2 w; w.x = cvt_pk_bf16(o[0], o[1]); w.y = cvt_pk_bf16(o[2], o[3]); *(u32x2*)((bf16*)act + row * DFF + cg) = w; } }
                }
                asm volatile("" ::: "memory");
            }
        }
    }
};
}

namespace att {
constexpr int OFF_V = 0, SHM_V = 16384, OFF_K = 32768, KROW = 144  , SHM_KP = 64 * KROW, OFF_WS = 32768 + 2 * 3 * SHM_KP, OFF_TBL = OFF_WS + 2048, OFF_QR = OFF_TBL + 1056, LDS_END = OFF_QR + 256 * KROW;
#define SBAR() __builtin_amdgcn_sched_barrier(0)
__device__ __forceinline__ int crow(int r, int hi) { return (r & 3) + 8 * (r >> 2) + 4 * hi; }
__device__ __forceinline__ int kswz(int row, int colB) { return row * KROW + colB; }
__device__ __forceinline__ int v_st(int k, int c) { const int kk = (k & ~0xC) | ((k & 4) << 1) | ((k & 8) >> 1); return ((kk >> 3) * 4 + (c >> 5)) * 512 + ((kk & 7) * 32 + (c & 31)) * 2; }
__device__ __forceinline__ int v_rd_base(int lane) { return ((lane & 3) << 3) | (((lane >> 2) & 3) << 6) | (((lane >> 4) & 1) << 5) | (((lane >> 5) & 1) << 8); }
constexpr int v_rd_off(int d0, int ks, int half) { return d0 * 512 + ks * 4096 + half * 2048; }
template <int OFF> __device__ __forceinline__ s16x4 tr_read(int vb) { s16x4 r; asm volatile("ds_read_b64_tr_b16 %0, %1 offset:%2" : "=&v"(r) : "v"(vb), "i"(OFF) : "memory"); return r; }
template <int D0> __device__ __forceinline__ void pv_one(f32x16& od, int vb, bf16x8 pa0, bf16x8 pa1, bf16x8 pa2, bf16x8 pa3) {
    const s16x4 l0 = tr_read<v_rd_off(D0, 0, 0)>(vb), h0 = tr_read<v_rd_off(D0, 0, 1)>(vb), l1 = tr_read<v_rd_off(D0, 1, 0)>(vb), h1 = tr_read<v_rd_off(D0, 1, 1)>(vb);
    const s16x4 l2 = tr_read<v_rd_off(D0, 2, 0)>(vb), h2 = tr_read<v_rd_off(D0, 2, 1)>(vb), l3 = tr_read<v_rd_off(D0, 3, 0)>(vb), h3 = tr_read<v_rd_off(D0, 3, 1)>(vb);
    asm volatile("s_waitcnt lgkmcnt(0)" ::: "memory"); SBAR();
#define PK(L, H) (bf16x8){L[0], L[1], L[2], L[3], H[0], H[1], H[2], H[3]}
    od = __builtin_amdgcn_mfma_f32_32x32x16_bf16(pa0, PK(l0, h0), od, 0, 0, 0);
    od = __builtin_amdgcn_mfma_f32_32x32x16_bf16(pa1, PK(l1, h1), od, 0, 0, 0);
    od = __builtin_amdgcn_mfma_f32_32x32x16_bf16(pa2, PK(l2, h2), od, 0, 0, 0);
    od = __builtin_amdgcn_mfma_f32_32x32x16_bf16(pa3, PK(l3, h3), od, 0, 0, 0);
#undef PK
}
__device__ __forceinline__ void pv_d0(f32x16* o, int vb, bf16x8 pa0, bf16x8 pa1, bf16x8 pa2, bf16x8 pa3) {
    pv_one<0>(o[0], vb, pa0, pa1, pa2, pa3); pv_one<1>(o[1], vb, pa0, pa1, pa2, pa3); pv_one<2>(o[2], vb, pa0, pa1, pa2, pa3); pv_one<3>(o[3], vb, pa0, pa1, pa2, pa3);
}
__device__ __forceinline__ float fma_s(float a, float s_uniform, float c) { float d; asm("v_fma_f32 %0, %1, %2, %3" : "=v"(d) : "v"(a), "s"(s_uniform), "v"(c)); return d; }
constexpr float THR2 = 8.0f * 1.4426950408889634f;
template <bool BIAS>
__device__ __forceinline__ void partialSM(f32x16& p0, f32x16& p1, float& m_reg, float& mn, float& alpha, float Cs, bool near, float bconst, int relbase, int hi, const LAS float* tbl) {
    float pmax;
    if (BIAS && near) {
#pragma unroll
        for (int r = 0; r < 16; ++r) { const int k = relbase + crow(r, hi);
            const int i0 = min(max(k, 0), 256), i1 = min(max(k + 32, 0), 256);
            p0[r] = fma_s(p0[r], Cs, tbl[i0]); p1[r] = fma_s(p1[r], Cs, tbl[i1]); }
        pmax = p0[0];
#pragma unroll
        for (int r = 1; r < 16; ++r) pmax = fmaxf(pmax, p0[r]);
#pragma unroll
        for (int r = 0; r < 16; ++r) pmax = fmaxf(pmax, p1[r]);
        { auto rr = __builtin_amdgcn_permlane32_swap(__float_as_uint(pmax), __float_as_uint(pmax), false, false); pmax = fmaxf(__uint_as_float(rr[0]), __uint_as_float(rr[1])); }
        if (__builtin_expect(__all(pmax - m_reg <= THR2), 1)) { mn = m_reg; alpha = 1.f; }
        else { mn = fmaxf(m_reg, pmax); alpha = __builtin_amdgcn_exp2f(m_reg - mn); m_reg = mn; }
#pragma unroll
        for (int r = 0; r < 16; ++r) { p0[r] = p0[r] - mn; p1[r] = p1[r] - mn; }
    } else {
        pmax = p0[0];
#pragma unroll
        for (int r = 1; r < 16; ++r) pmax = fmaxf(pmax, p0[r]);
#pragma unroll
        for (int r = 0; r < 16; ++r) pmax = fmaxf(pmax, p1[r]);
        { auto rr = __builtin_amdgcn_permlane32_swap(__float_as_uint(pmax), __float_as_uint(pmax), false, false); pmax = fmaxf(__uint_as_float(rr[0]), __uint_as_float(rr[1])); }
        pmax = fmaf(pmax, Cs, bconst);
        if (__builtin_expect(__all(pmax - m_reg <= THR2), 1)) { mn = m_reg; alpha = 1.f; }
        else { mn = fmaxf(m_reg, pmax); alpha = __builtin_amdgcn_exp2f(m_reg - mn); m_reg = mn; }
        const float off = bconst - mn;
#pragma unroll
        for (int r = 0; r < 16; ++r) { p0[r] = fma_s(p0[r], Cs, off); p1[r] = fma_s(p1[r], Cs, off); }
    }
#pragma unroll
    for (int r = 0; r < 16; ++r) p0[r] = __builtin_amdgcn_exp2f(p0[r]);
}
__device__ __forceinline__ void partialSM_ci(f32x16& p0, f32x16& p1, float& m_reg, float& alpha, f32x16& csp, bool first, bool near, float bcur, int relbase, int hi, const LAS float* tbl) {
    if (near) {
#pragma unroll
        for (int r = 0; r < 16; ++r) { const int k = relbase + crow(r, hi); const int i0 = min(max(k, 0), 256), i1 = min(max(k + 32, 0), 256);
            p0[r] += tbl[i0] - bcur; p1[r] += tbl[i1] - bcur; }
    }
    float pmax = p0[0];
#pragma unroll
    for (int r = 1; r < 16; ++r) pmax = fmaxf(pmax, p0[r]);
#pragma unroll
    for (int r = 0; r < 16; ++r) pmax = fmaxf(pmax, p1[r]);
    { auto rr = __builtin_amdgcn_permlane32_swap(__float_as_uint(pmax), __float_as_uint(pmax), false, false); pmax = fmaxf(__uint_as_float(rr[0]), __uint_as_float(rr[1])); }
    if (__builtin_expect(!first && __all(pmax <= THR2), 1)) { alpha = 1.f; }
    else { const float d = first ? pmax : fmaxf(pmax, 0.f); alpha = __builtin_amdgcn_exp2f(-d); m_reg += d;
#pragma unroll
        for (int r = 0; r < 16; ++r) { p0[r] -= d; p1[r] -= d; csp[r] -= d; } }
#pragma unroll
    for (int r = 0; r < 16; ++r) p0[r] = __builtin_amdgcn_exp2f(p0[r]);
}
__device__ __forceinline__ void finishSM(f32x16& p0, f32x16& p1, float alpha, float& l_reg, bf16x8& pa0, bf16x8& pa1, bf16x8& pa2, bf16x8& pa3) {
#pragma unroll
    for (int r = 0; r < 16; ++r) p1[r] = __builtin_amdgcn_exp2f(p1[r]);
    float ps = 0;
#pragma unroll
    for (int r = 0; r < 16; ++r) ps += p0[r];
#pragma unroll
    for (int r = 0; r < 16; ++r) ps += p1[r];
    { auto rr = __builtin_amdgcn_permlane32_swap(__float_as_uint(ps), __float_as_uint(ps), false, false); ps = __uint_as_float(rr[0]) + __uint_as_float(rr[1]); }
    l_reg = l_reg * alpha + ps;
#define PK4(P, BASE, OUT) do { unsigned a0 = cvt_pk_bf16(P[BASE + 0], P[BASE + 1]), a1 = cvt_pk_bf16(P[BASE + 2], P[BASE + 3]);   \
    unsigned b0 = cvt_pk_bf16(P[BASE + 4], P[BASE + 5]), b1 = cvt_pk_bf16(P[BASE + 6], P[BASE + 7]);                              \
    auto r0 = __builtin_amdgcn_permlane32_swap(a0, b0, false, false); auto r1 = __builtin_amdgcn_permlane32_swap(a1, b1, false, false); \
    u32x4 w = {r0[0], r1[0], r0[1], r1[1]}; OUT = *reinterpret_cast<bf16x8*>(&w); } while (0)
    PK4(p0, 0, pa0); PK4(p0, 8, pa1); PK4(p1, 0, pa2); PK4(p1, 8, pa3);
#undef PK4
}
template <int NP>
__device__ __forceinline__ void qkt(f32x16& p0, f32x16& p1, const LAS char* Ks, const bf16x8* qr, const LAS char* qrl, int r32, int hi, const f32x16& cinit) {
    p0 = cinit; p1 = cinit;
#pragma unroll
    for (int p = 0; p < NP; ++p)
#pragma unroll
        for (int d0 = 0; d0 < 4; ++d0) { const int cb = d0 * 32 + hi * 16;
            bf16x8 b0 = *(const LAS bf16x8*)(Ks + p * SHM_KP + kswz(r32, cb));
            bf16x8 b1 = *(const LAS bf16x8*)(Ks + p * SHM_KP + kswz(32 + r32, cb));
            const bf16x8 qf = (NP == 3 && p == 2) ? *(const LAS bf16x8*)(qrl + d0 * 32) : qr[p * 4 + d0];
            p0 = __builtin_amdgcn_mfma_f32_32x32x16_bf16(b0, qf, p0, 0, 0, 0);
            p1 = __builtin_amdgcn_mfma_f32_32x32x16_bf16(b1, qf, p1, 0, 0, 0); }
}
struct Ptrs { const bf16* q[3]; const bf16* k[3]; const bf16* v; };
struct StrDiff { static constexpr int LDQ = NIN, LDK = NIN, LDK2 = NIN, LDV = NIN; };
struct StrMla { static constexpr int LDQ = NQ, LDK = NKV, LDK2 = NIN, LDV = NKV; };
template <int NP, bool BIAS, int SDEPTH, class STR>
__device__ __forceinline__ void attn_body(const Ptrs& P, int seq, int qpos0, float Cs, LAS char* lds, f32x16 (&o)[4], int tid_in) {
    int tid = tid_in; asm volatile("" : "+v"(tid));
    const int wid = __builtin_amdgcn_readfirstlane(tid >> 6), lane = tid & 63, r32 = lane & 31, hi = lane >> 5;
    LAS char* V_lds = lds + OFF_V; LAS char* K_lds = lds + OFF_K;
    LAS float* wsl = (LAS float*)(lds + OFF_WS) + wid * 64; LAS float* li_l = wsl; LAS float* al_l = wsl + 32;
    const LAS float* tbl = (const LAS float*)(lds + OFF_TBL);
    constexpr int KB = NP * SHM_KP;
    constexpr bool CI = BIAS && (ATT_CINIT != 0);
    float m_reg = CI ? 0.f : -1e30f, l_reg = 0;
#pragma unroll
    for (int d = 0; d < 4; ++d) o[d] = f32x16{};
    constexpr int NPR = (NP == 3) ? 2 : NP;
    bf16x8 qr[NPR * 4];
#pragma unroll
    for (int p = 0; p < NPR; ++p)
#pragma unroll
        for (int d0 = 0; d0 < 4; ++d0) qr[p * 4 + d0] = *reinterpret_cast<const bf16x8*>(P.q[p] + (long)(wid * 32 + r32) * STR::LDQ + hi * 8 + d0 * 16);
    LAS char* qrl = lds + OFF_QR + (wid * 32 + r32) * KROW + hi * 16;
    if constexpr (NP == 3) {
#pragma unroll
        for (int d0 = 0; d0 < 4; ++d0) *(LAS bf16x8*)(qrl + d0 * 32) = *reinterpret_cast<const bf16x8*>(P.q[2] + (long)(wid * 32 + r32) * STR::LDQ + hi * 8 + d0 * 16);
    }
    const int kr = tid >> 3, kc = tid & 7, kst = kswz(kr, kc * 16);
    const int sr = tid >> 4, sc = (tid & 15) * 8, vst0 = v_st(sr, sc), vst1 = v_st(32 + sr, sc);
    const int vb0 = (int)(uintptr_t)V_lds + v_rd_base(lane);
    const int qlo = qpos0 + wid * 32;
    const float bL = BIAS ? tbl[0] : 0.f, bR = BIAS ? tbl[256] : 0.f;
    f32x16 csp = f32x16{}; float bcur = bL;
    if constexpr (CI) {
#pragma unroll
        for (int r = 0; r < 16; ++r) csp[r] = bL; }
    struct { bf16x8 vs0, vs1, ks[NP]; } st_[SDEPTH];
#define SLOAD(i, k0) do { st_[i].vs0 = *reinterpret_cast<const bf16x8*>(P.v + (long)((k0) + sr) * STR::LDV + sc); st_[i].vs1 = *reinterpret_cast<const bf16x8*>(P.v + (long)((k0) + 32 + sr) * STR::LDV + sc); \
    _Pragma("unroll") for (int p_ = 0; p_ < NP; ++p_) st_[i].ks[p_] = *reinterpret_cast<const bf16x8*>(P.k[p_] + (long)((k0) + kr) * (p_ == 2 ? STR::LDK2 : STR::LDK) + kc * 8); } while (0)
#define SWRITE(b, i) do { *(LAS bf16x8*)(V_lds + (b) * SHM_V + vst0) = st_[i].vs0; *(LAS bf16x8*)(V_lds + (b) * SHM_V + vst1) = st_[i].vs1; \
    _Pragma("unroll") for (int p_ = 0; p_ < NP; ++p_) *(LAS bf16x8*)(K_lds + (b) * KB + p_ * SHM_KP + kst) = st_[i].ks[p_]; } while (0)
#define SWAIT() do { if constexpr (SDEPTH == 2) { if constexpr (NP == 1) asm volatile("s_waitcnt vmcnt(3)" ::: "memory"); else asm volatile("s_waitcnt vmcnt(5)" ::: "memory"); } else asm volatile("s_waitcnt vmcnt(0)" ::: "memory"); } while (0)
#define RESC(a) do { if (__any((a) < 1.f)) { if (hi == 0) al_l[r32] = (a); asm volatile("s_waitcnt lgkmcnt(0)" ::: "memory"); \
    _Pragma("unroll") for (int d = 0; d < 4; ++d) _Pragma("unroll") for (int r = 0; r < 16; ++r) o[d][r] *= al_l[crow(r, hi)]; } } while (0)
#define TILEB(j, nearv, bcv, rbv) const int _rh##j = (j) * 64 + 63 - qlo, _rl##j = (j) * 64 - (qlo + 31); \
    const bool nearv = BIAS && (_rh##j > -128) && (_rl##j < 128); const float bcv = (_rh##j <= -128) ? bL : bR; const int rbv = (j) * 64 - (qlo + r32) + 128
#define CLS(nearv, bcv) do { if constexpr (CI) { if (!(nearv) && (bcv) != bcur) { const float _dl = (bcv) - bcur; _Pragma("unroll") for (int r = 0; r < 16; ++r) csp[r] += _dl; bcur = (bcv); } } } while (0)
#define PSM(P0, P1, MN, AL, first, nearv, bcv, rbv) do { if constexpr (CI) { partialSM_ci(P0, P1, m_reg, AL, csp, first, nearv, bcur, rbv, hi, tbl); MN = 0.f; } \
        else partialSM<BIAS>(P0, P1, m_reg, MN, AL, Cs, nearv, bcv, rbv, hi, tbl); } while (0)
    f32x16 pA0, pA1, pB0, pB1; float mnA, mnB, alA, alB; bf16x8 pa0, pa1, pa2, pa3; const int NT = seq / 64;
    constexpr int SE = 0, SO = SDEPTH - 1;
    SLOAD(SE, 0); asm volatile("s_waitcnt vmcnt(0)" ::: "memory"); SWRITE(0, SE); __syncthreads();
    { const int jj = 0; TILEB(jj, nr, bc, rb); CLS(nr, bc); qkt<NP>(pA0, pA1, K_lds, qr, qrl, r32, hi, csp); PSM(pA0, pA1, mnA, alA, true, nr, bc, rb); }
    SLOAD(SO, 64); if constexpr (SDEPTH == 2) { if (2 < NT) SLOAD(SE, 128); }
    SWAIT(); SWRITE(1, SO); __syncthreads();
    for (int j = 1; j + 1 < NT; j += 2) {
        TILEB(j, nrB, bcB, rbB); CLS(nrB, bcB);
        SBAR(); qkt<NP>(pB0, pB1, K_lds + KB, qr, qrl, r32, hi, csp);
        finishSM(pA0, pA1, alA, l_reg, pa0, pa1, pa2, pa3); SBAR();
        SLOAD(SO, (j + SDEPTH) * 64); SBAR();
        pv_d0(o, vb0, pa0, pa1, pa2, pa3);
        PSM(pB0, pB1, mnB, alB, false, nrB, bcB, rbB);
        __syncthreads(); SWAIT(); SWRITE(0, SE);
        RESC(alB); __syncthreads();
        const int j1 = j + 1; TILEB(j1, nrA, bcA, rbA); CLS(nrA, bcA);
        SBAR(); qkt<NP>(pA0, pA1, K_lds, qr, qrl, r32, hi, csp);
        finishSM(pB0, pB1, alB, l_reg, pa0, pa1, pa2, pa3); SBAR();
        if (SDEPTH == 1 || j + 3 < NT) SLOAD(SE, (j + 1 + SDEPTH) * 64); SBAR();
        pv_d0(o, vb0 + SHM_V, pa0, pa1, pa2, pa3);
        PSM(pA0, pA1, mnA, alA, false, nrA, bcA, rbA);
        __syncthreads(); SWAIT(); SWRITE(1, SO);
        RESC(alA); __syncthreads();
    }
    const int jl = NT - 1; TILEB(jl, nrL, bcL, rbL); CLS(nrL, bcL);
    SBAR(); qkt<NP>(pB0, pB1, K_lds + KB, qr, qrl, r32, hi, csp);
    finishSM(pA0, pA1, alA, l_reg, pa0, pa1, pa2, pa3); SBAR();
    pv_d0(o, vb0, pa0, pa1, pa2, pa3);
    PSM(pB0, pB1, mnB, alB, false, nrL, bcL, rbL);
    __syncthreads(); RESC(alB);
    finishSM(pB0, pB1, alB, l_reg, pa0, pa1, pa2, pa3); SBAR();
    pv_d0(o, vb0 + SHM_V, pa0, pa1, pa2, pa3);
    if (hi == 0) li_l[r32] = l_reg; asm volatile("s_waitcnt lgkmcnt(0)" ::: "memory");
#pragma unroll
    for (int r = 0; r < 16; ++r) { const float rl = __builtin_amdgcn_rcpf(li_l[crow(r, hi)]);
#pragma unroll
        for (int d = 0; d < 4; ++d) o[d][r] *= rl; }
    __syncthreads();
#undef SLOAD
#undef SWRITE
#undef SWAIT
#undef RESC
#undef TILEB
#undef CLS
#undef PSM
}
}

constexpr int NWAVES = 8;
constexpr int CW_BAR = 4096;
constexpr int RING_BYTES = 131072, MISC_OFF = RING_BYTES + 320, LDS_BYTES = 147456;
static_assert(att::LDS_END <= RING_BYTES, "attention LDS");

#define XB_TMO      128
#define XB_XCNT(j)  (256  + 64 * (j))
#define XB_XSUB(j)  (1280 + 64 * (j))
#define XB_XGEN(j)  (2304 + 64 * (j))
#define XB_TOP      3328
#define XB_TOPGEN   3392
#define XCD_BAR_WORDS 3456
#define XB_SPIN_CAP (1u << 21)
__device__ __forceinline__ unsigned xb_ld(unsigned* p)              { return __hip_atomic_load(p, __ATOMIC_RELAXED, __HIP_MEMORY_SCOPE_AGENT); }
__device__ __forceinline__ unsigned xb_add(unsigned* p, unsigned v) { return __hip_atomic_fetch_add(p, v, __ATOMIC_RELAXED, __HIP_MEMORY_SCOPE_AGENT); }
__device__ __forceinline__ unsigned xb_xcc_id() { return (unsigned)__builtin_amdgcn_s_getreg((3 << 11) | 20) & 0xFu; }
#define XB_SPIN(cond, bar) do { unsigned _sp = 0; while (cond) { __builtin_amdgcn_s_sleep(1); \
    if ((++_sp & 255u) == 0u) { if (xb_ld(&(bar)[XB_TMO])) break; if (_sp > XB_SPIN_CAP) { atomicAdd(&(bar)[XB_TMO], 1u); break; } } } } while (0)
struct XcdBarrier { unsigned* bar; unsigned x; volatile LAS unsigned* st; };
__device__ __forceinline__ XcdBarrier xcd_barrier_post(unsigned* bar, volatile LAS unsigned* st, bool leader) {
    XcdBarrier b; b.bar = bar; b.x = xb_xcc_id(); b.st = st;
    if (leader) (void)xb_add(&bar[XB_XCNT(b.x)], 1u);
    return b;
}
__device__ __forceinline__ void xcd_barrier_complete(unsigned* bar, unsigned x, unsigned& nloc, unsigned& nx) {
    const unsigned G = gridDim.x * gridDim.y * gridDim.z;
    unsigned sum, cnt, mine, sp = 0u;
    for (;;) {
        sum = 0u; cnt = 0u; mine = 0u;
#pragma unroll
        for (unsigned j = 0; j < 16; ++j) { const unsigned c = xb_ld(&bar[XB_XCNT(j)]); sum += c; cnt += (c > 0u) ? 1u : 0u; mine = (j == x) ? c : mine; }
        if (sum == G) break;
        __builtin_amdgcn_s_sleep(1);
        if ((++sp & 255u) == 0u) { if (xb_ld(&bar[XB_TMO])) break; if (sp > XB_SPIN_CAP) { atomicAdd(&bar[XB_TMO], 1u); break; } }
    }
    nloc = mine > 0u ? mine : 1u; nx = cnt > 0u ? cnt : 1u;
}
__device__ __forceinline__ void xcd_barrier(const XcdBarrier& b, bool leader) {
    asm volatile("s_waitcnt vmcnt(0)" ::: "memory");
    __syncthreads();
    if (leader) {
        unsigned* bar = b.bar;
        __builtin_amdgcn_s_waitcnt(0);
        unsigned nloc = b.st[0], nx = b.st[1];
        if (nloc == 0u) { xcd_barrier_complete(bar, b.x, nloc, nx); b.st[0] = nloc; b.st[1] = nx; }
        const unsigned old = xb_add(&bar[XB_XSUB(b.x)], 1u);
        const unsigned gen = old / nloc;
        if (old + 1u == (gen + 1u) * nloc) {
            __builtin_amdgcn_fence(__ATOMIC_RELEASE, "agent");
            asm volatile("s_waitcnt vmcnt(0)" ::: "memory");
            const unsigned og = xb_add(&bar[XB_TOP], 1u);
            const unsigned tg = og / nx;
            if (og + 1u == (tg + 1u) * nx) xb_add(&bar[XB_TOPGEN], 1u);
            else XB_SPIN(xb_ld(&bar[XB_TOPGEN]) == tg, bar);
            __builtin_amdgcn_fence(__ATOMIC_ACQUIRE, "agent");
            xb_add(&bar[XB_XGEN(b.x)], 1u);
            asm volatile("s_waitcnt vmcnt(0)" ::: "memory");
        } else {
            XB_SPIN(xb_ld(&bar[XB_XGEN(b.x)]) == gen, bar);
            __builtin_amdgcn_fence(__ATOMIC_ACQUIRE, "agent");
            asm volatile("s_waitcnt vmcnt(0)" ::: "memory");
        }
    }
    __syncthreads();
}

#define LDS_WAIT() asm volatile("s_waitcnt lgkmcnt(0)" ::: "memory")
template <int X> __device__ __forceinline__ float swz_xor(float v) { return __int_as_float(__builtin_amdgcn_ds_swizzle(__float_as_int(v), (X << 10) | 0x1f)); }
__device__ __forceinline__ float half_sum(float v) { v += swz_xor<1>(v); v += swz_xor<2>(v); v += swz_xor<4>(v); v += swz_xor<8>(v); v += swz_xor<16>(v); return v; }
__device__ __forceinline__ float wave_max(float v) {
    v = __builtin_fmaxf(v, swz_xor<1>(v)); v = __builtin_fmaxf(v, swz_xor<2>(v)); v = __builtin_fmaxf(v, swz_xor<4>(v)); v = __builtin_fmaxf(v, swz_xor<8>(v)); v = __builtin_fmaxf(v, swz_xor<16>(v));
    auto rr = __builtin_amdgcn_permlane32_swap(__float_as_uint(v), __float_as_uint(v), false, false);
    return __builtin_fmaxf(__uint_as_float(rr[0]), __uint_as_float(rr[1]));
}
__device__ __forceinline__ float wave_sum(float v) {
    v = half_sum(v);
    auto rr = __builtin_amdgcn_permlane32_swap(__float_as_uint(v), __float_as_uint(v), false, false);
    return __uint_as_float(rr[0]) + __uint_as_float(rr[1]);
}

template <class SrcFn>
__device__ __forceinline__ void transpose_item(const float* W, int K, int N, bf16* WT, int nblk, LAS float* scr, int item, int lane, SrcFn src) {
    const int kb = item / nblk, nb = item % nblk, k0 = 64 * kb, n0 = 32 * nb;
    const int scol = src(n0 + (lane & 31));
#pragma unroll 8
    for (int i = 0; i < 32; ++i) { const int kk = 2 * i + (lane >> 5); scr[kk * 33 + (lane & 31)] = scol >= 0 ? W[(size_t)(k0 + kk) * N + scol] : 0.f; }
    LDS_WAIT(); asm volatile("" ::: "memory");
    const int c = lane & 7;
#pragma unroll
    for (int j = 0; j < 4; ++j) { const int n = (lane >> 3) + 8 * j; const LAS float* s = scr + (8 * c) * 33 + n;
        u32x4 o; o.x = cvt_pk_bf16(s[0 * 33], s[1 * 33]); o.y = cvt_pk_bf16(s[2 * 33], s[3 * 33]); o.z = cvt_pk_bf16(s[4 * 33], s[5 * 33]); o.w = cvt_pk_bf16(s[6 * 33], s[7 * 33]);
        *(u32x4*)(WT + (size_t)(n0 + n) * K + k0 + 8 * c) = o; }
    LDS_WAIT(); asm volatile("" ::: "memory");
}
__device__ __forceinline__ void transpose_item_f8(const float* W, int K, int N, unsigned char* WT8, int nblk, LAS float* scr, int item, int lane, float scale) {
    const int kb = item / nblk, nb = item % nblk, k0 = 64 * kb, n0 = 32 * nb;
#pragma unroll 8
    for (int i = 0; i < 32; ++i) { const int kk = 2 * i + (lane >> 5); scr[kk * 33 + (lane & 31)] = W[(size_t)(k0 + kk) * N + n0 + (lane & 31)] * scale; }
    LDS_WAIT(); asm volatile("" ::: "memory");
    const int c = lane & 3;
#pragma unroll
    for (int j = 0; j < 2; ++j) { const int n = (lane >> 2) + 16 * j; const LAS float* s = scr + (16 * c) * 33 + n;
        u32x4 o; o.x = pack4_fp8(s[0 * 33], s[1 * 33], s[2 * 33], s[3 * 33]); o.y = pack4_fp8(s[4 * 33], s[5 * 33], s[6 * 33], s[7 * 33]);
        o.z = pack4_fp8(s[8 * 33], s[9 * 33], s[10 * 33], s[11 * 33]); o.w = pack4_fp8(s[12 * 33], s[13 * 33], s[14 * 33], s[15 * 33]);
        *(u32x4*)(WT8 + (size_t)(n0 + n) * K + k0 + 16 * c) = o; }
    LDS_WAIT(); asm volatile("" ::: "memory");
}
template <class SrcFn>
__device__ __forceinline__ void transpose_item_i8(const float* W, int K, int N, unsigned char* WT8, int nblk, LAS float* scr, int item, int lane, const unsigned* cmax, float* cs, SrcFn src) {
    const int kb = item / nblk, nb = item % nblk, k0 = 64 * kb, n0 = 32 * nb;
    const int scol = src(n0 + (lane & 31));
    const float cm = scol >= 0 ? __uint_as_float(cmax[scol]) : 0.f, inv = cm > 0.f ? 127.f / cm : 0.f;
    if (kb == 0 && lane < 32) cs[n0 + lane] = cm * (1.f / 127.f);
#pragma unroll 8
    for (int i = 0; i < 32; ++i) { const int kk = 2 * i + (lane >> 5); scr[kk * 33 + (lane & 31)] = scol >= 0 ? W[(size_t)(k0 + kk) * N + scol] * inv : 0.f; }
    LDS_WAIT(); asm volatile("" ::: "memory");
    const int c = lane & 3;
#pragma unroll
    for (int j = 0; j < 2; ++j) { const int n = (lane >> 2) + 16 * j; const LAS float* s = scr + (16 * c) * 33 + n;
        u32x4 o; o.x = pack4_i8(s[0 * 33], s[1 * 33], s[2 * 33], s[3 * 33]); o.y = pack4_i8(s[4 * 33], s[5 * 33], s[6 * 33], s[7 * 33]);
        o.z = pack4_i8(s[8 * 33], s[9 * 33], s[10 * 33], s[11 * 33]); o.w = pack4_i8(s[12 * 33], s[13 * 33], s[14 * 33], s[15 * 33]);
        *(u32x4*)(WT8 + (size_t)(n0 + n) * K + k0 + 16 * c) = o; }
    LDS_WAIT(); asm volatile("" ::: "memory");
}
__device__ __forceinline__ void absmax_item(const float* W, int N, unsigned* cmax, int item, int lane) {
    const int ncb = N / 64, kb = item / ncb, cb = item % ncb; const float* p = W + (size_t)(kb * 64) * N + cb * 64 + lane; float mx = 0.f;
#pragma unroll 16
    for (int i = 0; i < 64; ++i) mx = __builtin_fmaxf(mx, __builtin_fabsf(p[(size_t)i * N]));
    atomicMax(cmax + cb * 64 + lane, __float_as_uint(mx));
}
constexpr int NWAVES_ = 8;
template <int MODE, class SrcFn>
__device__ __forceinline__ void convert_strip(const float* W, int K, int N, unsigned char* WT, float* cs, int n0, float fscale, LAS float* lmax, int wave, int lane, SrcFn src) {
    const int rg = lane >> 3, cq = lane & 7, nchunk = K >> 7;
    int sc[4];
#pragma unroll
    for (int j = 0; j < 4; ++j) sc[j] = src(n0 + 4 * cq + j);
    const bool contig = __all(sc[0] >= 0 && (sc[0] & 3) == 0 && sc[1] == sc[0] + 1 && sc[2] == sc[0] + 2 && sc[3] == sc[0] + 3);
    auto ldrow = [&](int row) -> f32x4 {
        if (contig) return *(const f32x4*)(W + (size_t)row * N + sc[0]);
        f32x4 v;
#pragma unroll
        for (int j = 0; j < 4; ++j) v[j] = sc[j] >= 0 ? W[(size_t)row * N + sc[j]] : 0.f;
        return v; };
    f32x4 inv = (f32x4){fscale, fscale, fscale, fscale};
    if constexpr (MODE == 2) {
        f32x4 mx = (f32x4){0.f, 0.f, 0.f, 0.f};
        for (int c = wave; c < nchunk; c += NWAVES_) { f32x4 v[16];
#pragma unroll
            for (int i = 0; i < 16; ++i) v[i] = ldrow(c * 128 + 16 * rg + i);
#pragma unroll
            for (int i = 0; i < 16; ++i)
#pragma unroll
                for (int j = 0; j < 4; ++j) mx[j] = __builtin_fmaxf(mx[j], __builtin_fabsf(v[i][j])); }
#pragma unroll
        for (int j = 0; j < 4; ++j) { float m = mx[j]; m = __builtin_fmaxf(m, swz_xor<8>(m)); m = __builtin_fmaxf(m, swz_xor<16>(m));
            auto rr = __builtin_amdgcn_permlane32_swap(__float_as_uint(m), __float_as_uint(m), false, false); mx[j] = __builtin_fmaxf(__uint_as_float(rr[0]), __uint_as_float(rr[1])); }
        __syncthreads();
        if (lane < 8) *(LAS f32x4*)(lmax + wave * 32 + 4 * lane) = mx;
        __syncthreads();
        f32x4 cm = *(const LAS f32x4*)(lmax + 4 * cq);
#pragma unroll
        for (int w = 1; w < NWAVES_; ++w) { const f32x4 o = *(const LAS f32x4*)(lmax + w * 32 + 4 * cq);
#pragma unroll
            for (int j = 0; j < 4; ++j) cm[j] = __builtin_fmaxf(cm[j], o[j]); }
#pragma unroll
        for (int j = 0; j < 4; ++j) inv[j] = cm[j] > 0.f ? 127.f / cm[j] : 0.f;
        if (wave == 0 && lane < 8) *(f32x4*)(cs + n0 + 4 * lane) = cm * (1.f / 127.f);
    }
    constexpr int EB = (MODE == 0) ? 2 : 1; const size_t rowb = (size_t)K * EB;
    for (int c = wave; c < nchunk; c += NWAVES_) { f32x4 v[16];
#pragma unroll
        for (int i = 0; i < 16; ++i) v[i] = ldrow(c * 128 + 16 * rg + i) * inv;
#pragma unroll
        for (int j = 0; j < 4; ++j) { unsigned char* dst = WT + (size_t)(n0 + 4 * cq + j) * rowb + (size_t)(c * 128 + 16 * rg) * EB;
            if constexpr (MODE == 2) { u32x4 o; o.x = pack4_i8(v[0][j], v[1][j], v[2][j], v[3][j]); o.y = pack4_i8(v[4][j], v[5][j], v[6][j], v[7][j]); o.z = pack4_i8(v[8][j], v[9][j], v[10][j], v[11][j]); o.w = pack4_i8(v[12][j], v[13][j], v[14][j], v[15][j]); *(u32x4*)dst = o; }
            else if constexpr (MODE == 1) { u32x4 o; o.x = pack4_fp8(v[0][j], v[1][j], v[2][j], v[3][j]); o.y = pack4_fp8(v[4][j], v[5][j], v[6][j], v[7][j]); o.z = pack4_fp8(v[8][j], v[9][j], v[10][j], v[11][j]); o.w = pack4_fp8(v[12][j], v[13][j], v[14][j], v[15][j]); *(u32x4*)dst = o; }
            else { u32x4 o; o.x = cvt_pk_bf16(v[0][j], v[1][j]); o.y = cvt_pk_bf16(v[2][j], v[3][j]); o.z = cvt_pk_bf16(v[4][j], v[5][j]); o.w = cvt_pk_bf16(v[6][j], v[7][j]); *(u32x4*)dst = o;
                   o.x = cvt_pk_bf16(v[8][j], v[9][j]); o.y = cvt_pk_bf16(v[10][j], v[11][j]); o.z = cvt_pk_bf16(v[12][j], v[13][j]); o.w = cvt_pk_bf16(v[14][j], v[15][j]); *(u32x4*)(dst + 16) = o; } }
    }
}
__device__ __forceinline__ int t5_bucket(int rel) {
    const int ret = rel > 0 ? 16 : 0; const int n = rel < 0 ? -rel : rel;
    if (n < 8) return ret + n;
    int large = 2 + (31 - __builtin_clz((unsigned)(n * n)));
    large = large < 15 ? large : 15;
    return ret + large;
}
__device__ __forceinline__ void sincos_f32arg(float ang, float& c, float& s) {
    const double a = (double)ang; const double kq = __builtin_rint(a * 0.63661977236758134);
    double r = __builtin_fma(-kq, 1.5707963267948966, a); r = __builtin_fma(-kq, 6.123233995736766e-17, r);
    const int q = ((int)kq) & 3; const double r2 = r * r;
    const double sp = r * (1.0 + r2 * (-1.0 / 6 + r2 * (1.0 / 120 + r2 * (-1.0 / 5040 + r2 * (1.0 / 362880 + r2 * (-1.0 / 39916800))))));
    const double cp = 1.0 + r2 * (-0.5 + r2 * (1.0 / 24 + r2 * (-1.0 / 720 + r2 * (1.0 / 40320 + r2 * (-1.0 / 3628800 + r2 * (1.0 / 479001600))))));
    const double sv = (q == 0) ? sp : (q == 1) ? cp : (q == 2) ? -sp : -cp;
    const double cv = (q == 0) ? cp : (q == 1) ? -sp : (q == 2) ? -cp : sp;
    c = (float)cv; s = (float)sv;
}

struct Args { const float* in[23]; float* out; unsigned char* ws; float invf[32]; int lo, hi; };
typedef const __attribute__((address_space(4))) Args* ArgsP;

enum { I_XP = 0, I_XS, I_RELB, I_FNG, I_RAG, I_WIN, I_LQ1, I_LK1, I_LQ2, I_LK2, I_SUBG, I_QNG, I_WQUP, I_KVNG, I_WKVUP, I_WA, I_WB, I_WO, I_RFG, I_WUP, I_CW, I_CB, I_WD };

#define P_WINT ((bf16*)(ws + WS_WIN))
#define P_WQT ((bf16*)(ws + WS_WQ))
#define P_WKVT ((bf16*)(ws + WS_WKV))
#define P_WAT ((bf16*)(ws + WS_WA))
#define P_WBT ((bf16*)(ws + WS_WB))
#define P_WOT ((bf16*)(ws + WS_WO))
#define P_WUPT ((bf16*)(ws + WS_WUP))
#define P_WDT ((bf16*)(ws + WS_WD))
#define P_COS ((float*)(ws + WS_COS))
#define P_SIN ((float*)(ws + WS_SIN))
#define P_BIAS2 ((float*)(ws + WS_BIAS))
#define P_LAM ((float*)(ws + WS_LAM))
#define P_CSIN ((float*)(ws + WS_CSIN))
#define P_CSUP ((float*)(ws + WS_CSUP))
#define P_RSH ((float*)(ws + WS_RSH))
#define P_QL8 ((unsigned char*)(ws + WS_QL8))
#define P_KVL8 ((unsigned char*)(ws + WS_KVL8))
#define P_AO8 ((unsigned char*)(ws + WS_AO8))
#define P_BO8 ((unsigned char*)(ws + WS_BO8))
#define P_MG8 ((unsigned char*)(ws + WS_MG8))
#define P_X1 ((bf16*)(ws + WS_X1))
#define P_H ((bf16*)(ws + WS_H))
#define P_P ((bf16*)(ws + WS_P))
#define P_Q ((bf16*)(ws + WS_Q))
#define P_KV ((bf16*)(ws + WS_KV))
#define P_AO ((bf16*)(ws + WS_AO))
#define P_BO ((bf16*)(ws + WS_BO))
#define P_MG ((bf16*)(ws + WS_MG))
#define P_STASH ((float*)(ws + WS_STASH))
#define P_Y ((bf16*)(ws + WS_Y))
#define P_ACT ((bf16*)(ws + WS_ACTV))
#define XG() ((g < 2) ? A->in[I_XP] + (size_t)g * TG * DM : A->in[I_XS] + (size_t)(g - 2) * TG * DM)
#define OG() (A->out + (size_t)g * TG * DM)
constexpr int NSTEP_PER_GROUP = I8_MID ? 14 : 12, NSTEPS = 1 + NGRP * NSTEP_PER_GROUP;

__global__ void __launch_bounds__(NWAVES * 64, 2) enc_fwd(Args args) {
    extern __shared__ __attribute__((aligned(16))) unsigned char lds[];
    LAS unsigned char* ldsL = (LAS unsigned char*)lds;
    volatile LAS unsigned* MISC = (volatile LAS unsigned*)(ldsL + MISC_OFF);
    const int wave = __builtin_amdgcn_readfirstlane((int)threadIdx.x >> 6);
    const int G = gridDim.x; const int bx = blockIdx.x; const int vcu0 = (G % 8 == 0) ? (bx % 8) * (G / 8) + bx / 8 : bx;
    unsigned char* ws = args.ws;
    unsigned* ctl = (unsigned*)(ws + WS_CTL);
    { const int tid0 = wave * 64 + lane_id_fresh(); for (int u = tid0; u < (LDS_BYTES - RING_BYTES) / 4; u += NWAVES * 64) ((LAS unsigned*)(ldsL + RING_BYTES))[u] = 0u; }
    __syncthreads();
    XcdBarrier bar; bar.bar = ctl + CW_BAR; bar.x = 0; bar.st = nullptr;
#if !MK_PER_STEP_LAUNCH
    bar = xcd_barrier_post(ctl + CW_BAR, MISC + 8, (wave * 64 + lane_id_fresh()) == 0);
#endif
    const int lo = args.lo, hi = args.hi;
    int step = 0;
#ifndef EN_MASK
#define EN_MASK 0xFFFFFF
#endif
#define EN(k) (((EN_MASK) >> (k)) & 1)
#define RUN() (step >= lo && step < hi)
#define LOCAL_TID() ArgsP A = (ArgsP)__builtin_amdgcn_kernarg_segment_ptr(); asm volatile("" : "+s"(A)); unsigned char* const ws = A->ws; (void)ws; int lane_ = lane_id_fresh(); asm volatile("" : "+v"(lane_)); const int lane = lane_; const int tid = wave * 64 + lane; (void)tid; int gw = gw0, vcu = vcu0; asm volatile("" : "+s"(gw), "+s"(vcu)); (void)gw; (void)vcu
#if MK_PER_STEP_LAUNCH
#define SEAM() do { ++step; } while (0)
#else
#define SEAM() do { if (RUN() && step + 1 < hi) xcd_barrier(bar, (wave * 64 + lane_id_fresh()) == 0); ++step; } while (0)
#endif
    const int gw0 = vcu0 * NWAVES + wave, NGW = G * NWAVES;

    if (RUN() && EN(0)) { LOCAL_TID();
        LAS float* lmax = (LAS float*)ldsL;
        auto ident = [](int n) -> int { return n; };
        auto srcIn = [](int n) -> int { if (n < C_GATE) return n; if (n < C_KPE) return n + 64; if (n < C_KPE + 64) { const int j = n - C_KPE; return 7680 + ((j & 1) ? 32 + (j >> 1) : (j >> 1)); } return -1; };
        auto srcQ = [](int n) -> int { if (n < 2048) return (n >> 7) * 192 + (n & 127); const int j = n - 2048, hh = j >> 6, jj = j & 63; return hh * 192 + 128 + ((jj & 1) ? 32 + (jj >> 1) : (jj >> 1)); };
        auto srcUp = [](int n) -> int { return CONV_FUSE ? ((n & 128) ? DFF : 0) + (n >> 8) * 128 + (n & 127) : n; };
        constexpr int T0 = DM / 32, T1 = T0 + NIN / 32, T2 = T1 + NUP / 32, T3 = T2 + DM / 32, T4 = T3 + DM / 32, T5 = T4 + DM / 32, T6 = T5 + NQ / 32, T7 = T6 + NKV / 32;
        for (int s = vcu; s < T7; s += G) {
            if (s < T0) { const int n0 = 32 * s;
                if (FP8_DOWN) convert_strip<1>(A->in[I_WD], DFF, DM, (unsigned char*)P_WDT, nullptr, n0, S_WD, lmax, wave, lane, ident); else convert_strip<0>(A->in[I_WD], DFF, DM, (unsigned char*)P_WDT, nullptr, n0, 1.f, lmax, wave, lane, ident); }
            else if (s < T1) { const int n0 = 32 * (s - T0);
                if (I8_IN) convert_strip<2>(A->in[I_WIN], DM, 15936, (unsigned char*)P_WINT, P_CSIN, n0, 1.f, lmax, wave, lane, srcIn); else convert_strip<0>(A->in[I_WIN], DM, 15936, (unsigned char*)P_WINT, nullptr, n0, 1.f, lmax, wave, lane, srcIn); }
            else if (s < T2) { const int n0 = 32 * (s - T1);
                if (I8_UP) convert_strip<2>(A->in[I_WUP], DM, NUP, (unsigned char*)P_WUPT, P_CSUP, n0, 1.f, lmax, wave, lane, srcUp); else convert_strip<0>(A->in[I_WUP], DM, NUP, (unsigned char*)P_WUPT, nullptr, n0, 1.f, lmax, wave, lane, srcUp); }
            else if (s < T3) { const int n0 = 32 * (s - T2);
                if (I8_MID) convert_strip<2>(A->in[I_WO], DM, DM, (unsigned char*)P_WOT, (float*)(ws + WS_CSO), n0, 1.f, lmax, wave, lane, ident); else convert_strip<0>(A->in[I_WO], DM, DM, (unsigned char*)P_WOT, nullptr, n0, 1.f, lmax, wave, lane, ident); }
            else if (s < T4) { const int n0 = 32 * (s - T3);
                if (I8_MID) convert_strip<2>(A->in[I_WA], 2048, DM, (unsigned char*)P_WAT, (float*)(ws + WS_CSA), n0, 1.f, lmax, wave, lane, ident); else convert_strip<0>(A->in[I_WA], 2048, DM, (unsigned char*)P_WAT, nullptr, n0, 1.f, lmax, wave, lane, ident); }
            else if (s < T5) { const int n0 = 32 * (s - T4);
                if (I8_MID) convert_strip<2>(A->in[I_WB], 2048, DM, (unsigned char*)P_WBT, (float*)(ws + WS_CSB), n0, 1.f, lmax, wave, lane, ident); else convert_strip<0>(A->in[I_WB], 2048, DM, (unsigned char*)P_WBT, nullptr, n0, 1.f, lmax, wave, lane, ident); }
            else if (s < T6) { const int n0 = 32 * (s - T5);
                if (I8_MID) convert_strip<2>(A->in[I_WQUP], 1024, NQ, (unsigned char*)P_WQT, (float*)(ws + WS_CSQ), n0, 1.f, lmax, wave, lane, srcQ); else convert_strip<0>(A->in[I_WQUP], 1024, NQ, (unsigned char*)P_WQT, nullptr, n0, 1.f, lmax, wave, lane, srcQ); }
            else { const int n0 = 32 * (s - T6);
                if (I8_MID) convert_strip<2>(A->in[I_WKVUP], 512, NKV, (unsigned char*)P_WKVT, (float*)(ws + WS_CSKV), n0, 1.f, lmax, wave, lane, ident); else convert_strip<0>(A->in[I_WKVUP], 512, NKV, (unsigned char*)P_WKVT, nullptr, n0, 1.f, lmax, wave, lane, ident); }
        }
        for (int i = bx * (NWAVES * 64) + tid; i < 8192 * 32; i += G * NWAVES * 64) { const int pos = i >> 5, k = i & 31; float c, s; sincos_f32arg((float)pos * A->invf[k], c, s); P_COS[i] = c; P_SIN[i] = s; }
        if (bx == 0) {
            for (int i = tid; i < 16 * 257; i += NWAVES * 64) { const int h = i / 257, j = i % 257; P_BIAS2[h * 260 + j] = A->in[I_RELB][t5_bucket(j - 128) * 16 + h] * 1.4426950408889634f; }
            if (wave == 0) { const float a = wave_sum(A->in[I_LQ1][lane] * A->in[I_LK1][lane]), b = wave_sum(A->in[I_LQ2][lane] * A->in[I_LK2][lane]);
                if (lane == 0) P_LAM[0] = expf(a) - expf(b) + 0.2f; }
        }
    }
    SEAM();

    for (int g = 0; g < NGRP; ++g) {
        const int seqlen = (g < 2) ? 4096 : 8192, posmask = seqlen - 1;

        if (RUN() && EN(1)) { LOCAL_TID();
            const float* gv = A->in[I_RAG];
            for (int m = gw; m < TG; m += NGW) {
                const f32x4* xr = (const f32x4*)(XG() + (size_t)m * DM) + lane; f32x4 v[16]; float s = 0.f;
#pragma unroll
                for (int j = 0; j < 16; ++j) { v[j] = xr[64 * j]; s += (v[j].x * v[j].x + v[j].y * v[j].y) + (v[j].z * v[j].z + v[j].w * v[j].w); }
                const float rstd = 1.0f / sqrtf(wave_sum(s) * (1.f / DM) + EPS);
                if (I8_IN) { float mx = 0.f;
#pragma unroll
                    for (int j = 0; j < 16; ++j) { const f32x4 gg = ((const f32x4*)gv)[64 * j + lane]; v[j] = v[j] * rstd * gg; mx = __builtin_fmaxf(__builtin_fmaxf(mx, __builtin_fmaxf(__builtin_fabsf(v[j].x), __builtin_fabsf(v[j].y))), __builtin_fmaxf(__builtin_fabsf(v[j].z), __builtin_fabsf(v[j].w))); }
                    mx = wave_max(mx); const float inv = mx > 0.f ? 127.f / mx : 0.f; if (lane == 0) P_RSH[m] = mx * (1.f / 127.f);
                    unsigned* o4 = (unsigned*)((unsigned char*)P_H + (size_t)m * DM) + lane;
#pragma unroll
                    for (int j = 0; j < 16; ++j) o4[64 * j] = pack4_i8(v[j].x * inv, v[j].y * inv, v[j].z * inv, v[j].w * inv);
                } else {
                u32x2* o8 = (u32x2*)(P_H + (size_t)m * DM) + lane;
#pragma unroll
                for (int j = 0; j < 16; ++j) { const f32x4 gg = ((const f32x4*)gv)[64 * j + lane]; u32x2 w; w.x = cvt_pk_bf16(v[j].x * rstd * gg.x, v[j].y * rstd * gg.y); w.y = cvt_pk_bf16(v[j].z * rstd * gg.z, v[j].w * rstd * gg.w); o8[64 * j] = w; }
                }
            }
        }
        SEAM();

        if (RUN() && EN(2)) { LOCAL_TID();
            pg8::Gemm gm{P_H, I8_IN ? DM / 2 : DM, P_WINT, TG, NIN, I8_IN ? DM / 2 : DM}; pg8::StaticOrder S; S.init(TG, NIN, G, bx);
            pg8::EpiStoreT<I8_IN != 0, WS_RSH, WS_CSIN> E{P_P, NIN, C_GATE / 256, C_KPE / 256, ATT_CINIT ? CS_DIFF : 1.f, ws};
            REP_LOOP_GEMM { int l2_ = lane_id_fresh(); asm volatile("" : "+v"(l2_)); pg8::gemm_phase<pg8::EpiStoreT<I8_IN != 0, WS_RSH, WS_CSIN>, I8_IN ? 2 : 0>(ldsL, gm, S, E, wave * 64 + l2_); }
        }
        SEAM();

        if (RUN() && EN(3)) { LOCAL_TID();
            const float* gq = A->in[I_QNG]; const float* gkv = A->in[I_KVNG];
            for (int m = gw; m < TG; m += NGW) {
                bf16* prow = P_P + (size_t)m * NIN;
                { u32x4 a = *(const u32x4*)(prow + C_QLAT + lane * 8), b = *(const u32x4*)(prow + C_QLAT + 512 + lane * 8);
                  float x[16] = {bf_lo(a.x), bf_hi(a.x), bf_lo(a.y), bf_hi(a.y), bf_lo(a.z), bf_hi(a.z), bf_lo(a.w), bf_hi(a.w), bf_lo(b.x), bf_hi(b.x), bf_lo(b.y), bf_hi(b.y), bf_lo(b.z), bf_hi(b.z), bf_lo(b.w), bf_hi(b.w)};
                  float s = 0.f;
#pragma unroll
                  for (int j = 0; j < 16; ++j) s += x[j] * x[j];
                  const float rstd = 1.0f / sqrtf(wave_sum(s) * (1.f / 1024) + EPS);
                  const f32x4 g0 = *(const f32x4*)(gq + lane * 8), g1 = *(const f32x4*)(gq + lane * 8 + 4), g2 = *(const f32x4*)(gq + 512 + lane * 8), g3 = *(const f32x4*)(gq + 512 + lane * 8 + 4);
                  u32x4 oa, ob;
                  oa.x = cvt_pk_bf16(x[0] * rstd * g0.x, x[1] * rstd * g0.y); oa.y = cvt_pk_bf16(x[2] * rstd * g0.z, x[3] * rstd * g0.w); oa.z = cvt_pk_bf16(x[4] * rstd * g1.x, x[5] * rstd * g1.y); oa.w = cvt_pk_bf16(x[6] * rstd * g1.z, x[7] * rstd * g1.w);
                  ob.x = cvt_pk_bf16(x[8] * rstd * g2.x, x[9] * rstd * g2.y); ob.y = cvt_pk_bf16(x[10] * rstd * g2.z, x[11] * rstd * g2.w); ob.z = cvt_pk_bf16(x[12] * rstd * g3.x, x[13] * rstd * g3.y); ob.w = cvt_pk_bf16(x[14] * rstd * g3.z, x[15] * rstd * g3.w);
                  if (I8_MID) { float y[16]; float mx = 0.f; const float gg[16] = {g0.x, g0.y, g0.z, g0.w, g1.x, g1.y, g1.z, g1.w, g2.x, g2.y, g2.z, g2.w, g3.x, g3.y, g3.z, g3.w};
#pragma unroll
                      for (int j = 0; j < 16; ++j) { y[j] = x[j] * rstd * gg[j]; mx = __builtin_fmaxf(mx, __builtin_fabsf(y[j])); }
                      mx = wave_max(mx); const float inv = mx > 0.f ? 127.f / mx : 0.f; if (lane == 0) ((float*)(ws + WS_RSQL))[m] = mx * (1.f / 127.f);
                      u32x2 q0, q1; q0.x = pack4_i8(y[0] * inv, y[1] * inv, y[2] * inv, y[3] * inv); q0.y = pack4_i8(y[4] * inv, y[5] * inv, y[6] * inv, y[7] * inv);
                      q1.x = pack4_i8(y[8] * inv, y[9] * inv, y[10] * inv, y[11] * inv); q1.y = pack4_i8(y[12] * inv, y[13] * inv, y[14] * inv, y[15] * inv);
                      *(u32x2*)(P_QL8 + (size_t)m * 1024 + lane * 8) = q0; *(u32x2*)(P_QL8 + (size_t)m * 1024 + 512 + lane * 8) = q1;
                  } else { *(u32x4*)(prow + C_QLAT + lane * 8) = oa; *(u32x4*)(prow + C_QLAT + 512 + lane * 8) = ob; } }
                { u32x4 a = *(const u32x4*)(prow + C_KVLAT + lane * 8);
                  float x[8] = {bf_lo(a.x), bf_hi(a.x), bf_lo(a.y), bf_hi(a.y), bf_lo(a.z), bf_hi(a.z), bf_lo(a.w), bf_hi(a.w)};
                  float s = 0.f;
#pragma unroll
                  for (int j = 0; j < 8; ++j) s += x[j] * x[j];
                  const float rstd = 1.0f / sqrtf(wave_sum(s) * (1.f / 512) + EPS);
                  const f32x4 g0 = *(const f32x4*)(gkv + lane * 8), g1 = *(const f32x4*)(gkv + lane * 8 + 4);
                  u32x4 oa;
                  oa.x = cvt_pk_bf16(x[0] * rstd * g0.x, x[1] * rstd * g0.y); oa.y = cvt_pk_bf16(x[2] * rstd * g0.z, x[3] * rstd * g0.w); oa.z = cvt_pk_bf16(x[4] * rstd * g1.x, x[5] * rstd * g1.y); oa.w = cvt_pk_bf16(x[6] * rstd * g1.z, x[7] * rstd * g1.w);
                  if (I8_MID) { float y[8]; float mx = 0.f; const float gg[8] = {g0.x, g0.y, g0.z, g0.w, g1.x, g1.y, g1.z, g1.w};
#pragma unroll
                      for (int j = 0; j < 8; ++j) { y[j] = x[j] * rstd * gg[j]; mx = __builtin_fmaxf(mx, __builtin_fabsf(y[j])); }
                      mx = wave_max(mx); const float inv = mx > 0.f ? 127.f / mx : 0.f; if (lane == 0) ((float*)(ws + WS_RSKVL))[m] = mx * (1.f / 127.f);
                      u32x2 q0; q0.x = pack4_i8(y[0] * inv, y[1] * inv, y[2] * inv, y[3] * inv); q0.y = pack4_i8(y[4] * inv, y[5] * inv, y[6] * inv, y[7] * inv);
                      *(u32x2*)(P_KVL8 + (size_t)m * 512 + lane * 8) = q0;
                  } else *(u32x4*)(prow + C_KVLAT + lane * 8) = oa; }
                if (lane < 32) { const int pos = m & posmask; unsigned w = *(const unsigned*)(prow + C_KPE + 2 * lane); const float x1 = bf_lo(w), x2 = bf_hi(w);
                  const float c = P_COS[pos * 32 + lane], s = P_SIN[pos * 32 + lane];
                  *(unsigned*)(prow + C_KPE + 2 * lane) = cvt_pk_bf16(x1 * c - x2 * s, x1 * s + x2 * c); }
            }
        }
        SEAM();

        if (RUN() && EN(4)) { LOCAL_TID();
            if (EN(18)) { pg8::Gemm gm{I8_MID ? (const bf16*)P_QL8 : P_P + C_QLAT, I8_MID ? 512 : NIN, P_WQT, TG, NQ, I8_MID ? 512 : 1024}; pg8::StaticOrder S; S.init(TG, NQ, G, bx);
              pg8::EpiQT<I8_MID != 0> E{P_Q, NQ, ws, posmask}; REP_LOOP_GEMM { int l2_ = lane_id_fresh(); asm volatile("" : "+v"(l2_)); pg8::gemm_phase<pg8::EpiQT<I8_MID != 0>, I8_MID ? 2 : 0>(ldsL, gm, S, E, wave * 64 + l2_); } }
            if (EN(19)) { pg8::Gemm gm{I8_MID ? (const bf16*)P_KVL8 : P_P + C_KVLAT, I8_MID ? 256 : NIN, P_WKVT, TG, NKV, I8_MID ? 256 : 512}; pg8::StaticOrder S; S.init(TG, NKV, G, bx);
              pg8::EpiStoreT<I8_MID != 0, WS_RSKVL, WS_CSKV> E{P_KV, NKV, 0, 0, 1.f, ws}; REP_LOOP_GEMM { int l2_ = lane_id_fresh(); asm volatile("" : "+v"(l2_)); pg8::gemm_phase<pg8::EpiStoreT<I8_MID != 0, WS_RSKVL, WS_CSKV>, I8_MID ? 2 : 0>(ldsL, gm, S, E, wave * 64 + l2_); } }
        }
        SEAM();

        if (RUN() && EN(5)) { LOCAL_TID();
            const int wid = wave;
            const float lam = P_LAM[0];
            if (EN(16)) _Pragma("unroll 1") for (int rep = 0; rep < REP_DIFF; ++rep) for (int u = vcu; u < 512; u += G) {
                const int head = u >> 5, rb = u & 31, row0 = rb * 256, kbase = (seqlen == 4096) ? (rb >> 4) * 4096 : 0, qpos0 = row0 - kbase;
                __syncthreads();
                if (tid < 257) ((float*)(lds + att::OFF_TBL))[tid] = P_BIAS2[head * 260 + tid];
                __syncthreads();
#pragma unroll 1
                for (int c = 0; c < 2; ++c) {
                    att::Ptrs P;
                    P.q[0] = P_P + (size_t)row0 * NIN + C_DQ + head * 128 + c * 64; P.q[1] = P.q[0]; P.q[2] = P.q[0];
                    P.k[0] = P_P + (size_t)kbase * NIN + C_DK + head * 128 + c * 64; P.k[1] = P.k[0]; P.k[2] = P.k[0];
                    P.v = P_P + (size_t)kbase * NIN + C_DV + head * 128;
                    f32x16 o[4];
                    att::attn_body<1, true, 2, att::StrDiff>(P, seqlen, qpos0, 0.125f * 1.4426950408889634f, (LAS char*)ldsL, o, tid);
                    int tid_e = tid; asm volatile("" : "+v"(tid_e));
                    const int r32 = tid_e & 31, hh = (tid_e >> 5) & 1;
                    f32x4* myst = (f32x4*)(P_STASH + ((size_t)bx * 512 + tid_e) * 64);
                    if (c == 0) {
#pragma unroll
                        for (int d = 0; d < 4; ++d)
#pragma unroll
                            for (int r4 = 0; r4 < 4; ++r4) myst[d * 4 + r4] = (f32x4){o[d][4 * r4], o[d][4 * r4 + 1], o[d][4 * r4 + 2], o[d][4 * r4 + 3]};
                    } else {
                        float ss[16];
#pragma unroll
                        for (int r = 0; r < 16; ++r) ss[r] = 0.f;
#pragma unroll
                        for (int d = 0; d < 4; ++d)
#pragma unroll
                            for (int r4 = 0; r4 < 4; ++r4) { const f32x4 s0 = myst[d * 4 + r4];
#pragma unroll
                                for (int j = 0; j < 4; ++j) { const float a = s0[j] - lam * o[d][4 * r4 + j]; o[d][4 * r4 + j] = a; ss[4 * r4 + j] += a * a; } }
#pragma unroll
                        for (int r = 0; r < 16; ++r) ss[r] = 0.8f / sqrtf(half_sum(ss[r]) * (1.f / 128) + EPS);
                        const float* sg = A->in[I_SUBG];
                        float gsub[4];
#pragma unroll
                        for (int d = 0; d < 4; ++d) gsub[d] = sg[d * 32 + r32];
#pragma unroll
                        for (int r = 0; r < 16; ++r) { bf16* orow = P_AO + (size_t)(row0 + wid * 32 + att::crow(r, hh)) * 2048 + head * 128 + r32;
#pragma unroll
                            for (int d = 0; d < 4; ++d) orow[d * 32] = (bf16)(cvt_pk_bf16(o[d][r] * ss[r] * gsub[d], 0.f) & 0xffffu); }
                    }
                }
            }
            if (EN(17)) _Pragma("unroll 1") for (int rep = 0; rep < REP_MLA; ++rep) for (int u = vcu; u < 512; u += G) {
                const int head = u >> 5, rb = u & 31, row0 = rb * 256, kbase = (seqlen == 4096) ? (rb >> 4) * 4096 : 0;
                att::Ptrs P;
                P.q[0] = P_Q + (size_t)row0 * NQ + head * 128; P.q[1] = P.q[0] + 64; P.q[2] = P_Q + (size_t)row0 * NQ + 2048 + head * 64;
                P.k[0] = P_KV + (size_t)kbase * NKV + head * 256; P.k[1] = P.k[0] + 64; P.k[2] = P_P + (size_t)kbase * NIN + C_KPE;
                P.v = P_KV + (size_t)kbase * NKV + head * 256 + 128;
                f32x16 o[4];
                att::attn_body<3, false, 1, att::StrMla>(P, seqlen, 0, 0.07216878364870323f * 1.4426950408889634f, (LAS char*)ldsL, o, tid);
                int tid_e = tid; asm volatile("" : "+v"(tid_e));
                const int r32 = tid_e & 31, hh = (tid_e >> 5) & 1;
#pragma unroll
                for (int r = 0; r < 16; ++r) { bf16* orow = P_BO + (size_t)(row0 + wid * 32 + att::crow(r, hh)) * 2048 + head * 128 + r32;
#pragma unroll
                    for (int d = 0; d < 4; ++d) orow[d * 32] = (bf16)(cvt_pk_bf16(o[d][r], 0.f) & 0xffffu); }
            }
        }
        SEAM();

#if I8_MID
        if (RUN()) { LOCAL_TID();
            for (int m = gw; m < 2 * TG; m += NGW) { const int row = m >> 1; const bool isB = m & 1;
                const bf16* srow = (isB ? P_BO : P_AO) + (size_t)row * 2048 + lane * 8; u32x4 a[4]; float mx = 0.f;
#pragma unroll
                for (int j = 0; j < 4; ++j) { a[j] = *(const u32x4*)(srow + 512 * j);
                    mx = __builtin_fmaxf(mx, __builtin_fmaxf(__builtin_fmaxf(__builtin_fmaxf(__builtin_fabsf(bf_lo(a[j].x)), __builtin_fabsf(bf_hi(a[j].x))), __builtin_fmaxf(__builtin_fabsf(bf_lo(a[j].y)), __builtin_fabsf(bf_hi(a[j].y)))),
                                                      __builtin_fmaxf(__builtin_fmaxf(__builtin_fabsf(bf_lo(a[j].z)), __builtin_fabsf(bf_hi(a[j].z))), __builtin_fmaxf(__builtin_fabsf(bf_lo(a[j].w)), __builtin_fabsf(bf_hi(a[j].w)))))); }
                mx = wave_max(mx); const float inv = mx > 0.f ? 127.f / mx : 0.f; if (lane == 0) ((float*)(ws + (isB ? WS_RSB : WS_RSA)))[row] = mx * (1.f / 127.f);
                unsigned char* drow = (isB ? P_BO8 : P_AO8) + (size_t)row * 2048 + lane * 8;
#pragma unroll
                for (int j = 0; j < 4; ++j) { u32x2 q; q.x = pack4_i8(bf_lo(a[j].x) * inv, bf_hi(a[j].x) * inv, bf_lo(a[j].y) * inv, bf_hi(a[j].y) * inv); q.y = pack4_i8(bf_lo(a[j].z) * inv, bf_hi(a[j].z) * inv, bf_lo(a[j].w) * inv, bf_hi(a[j].w) * inv); *(u32x2*)(drow + 512 * j) = q; }
            }
        }
        SEAM();
#endif

        if (RUN() && EN(6)) { LOCAL_TID();
            if (EN(20)) { pg8::Gemm gm{I8_MID ? (const bf16*)P_AO8 : P_AO, I8_MID ? 1024 : 2048, P_WAT, TG, DM, I8_MID ? 1024 : 2048}; pg8::StaticOrder S; S.init(TG, DM, G, bx);
              pg8::EpiGateAT<I8_MID != 0> E{P_MG, DM, P_P + C_GATE, NIN, ws}; REP_LOOP_GEMM { int l2_ = lane_id_fresh(); asm volatile("" : "+v"(l2_)); pg8::gemm_phase<pg8::EpiGateAT<I8_MID != 0>, I8_MID ? 2 : 0>(ldsL, gm, S, E, wave * 64 + l2_); } }
            if (EN(21)) { pg8::Gemm gm{I8_MID ? (const bf16*)P_BO8 : P_BO, I8_MID ? 1024 : 2048, P_WBT, TG, DM, I8_MID ? 1024 : 2048}; pg8::StaticOrder S; S.init(TG, DM, G, bx);
              pg8::EpiGateBT<I8_MID != 0> E{P_MG, DM, P_P + C_GATE + DM, NIN, P_MG, DM, ws}; REP_LOOP_GEMM { int l2_ = lane_id_fresh(); asm volatile("" : "+v"(l2_)); pg8::gemm_phase<pg8::EpiGateBT<I8_MID != 0>, I8_MID ? 2 : 0>(ldsL, gm, S, E, wave * 64 + l2_); } }
        }
        SEAM();

#if I8_MID
        if (RUN()) { LOCAL_TID();
            for (int m = gw; m < TG; m += NGW) {
                const bf16* srow = P_MG + (size_t)m * DM + lane * 8; u32x4 a[8]; float mx = 0.f;
#pragma unroll
                for (int j = 0; j < 8; ++j) { a[j] = *(const u32x4*)(srow + 512 * j);
                    mx = __builtin_fmaxf(mx, __builtin_fmaxf(__builtin_fmaxf(__builtin_fmaxf(__builtin_fabsf(bf_lo(a[j].x)), __builtin_fabsf(bf_hi(a[j].x))), __builtin_fmaxf(__builtin_fabsf(bf_lo(a[j].y)), __builtin_fabsf(bf_hi(a[j].y)))),
                                                      __builtin_fmaxf(__builtin_fmaxf(__builtin_fabsf(bf_lo(a[j].z)), __builtin_fabsf(bf_hi(a[j].z))), __builtin_fmaxf(__builtin_fabsf(bf_lo(a[j].w)), __builtin_fabsf(bf_hi(a[j].w)))))); }
                mx = wave_max(mx); const float inv = mx > 0.f ? 127.f / mx : 0.f; if (lane == 0) ((float*)(ws + WS_RSM))[m] = mx * (1.f / 127.f);
                unsigned char* drow = P_MG8 + (size_t)m * DM + lane * 8;
#pragma unroll
                for (int j = 0; j < 8; ++j) { u32x2 q; q.x = pack4_i8(bf_lo(a[j].x) * inv, bf_hi(a[j].x) * inv, bf_lo(a[j].y) * inv, bf_hi(a[j].y) * inv); q.y = pack4_i8(bf_lo(a[j].z) * inv, bf_hi(a[j].z) * inv, bf_lo(a[j].w) * inv, bf_hi(a[j].w) * inv); *(u32x2*)(drow + 512 * j) = q; }
            }
        }
        SEAM();
#endif

        if (RUN() && EN(7)) { LOCAL_TID();
            pg8::Gemm gm{I8_MID ? (const bf16*)P_MG8 : P_MG, I8_MID ? DM / 2 : DM, P_WOT, TG, DM, I8_MID ? DM / 2 : DM}; pg8::StaticOrder S; S.init(TG, DM, G, bx);
            pg8::EpiResT<I8_MID != 0, false> E{XG(), P_X1, DM, 1.f, ws}; REP_LOOP_GEMM { int l2_ = lane_id_fresh(); asm volatile("" : "+v"(l2_)); pg8::gemm_phase<pg8::EpiResT<I8_MID != 0, false>, I8_MID ? 2 : 0>(ldsL, gm, S, E, wave * 64 + l2_); }
        }
        SEAM();

        if (RUN() && EN(8)) { LOCAL_TID();
            const float* gv = A->in[I_RFG];
            for (int m = gw; m < TG; m += NGW) {
                const u32x2* xr = (const u32x2*)(P_X1 + (size_t)m * DM) + lane; f32x4 v[16]; float s = 0.f;
#pragma unroll
                for (int j = 0; j < 16; ++j) { const u32x2 w = xr[64 * j]; v[j] = (f32x4){bf_lo(w.x), bf_hi(w.x), bf_lo(w.y), bf_hi(w.y)}; s += (v[j].x * v[j].x + v[j].y * v[j].y) + (v[j].z * v[j].z + v[j].w * v[j].w); }
                const float rstd = 1.0f / sqrtf(wave_sum(s) * (1.f / DM) + EPS);
                if (I8_UP) { float mx = 0.f;
#pragma unroll
                    for (int j = 0; j < 16; ++j) { const f32x4 gg = ((const f32x4*)gv)[64 * j + lane]; v[j] = v[j] * rstd * gg; mx = __builtin_fmaxf(__builtin_fmaxf(mx, __builtin_fmaxf(__builtin_fabsf(v[j].x), __builtin_fabsf(v[j].y))), __builtin_fmaxf(__builtin_fabsf(v[j].z), __builtin_fabsf(v[j].w))); }
                    mx = wave_max(mx); const float inv = mx > 0.f ? 127.f / mx : 0.f; if (lane == 0) P_RSH[m] = mx * (1.f / 127.f);
                    unsigned* o4 = (unsigned*)((unsigned char*)P_H + (size_t)m * DM) + lane;
#pragma unroll
                    for (int j = 0; j < 16; ++j) o4[64 * j] = pack4_i8(v[j].x * inv, v[j].y * inv, v[j].z * inv, v[j].w * inv);
                } else {
                u32x2* o8 = (u32x2*)(P_H + (size_t)m * DM) + lane;
#pragma unroll
                for (int j = 0; j < 16; ++j) { const f32x4 gg = ((const f32x4*)gv)[64 * j + lane]; u32x2 w; w.x = cvt_pk_bf16(v[j].x * rstd * gg.x, v[j].y * rstd * gg.y); w.y = cvt_pk_bf16(v[j].z * rstd * gg.z, v[j].w * rstd * gg.w); o8[64 * j] = w; }
                }
            }
        }
        SEAM();

        if (RUN() && EN(9)) { LOCAL_TID();
            pg8::Gemm gm{P_H, I8_UP ? DM / 2 : DM, P_WUPT, TG, NUP, I8_UP ? DM / 2 : DM}; pg8::StaticOrder S; S.init(TG, NUP, G, bx);
#if CONV_FUSE
            static_assert(I8_UP, "CONV_FUSE needs the int8 up GEMM");
            pg8::EpiConv E{(unsigned char*)P_ACT, P_Y, A->in[I_CW], A->in[I_CB], ws, FP8_DOWN ? S_ACT8 : 1.f}; REP_LOOP_GEMM { int l2_ = lane_id_fresh(); asm volatile("" : "+v"(l2_)); pg8::gemm_phase<pg8::EpiConv, 2>(ldsL, gm, S, E, wave * 64 + l2_); }
#else
            pg8::EpiStoreT<I8_UP != 0, WS_RSH, WS_CSUP> E{P_Y, NUP, 0, 0, 1.f, ws}; REP_LOOP_GEMM { int l2_ = lane_id_fresh(); asm volatile("" : "+v"(l2_)); pg8::gemm_phase<pg8::EpiStoreT<I8_UP != 0, WS_RSH, WS_CSUP>, I8_UP ? 2 : 0>(ldsL, gm, S, E, wave * 64 + l2_); }
#endif
        }
        SEAM();

#if CONV_FUSE
        if (RUN() && EN(10)) { LOCAL_TID();
            const float* cw = A->in[I_CW]; const float* cb = A->in[I_CB];
            constexpr int NCB = DFF / 256, NITEM = NCB * (TG / 64) * 2;
            for (int it = gw; it < NITEM; it += NGW) {
                const int cbk = it % NCB, be = it / NCB, b = be >> 1, edge = be & 1, c0 = cbk * 256 + lane * 4, t = b * 64 + (edge ? 63 : 0);
                const int colg = (c0 >> 7) * 256 + (c0 & 127);
                const f32x4 wg0 = *(const f32x4*)(cw + c0), wg1 = *(const f32x4*)(cw + NUP + c0), wg2 = *(const f32x4*)(cw + 2 * NUP + c0), bg = *(const f32x4*)(cb + c0);
                const f32x4 wu0 = *(const f32x4*)(cw + DFF + c0), wu1 = *(const f32x4*)(cw + NUP + DFF + c0), wu2 = *(const f32x4*)(cw + 2 * NUP + DFF + c0), bu = *(const f32x4*)(cb + DFF + c0);
                auto ldyb = [&](int blk, int slot, f32x4& yg, f32x4& yu) {
                    const bf16* p = P_Y + ((size_t)blk * 4 + slot) * NUP + colg; const u32x2 a = *(const u32x2*)p, bb = *(const u32x2*)(p + 128);
                    yg = (f32x4){bf_lo(a.x), bf_hi(a.x), bf_lo(a.y), bf_hi(a.y)}; yu = (f32x4){bf_lo(bb.x), bf_hi(bb.x), bf_lo(bb.y), bf_hi(bb.y)}; };
                const f32x4 z = (f32x4){0.f, 0.f, 0.f, 0.f};
                f32x4 pg = z, pu = z, cg, cu, ng = z, nu = z;
                if (edge == 0) { ldyb(b, 0, cg, cu); ldyb(b, 1, ng, nu); if ((t & posmask) != 0) ldyb(b - 1, 3, pg, pu); }
                else { ldyb(b, 3, cg, cu); ldyb(b, 2, pg, pu); if (((t + 1) & posmask) != 0) ldyb(b + 1, 0, ng, nu); }
                const f32x4 ug = wg0 * pg + wg1 * cg + wg2 * ng + bg, uu = wu0 * pu + wu1 * cu + wu2 * nu + bu;
                float a[4];
#pragma unroll
                for (int j = 0; j < 4; ++j) a[j] = ug[j] * fast_sigmoid(ug[j]) * uu[j];
                if (FP8_DOWN) *(unsigned*)((unsigned char*)P_ACT + (size_t)t * DFF + c0) = pack4_fp8(a[0] * S_ACT8, a[1] * S_ACT8, a[2] * S_ACT8, a[3] * S_ACT8);
                else { u32x2 w; w.x = cvt_pk_bf16(a[0], a[1]); w.y = cvt_pk_bf16(a[2], a[3]); *(u32x2*)(P_ACT + (size_t)t * DFF + c0) = w; }
            }
        }
#else
        if (RUN() && EN(10)) { LOCAL_TID();
            const float* cw = A->in[I_CW]; const float* cb = A->in[I_CB];
            constexpr int RCH = 64, NCB = DFF / 256, NITEM = NCB * (TG / RCH);
            for (int it = gw; it < NITEM; it += NGW) {
                const int cbk = it % NCB, rc = it / NCB, c0 = cbk * 256 + lane * 4, t0 = rc * RCH;
                f32x4 wg0 = *(const f32x4*)(cw + c0), wg1 = *(const f32x4*)(cw + NUP + c0), wg2 = *(const f32x4*)(cw + 2 * NUP + c0), bg = *(const f32x4*)(cb + c0);
                f32x4 wu0 = *(const f32x4*)(cw + DFF + c0), wu1 = *(const f32x4*)(cw + NUP + DFF + c0), wu2 = *(const f32x4*)(cw + 2 * NUP + DFF + c0), bu = *(const f32x4*)(cb + DFF + c0);
                auto ldrow = [&](int t, f32x4& yg, f32x4& yu) {
                    const u32x2 a = *(const u32x2*)(P_Y + (size_t)t * NUP + c0), b = *(const u32x2*)(P_Y + (size_t)t * NUP + DFF + c0);
                    yg = (f32x4){bf_lo(a.x), bf_hi(a.x), bf_lo(a.y), bf_hi(a.y)}; yu = (f32x4){bf_lo(b.x), bf_hi(b.x), bf_lo(b.y), bf_hi(b.y)}; };
                const f32x4 z = (f32x4){0.f, 0.f, 0.f, 0.f};
                f32x4 pg = z, pu = z, cg, cu, ng, nu;
                if ((t0 & posmask) != 0) ldrow(t0 - 1, pg, pu);
                ldrow(t0, cg, cu);
#pragma unroll 4
                for (int t = t0; t < t0 + RCH; ++t) {
                    if (((t + 1) & posmask) != 0) ldrow(t + 1, ng, nu); else { ng = z; nu = z; }
                    const f32x4 ug = wg0 * pg + wg1 * cg + wg2 * ng + bg, uu = wu0 * pu + wu1 * cu + wu2 * nu + bu;
                    float a[4];
#pragma unroll
                    for (int j = 0; j < 4; ++j) a[j] = ug[j] * fast_sigmoid(ug[j]) * uu[j];
                    if (FP8_DOWN) *(unsigned*)((unsigned char*)P_ACT + (size_t)t * DFF + c0) = pack4_fp8(a[0] * S_ACT8, a[1] * S_ACT8, a[2] * S_ACT8, a[3] * S_ACT8);
                    else { u32x2 w; w.x = cvt_pk_bf16(a[0], a[1]); w.y = cvt_pk_bf16(a[2], a[3]); *(u32x2*)(P_ACT + (size_t)t * DFF + c0) = w; }
                    pg = cg; pu = cu; cg = ng; cu = nu;
                }
            }
        }
#endif
        SEAM();

        if (RUN() && EN(11)) { LOCAL_TID();
            pg8::Gemm gm{P_ACT, FP8_DOWN ? DFF / 2 : DFF, P_WDT, TG, DM, FP8_DOWN ? DFF / 2 : DFF}; pg8::StaticOrder S; S.init(TG, DM, G, bx);
            pg8::EpiResT<false, true> E{P_X1, P_X1, DM, FP8_DOWN ? 1.f / (S_WD * S_ACT8) : 1.f, ws}; { int l2_ = lane_id_fresh(); asm volatile("" : "+v"(l2_)); pg8::gemm_phase<pg8::EpiResT<false, true>, FP8_DOWN ? 1 : 0>(ldsL, gm, S, E, wave * 64 + l2_); }
        }
        SEAM();

        if (RUN() && EN(12)) { LOCAL_TID();
            const float* gv = A->in[I_FNG];
            for (int m = gw; m < TG; m += NGW) {
                const u32x2* xr = (const u32x2*)(P_X1 + (size_t)m * DM) + lane; f32x4* orow = (f32x4*)(OG() + (size_t)m * DM) + lane; f32x4 v[16]; float s = 0.f;
#pragma unroll
                for (int j = 0; j < 16; ++j) { const u32x2 w = xr[64 * j]; v[j] = (f32x4){bf_lo(w.x), bf_hi(w.x), bf_lo(w.y), bf_hi(w.y)}; s += (v[j].x * v[j].x + v[j].y * v[j].y) + (v[j].z * v[j].z + v[j].w * v[j].w); }
                const float rstd = 1.0f / sqrtf(wave_sum(s) * (1.f / DM) + EPS);
#pragma unroll
                for (int j = 0; j < 16; ++j) { const f32x4 gg = ((const f32x4*)gv)[64 * j + lane]; orow[64 * j] = v[j] * rstd * gg; }
            }
        }
        SEAM();
    }
#undef RUN
#undef SEAM
}

extern "C" void kernel_launch(void* const* d_in, const int* in_sizes, int n_in, void* d_out, int out_size, void* d_ws, size_t ws_size, hipStream_t stream) {
    static int grid = 0;
    if (grid == 0) {
        if (n_in != 23 || out_size != NTOK * DM || ws_size < WS_END) { fprintf(stderr, "kernel_launch: unexpected shapes: n_in %d out %d ws %zu (need %zu)\n", n_in, out_size, ws_size, (size_t)WS_END); grid = -1; return; }
        int dev = 0, cus = 0, per_cu = 0;
        if (hipGetDevice(&dev) != hipSuccess || hipDeviceGetAttribute(&cus, hipDeviceAttributeMultiprocessorCount, dev) != hipSuccess) { grid = -1; return; }
        if (hipFuncSetAttribute((const void*)enc_fwd, hipFuncAttributeMaxDynamicSharedMemorySize, LDS_BYTES) != hipSuccess) { fprintf(stderr, "kernel_launch: hipFuncSetAttribute failed\n"); grid = -1; return; }
        if (hipOccupancyMaxActiveBlocksPerMultiprocessor(&per_cu, (const void*)enc_fwd, NWAVES * 64, LDS_BYTES) != hipSuccess || per_cu < 1) { fprintf(stderr, "kernel_launch: occupancy query says %d\n", per_cu); per_cu = 1; }
        (void)hipGetLastError();
        grid = cus;
    }
    if (grid < 0) return;
    (void)hipMemsetAsync((char*)d_ws + WS_CTL, 0, CTL_ZERO_BYTES, stream);
    Args a{};
    for (int i = 0; i < 23; ++i) a.in[i] = (const float*)d_in[i];
    a.out = (float*)d_out; a.ws = (unsigned char*)d_ws;
    for (int i = 0; i < 32; ++i) a.invf[i] = powf(10000.0f, -(float)(2 * i) / 64.0f);
#if MK_PER_STEP_LAUNCH
    for (int s = 0; s < NSTEPS; ++s) { a.lo = s; a.hi = s + 1; hipLaunchKernelGGL(enc_fwd, dim3(grid), dim3(NWAVES * 64), LDS_BYTES, stream, a); }
#else
    a.lo = 0; a.hi = NSTEPS;
    hipLaunchKernelGGL(enc_fwd, dim3(grid), dim3(NWAVES * 64), LDS_BYTES, stream, a);
#endif
    const hipError_t le = hipPeekAtLastError();
    if (le != hipSuccess) fprintf(stderr, "kernel_launch: launch failed: %s\n", hipGetErrorName(le));
}
```

```cpp
#include <hip/hip_runtime.h>
#include <cstdio>
#include <cstdint>
#include <cmath>

#ifndef I8_IN
#define I8_IN 1
#endif
#ifndef ATT_CINIT
#define ATT_CINIT 1
#endif
constexpr float CS_DIFF = 0.125f * 1.4426950408889634f;
#ifndef CONV_FUSE
#define CONV_FUSE 1
#endif
#ifndef I8_MID
#define I8_MID 1
#endif
#ifndef I8_UP
#define I8_UP 1
#endif
#ifndef FP8_DOWN
#define FP8_DOWN 1
#endif
constexpr float S_WD = 1024.f, S_ACT8 = 8.f;
#ifndef REP_GEMM
#define REP_GEMM 1
#endif
#ifndef REP_DIFF
#define REP_DIFF 1
#endif
#ifndef REP_MLA
#define REP_MLA 1
#endif
#if REP_GEMM == 1
#define REP_LOOP_GEMM
#else
#define REP_LOOP_GEMM _Pragma("unroll 1") for (int rep = 0; rep < REP_GEMM; ++rep)
#endif
#ifndef MK_PER_STEP_LAUNCH
#define MK_PER_STEP_LAUNCH 0
#endif

typedef unsigned short bf16;
typedef short bf16x8 __attribute__((ext_vector_type(8)));
typedef short s16x4 __attribute__((ext_vector_type(4)));
typedef float f32x4 __attribute__((ext_vector_type(4)));
typedef float f32x2 __attribute__((ext_vector_type(2)));
typedef float f32x16 __attribute__((ext_vector_type(16)));
typedef unsigned u32x4 __attribute__((ext_vector_type(4)));
typedef unsigned u32x2 __attribute__((ext_vector_type(2)));
typedef int i32x4 __attribute__((ext_vector_type(4)));
typedef int i32x8 __attribute__((ext_vector_type(8)));
#define LAS __attribute__((address_space(3)))

__device__ __forceinline__ unsigned cvt_pk_bf16(float lo, float hi) { unsigned r; asm volatile("v_cvt_pk_bf16_f32 %0, %1, %2" : "=v"(r) : "v"(lo), "v"(hi)); return r; }
__device__ __forceinline__ float bf_lo(unsigned w) { return __uint_as_float(w << 16); }
__device__ __forceinline__ float bf_hi(unsigned w) { return __uint_as_float(w & 0xffff0000u); }
__device__ __forceinline__ float clamp448(float x) { return __builtin_fminf(__builtin_fmaxf(x, -448.f), 448.f); }
__device__ __forceinline__ unsigned pack4_fp8(float a, float b, float c, float d) { int w = 0; w = __builtin_amdgcn_cvt_pk_fp8_f32(clamp448(a), clamp448(b), w, false); w = __builtin_amdgcn_cvt_pk_fp8_f32(clamp448(c), clamp448(d), w, true); return (unsigned)w; }
__device__ __forceinline__ unsigned pack4_i8(float a, float b, float c, float d) { const int ia = (int)__builtin_rintf(a), ib = (int)__builtin_rintf(b), ic = (int)__builtin_rintf(c), id = (int)__builtin_rintf(d);
    return (unsigned)(ia & 255) | ((unsigned)(ib & 255) << 8) | ((unsigned)(ic & 255) << 16) | ((unsigned)id << 24); }
__device__ __forceinline__ float fast_sigmoid(float x) { return __builtin_amdgcn_rcpf(1.0f + __builtin_amdgcn_exp2f(-1.4426950408889634f * x)); }

__device__ __forceinline__ int lane_id_fresh() { unsigned ones = ~0u; asm volatile("" : "+s"(ones)); return (int)__builtin_amdgcn_mbcnt_hi(ones, __builtin_amdgcn_mbcnt_lo(ones, 0u)); }

constexpr int DM = 4096, NTOK = 32768, TG = 8192, NGRP = 4;
constexpr int NIN = 16128;
constexpr int C_DQ = 0, C_DK = 2048, C_DV = 4096, C_QLAT = 6144, C_KVLAT = 7168, C_GATE = 7680, C_KPE = 15872;
constexpr int DFF = 11008, NUP = 22016, NQ = 3072, NKV = 4096;
constexpr float EPS = 1e-6f;

constexpr size_t MiB = 1u << 20;
constexpr size_t WS_CTL = 0, CTL_ZERO_BYTES = 1 * MiB;
constexpr size_t WS_COS = 1 * MiB, WS_SIN = 2 * MiB, WS_BIAS = 3 * MiB, WS_LAM = 3 * MiB + 32768;
constexpr size_t WS_CSIN = 3 * MiB + 65536, WS_CSUP = 3 * MiB + 131072, WS_RSH = 3 * MiB + 262144;
constexpr size_t WS_CSQ = 3 * MiB + 320 * 1024, WS_CSKV = 3 * MiB + 336 * 1024, WS_CSA = 3 * MiB + 352 * 1024, WS_CSB = 3 * MiB + 368 * 1024, WS_CSO = 3 * MiB + 384 * 1024;
constexpr size_t WS_RSQL = 3 * MiB + 400 * 1024, WS_RSKVL = 3 * MiB + 432 * 1024, WS_RSA = 3 * MiB + 464 * 1024, WS_RSB = 3 * MiB + 496 * 1024, WS_RSM = 3 * MiB + 528 * 1024;
constexpr size_t WS_WIN = 4 * MiB, WS_WQ = 130 * MiB, WS_WKV = 136 * MiB, WS_WA = 140 * MiB, WS_WB = 156 * MiB, WS_WO = 172 * MiB, WS_WUP = 204 * MiB, WS_WD = 376 * MiB;
constexpr size_t WS_ACT = 462 * MiB;
constexpr size_t WS_H = WS_ACT, WS_P = WS_ACT + 64 * MiB, WS_Q = WS_ACT + 316 * MiB, WS_KV = WS_ACT + 364 * MiB, WS_AO = WS_ACT + 428 * MiB, WS_BO = WS_ACT + 460 * MiB, WS_MG = WS_ACT + 492 * MiB, WS_STASH = WS_ACT + 556 * MiB;
constexpr size_t WS_Y = WS_ACT + 64 * MiB, WS_ACTV = WS_ACT + 408 * MiB;
constexpr size_t WS_QL8 = WS_ACT + 588 * MiB, WS_KVL8 = WS_ACT + 596 * MiB, WS_AO8 = WS_ACT + 600 * MiB, WS_BO8 = WS_ACT + 616 * MiB, WS_MG8 = WS_ACT + 632 * MiB;
constexpr size_t WS_X1 = WS_ACT + 664 * MiB;
constexpr size_t WS_END = WS_ACT + 728 * MiB;
static_assert(WS_WIN + (size_t)NIN * DM * 2 <= WS_WQ && WS_WUP + (size_t)NUP * DM * 2 <= WS_WD && WS_WD + (size_t)DM * DFF * 2 <= WS_ACT, "weight map");
static_assert(WS_P + (size_t)TG * NIN * 2 <= WS_Q && WS_Y + (size_t)TG * NUP * 2 <= WS_ACTV && WS_ACTV + (size_t)TG * DFF * 2 <= WS_STASH + 32 * MiB, "activation map");

namespace pg8 {
constexpr int BM = 256, BK = 64, HALF = 128, HTB = HALF * BK * 2, STAGE_BYTES = 8 * HTB, NXCD = 8, WGM = 8;
__host__ __device__ __forceinline__ int lds_byte(int r, int c) { const int st = (r >> 4) * 2 + (c >> 5), rr = r & 15, cc = c & 31, ob = rr * 64 + cc * 2; return st * 1024 + (ob ^ (((ob >> 9) & 1) << 5)); }
__host__ __device__ __forceinline__ void stage_rc(int b, int& R, int& C) { const int st = b / 1024, sb = b % 1024, swz = sb ^ (((sb >> 9) & 1) << 5); R = (st >> 1) * 16 + swz / 64; C = (st & 1) * 32 + (swz % 64) / 2; }
__host__ __device__ __forceinline__ int perm32(int rho) { const int n = rho >> 4, i = rho & 15; return 8 * (i >> 2) + 4 * n + (i & 3); }

struct Unit { int pm, pn; };
struct Gemm { const bf16* A; int lda; const bf16* Bt; int M, N, K; };

struct StaticOrder {
    int nM, nN, nwg, G, c;
    __device__ void init(int M, int N, int G_, int c_) { nM = M / BM; nN = N / BM; nwg = nM * nN; G = G_; c = c_; }
    __device__ bool next(int i, Unit& u) const {
        const long L = (long)i * G + c; if (L >= nwg) return false;
        int wgid = (int)L; { const int q = nwg / NXCD, r = nwg % NXCD, xcd = wgid % NXCD, off = wgid / NXCD; wgid = (xcd < r ? xcd * (q + 1) : r * (q + 1) + (xcd - r) * q) + off; }
        const int nig = WGM * nN, gid = wgid / nig, fm = gid * WGM, gsz = (nM - fm) < WGM ? (nM - fm) : WGM;
        u.pm = fm + ((wgid % nig) % gsz); u.pn = (wgid % nig) / gsz; return true;
    }
};

template <int MODE> struct AccSel { typedef f32x4 T; }; template <> struct AccSel<2> { typedef i32x4 T; };
__device__ __forceinline__ f32x4 tof(f32x4 v) { return v; }
__device__ __forceinline__ f32x4 tof(i32x4 v) { return __builtin_convertvector(v, f32x4); }

template <class Epi, int MODE = 0>
__device__ __forceinline__ void gemm_phase(LAS unsigned char* lds, const Gemm g, const StaticOrder& S, const Epi& E, int tid_in) {
    int tid = tid_in; asm volatile("" : "+v"(tid));
    const int wid = __builtin_amdgcn_readfirstlane(tid >> 6), lane = tid & 63, wr = wid >> 2, wc = wid & 3, fr = lane & 15, fq = lane >> 4;
    int K = g.K, lda = g.lda; asm volatile("" : "+s"(K), "+s"(lda));
    const int nt = K / BK;
    unsigned voffA[2], voffB[2];
#pragma unroll
    for (int i = 0; i < 2; ++i) { int R, C; stage_rc(tid * 16 + i * 8192, R, C); const int Rb = (R & ~31) + perm32(R & 31);
        voffA[i] = (unsigned)(R * lda + C) * 2u; voffB[i] = (unsigned)(Rb * K + C) * 2u; }
    const size_t kstep = (size_t)(BK * 2);
    const size_t hstepA = (size_t)HALF * lda * 2, hstepB = (size_t)HALF * K * 2;
    const size_t tstepA = 2 * hstepA, tstepB = 2 * hstepB;
    const unsigned ldsw = (unsigned)wid * 1024u;
    const int aoff = lds_byte(wr * 64 + fr, fq * 8), boff = lds_byte(wc * 32 + fr, fq * 8);
#define PG8_SA(b, h) (((b) * 2 + (h)) * HTB)
#define PG8_SB(b, h) ((4 + (b) * 2 + (h)) * HTB)
#define PG8_STAGE(bufoff, gbase, voff) do { _Pragma("unroll") for (int _i = 0; _i < 2; ++_i) \
        __builtin_amdgcn_global_load_lds((const unsigned*)((const char*)(gbase) + (voff)[_i]), (LAS unsigned*)(lds + (bufoff) + ldsw + _i * 8192), 16, 0, 0); } while (0)
#define PG8_CAT(x, y) __builtin_shufflevector(__builtin_bit_cast(i32x4, x), __builtin_bit_cast(i32x4, y), 0, 1, 2, 3, 4, 5, 6, 7)
#define PG8_LDA(dst, b, h) do { _Pragma("unroll") for (int m = 0; m < 4; ++m) dst[m] = PG8_CAT(*(const LAS bf16x8*)(lds + PG8_SA(b, h) + aoff + m * 2048), *(const LAS bf16x8*)(lds + PG8_SA(b, h) + aoff + m * 2048 + 1024)); } while (0)
#define PG8_LDB(dst, b, h) do { _Pragma("unroll") for (int n = 0; n < 2; ++n) dst[n] = PG8_CAT(*(const LAS bf16x8*)(lds + PG8_SB(b, h) + boff + n * 2048), *(const LAS bf16x8*)(lds + PG8_SB(b, h) + boff + n * 2048 + 1024)); } while (0)
#define PG8_LO4(v) __builtin_shufflevector(v, v, 0, 1, 2, 3)
#define PG8_HI4(v) __builtin_shufflevector(v, v, 4, 5, 6, 7)
#define PG8_LO(v) __builtin_bit_cast(bf16x8, __builtin_shufflevector(v, v, 0, 1, 2, 3))
#define PG8_HI(v) __builtin_bit_cast(bf16x8, __builtin_shufflevector(v, v, 4, 5, 6, 7))
#define PG8_MMA(ai, bj, At, Bt) do { __builtin_amdgcn_s_setprio(1); _Pragma("unroll") for (int m = 0; m < 4; ++m) _Pragma("unroll") for (int n = 0; n < 2; ++n) { \
        if constexpr (F8) asm volatile("v_mfma_f32_16x16x128_f8f6f4 %0, %1, %2, %0" : "+v"(acc[ai][bj][m][n]) : "v"(Bt[n]), "v"(At[m]));   \
        else if constexpr (MODE == 2) { acc[ai][bj][m][n] = __builtin_amdgcn_mfma_i32_16x16x64_i8(PG8_LO4(Bt[n]), PG8_LO4(At[m]), acc[ai][bj][m][n], 0, 0, 0); \
               acc[ai][bj][m][n] = __builtin_amdgcn_mfma_i32_16x16x64_i8(PG8_HI4(Bt[n]), PG8_HI4(At[m]), acc[ai][bj][m][n], 0, 0, 0); } \
        else { acc[ai][bj][m][n] = __builtin_amdgcn_mfma_f32_16x16x32_bf16(PG8_LO(Bt[n]), PG8_LO(At[m]), acc[ai][bj][m][n], 0, 0, 0); \
               acc[ai][bj][m][n] = __builtin_amdgcn_mfma_f32_16x16x32_bf16(PG8_HI(Bt[n]), PG8_HI(At[m]), acc[ai][bj][m][n], 0, 0, 0); } } __builtin_amdgcn_s_setprio(0); } while (0)
#define PG8_WAIT_V(n) asm volatile("s_waitcnt vmcnt(" #n ")" ::: "memory")
#define PG8_WAIT_L(n) asm volatile("s_waitcnt lgkmcnt(" #n ")" ::: "memory")
#define PG8_BAR __builtin_amdgcn_s_barrier()
#define PG8_SCHED __builtin_amdgcn_sched_barrier(0)
    Unit cur, nxt; int ui = 0;
    if (!S.next(0, cur)) return;
    constexpr bool F8 = (MODE == 1); typedef typename AccSel<MODE>::T AccT; AccT acc[2][2][4][2];
#pragma unroll
    for (int a = 0; a < 2; ++a)
#pragma unroll
        for (int b = 0; b < 2; ++b)
#pragma unroll
            for (int m = 0; m < 4; ++m)
#pragma unroll
                for (int n = 0; n < 2; ++n) acc[a][b][m][n] = AccT{};
    i32x8 At[4], B0[2], B1[2];
    const char* cA = (const char*)g.A + (size_t)cur.pm * tstepA; const char* cB = (const char*)g.Bt + (size_t)cur.pn * tstepB;
    PG8_STAGE(PG8_SB(0, 0), cB, voffB); PG8_STAGE(PG8_SB(0, 1), cB + hstepB, voffB); PG8_STAGE(PG8_SA(0, 0), cA, voffA); PG8_STAGE(PG8_SA(0, 1), cA + hstepA, voffA);
    if (wr == 1) PG8_BAR;
    PG8_WAIT_V(2); PG8_BAR;
    PG8_STAGE(PG8_SB(1, 0), cB + kstep, voffB); PG8_STAGE(PG8_SA(1, 0), cA + kstep, voffA); PG8_STAGE(PG8_SB(1, 1), cB + hstepB + kstep, voffB);
    PG8_WAIT_V(6); PG8_BAR;
    for (;;) {
        const bool has_next = S.next(ui + 1, nxt);
        const char* nA = has_next ? (const char*)g.A + (size_t)nxt.pm * tstepA : cA; const char* nB = has_next ? (const char*)g.Bt + (size_t)nxt.pn * tstepB : cB;
        for (int t = 0; t < nt; t += 2) {
            const bool last = (t == nt - 2);
            const char* a1 = cA + (size_t)(t + 1) * kstep;
            const char* a2 = last ? nA : cA + (size_t)(t + 2) * kstep; const char* b2 = last ? nB : cB + (size_t)(t + 2) * kstep;
            const char* a3 = a2 + kstep; const char* b3 = b2 + kstep;
            PG8_LDB(B0, 0, 0); PG8_LDB(B1, 0, 1); PG8_SCHED; PG8_LDA(At, 0, 0); PG8_STAGE(PG8_SA(1, 1), a1 + hstepA, voffA);
            PG8_WAIT_V(8); PG8_WAIT_L(0); PG8_BAR; PG8_MMA(0, 0, At, B0); PG8_MMA(0, 1, At, B1); PG8_BAR; PG8_SCHED;
            PG8_LDA(At, 0, 1); PG8_STAGE(PG8_SB(0, 0), b2, voffB); PG8_STAGE(PG8_SB(0, 1), b2 + hstepB, voffB); PG8_STAGE(PG8_SA(0, 0), a2, voffA);
            PG8_WAIT_V(8); PG8_WAIT_L(0); PG8_BAR; PG8_MMA(1, 0, At, B0); PG8_MMA(1, 1, At, B1); PG8_BAR; PG8_SCHED;
            PG8_LDB(B0, 1, 0); PG8_LDB(B1, 1, 1); PG8_SCHED; PG8_LDA(At, 1, 0); PG8_STAGE(PG8_SA(0, 1), a2 + hstepA, voffA);
            PG8_WAIT_V(8); PG8_WAIT_L(0); PG8_BAR; PG8_MMA(0, 0, At, B0); PG8_MMA(0, 1, At, B1); PG8_BAR; PG8_SCHED;
            PG8_LDA(At, 1, 1); PG8_STAGE(PG8_SB(1, 0), b3, voffB); PG8_STAGE(PG8_SB(1, 1), b3 + hstepB, voffB); PG8_STAGE(PG8_SA(1, 0), a3, voffA);
            PG8_WAIT_V(8); PG8_WAIT_L(0); PG8_BAR; PG8_MMA(1, 0, At, B0); PG8_MMA(1, 1, At, B1); PG8_BAR; PG8_SCHED;
        }
        if (wr == 0) PG8_BAR;
        if constexpr (F8) asm volatile("s_nop 15\n\ts_nop 15" ::: "memory");
        { int l3_ = lane_id_fresh(); asm volatile("" : "+v"(l3_)); E(acc, cur, wr, wc, l3_ & 15, l3_ >> 4); }
        if (!has_next) break;
#pragma unroll
        for (int a = 0; a < 2; ++a)
#pragma unroll
            for (int b = 0; b < 2; ++b)
#pragma unroll
                for (int m = 0; m < 4; ++m)
#pragma unroll
                    for (int n = 0; n < 2; ++n) acc[a][b][m][n] = AccT{};
        cur = nxt; cA = nA; cB = nB; ++ui;
        if (wr == 1) PG8_BAR;
    }
    PG8_WAIT_V(0);
    PG8_BAR;
#undef PG8_SA
#undef PG8_SB
#undef PG8_STAGE
#undef PG8_LDA
#undef PG8_LDB
#undef PG8_MMA
#undef PG8_CAT
#undef PG8_LO
#undef PG8_LO4
#undef PG8_HI4
#undef PG8_HI
#undef PG8_WAIT_V
#undef PG8_WAIT_L
#undef PG8_BAR
#undef PG8_SCHED
}

template <bool SC, size_t RSOFF = 0, size_t CSOFF = 0> struct EpiStoreT {
    bf16* O; int ldc; int sig_lo, sig_hi; float scale; const unsigned char* wsb;
    template <class AccT> __device__ __forceinline__ void operator()(const AccT (&acc)[2][2][4][2], const Unit& u, int wr, int wc, int fr, int fq) const {
        const bool sig = (u.pn >= sig_lo && u.pn < sig_hi);
        const int row0 = u.pm * BM + wr * 64 + fr, col0 = u.pn * BM + wc * 32 + 8 * fq;
        const float* rs = (const float*)(wsb + RSOFF); const float* cs = (const float*)(wsb + CSOFF);
        const float tsc = (u.pn < 8) ? scale : 1.f;
        f32x4 cv[2][2];
#pragma unroll
        for (int bj = 0; bj < 2; ++bj) { if constexpr (SC) { cv[bj][0] = *(const f32x4*)(cs + col0 + bj * HALF) * tsc; cv[bj][1] = *(const f32x4*)(cs + col0 + bj * HALF + 4) * tsc; } else { cv[bj][0] = (f32x4){tsc, tsc, tsc, tsc}; cv[bj][1] = cv[bj][0]; } }
#pragma unroll
        for (int ai = 0; ai < 2; ++ai)
#pragma unroll
            for (int m = 0; m < 4; ++m) { bf16* rowp = O + (size_t)(row0 + ai * HALF + m * 16) * ldc + col0; float rsv = 1.f; if constexpr (SC) rsv = rs[row0 + ai * HALF + m * 16];
#pragma unroll
                for (int bj = 0; bj < 2; ++bj) { f32x4 v0 = tof(acc[ai][bj][m][0]) * (cv[bj][0] * rsv), v1 = tof(acc[ai][bj][m][1]) * (cv[bj][1] * rsv);
                    if (sig) {
#pragma unroll
                        for (int j = 0; j < 4; ++j) { v0[j] = fast_sigmoid(v0[j]); v1[j] = fast_sigmoid(v1[j]); } }
                    u32x4 w; w.x = cvt_pk_bf16(v0[0], v0[1]); w.y = cvt_pk_bf16(v0[2], v0[3]); w.z = cvt_pk_bf16(v1[0], v1[1]); w.w = cvt_pk_bf16(v1[2], v1[3]);
                    *(u32x4*)(rowp + bj * HALF) = w; }
                asm volatile("" ::: "memory"); }
    }
};
template <bool SC> struct EpiQT {
    bf16* O; int ldc; const unsigned char* wsb; int posmask;
    template <class AccT> __device__ __forceinline__ void operator()(const AccT (&acc)[2][2][4][2], const Unit& u, int wr, int wc, int fr, int fq) const {
        const bool rope = (u.pn >= 8);
        const int row0 = u.pm * BM + wr * 64 + fr, col0 = u.pn * BM + wc * 32 + 8 * fq;
        const float* cosT = (const float*)(wsb + WS_COS); const float* sinT = (const float*)(wsb + WS_SIN); const float* rs = (const float*)(wsb + WS_RSQL); const float* cs = (const float*)(wsb + WS_CSQ);
        f32x4 cv[2][2];
#pragma unroll
        for (int bj = 0; bj < 2; ++bj) { if constexpr (SC) { cv[bj][0] = *(const f32x4*)(cs + col0 + bj * HALF); cv[bj][1] = *(const f32x4*)(cs + col0 + bj * HALF + 4); } else { cv[bj][0] = (f32x4){1.f, 1.f, 1.f, 1.f}; cv[bj][1] = cv[bj][0]; } }
#pragma unroll
        for (int ai = 0; ai < 2; ++ai)
#pragma unroll
            for (int m = 0; m < 4; ++m) { const int row = row0 + ai * HALF + m * 16; bf16* rowp = O + (size_t)row * ldc + col0; const int pos = row & posmask; float rsv = 1.f; if constexpr (SC) rsv = rs[row];
#pragma unroll
                for (int bj = 0; bj < 2; ++bj) { f32x4 v0 = tof(acc[ai][bj][m][0]) * (cv[bj][0] * rsv), v1 = tof(acc[ai][bj][m][1]) * (cv[bj][1] * rsv);
                    if (rope) { const int i0 = (((col0 + bj * HALF) & 63) >> 1);
                        const f32x4 c = *(const f32x4*)(cosT + (size_t)pos * 32 + i0), s = *(const f32x4*)(sinT + (size_t)pos * 32 + i0);
                        f32x4 a, b;
                        a[0] = v0[0] * c[0] - v0[1] * s[0]; a[1] = v0[0] * s[0] + v0[1] * c[0]; a[2] = v0[2] * c[1] - v0[3] * s[1]; a[3] = v0[2] * s[1] + v0[3] * c[1];
                        b[0] = v1[0] * c[2] - v1[1] * s[2]; b[1] = v1[0] * s[2] + v1[1] * c[2]; b[2] = v1[2] * c[3] - v1[3] * s[3]; b[3] = v1[2] * s[3] + v1[3] * c[3];
                        v0 = a; v1 = b; }
                    u32x4 w; w.x = cvt_pk_bf16(v0[0], v0[1]); w.y = cvt_pk_bf16(v0[2], v0[3]); w.z = cvt_pk_bf16(v1[0], v1[1]); w.w = cvt_pk_bf16(v1[2], v1[3]);
                    *(u32x4*)(rowp + bj * HALF) = w; } }
    }
};
template <bool SC> struct EpiGateAT {
    bf16* part; int ldp; const bf16* gate; int ldg; const unsigned char* wsb;
    template <class AccT> __device__ __forceinline__ void operator()(const AccT (&acc)[2][2][4][2], const Unit& u, int wr, int wc, int fr, int fq) const {
        const int row0 = u.pm * BM + wr * 64 + fr, col0 = u.pn * BM + wc * 32 + 8 * fq;
        const float* rs = (const float*)(wsb + WS_RSA); const float* cs = (const float*)(wsb + WS_CSA);
        f32x4 cv[2][2];
#pragma unroll
        for (int bj = 0; bj < 2; ++bj) { if constexpr (SC) { cv[bj][0] = *(const f32x4*)(cs + col0 + bj * HALF); cv[bj][1] = *(const f32x4*)(cs + col0 + bj * HALF + 4); } else { cv[bj][0] = (f32x4){1.f, 1.f, 1.f, 1.f}; cv[bj][1] = cv[bj][0]; } }
#pragma unroll
        for (int ai = 0; ai < 2; ++ai) {
            u32x4 gw[4][2]; float rsv[4];
#pragma unroll
            for (int m = 0; m < 4; ++m) { const size_t row = (size_t)(row0 + ai * HALF + m * 16); rsv[m] = 1.f; if constexpr (SC) rsv[m] = rs[row];
#pragma unroll
                for (int bj = 0; bj < 2; ++bj) gw[m][bj] = *(const u32x4*)(gate + row * ldg + col0 + bj * HALF); }
#pragma unroll
            for (int m = 0; m < 4; ++m) { const size_t row = (size_t)(row0 + ai * HALF + m * 16);
#pragma unroll
                for (int bj = 0; bj < 2; ++bj) { const f32x4 v0 = tof(acc[ai][bj][m][0]) * (cv[bj][0] * rsv[m]), v1 = tof(acc[ai][bj][m][1]) * (cv[bj][1] * rsv[m]); const u32x4 g = gw[m][bj];
                    u32x4 w; w.x = cvt_pk_bf16(v0[0] * bf_lo(g.x), v0[1] * bf_hi(g.x)); w.y = cvt_pk_bf16(v0[2] * bf_lo(g.y), v0[3] * bf_hi(g.y)); w.z = cvt_pk_bf16(v1[0] * bf_lo(g.z), v1[1] * bf_hi(g.z)); w.w = cvt_pk_bf16(v1[2] * bf_lo(g.w), v1[3] * bf_hi(g.w));
                    *(u32x4*)(part + row * ldp + col0 + bj * HALF) = w; } }
            asm volatile("" ::: "memory");
        }
    }
};
template <bool SC> struct EpiGateBT {
    const bf16* part; int ldp; const bf16* gate; int ldg; bf16* O; int ldc; const unsigned char* wsb;
    template <class AccT> __device__ __forceinline__ void operator()(const AccT (&acc)[2][2][4][2], const Unit& u, int wr, int wc, int fr, int fq) const {
        const int row0 = u.pm * BM + wr * 64 + fr, col0 = u.pn * BM + wc * 32 + 8 * fq;
        const float* rs = (const float*)(wsb + WS_RSB); const float* cs = (const float*)(wsb + WS_CSB);
        f32x4 cv[2][2];
#pragma unroll
        for (int bj = 0; bj < 2; ++bj) { if constexpr (SC) { cv[bj][0] = *(const f32x4*)(cs + col0 + bj * HALF); cv[bj][1] = *(const f32x4*)(cs + col0 + bj * HALF + 4); } else { cv[bj][0] = (f32x4){1.f, 1.f, 1.f, 1.f}; cv[bj][1] = cv[bj][0]; } }
#pragma unroll
        for (int ai = 0; ai < 2; ++ai) {
            u32x4 gw[4][2], pw[4][2]; float rsv[4];
#pragma unroll
            for (int m = 0; m < 4; ++m) { const size_t row = (size_t)(row0 + ai * HALF + m * 16); rsv[m] = 1.f; if constexpr (SC) rsv[m] = rs[row];
#pragma unroll
                for (int bj = 0; bj < 2; ++bj) { gw[m][bj] = *(const u32x4*)(gate + row * ldg + col0 + bj * HALF); pw[m][bj] = *(const u32x4*)(part + row * ldp + col0 + bj * HALF); } }
#pragma unroll
            for (int m = 0; m < 4; ++m) { const size_t row = (size_t)(row0 + ai * HALF + m * 16);
#pragma unroll
                for (int bj = 0; bj < 2; ++bj) { const f32x4 v0 = tof(acc[ai][bj][m][0]) * (cv[bj][0] * rsv[m]), v1 = tof(acc[ai][bj][m][1]) * (cv[bj][1] * rsv[m]); const u32x4 g = gw[m][bj], p = pw[m][bj];
                    u32x4 w; w.x = cvt_pk_bf16(bf_lo(p.x) + v0[0] * bf_lo(g.x), bf_hi(p.x) + v0[1] * bf_hi(g.x)); w.y = cvt_pk_bf16(bf_lo(p.y) + v0[2] * bf_lo(g.y), bf_hi(p.y) + v0[3] * bf_hi(g.y));
                    w.z = cvt_pk_bf16(bf_lo(p.z) + v1[0] * bf_lo(g.z), bf_hi(p.z) + v1[1] * bf_hi(g.z)); w.w = cvt_pk_bf16(bf_lo(p.w) + v1[2] * bf_lo(g.w), bf_hi(p.w) + v1[3] * bf_hi(g.w));
                    *(u32x4*)(O + row * ldc + col0 + bj * HALF) = w; } }
            asm volatile("" ::: "memory");
        }
    }
};
template <bool SC, bool SRCB> struct EpiResT {
    const void* src; bf16* dst; int ld; float scale; const unsigned char* wsb;
    template <class AccT> __device__ __forceinline__ void operator()(const AccT (&acc)[2][2][4][2], const Unit& u, int wr, int wc, int fr, int fq) const {
        const int row0 = u.pm * BM + wr * 64 + fr, col0 = u.pn * BM + wc * 32 + 8 * fq;
        const float* rs = (const float*)(wsb + WS_RSM); const float* cs = (const float*)(wsb + WS_CSO);
        f32x4 cv[2][2];
#pragma unroll
        for (int bj = 0; bj < 2; ++bj) { if constexpr (SC) { cv[bj][0] = *(const f32x4*)(cs + col0 + bj * HALF); cv[bj][1] = *(const f32x4*)(cs + col0 + bj * HALF + 4); } else { cv[bj][0] = (f32x4){scale, scale, scale, scale}; cv[bj][1] = cv[bj][0]; } }
#pragma unroll
        for (int ai = 0; ai < 2; ++ai)
#pragma unroll
            for (int mh = 0; mh < 2; ++mh) {
                f32x4 sv[2][2][2]; float rsv[2];
#pragma unroll
                for (int mm = 0; mm < 2; ++mm) { const int m = 2 * mh + mm; const size_t off = (size_t)(row0 + ai * HALF + m * 16) * ld + col0; rsv[mm] = 1.f; if constexpr (SC) rsv[mm] = rs[row0 + ai * HALF + m * 16];
#pragma unroll
                    for (int bj = 0; bj < 2; ++bj) {
                        if constexpr (SRCB) { const u32x4 w = *(const u32x4*)((const bf16*)src + off + bj * HALF); sv[mm][bj][0] = (f32x4){bf_lo(w.x), bf_hi(w.x), bf_lo(w.y), bf_hi(w.y)}; sv[mm][bj][1] = (f32x4){bf_lo(w.z), bf_hi(w.z), bf_lo(w.w), bf_hi(w.w)}; }
                        else { const float* sp = (const float*)src + off + bj * HALF; sv[mm][bj][0] = *(const f32x4*)sp; sv[mm][bj][1] = *(const f32x4*)(sp + 4); } } }
#pragma unroll
                for (int mm = 0; mm < 2; ++mm) { const int m = 2 * mh + mm; const size_t off = (size_t)(row0 + ai * HALF + m * 16) * ld + col0;
#pragma unroll
                    for (int bj = 0; bj < 2; ++bj) { const f32x4 o0 = sv[mm][bj][0] + tof(acc[ai][bj][m][0]) * (cv[bj][0] * rsv[mm]), o1 = sv[mm][bj][1] + tof(acc[ai][bj][m][1]) * (cv[bj][1] * rsv[mm]);
                        u32x4 w; w.x = cvt_pk_bf16(o0[0], o0[1]); w.y = cvt_pk_bf16(o0[2], o0[3]); w.z = cvt_pk_bf16(o1[0], o1[1]); w.w = cvt_pk_bf16(o1[2], o1[3]); *(u32x4*)(dst + off + bj * HALF) = w; } }
                asm volatile("" ::: "memory");
            }
    }
};

__device__ __forceinline__ float dpp_from_prev_lane(float v) { return __builtin_bit_cast(float, __builtin_amdgcn_update_dpp(0, __builtin_bit_cast(int, v), 0x121, 0xF, 0xF, false)); }
__device__ __forceinline__ float dpp_from_next_lane(float v) { return __builtin_bit_cast(float, __builtin_amdgcn_update_dpp(0, __builtin_bit_cast(int, v), 0x12F, 0xF, 0xF, false)); }
struct EpiConv {
    unsigned char* act; bf16* yb; const float* cw; const float* cb; const unsigned char* wsb; float oscale;
    template <class AccT> __device__ __forceinline__ void operator()(const AccT (&acc)[2][2][4][2], const Unit& u, int wr, int wc, int fr, int fq) const {
        const float* rs = (const float*)(wsb + WS_RSH); const float* cs = (const float*)(wsb + WS_CSUP);
#pragma unroll
        for (int n = 0; n < 2; ++n) {
            const int ch0 = wc * 32 + 8 * fq + 4 * n, cg = u.pn * 128 + ch0, colg = u.pn * BM + ch0;
            const f32x4 csg = *(const f32x4*)(cs + colg), csu = *(const f32x4*)(cs + colg + HALF), bg = *(const f32x4*)(cb + cg), bu = *(const f32x4*)(cb + DFF + cg);
            f32x4 wg[3], wu[3];
#pragma unroll
            for (int t = 0; t < 3; ++t) { wg[t] = *(const f32x4*)(cw + t * NUP + cg); wu[t] = *(const f32x4*)(cw + t * NUP + DFF + cg); }
#pragma unroll
            for (int ai = 0; ai < 2; ++ai) {
                const int rowb = u.pm * BM + ai * HALF + wr * 64;
                f32x4 yg[4], yu[4];
#pragma unroll
                for (int m = 0; m < 4; ++m) { const float rsv = rs[rowb + 16 * m + fr]; yg[m] = tof(acc[ai][0][m][n]) * (csg * rsv); yu[m] = tof(acc[ai][1][m][n]) * (csu * rsv); }
                if (fr < 2 || fr >= 14) { const bool lo = fr < 2; bf16* yr = yb + ((size_t)(rowb >> 6) * 4 + (lo ? fr : fr - 12)) * NUP + colg;
                    const f32x4 a0 = lo ? yg[0] : yg[3], b0 = lo ? yu[0] : yu[3];
                    u32x2 w; w.x = cvt_pk_bf16(a0[0], a0[1]); w.y = cvt_pk_bf16(a0[2], a0[3]); *(u32x2*)yr = w;
                    w.x = cvt_pk_bf16(b0[0], b0[1]); w.y = cvt_pk_bf16(b0[2], b0[3]); *(u32x2*)(yr + HALF) = w; }
#pragma unroll
                for (int m = 0; m < 4; ++m) {
                    float o[4];
#pragma unroll
                    for (int e = 0; e < 4; ++e) {
                        const float gc = yg[m][e], uc = yu[m][e];
                        const float gsp = (m > 0 && fr == 15) ? yg[m > 0 ? m - 1 : 0][e] : gc, usp = (m > 0 && fr == 15) ? yu[m > 0 ? m - 1 : 0][e] : uc;
                        const float gsn = (m < 3 && fr == 0) ? yg[m < 3 ? m + 1 : 3][e] : gc, usn = (m < 3 && fr == 0) ? yu[m < 3 ? m + 1 : 3][e] : uc;
                        const float gp = dpp_from_prev_lane(gsp), up = dpp_from_prev_lane(usp), gn = dpp_from_next_lane(gsn), un = dpp_from_next_lane(usn);
                        const float ug = wg[0][e] * gp + wg[1][e] * gc + wg[2][e] * gn + bg[e];
                        const float uu = wu[0][e] * up + wu[1][e] * uc + wu[2][e] * un + bu[e];
                        o[e] = ug * fast_sigmoid(ug) * uu * oscale; }
                    const bool edge = (m == 0 && fr == 0) || (m == 3 && fr == 15);
                    if (!edge) { const size_t row = (size_t)(rowb + 16 * m + fr);
                        if (FP8_DOWN) *(unsigned*)(act + row * DFF + cg) = pack4_fp8(o[0], o[1], o[2], o[3]);
                        else { u32x2 w; w.x = cvt_pk_bf16(o[0], o[1]); w.y = cvt_pk_bf16(o[2], o[3]); *(u32x2*)((bf16*)act + row * DFF + cg) = w; } }
                }
                asm volatile("" ::: "memory");
            }
        }
    }
};
}

namespace att {
constexpr int OFF_V = 0, SHM_V = 16384, OFF_K = 32768, KROW = 144  , SHM_KP = 64 * KROW, OFF_WS = 32768 + 2 * 3 * SHM_KP, OFF_TBL = OFF_WS + 2048, OFF_QR = OFF_TBL + 1056, LDS_END = OFF_QR + 256 * KROW;
#define SBAR() __builtin_amdgcn_sched_barrier(0)
__device__ __forceinline__ int crow(int r, int hi) { return (r & 3) + 8 * (r >> 2) + 4 * hi; }
__device__ __forceinline__ int kswz(int row, int colB) { return row * KROW + colB; }
__device__ __forceinline__ int v_st(int k, int c) { const int kk = (k & ~0xC) | ((k & 4) << 1) | ((k & 8) >> 1); return ((kk >> 3) * 4 + (c >> 5)) * 512 + ((kk & 7) * 32 + (c & 31)) * 2; }
__device__ __forceinline__ int v_rd_base(int lane) { return ((lane & 3) << 3) | (((lane >> 2) & 3) << 6) | (((lane >> 4) & 1) << 5) | (((lane >> 5) & 1) << 8); }
constexpr int v_rd_off(int d0, int ks, int half) { return d0 * 512 + ks * 4096 + half * 2048; }
template <int OFF> __device__ __forceinline__ s16x4 tr_read(int vb) { s16x4 r; asm volatile("ds_read_b64_tr_b16 %0, %1 offset:%2" : "=&v"(r) : "v"(vb), "i"(OFF) : "memory"); return r; }
template <int D0> __device__ __forceinline__ void pv_one(f32x16& od, int vb, bf16x8 pa0, bf16x8 pa1, bf16x8 pa2, bf16x8 pa3) {
    const s16x4 l0 = tr_read<v_rd_off(D0, 0, 0)>(vb), h0 = tr_read<v_rd_off(D0, 0, 1)>(vb), l1 = tr_read<v_rd_off(D0, 1, 0)>(vb), h1 = tr_read<v_rd_off(D0, 1, 1)>(vb);
    const s16x4 l2 = tr_read<v_rd_off(D0, 2, 0)>(vb), h2 = tr_read<v_rd_off(D0, 2, 1)>(vb), l3 = tr_read<v_rd_off(D0, 3, 0)>(vb), h3 = tr_read<v_rd_off(D0, 3, 1)>(vb);
    asm volatile("s_waitcnt lgkmcnt(0)" ::: "memory"); SBAR();
#define PK(L, H) (bf16x8){L[0], L[1], L[2], L[3], H[0], H[1], H[2], H[3]}
    od = __builtin_amdgcn_mfma_f32_32x32x16_bf16(pa0, PK(l0, h0), od, 0, 0, 0);
    od = __builtin_amdgcn_mfma_f32_32x32x16_bf16(pa1, PK(l1, h1), od, 0, 0, 0);
    od = __builtin_amdgcn_mfma_f32_32x32x16_bf16(pa2, PK(l2, h2), od, 0, 0, 0);
    od = __builtin_amdgcn_mfma_f32_32x32x16_bf16(pa3, PK(l3, h3), od, 0, 0, 0);
#undef PK
}
__device__ __forceinline__ void pv_d0(f32x16* o, int vb, bf16x8 pa0, bf16x8 pa1, bf16x8 pa2, bf16x8 pa3) {
    pv_one<0>(o[0], vb, pa0, pa1, pa2, pa3); pv_one<1>(o[1], vb, pa0, pa1, pa2, pa3); pv_one<2>(o[2], vb, pa0, pa1, pa2, pa3); pv_one<3>(o[3], vb, pa0, pa1, pa2, pa3);
}
__device__ __forceinline__ float fma_s(float a, float s_uniform, float c) { float d; asm("v_fma_f32 %0, %1, %2, %3" : "=v"(d) : "v"(a), "s"(s_uniform), "v"(c)); return d; }
constexpr float THR2 = 8.0f * 1.4426950408889634f;
template <bool BIAS>
__device__ __forceinline__ void partialSM(f32x16& p0, f32x16& p1, float& m_reg, float& mn, float& alpha, float Cs, bool near, float bconst, int relbase, int hi, const LAS float* tbl) {
    float pmax;
    if (BIAS && near) {
#pragma unroll
        for (int r = 0; r < 16; ++r) { const int k = relbase + crow(r, hi);
            const int i0 = min(max(k, 0), 256), i1 = min(max(k + 32, 0), 256);
            p0[r] = fma_s(p0[r], Cs, tbl[i0]); p1[r] = fma_s(p1[r], Cs, tbl[i1]); }
        pmax = p0[0];
#pragma unroll
        for (int r = 1; r < 16; ++r) pmax = fmaxf(pmax, p0[r]);
#pragma unroll
        for (int r = 0; r < 16; ++r) pmax = fmaxf(pmax, p1[r]);
        { auto rr = __builtin_amdgcn_permlane32_swap(__float_as_uint(pmax), __float_as_uint(pmax), false, false); pmax = fmaxf(__uint_as_float(rr[0]), __uint_as_float(rr[1])); }
        if (__builtin_expect(__all(pmax - m_reg <= THR2), 1)) { mn = m_reg; alpha = 1.f; }
        else { mn = fmaxf(m_reg, pmax); alpha = __builtin_amdgcn_exp2f(m_reg - mn); m_reg = mn; }
#pragma unroll
        for (int r = 0; r < 16; ++r) { p0[r] = p0[r] - mn; p1[r] = p1[r] - mn; }
    } else {
        pmax = p0[0];
#pragma unroll
        for (int r = 1; r < 16; ++r) pmax = fmaxf(pmax, p0[r]);
#pragma unroll
        for (int r = 0; r < 16; ++r) pmax = fmaxf(pmax, p1[r]);
        { auto rr = __builtin_amdgcn_permlane32_swap(__float_as_uint(pmax), __float_as_uint(pmax), false, false); pmax = fmaxf(__uint_as_float(rr[0]), __uint_as_float(rr[1])); }
        pmax = fmaf(pmax, Cs, bconst);
        if (__builtin_expect(__all(pmax - m_reg <= THR2), 1)) { mn = m_reg; alpha = 1.f; }
        else { mn = fmaxf(m_reg, pmax); alpha = __builtin_amdgcn_exp2f(m_reg - mn); m_reg = mn; }
        const float off = bconst - mn;
#pragma unroll
        for (int r = 0; r < 16; ++r) { p0[r] = fma_s(p0[r], Cs, off); p1[r] = fma_s(p1[r], Cs, off); }
    }
#pragma unroll
    for (int r = 0; r < 16; ++r) p0[r] = __builtin_amdgcn_exp2f(p0[r]);
}
__device__ __forceinline__ void partialSM_ci(f32x16& p0, f32x16& p1, float& m_reg, float& alpha, f32x16& csp, bool first, bool near, float bcur, int relbase, int hi, const LAS float* tbl) {
    if (near) {
#pragma unroll
        for (int r = 0; r < 16; ++r) { const int k = relbase + crow(r, hi); const int i0 = min(max(k, 0), 256), i1 = min(max(k + 32, 0), 256);
            p0[r] += tbl[i0] - bcur; p1[r] += tbl[i1] - bcur; }
    }
    float pmax = p0[0];
#pragma unroll
    for (int r = 1; r < 16; ++r) pmax = fmaxf(pmax, p0[r]);
#pragma unroll
    for (int r = 0; r < 16; ++r) pmax = fmaxf(pmax, p1[r]);
    { auto rr = __builtin_amdgcn_permlane32_swap(__float_as_uint(pmax), __float_as_uint(pmax), false, false); pmax = fmaxf(__uint_as_float(rr[0]), __uint_as_float(rr[1])); }
    if (__builtin_expect(!first && __all(pmax <= THR2), 1)) { alpha = 1.f; }
    else { const float d = first ? pmax : fmaxf(pmax, 0.f); alpha = __builtin_amdgcn_exp2f(-d); m_reg += d;
#pragma unroll
        for (int r = 0; r < 16; ++r) { p0[r] -= d; p1[r] -= d; csp[r] -= d; } }
#pragma unroll
    for (int r = 0; r < 16; ++r) p0[r] = __builtin_amdgcn_exp2f(p0[r]);
}
__device__ __forceinline__ void finishSM(f32x16& p0, f32x16& p1, float alpha, float& l_reg, bf16x8& pa0, bf16x8& pa1, bf16x8& pa2, bf16x8& pa3) {
#pragma unroll
    for (int r = 0; r < 16; ++r) p1[r] = __builtin_amdgcn_exp2f(p1[r]);
    float ps = 0;
#pragma unroll
    for (int r = 0; r < 16; ++r) ps += p0[r];
#pragma unroll
    for (int r = 0; r < 16; ++r) ps += p1[r];
    { auto rr = __builtin_amdgcn_permlane32_swap(__float_as_uint(ps), __float_as_uint(ps), false, false); ps = __uint_as_float(rr[0]) + __uint_as_float(rr[1]); }
    l_reg = l_reg * alpha + ps;
#define PK4(P, BASE, OUT) do { unsigned a0 = cvt_pk_bf16(P[BASE + 0], P[BASE + 1]), a1 = cvt_pk_bf16(P[BASE + 2], P[BASE + 3]);   \
    unsigned b0 = cvt_pk_bf16(P[BASE + 4], P[BASE + 5]), b1 = cvt_pk_bf16(P[BASE + 6], P[BASE + 7]);                              \
    auto r0 = __builtin_amdgcn_permlane32_swap(a0, b0, false, false); auto r1 = __builtin_amdgcn_permlane32_swap(a1, b1, false, false); \
    u32x4 w = {r0[0], r1[0], r0[1], r1[1]}; OUT = *reinterpret_cast<bf16x8*>(&w); } while (0)
    PK4(p0, 0, pa0); PK4(p0, 8, pa1); PK4(p1, 0, pa2); PK4(p1, 8, pa3);
#undef PK4
}
template <int NP>
__device__ __forceinline__ void qkt(f32x16& p0, f32x16& p1, const LAS char* Ks, const bf16x8* qr, const LAS char* qrl, int r32, int hi, const f32x16& cinit) {
    p0 = cinit; p1 = cinit;
#pragma unroll
    for (int p = 0; p < NP; ++p)
#pragma unroll
        for (int d0 = 0; d0 < 4; ++d0) { const int cb = d0 * 32 + hi * 16;
            bf16x8 b0 = *(const LAS bf16x8*)(Ks + p * SHM_KP + kswz(r32, cb));
            bf16x8 b1 = *(const LAS bf16x8*)(Ks + p * SHM_KP + kswz(32 + r32, cb));
            const bf16x8 qf = (NP == 3 && p == 2) ? *(const LAS bf16x8*)(qrl + d0 * 32) : qr[p * 4 + d0];
            p0 = __builtin_amdgcn_mfma_f32_32x32x16_bf16(b0, qf, p0, 0, 0, 0);
            p1 = __builtin_amdgcn_mfma_f32_32x32x16_bf16(b1, qf, p1, 0, 0, 0); }
}
struct Ptrs { const bf16* q[3]; const bf16* k[3]; const bf16* v; };
struct StrDiff { static constexpr int LDQ = NIN, LDK = NIN, LDK2 = NIN, LDV = NIN; };
struct StrMla { static constexpr int LDQ = NQ, LDK = NKV, LDK2 = NIN, LDV = NKV; };
template <int NP, bool BIAS, int SDEPTH, class STR>
__device__ __forceinline__ void attn_body(const Ptrs& P, int seq, int qpos0, float Cs, LAS char* lds, f32x16 (&o)[4], int tid_in) {
    int tid = tid_in; asm volatile("" : "+v"(tid));
    const int wid = __builtin_amdgcn_readfirstlane(tid >> 6), lane = tid & 63, r32 = lane & 31, hi = lane >> 5;
    LAS char* V_lds = lds + OFF_V; LAS char* K_lds = lds + OFF_K;
    LAS float* wsl = (LAS float*)(lds + OFF_WS) + wid * 64; LAS float* li_l = wsl; LAS float* al_l = wsl + 32;
    const LAS float* tbl = (const LAS float*)(lds + OFF_TBL);
    constexpr int KB = NP * SHM_KP;
    constexpr bool CI = BIAS && (ATT_CINIT != 0);
    float m_reg = CI ? 0.f : -1e30f, l_reg = 0;
#pragma unroll
    for (int d = 0; d < 4; ++d) o[d] = f32x16{};
    constexpr int NPR = (NP == 3) ? 2 : NP;
    bf16x8 qr[NPR * 4];
#pragma unroll
    for (int p = 0; p < NPR; ++p)
#pragma unroll
        for (int d0 = 0; d0 < 4; ++d0) qr[p * 4 + d0] = *reinterpret_cast<const bf16x8*>(P.q[p] + (long)(wid * 32 + r32) * STR::LDQ + hi * 8 + d0 * 16);
    LAS char* qrl = lds + OFF_QR + (wid * 32 + r32) * KROW + hi * 16;
    if constexpr (NP == 3) {
#pragma unroll
        for (int d0 = 0; d0 < 4; ++d0) *(LAS bf16x8*)(qrl + d0 * 32) = *reinterpret_cast<const bf16x8*>(P.q[2] + (long)(wid * 32 + r32) * STR::LDQ + hi * 8 + d0 * 16);
    }
    const int kr = tid >> 3, kc = tid & 7, kst = kswz(kr, kc * 16);
    const int sr = tid >> 4, sc = (tid & 15) * 8, vst0 = v_st(sr, sc), vst1 = v_st(32 + sr, sc);
    const int vb0 = (int)(uintptr_t)V_lds + v_rd_base(lane);
    const int qlo = qpos0 + wid * 32;
    const float bL = BIAS ? tbl[0] : 0.f, bR = BIAS ? tbl[256] : 0.f;
    f32x16 csp = f32x16{}; float bcur = bL;
    if constexpr (CI) {
#pragma unroll
        for (int r = 0; r < 16; ++r) csp[r] = bL; }
    struct { bf16x8 vs0, vs1, ks[NP]; } st_[SDEPTH];
#define SLOAD(i, k0) do { st_[i].vs0 = *reinterpret_cast<const bf16x8*>(P.v + (long)((k0) + sr) * STR::LDV + sc); st_[i].vs1 = *reinterpret_cast<const bf16x8*>(P.v + (long)((k0) + 32 + sr) * STR::LDV + sc); \
    _Pragma("unroll") for (int p_ = 0; p_ < NP; ++p_) st_[i].ks[p_] = *reinterpret_cast<const bf16x8*>(P.k[p_] + (long)((k0) + kr) * (p_ == 2 ? STR::LDK2 : STR::LDK) + kc * 8); } while (0)
#define SWRITE(b, i) do { *(LAS bf16x8*)(V_lds + (b) * SHM_V + vst0) = st_[i].vs0; *(LAS bf16x8*)(V_lds + (b) * SHM_V + vst1) = st_[i].vs1; \
    _Pragma("unroll") for (int p_ = 0; p_ < NP; ++p_) *(LAS bf16x8*)(K_lds + (b) * KB + p_ * SHM_KP + kst) = st_[i].ks[p_]; } while (0)
#define SWAIT() do { if constexpr (SDEPTH == 2) { if constexpr (NP == 1) asm volatile("s_waitcnt vmcnt(3)" ::: "memory"); else asm volatile("s_waitcnt vmcnt(5)" ::: "memory"); } else asm volatile("s_waitcnt vmcnt(0)" ::: "memory"); } while (0)
#define RESC(a) do { if (__any((a) < 1.f)) { if (hi == 0) al_l[r32] = (a); asm volatile("s_waitcnt lgkmcnt(0)" ::: "memory"); \
    _Pragma("unroll") for (int d = 0; d < 4; ++d) _Pragma("unroll") for (int r = 0; r < 16; ++r) o[d][r] *= al_l[crow(r, hi)]; } } while (0)
#define TILEB(j, nearv, bcv, rbv) const int _rh##j = (j) * 64 + 63 - qlo, _rl##j = (j) * 64 - (qlo + 31); \
    const bool nearv = BIAS && (_rh##j > -128) && (_rl##j < 128); const float bcv = (_rh##j <= -128) ? bL : bR; const int rbv = (j) * 64 - (qlo + r32) + 128
#define CLS(nearv, bcv) do { if constexpr (CI) { if (!(nearv) && (bcv) != bcur) { const float _dl = (bcv) - bcur; _Pragma("unroll") for (int r = 0; r < 16; ++r) csp[r] += _dl; bcur = (bcv); } } } while (0)
#define PSM(P0, P1, MN, AL, first, nearv, bcv, rbv) do { if constexpr (CI) { partialSM_ci(P0, P1, m_reg, AL, csp, first, nearv, bcur, rbv, hi, tbl); MN = 0.f; } \
        else partialSM<BIAS>(P0, P1, m_reg, MN, AL, Cs, nearv, bcv, rbv, hi, tbl); } while (0)
    f32x16 pA0, pA1, pB0, pB1; float mnA, mnB, alA, alB; bf16x8 pa0, pa1, pa2, pa3; const int NT = seq / 64;
    constexpr int SE = 0, SO = SDEPTH - 1;
    SLOAD(SE, 0); asm volatile("s_waitcnt vmcnt(0)" ::: "memory"); SWRITE(0, SE); __syncthreads();
    { const int jj = 0; TILEB(jj, nr, bc, rb); CLS(nr, bc); qkt<NP>(pA0, pA1, K_lds, qr, qrl, r32, hi, csp); PSM(pA0, pA1, mnA, alA, true, nr, bc, rb); }
    SLOAD(SO, 64); if constexpr (SDEPTH == 2) { if (2 < NT) SLOAD(SE, 128); }
    SWAIT(); SWRITE(1, SO); __syncthreads();
    for (int j = 1; j + 1 < NT; j += 2) {
        TILEB(j, nrB, bcB, rbB); CLS(nrB, bcB);
        SBAR(); qkt<NP>(pB0, pB1, K_lds + KB, qr, qrl, r32, hi, csp);
        finishSM(pA0, pA1, alA, l_reg, pa0, pa1, pa2, pa3); SBAR();
        SLOAD(SO, (j + SDEPTH) * 64); SBAR();
        pv_d0(o, vb0, pa0, pa1, pa2, pa3);
        PSM(pB0, pB1, mnB, alB, false, nrB, bcB, rbB);
        __syncthreads(); SWAIT(); SWRITE(0, SE);
        RESC(alB); __syncthreads();
        const int j1 = j + 1; TILEB(j1, nrA, bcA, rbA); CLS(nrA, bcA);
        SBAR(); qkt<NP>(pA0, pA1, K_lds, qr, qrl, r32, hi, csp);
        finishSM(pB0, pB1, alB, l_reg, pa0, pa1, pa2, pa3); SBAR();
        if (SDEPTH == 1 || j + 3 < NT) SLOAD(SE, (j + 1 + SDEPTH) * 64); SBAR();
        pv_d0(o, vb0 + SHM_V, pa0, pa1, pa2, pa3);
        PSM(pA0, pA1, mnA, alA, false, nrA, bcA, rbA);
        __syncthreads(); SWAIT(); SWRITE(1, SO);
        RESC(alA); __syncthreads();
    }
    const int jl = NT - 1; TILEB(jl, nrL, bcL, rbL); CLS(nrL, bcL);
    SBAR(); qkt<NP>(pB0, pB1, K_lds + KB, qr, qrl, r32, hi, csp);
    finishSM(pA0, pA1, alA, l_reg, pa0, pa1, pa2, pa3); SBAR();
    pv_d0(o, vb0, pa0, pa1, pa2, pa3);
    PSM(pB0, pB1, mnB, alB, false, nrL, bcL, rbL);
    __syncthreads(); RESC(alB);
    finishSM(pB0, pB1, alB, l_reg, pa0, pa1, pa2, pa3); SBAR();
    pv_d0(o, vb0 + SHM_V, pa0, pa1, pa2, pa3);
    if (hi == 0) li_l[r32] = l_reg; asm volatile("s_waitcnt lgkmcnt(0)" ::: "memory");
#pragma unroll
    for (int r = 0; r < 16; ++r) { const float rl = __builtin_amdgcn_rcpf(li_l[crow(r, hi)]);
#pragma unroll
        for (int d = 0; d < 4; ++d) o[d][r] *= rl; }
    __syncthreads();
#undef SLOAD
#undef SWRITE
#undef SWAIT
#undef RESC
#undef TILEB
#undef CLS
#undef PSM
}
}

constexpr int NWAVES = 8;
constexpr int CW_BAR = 4096;
constexpr int RING_BYTES = 131072, MISC_OFF = RING_BYTES + 320, LDS_BYTES = 147456;
static_assert(att::LDS_END <= RING_BYTES, "attention LDS");

#define XB_TMO      128
#define XB_XCNT(j)  (256  + 64 * (j))
#define XB_XSUB(j)  (1280 + 64 * (j))
#define XB_XGEN(j)  (2304 + 64 * (j))
#define XB_TOP      3328
#define XB_TOPGEN   3392
#define XCD_BAR_WORDS 3456
#define XB_SPIN_CAP (1u << 21)
__device__ __forceinline__ unsigned xb_ld(unsigned* p)              { return __hip_atomic_load(p, __ATOMIC_RELAXED, __HIP_MEMORY_SCOPE_AGENT); }
__device__ __forceinline__ unsigned xb_add(unsigned* p, unsigned v) { return __hip_atomic_fetch_add(p, v, __ATOMIC_RELAXED, __HIP_MEMORY_SCOPE_AGENT); }
__device__ __forceinline__ unsigned xb_xcc_id() { return (unsigned)__builtin_amdgcn_s_getreg((3 << 11) | 20) & 0xFu; }
#define XB_SPIN(cond, bar) do { unsigned _sp = 0; while (cond) { __builtin_amdgcn_s_sleep(1); \
    if ((++_sp & 255u) == 0u) { if (xb_ld(&(bar)[XB_TMO])) break; if (_sp > XB_SPIN_CAP) { atomicAdd(&(bar)[XB_TMO], 1u); break; } } } } while (0)
struct XcdBarrier { unsigned* bar; unsigned x; volatile LAS unsigned* st; };
__device__ __forceinline__ XcdBarrier xcd_barrier_post(unsigned* bar, volatile LAS unsigned* st, bool leader) {
    XcdBarrier b; b.bar = bar; b.x = xb_xcc_id(); b.st = st;
    if (leader) (void)xb_add(&bar[XB_XCNT(b.x)], 1u);
    return b;
}
__device__ __forceinline__ void xcd_barrier_complete(unsigned* bar, unsigned x, unsigned& nloc, unsigned& nx) {
    const unsigned G = gridDim.x * gridDim.y * gridDim.z;
    unsigned sum, cnt, mine, sp = 0u;
    for (;;) {
        sum = 0u; cnt = 0u; mine = 0u;
#pragma unroll
        for (unsigned j = 0; j < 16; ++j) { const unsigned c = xb_ld(&bar[XB_XCNT(j)]); sum += c; cnt += (c > 0u) ? 1u : 0u; mine = (j == x) ? c : mine; }
        if (sum == G) break;
        __builtin_amdgcn_s_sleep(1);
        if ((++sp & 255u) == 0u) { if (xb_ld(&bar[XB_TMO])) break; if (sp > XB_SPIN_CAP) { atomicAdd(&bar[XB_TMO], 1u); break; } }
    }
    nloc = mine > 0u ? mine : 1u; nx = cnt > 0u ? cnt : 1u;
}
__device__ __forceinline__ void xcd_barrier(const XcdBarrier& b, bool leader) {
    asm volatile("s_waitcnt vmcnt(0)" ::: "memory");
    __syncthreads();
    if (leader) {
        unsigned* bar = b.bar;
        __builtin_amdgcn_s_waitcnt(0);
        unsigned nloc = b.st[0], nx = b.st[1];
        if (nloc == 0u) { xcd_barrier_complete(bar, b.x, nloc, nx); b.st[0] = nloc; b.st[1] = nx; }
        const unsigned old = xb_add(&bar[XB_XSUB(b.x)], 1u);
        const unsigned gen = old / nloc;
        if (old + 1u == (gen + 1u) * nloc) {
            __builtin_amdgcn_fence(__ATOMIC_RELEASE, "agent");
            asm volatile("s_waitcnt vmcnt(0)" ::: "memory");
            const unsigned og = xb_add(&bar[XB_TOP], 1u);
            const unsigned tg = og / nx;
            if (og + 1u == (tg + 1u) * nx) xb_add(&bar[XB_TOPGEN], 1u);
            else XB_SPIN(xb_ld(&bar[XB_TOPGEN]) == tg, bar);
            __builtin_amdgcn_fence(__ATOMIC_ACQUIRE, "agent");
            xb_add(&bar[XB_XGEN(b.x)], 1u);
            asm volatile("s_waitcnt vmcnt(0)" ::: "memory");
        } else {
            XB_SPIN(xb_ld(&bar[XB_XGEN(b.x)]) == gen, bar);
            __builtin_amdgcn_fence(__ATOMIC_ACQUIRE, "agent");
            asm volatile("s_waitcnt vmcnt(0)" ::: "memory");
        }
    }
    __syncthreads();
}

#define LDS_WAIT() asm volatile("s_waitcnt lgkmcnt(0)" ::: "memory")
template <int X> __device__ __forceinline__ float swz_xor(float v) { return __int_as_float(__builtin_amdgcn_ds_swizzle(__float_as_int(v), (X << 10) | 0x1f)); }
__device__ __forceinline__ float half_sum(float v) { v += swz_xor<1>(v); v += swz_xor<2>(v); v += swz_xor<4>(v); v += swz_xor<8>(v); v += swz_xor<16>(v); return v; }
__device__ __forceinline__ float wave_max(float v) {
    v = __builtin_fmaxf(v, swz_xor<1>(v)); v = __builtin_fmaxf(v, swz_xor<2>(v)); v = __builtin_fmaxf(v, swz_xor<4>(v)); v = __builtin_fmaxf(v, swz_xor<8>(v)); v = __builtin_fmaxf(v, swz_xor<16>(v));
    auto rr = __builtin_amdgcn_permlane32_swap(__float_as_uint(v), __float_as_uint(v), false, false);
    return __builtin_fmaxf(__uint_as_float(rr[0]), __uint_as_float(rr[1]));
}
__device__ __forceinline__ float wave_sum(float v) {
    v = half_sum(v);
    auto rr = __builtin_amdgcn_permlane32_swap(__float_as_uint(v), __float_as_uint(v), false, false);
    return __uint_as_float(rr[0]) + __uint_as_float(rr[1]);
}

constexpr int NWAVES_ = 8;
template <int MODE, class SrcFn>
__device__ __forceinline__ void convert_strip(const float* W, int K, int N, unsigned char* WT, float* cs, int n0, float fscale, LAS float* lmax, int wave, int lane, SrcFn src) {
    const int rg = lane >> 3, cq = lane & 7, nchunk = K >> 7;
    int sc[4];
#pragma unroll
    for (int j = 0; j < 4; ++j) sc[j] = src(n0 + 4 * cq + j);
    const bool contig = __all(sc[0] >= 0 && (sc[0] & 3) == 0 && sc[1] == sc[0] + 1 && sc[2] == sc[0] + 2 && sc[3] == sc[0] + 3);
    auto ldrow = [&](int row) -> f32x4 {
        if (contig) return *(const f32x4*)(W + (size_t)row * N + sc[0]);
        f32x4 v;
#pragma unroll
        for (int j = 0; j < 4; ++j) v[j] = sc[j] >= 0 ? W[(size_t)row * N + sc[j]] : 0.f;
        return v; };
    f32x4 inv = (f32x4){fscale, fscale, fscale, fscale};
    if constexpr (MODE == 2) {
        f32x4 mx = (f32x4){0.f, 0.f, 0.f, 0.f};
        for (int c = wave; c < nchunk; c += NWAVES_) { f32x4 v[16];
#pragma unroll
            for (int i = 0; i < 16; ++i) v[i] = ldrow(c * 128 + 16 * rg + i);
#pragma unroll
            for (int i = 0; i < 16; ++i)
#pragma unroll
                for (int j = 0; j < 4; ++j) mx[j] = __builtin_fmaxf(mx[j], __builtin_fabsf(v[i][j])); }
#pragma unroll
        for (int j = 0; j < 4; ++j) { float m = mx[j]; m = __builtin_fmaxf(m, swz_xor<8>(m)); m = __builtin_fmaxf(m, swz_xor<16>(m));
            auto rr = __builtin_amdgcn_permlane32_swap(__float_as_uint(m), __float_as_uint(m), false, false); mx[j] = __builtin_fmaxf(__uint_as_float(rr[0]), __uint_as_float(rr[1])); }
        __syncthreads();
        if (lane < 8) *(LAS f32x4*)(lmax + wave * 32 + 4 * lane) = mx;
        __syncthreads();
        f32x4 cm = *(const LAS f32x4*)(lmax + 4 * cq);
#pragma unroll
        for (int w = 1; w < NWAVES_; ++w) { const f32x4 o = *(const LAS f32x4*)(lmax + w * 32 + 4 * cq);
#pragma unroll
            for (int j = 0; j < 4; ++j) cm[j] = __builtin_fmaxf(cm[j], o[j]); }
#pragma unroll
        for (int j = 0; j < 4; ++j) inv[j] = cm[j] > 0.f ? 127.f / cm[j] : 0.f;
        if (wave == 0 && lane < 8) *(f32x4*)(cs + n0 + 4 * lane) = cm * (1.f / 127.f);
    }
    constexpr int EB = (MODE == 0) ? 2 : 1; const size_t rowb = (size_t)K * EB;
    for (int c = wave; c < nchunk; c += NWAVES_) { f32x4 v[16];
#pragma unroll
        for (int i = 0; i < 16; ++i) v[i] = ldrow(c * 128 + 16 * rg + i) * inv;
#pragma unroll
        for (int j = 0; j < 4; ++j) { unsigned char* dst = WT + (size_t)(n0 + 4 * cq + j) * rowb + (size_t)(c * 128 + 16 * rg) * EB;
            if constexpr (MODE == 2) { u32x4 o; o.x = pack4_i8(v[0][j], v[1][j], v[2][j], v[3][j]); o.y = pack4_i8(v[4][j], v[5][j], v[6][j], v[7][j]); o.z = pack4_i8(v[8][j], v[9][j], v[10][j], v[11][j]); o.w = pack4_i8(v[12][j], v[13][j], v[14][j], v[15][j]); *(u32x4*)dst = o; }
            else if constexpr (MODE == 1) { u32x4 o; o.x = pack4_fp8(v[0][j], v[1][j], v[2][j], v[3][j]); o.y = pack4_fp8(v[4][j], v[5][j], v[6][j], v[7][j]); o.z = pack4_fp8(v[8][j], v[9][j], v[10][j], v[11][j]); o.w = pack4_fp8(v[12][j], v[13][j], v[14][j], v[15][j]); *(u32x4*)dst = o; }
            else { u32x4 o; o.x = cvt_pk_bf16(v[0][j], v[1][j]); o.y = cvt_pk_bf16(v[2][j], v[3][j]); o.z = cvt_pk_bf16(v[4][j], v[5][j]); o.w = cvt_pk_bf16(v[6][j], v[7][j]); *(u32x4*)dst = o;
                   o.x = cvt_pk_bf16(v[8][j], v[9][j]); o.y = cvt_pk_bf16(v[10][j], v[11][j]); o.z = cvt_pk_bf16(v[12][j], v[13][j]); o.w = cvt_pk_bf16(v[14][j], v[15][j]); *(u32x4*)(dst + 16) = o; } }
    }
}
__device__ __forceinline__ int t5_bucket(int rel) {
    const int ret = rel > 0 ? 16 : 0; const int n = rel < 0 ? -rel : rel;
    if (n < 8) return ret + n;
    int large = 2 + (31 - __builtin_clz((unsigned)(n * n)));
    large = large < 15 ? large : 15;
    return ret + large;
}
__device__ __forceinline__ void sincos_f32arg(float ang, float& c, float& s) {
    const double a = (double)ang; const double kq = __builtin_rint(a * 0.63661977236758134);
    double r = __builtin_fma(-kq, 1.5707963267948966, a); r = __builtin_fma(-kq, 6.123233995736766e-17, r);
    const int q = ((int)kq) & 3; const double r2 = r * r;
    const double sp = r * (1.0 + r2 * (-1.0 / 6 + r2 * (1.0 / 120 + r2 * (-1.0 / 5040 + r2 * (1.0 / 362880 + r2 * (-1.0 / 39916800))))));
    const double cp = 1.0 + r2 * (-0.5 + r2 * (1.0 / 24 + r2 * (-1.0 / 720 + r2 * (1.0 / 40320 + r2 * (-1.0 / 3628800 + r2 * (1.0 / 479001600))))));
    const double sv = (q == 0) ? sp : (q == 1) ? cp : (q == 2) ? -sp : -cp;
    const double cv = (q == 0) ? cp : (q == 1) ? -sp : (q == 2) ? -cp : sp;
    c = (float)cv; s = (float)sv;
}

struct Args { const float* in[23]; float* out; unsigned char* ws; float invf[32]; int lo, hi; };
typedef const __attribute__((address_space(4))) Args* ArgsP;

enum { I_XP = 0, I_XS, I_RELB, I_FNG, I_RAG, I_WIN, I_LQ1, I_LK1, I_LQ2, I_LK2, I_SUBG, I_QNG, I_WQUP, I_KVNG, I_WKVUP, I_WA, I_WB, I_WO, I_RFG, I_WUP, I_CW, I_CB, I_WD };

#define P_WINT ((bf16*)(ws + WS_WIN))
#define P_WQT ((bf16*)(ws + WS_WQ))
#define P_WKVT ((bf16*)(ws + WS_WKV))
#define P_WAT ((bf16*)(ws + WS_WA))
#define P_WBT ((bf16*)(ws + WS_WB))
#define P_WOT ((bf16*)(ws + WS_WO))
#define P_WUPT ((bf16*)(ws + WS_WUP))
#define P_WDT ((bf16*)(ws + WS_WD))
#define P_COS ((float*)(ws + WS_COS))
#define P_SIN ((float*)(ws + WS_SIN))
#define P_BIAS2 ((float*)(ws + WS_BIAS))
#define P_LAM ((float*)(ws + WS_LAM))
#define P_CSIN ((float*)(ws + WS_CSIN))
#define P_CSUP ((float*)(ws + WS_CSUP))
#define P_RSH ((float*)(ws + WS_RSH))
#define P_QL8 ((unsigned char*)(ws + WS_QL8))
#define P_KVL8 ((unsigned char*)(ws + WS_KVL8))
#define P_AO8 ((unsigned char*)(ws + WS_AO8))
#define P_BO8 ((unsigned char*)(ws + WS_BO8))
#define P_MG8 ((unsigned char*)(ws + WS_MG8))
#define P_X1 ((bf16*)(ws + WS_X1))
#define P_H ((bf16*)(ws + WS_H))
#define P_P ((bf16*)(ws + WS_P))
#define P_Q ((bf16*)(ws + WS_Q))
#define P_KV ((bf16*)(ws + WS_KV))
#define P_AO ((bf16*)(ws + WS_AO))
#define P_BO ((bf16*)(ws + WS_BO))
#define P_MG ((bf16*)(ws + WS_MG))
#define P_STASH ((float*)(ws + WS_STASH))
#define P_Y ((bf16*)(ws + WS_Y))
#define P_ACT ((bf16*)(ws + WS_ACTV))
#define XG() ((g < 2) ? A->in[I_XP] + (size_t)g * TG * DM : A->in[I_XS] + (size_t)(g - 2) * TG * DM)
#define OG() (A->out + (size_t)g * TG * DM)
constexpr int NSTEP_PER_GROUP = I8_MID ? 14 : 12, NSTEPS = NGRP * NSTEP_PER_GROUP;

__global__ void __launch_bounds__(NWAVES * 64, 2) enc_fwd(Args args) {
    extern __shared__ __attribute__((aligned(16))) unsigned char lds[];
    LAS unsigned char* ldsL = (LAS unsigned char*)lds;
    volatile LAS unsigned* MISC = (volatile LAS unsigned*)(ldsL + MISC_OFF);
    const int wave = __builtin_amdgcn_readfirstlane((int)threadIdx.x >> 6);
    const int G = gridDim.x; const int bx = blockIdx.x; const int vcu0 = (G % 8 == 0) ? (bx % 8) * (G / 8) + bx / 8 : bx;
    unsigned char* ws = args.ws;
    unsigned* ctl = (unsigned*)(ws + WS_CTL);
    { const int tid0 = wave * 64 + lane_id_fresh(); for (int u = tid0; u < (LDS_BYTES - RING_BYTES) / 4; u += NWAVES * 64) ((LAS unsigned*)(ldsL + RING_BYTES))[u] = 0u; }
    __syncthreads();
    XcdBarrier bar; bar.bar = ctl + CW_BAR; bar.x = 0; bar.st = nullptr;
#if !MK_PER_STEP_LAUNCH
    bar = xcd_barrier_post(ctl + CW_BAR, MISC + 8, (wave * 64 + lane_id_fresh()) == 0);
#endif
    const int lo = args.lo, hi = args.hi;
    int step = 0;
#ifndef EN_MASK
#define EN_MASK 0xFFFFFF
#endif
#define EN(k) (((EN_MASK) >> (k)) & 1)
#define RUN() (step >= lo && step < hi)
#define LOCAL_TID() ArgsP A = (ArgsP)__builtin_amdgcn_kernarg_segment_ptr(); asm volatile("" : "+s"(A)); unsigned char* const ws = A->ws; (void)ws; int lane_ = lane_id_fresh(); asm volatile("" : "+v"(lane_)); const int lane = lane_; const int tid = wave * 64 + lane; (void)tid; int gw = gw0, vcu = vcu0; asm volatile("" : "+s"(gw), "+s"(vcu)); (void)gw; (void)vcu
#if MK_PER_STEP_LAUNCH
#define SEAM() do { ++step; } while (0)
#else
#define SEAM() do { if (RUN() && step + 1 < hi) xcd_barrier(bar, (wave * 64 + lane_id_fresh()) == 0); ++step; } while (0)
#endif
    const int gw0 = vcu0 * NWAVES + wave, NGW = G * NWAVES;

    if (RUN() && EN(0)) { LOCAL_TID();
        LAS float* lmax = (LAS float*)ldsL;
        auto ident = [](int n) -> int { return n; };
        auto srcIn = [](int n) -> int { if (n < C_GATE) return n; if (n < C_KPE) return n + 64; if (n < C_KPE + 64) { const int j = n - C_KPE; return 7680 + ((j & 1) ? 32 + (j >> 1) : (j >> 1)); } return -1; };
        auto srcQ = [](int n) -> int { if (n < 2048) return (n >> 7) * 192 + (n & 127); const int j = n - 2048, hh = j >> 6, jj = j & 63; return hh * 192 + 128 + ((jj & 1) ? 32 + (jj >> 1) : (jj >> 1)); };
        auto srcUp = [](int n) -> int { return CONV_FUSE ? ((n & 128) ? DFF : 0) + (n >> 8) * 128 + (n & 127) : n; };
        constexpr int T0 = DM / 32, T1 = T0 + NIN / 32, T2 = T1 + NUP / 32, T3 = T2 + DM / 32, T4 = T3 + DM / 32, T5 = T4 + DM / 32, T6 = T5 + NQ / 32, T7 = T6 + NKV / 32;
        for (int s = vcu; s < T7; s += G) {
            if (s < T0) { const int n0 = 32 * s;
                if (FP8_DOWN) convert_strip<1>(A->in[I_WD], DFF, DM, (unsigned char*)P_WDT, nullptr, n0, S_WD, lmax, wave, lane, ident); else convert_strip<0>(A->in[I_WD], DFF, DM, (unsigned char*)P_WDT, nullptr, n0, 1.f, lmax, wave, lane, ident); }
            else if (s < T1) { const int n0 = 32 * (s - T0);
                if (I8_IN) convert_strip<2>(A->in[I_WIN], DM, 15936, (unsigned char*)P_WINT, P_CSIN, n0, 1.f, lmax, wave, lane, srcIn); else convert_strip<0>(A->in[I_WIN], DM, 15936, (unsigned char*)P_WINT, nullptr, n0, 1.f, lmax, wave, lane, srcIn); }
            else if (s < T2) { const int n0 = 32 * (s - T1);
                if (I8_UP) convert_strip<2>(A->in[I_WUP], DM, NUP, (unsigned char*)P_WUPT, P_CSUP, n0, 1.f, lmax, wave, lane, srcUp); else convert_strip<0>(A->in[I_WUP], DM, NUP, (unsigned char*)P_WUPT, nullptr, n0, 1.f, lmax, wave, lane, srcUp); }
            else if (s < T3) { const int n0 = 32 * (s - T2);
                if (I8_MID) convert_strip<2>(A->in[I_WO], DM, DM, (unsigned char*)P_WOT, (float*)(ws + WS_CSO), n0, 1.f, lmax, wave, lane, ident); else convert_strip<0>(A->in[I_WO], DM, DM, (unsigned char*)P_WOT, nullptr, n0, 1.f, lmax, wave, lane, ident); }
            else if (s < T4) { const int n0 = 32 * (s - T3);
                if (I8_MID) convert_strip<2>(A->in[I_WA], 2048, DM, (unsigned char*)P_WAT, (float*)(ws + WS_CSA), n0, 1.f, lmax, wave, lane, ident); else convert_strip<0>(A->in[I_WA], 2048, DM, (unsigned char*)P_WAT, nullptr, n0, 1.f, lmax, wave, lane, ident); }
            else if (s < T5) { const int n0 = 32 * (s - T4);
                if (I8_MID) convert_strip<2>(A->in[I_WB], 2048, DM, (unsigned char*)P_WBT, (float*)(ws + WS_CSB), n0, 1.f, lmax, wave, lane, ident); else convert_strip<0>(A->in[I_WB], 2048, DM, (unsigned char*)P_WBT, nullptr, n0, 1.f, lmax, wave, lane, ident); }
            else if (s < T6) { const int n0 = 32 * (s - T5);
                if (I8_MID) convert_strip<2>(A->in[I_WQUP], 1024, NQ, (unsigned char*)P_WQT, (float*)(ws + WS_CSQ), n0, 1.f, lmax, wave, lane, srcQ); else convert_strip<0>(A->in[I_WQUP], 1024, NQ, (unsigned char*)P_WQT, nullptr, n0, 1.f, lmax, wave, lane, srcQ); }
            else { const int n0 = 32 * (s - T6);
                if (I8_MID) convert_strip<2>(A->in[I_WKVUP], 512, NKV, (unsigned char*)P_WKVT, (float*)(ws + WS_CSKV), n0, 1.f, lmax, wave, lane, ident); else convert_strip<0>(A->in[I_WKVUP], 512, NKV, (unsigned char*)P_WKVT, nullptr, n0, 1.f, lmax, wave, lane, ident); }
        }
        for (int i = bx * (NWAVES * 64) + tid; i < 8192 * 32; i += G * NWAVES * 64) { const int pos = i >> 5, k = i & 31; float c, s; sincos_f32arg((float)pos * A->invf[k], c, s); P_COS[i] = c; P_SIN[i] = s; }
        if (bx == 0) {
            for (int i = tid; i < 16 * 257; i += NWAVES * 64) { const int h = i / 257, j = i % 257; P_BIAS2[h * 260 + j] = A->in[I_RELB][t5_bucket(j - 128) * 16 + h] * 1.4426950408889634f; }
            if (wave == 0) { const float a = wave_sum(A->in[I_LQ1][lane] * A->in[I_LK1][lane]), b = wave_sum(A->in[I_LQ2][lane] * A->in[I_LK2][lane]);
                if (lane == 0) P_LAM[0] = expf(a) - expf(b) + 0.2f; }
        }
    }

    for (int g = 0; g < NGRP; ++g) {
        const int seqlen = (g < 2) ? 4096 : 8192, posmask = seqlen - 1;

        if (RUN() && EN(1)) { LOCAL_TID();
            const float* gv = A->in[I_RAG];
            for (int m = gw; m < TG; m += NGW) {
                const f32x4* xr = (const f32x4*)(XG() + (size_t)m * DM) + lane; f32x4 v[16]; float s = 0.f;
#pragma unroll
                for (int j = 0; j < 16; ++j) { v[j] = xr[64 * j]; s += (v[j].x * v[j].x + v[j].y * v[j].y) + (v[j].z * v[j].z + v[j].w * v[j].w); }
                const float rstd = 1.0f / sqrtf(wave_sum(s) * (1.f / DM) + EPS);
                if (I8_IN) { float mx = 0.f;
#pragma unroll
                    for (int j = 0; j < 16; ++j) { const f32x4 gg = ((const f32x4*)gv)[64 * j + lane]; v[j] = v[j] * rstd * gg; mx = __builtin_fmaxf(__builtin_fmaxf(mx, __builtin_fmaxf(__builtin_fabsf(v[j].x), __builtin_fabsf(v[j].y))), __builtin_fmaxf(__builtin_fabsf(v[j].z), __builtin_fabsf(v[j].w))); }
                    mx = wave_max(mx); const float inv = mx > 0.f ? 127.f / mx : 0.f; if (lane == 0) P_RSH[m] = mx * (1.f / 127.f);
                    unsigned* o4 = (unsigned*)((unsigned char*)P_H + (size_t)m * DM) + lane;
#pragma unroll
                    for (int j = 0; j < 16; ++j) o4[64 * j] = pack4_i8(v[j].x * inv, v[j].y * inv, v[j].z * inv, v[j].w * inv);
                } else {
                u32x2* o8 = (u32x2*)(P_H + (size_t)m * DM) + lane;
#pragma unroll
                for (int j = 0; j < 16; ++j) { const f32x4 gg = ((const f32x4*)gv)[64 * j + lane]; u32x2 w; w.x = cvt_pk_bf16(v[j].x * rstd * gg.x, v[j].y * rstd * gg.y); w.y = cvt_pk_bf16(v[j].z * rstd * gg.z, v[j].w * rstd * gg.w); o8[64 * j] = w; }
                }
            }
        }
        SEAM();

        if (RUN() && EN(2)) { LOCAL_TID();
            pg8::Gemm gm{P_H, I8_IN ? DM / 2 : DM, P_WINT, TG, NIN, I8_IN ? DM / 2 : DM}; pg8::StaticOrder S; S.init(TG, NIN, G, bx);
            pg8::EpiStoreT<I8_IN != 0, WS_RSH, WS_CSIN> E{P_P, NIN, C_GATE / 256, C_KPE / 256, ATT_CINIT ? CS_DIFF : 1.f, ws};
            REP_LOOP_GEMM { int l2_ = lane_id_fresh(); asm volatile("" : "+v"(l2_)); pg8::gemm_phase<pg8::EpiStoreT<I8_IN != 0, WS_RSH, WS_CSIN>, I8_IN ? 2 : 0>(ldsL, gm, S, E, wave * 64 + l2_); }
        }
        SEAM();

        if (RUN() && EN(3)) { LOCAL_TID();
            const float* gq = A->in[I_QNG]; const float* gkv = A->in[I_KVNG];
            for (int m = gw; m < TG; m += NGW) {
                bf16* prow = P_P + (size_t)m * NIN;
                { u32x4 a = *(const u32x4*)(prow + C_QLAT + lane * 8), b = *(const u32x4*)(prow + C_QLAT + 512 + lane * 8);
                  float x[16] = {bf_lo(a.x), bf_hi(a.x), bf_lo(a.y), bf_hi(a.y), bf_lo(a.z), bf_hi(a.z), bf_lo(a.w), bf_hi(a.w), bf_lo(b.x), bf_hi(b.x), bf_lo(b.y), bf_hi(b.y), bf_lo(b.z), bf_hi(b.z), bf_lo(b.w), bf_hi(b.w)};
                  float s = 0.f;
#pragma unroll
                  for (int j = 0; j < 16; ++j) s += x[j] * x[j];
                  const float rstd = 1.0f / sqrtf(wave_sum(s) * (1.f / 1024) + EPS);
                  const f32x4 g0 = *(const f32x4*)(gq + lane * 8), g1 = *(const f32x4*)(gq + lane * 8 + 4), g2 = *(const f32x4*)(gq + 512 + lane * 8), g3 = *(const f32x4*)(gq + 512 + lane * 8 + 4);
                  u32x4 oa, ob;
                  oa.x = cvt_pk_bf16(x[0] * rstd * g0.x, x[1] * rstd * g0.y); oa.y = cvt_pk_bf16(x[2] * rstd * g0.z, x[3] * rstd * g0.w); oa.z = cvt_pk_bf16(x[4] * rstd * g1.x, x[5] * rstd * g1.y); oa.w = cvt_pk_bf16(x[6] * rstd * g1.z, x[7] * rstd * g1.w);
                  ob.x = cvt_pk_bf16(x[8] * rstd * g2.x, x[9] * rstd * g2.y); ob.y = cvt_pk_bf16(x[10] * rstd * g2.z, x[11] * rstd * g2.w); ob.z = cvt_pk_bf16(x[12] * rstd * g3.x, x[13] * rstd * g3.y); ob.w = cvt_pk_bf16(x[14] * rstd * g3.z, x[15] * rstd * g3.w);
                  if (I8_MID) { float y[16]; float mx = 0.f; const float gg[16] = {g0.x, g0.y, g0.z, g0.w, g1.x, g1.y, g1.z, g1.w, g2.x, g2.y, g2.z, g2.w, g3.x, g3.y, g3.z, g3.w};
#pragma unroll
                      for (int j = 0; j < 16; ++j) { y[j] = x[j] * rstd * gg[j]; mx = __builtin_fmaxf(mx, __builtin_fabsf(y[j])); }
                      mx = wave_max(mx); const float inv = mx > 0.f ? 127.f / mx : 0.f; if (lane == 0) ((float*)(ws + WS_RSQL))[m] = mx * (1.f / 127.f);
                      u32x2 q0, q1; q0.x = pack4_i8(y[0] * inv, y[1] * inv, y[2] * inv, y[3] * inv); q0.y = pack4_i8(y[4] * inv, y[5] * inv, y[6] * inv, y[7] * inv);
                      q1.x = pack4_i8(y[8] * inv, y[9] * inv, y[10] * inv, y[11] * inv); q1.y = pack4_i8(y[12] * inv, y[13] * inv, y[14] * inv, y[15] * inv);
                      *(u32x2*)(P_QL8 + (size_t)m * 1024 + lane * 8) = q0; *(u32x2*)(P_QL8 + (size_t)m * 1024 + 512 + lane * 8) = q1;
                  } else { *(u32x4*)(prow + C_QLAT + lane * 8) = oa; *(u32x4*)(prow + C_QLAT + 512 + lane * 8) = ob; } }
                { u32x4 a = *(const u32x4*)(prow + C_KVLAT + lane * 8);
                  float x[8] = {bf_lo(a.x), bf_hi(a.x), bf_lo(a.y), bf_hi(a.y), bf_lo(a.z), bf_hi(a.z), bf_lo(a.w), bf_hi(a.w)};
                  float s = 0.f;
#pragma unroll
                  for (int j = 0; j < 8; ++j) s += x[j] * x[j];
                  const float rstd = 1.0f / sqrtf(wave_sum(s) * (1.f / 512) + EPS);
                  const f32x4 g0 = *(const f32x4*)(gkv + lane * 8), g1 = *(const f32x4*)(gkv + lane * 8 + 4);
                  u32x4 oa;
                  oa.x = cvt_pk_bf16(x[0] * rstd * g0.x, x[1] * rstd * g0.y); oa.y = cvt_pk_bf16(x[2] * rstd * g0.z, x[3] * rstd * g0.w); oa.z = cvt_pk_bf16(x[4] * rstd * g1.x, x[5] * rstd * g1.y); oa.w = cvt_pk_bf16(x[6] * rstd * g1.z, x[7] * rstd * g1.w);
                  if (I8_MID) { float y[8]; float mx = 0.f; const float gg[8] = {g0.x, g0.y, g0.z, g0.w, g1.x, g1.y, g1.z, g1.w};
#pragma unroll
                      for (int j = 0; j < 8; ++j) { y[j] = x[j] * rstd * gg[j]; mx = __builtin_fmaxf(mx, __builtin_fabsf(y[j])); }
                      mx = wave_max(mx); const float inv = mx > 0.f ? 127.f / mx : 0.f; if (lane == 0) ((float*)(ws + WS_RSKVL))[m] = mx * (1.f / 127.f);
                      u32x2 q0; q0.x = pack4_i8(y[0] * inv, y[1] * inv, y[2] * inv, y[3] * inv); q0.y = pack4_i8(y[4] * inv, y[5] * inv, y[6] * inv, y[7] * inv);
                      *(u32x2*)(P_KVL8 + (size_t)m * 512 + lane * 8) = q0;
                  } else *(u32x4*)(prow + C_KVLAT + lane * 8) = oa; }
                if (lane < 32) { const int pos = m & posmask; unsigned w = *(const unsigned*)(prow + C_KPE + 2 * lane); const float x1 = bf_lo(w), x2 = bf_hi(w);
                  const float c = P_COS[pos * 32 + lane], s = P_SIN[pos * 32 + lane];
                  *(unsigned*)(prow + C_KPE + 2 * lane) = cvt_pk_bf16(x1 * c - x2 * s, x1 * s + x2 * c); }
            }
        }
        SEAM();

        if (RUN() && EN(4)) { LOCAL_TID();
            if (EN(18)) { pg8::Gemm gm{I8_MID ? (const bf16*)P_QL8 : P_P + C_QLAT, I8_MID ? 512 : NIN, P_WQT, TG, NQ, I8_MID ? 512 : 1024}; pg8::StaticOrder S; S.init(TG, NQ, G, bx);
              pg8::EpiQT<I8_MID != 0> E{P_Q, NQ, ws, posmask}; REP_LOOP_GEMM { int l2_ = lane_id_fresh(); asm volatile("" : "+v"(l2_)); pg8::gemm_phase<pg8::EpiQT<I8_MID != 0>, I8_MID ? 2 : 0>(ldsL, gm, S, E, wave * 64 + l2_); } }
            if (EN(19)) { pg8::Gemm gm{I8_MID ? (const bf16*)P_KVL8 : P_P + C_KVLAT, I8_MID ? 256 : NIN, P_WKVT, TG, NKV, I8_MID ? 256 : 512}; pg8::StaticOrder S; S.init(TG, NKV, G, bx);
              pg8::EpiStoreT<I8_MID != 0, WS_RSKVL, WS_CSKV> E{P_KV, NKV, 0, 0, 1.f, ws}; REP_LOOP_GEMM { int l2_ = lane_id_fresh(); asm volatile("" : "+v"(l2_)); pg8::gemm_phase<pg8::EpiStoreT<I8_MID != 0, WS_RSKVL, WS_CSKV>, I8_MID ? 2 : 0>(ldsL, gm, S, E, wave * 64 + l2_); } }
        }
        SEAM();

        if (RUN() && EN(5)) { LOCAL_TID();
            const int wid = wave;
            const float lam = P_LAM[0];
            if (EN(16)) _Pragma("unroll 1") for (int rep = 0; rep < REP_DIFF; ++rep) for (int u = vcu; u < 512; u += G) {
                const int head = u >> 5, rb = u & 31, row0 = rb * 256, kbase = (seqlen == 4096) ? (rb >> 4) * 4096 : 0, qpos0 = row0 - kbase;
                __syncthreads();
                if (tid < 257) ((float*)(lds + att::OFF_TBL))[tid] = P_BIAS2[head * 260 + tid];
                __syncthreads();
#pragma unroll 1
                for (int c = 0; c < 2; ++c) {
                    att::Ptrs P;
                    P.q[0] = P_P + (size_t)row0 * NIN + C_DQ + head * 128 + c * 64; P.q[1] = P.q[0]; P.q[2] = P.q[0];
                    P.k[0] = P_P + (size_t)kbase * NIN + C_DK + head * 128 + c * 64; P.k[1] = P.k[0]; P.k[2] = P.k[0];
                    P.v = P_P + (size_t)kbase * NIN + C_DV + head * 128;
                    f32x16 o[4];
                    att::attn_body<1, true, 2, att::StrDiff>(P, seqlen, qpos0, 0.125f * 1.4426950408889634f, (LAS char*)ldsL, o, tid);
                    int tid_e = tid; asm volatile("" : "+v"(tid_e));
                    const int r32 = tid_e & 31, hh = (tid_e >> 5) & 1;
                    f32x4* myst = (f32x4*)(P_STASH + ((size_t)bx * 512 + tid_e) * 64);
                    if (c == 0) {
#pragma unroll
                        for (int d = 0; d < 4; ++d)
#pragma unroll
                            for (int r4 = 0; r4 < 4; ++r4) myst[d * 4 + r4] = (f32x4){o[d][4 * r4], o[d][4 * r4 + 1], o[d][4 * r4 + 2], o[d][4 * r4 + 3]};
                    } else {
                        float ss[16];
#pragma unroll
                        for (int r = 0; r < 16; ++r) ss[r] = 0.f;
#pragma unroll
                        for (int d = 0; d < 4; ++d)
#pragma unroll
                            for (int r4 = 0; r4 < 4; ++r4) { const f32x4 s0 = myst[d * 4 + r4];
#pragma unroll
                                for (int j = 0; j < 4; ++j) { const float a = s0[j] - lam * o[d][4 * r4 + j]; o[d][4 * r4 + j] = a; ss[4 * r4 + j] += a * a; } }
#pragma unroll
                        for (int r = 0; r < 16; ++r) ss[r] = 0.8f / sqrtf(half_sum(ss[r]) * (1.f / 128) + EPS);
                        const float* sg = A->in[I_SUBG];
                        float gsub[4];
#pragma unroll
                        for (int d = 0; d < 4; ++d) gsub[d] = sg[d * 32 + r32];
#pragma unroll
                        for (int r = 0; r < 16; ++r) { bf16* orow = P_AO + (size_t)(row0 + wid * 32 + att::crow(r, hh)) * 2048 + head * 128 + r32;
#pragma unroll
                            for (int d = 0; d < 4; ++d) orow[d * 32] = (bf16)(cvt_pk_bf16(o[d][r] * ss[r] * gsub[d], 0.f) & 0xffffu); }
                    }
                }
            }
            if (EN(17)) _Pragma("unroll 1") for (int rep = 0; rep < REP_MLA; ++rep) for (int u = vcu; u < 512; u += G) {
                const int head = u >> 5, rb = u & 31, row0 = rb * 256, kbase = (seqlen == 4096) ? (rb >> 4) * 4096 : 0;
                att::Ptrs P;
                P.q[0] = P_Q + (size_t)row0 * NQ + head * 128; P.q[1] = P.q[0] + 64; P.q[2] = P_Q + (size_t)row0 * NQ + 2048 + head * 64;
                P.k[0] = P_KV + (size_t)kbase * NKV + head * 256; P.k[1] = P.k[0] + 64; P.k[2] = P_P + (size_t)kbase * NIN + C_KPE;
                P.v = P_KV + (size_t)kbase * NKV + head * 256 + 128;
                f32x16 o[4];
                att::attn_body<3, false, 1, att::StrMla>(P, seqlen, 0, 0.07216878364870323f * 1.4426950408889634f, (LAS char*)ldsL, o, tid);
                int tid_e = tid; asm volatile("" : "+v"(tid_e));
                const int r32 = tid_e & 31, hh = (tid_e >> 5) & 1;
#pragma unroll
                for (int r = 0; r < 16; ++r) { bf16* orow = P_BO + (size_t)(row0 + wid * 32 + att::crow(r, hh)) * 2048 + head * 128 + r32;
#pragma unroll
                    for (int d = 0; d < 4; ++d) orow[d * 32] = (bf16)(cvt_pk_bf16(o[d][r], 0.f) & 0xffffu); }
            }
        }
        SEAM();

#if I8_MID
        if (RUN()) { LOCAL_TID();
            for (int m = gw; m < 2 * TG; m += NGW) { const int row = m >> 1; const bool isB = m & 1;
                const bf16* srow = (isB ? P_BO : P_AO) + (size_t)row * 2048 + lane * 8; u32x4 a[4]; float mx = 0.f;
#pragma unroll
                for (int j = 0; j < 4; ++j) { a[j] = *(const u32x4*)(srow + 512 * j);
                    mx = __builtin_fmaxf(mx, __builtin_fmaxf(__builtin_fmaxf(__builtin_fmaxf(__builtin_fabsf(bf_lo(a[j].x)), __builtin_fabsf(bf_hi(a[j].x))), __builtin_fmaxf(__builtin_fabsf(bf_lo(a[j].y)), __builtin_fabsf(bf_hi(a[j].y)))),
                                                      __builtin_fmaxf(__builtin_fmaxf(__builtin_fabsf(bf_lo(a[j].z)), __builtin_fabsf(bf_hi(a[j].z))), __builtin_fmaxf(__builtin_fabsf(bf_lo(a[j].w)), __builtin_fabsf(bf_hi(a[j].w)))))); }
                mx = wave_max(mx); const float inv = mx > 0.f ? 127.f / mx : 0.f; if (lane == 0) ((float*)(ws + (isB ? WS_RSB : WS_RSA)))[row] = mx * (1.f / 127.f);
                unsigned char* drow = (isB ? P_BO8 : P_AO8) + (size_t)row * 2048 + lane * 8;
#pragma unroll
                for (int j = 0; j < 4; ++j) { u32x2 q; q.x = pack4_i8(bf_lo(a[j].x) * inv, bf_hi(a[j].x) * inv, bf_lo(a[j].y) * inv, bf_hi(a[j].y) * inv); q.y = pack4_i8(bf_lo(a[j].z) * inv, bf_hi(a[j].z) * inv, bf_lo(a[j].w) * inv, bf_hi(a[j].w) * inv); *(u32x2*)(drow + 512 * j) = q; }
            }
        }
        SEAM();
#endif

        if (RUN() && EN(6)) { LOCAL_TID();
            if (EN(20)) { pg8::Gemm gm{I8_MID ? (const bf16*)P_AO8 : P_AO, I8_MID ? 1024 : 2048, P_WAT, TG, DM, I8_MID ? 1024 : 2048}; pg8::StaticOrder S; S.init(TG, DM, G, bx);
              pg8::EpiGateAT<I8_MID != 0> E{P_MG, DM, P_P + C_GATE, NIN, ws}; REP_LOOP_GEMM { int l2_ = lane_id_fresh(); asm volatile("" : "+v"(l2_)); pg8::gemm_phase<pg8::EpiGateAT<I8_MID != 0>, I8_MID ? 2 : 0>(ldsL, gm, S, E, wave * 64 + l2_); } }
            if (EN(21)) { pg8::Gemm gm{I8_MID ? (const bf16*)P_BO8 : P_BO, I8_MID ? 1024 : 2048, P_WBT, TG, DM, I8_MID ? 1024 : 2048}; pg8::StaticOrder S; S.init(TG, DM, G, bx);
              pg8::EpiGateBT<I8_MID != 0> E{P_MG, DM, P_P + C_GATE + DM, NIN, P_MG, DM, ws}; REP_LOOP_GEMM { int l2_ = lane_id_fresh(); asm volatile("" : "+v"(l2_)); pg8::gemm_phase<pg8::EpiGateBT<I8_MID != 0>, I8_MID ? 2 : 0>(ldsL, gm, S, E, wave * 64 + l2_); } }
        }
        SEAM();

#if I8_MID
        if (RUN()) { LOCAL_TID();
            for (int m = gw; m < TG; m += NGW) {
                const bf16* srow = P_MG + (size_t)m * DM + lane * 8; u32x4 a[8]; float mx = 0.f;
#pragma unroll
                for (int j = 0; j < 8; ++j) { a[j] = *(const u32x4*)(srow + 512 * j);
                    mx = __builtin_fmaxf(mx, __builtin_fmaxf(__builtin_fmaxf(__builtin_fmaxf(__builtin_fabsf(bf_lo(a[j].x)), __builtin_fabsf(bf_hi(a[j].x))), __builtin_fmaxf(__builtin_fabsf(bf_lo(a[j].y)), __builtin_fabsf(bf_hi(a[j].y)))),
                                                      __builtin_fmaxf(__builtin_fmaxf(__builtin_fabsf(bf_lo(a[j].z)), __builtin_fabsf(bf_hi(a[j].z))), __builtin_fmaxf(__builtin_fabsf(bf_lo(a[j].w)), __builtin_fabsf(bf_hi(a[j].w)))))); }
                mx = wave_max(mx); const float inv = mx > 0.f ? 127.f / mx : 0.f; if (lane == 0) ((float*)(ws + WS_RSM))[m] = mx * (1.f / 127.f);
                unsigned char* drow = P_MG8 + (size_t)m * DM + lane * 8;
#pragma unroll
                for (int j = 0; j < 8; ++j) { u32x2 q; q.x = pack4_i8(bf_lo(a[j].x) * inv, bf_hi(a[j].x) * inv, bf_lo(a[j].y) * inv, bf_hi(a[j].y) * inv); q.y = pack4_i8(bf_lo(a[j].z) * inv, bf_hi(a[j].z) * inv, bf_lo(a[j].w) * inv, bf_hi(a[j].w) * inv); *(u32x2*)(drow + 512 * j) = q; }
            }
        }
        SEAM();
#endif

        if (RUN() && EN(7)) { LOCAL_TID();
            pg8::Gemm gm{I8_MID ? (const bf16*)P_MG8 : P_MG, I8_MID ? DM / 2 : DM, P_WOT, TG, DM, I8_MID ? DM / 2 : DM}; pg8::StaticOrder S; S.init(TG, DM, G, bx);
            pg8::EpiResT<I8_MID != 0, false> E{XG(), P_X1, DM, 1.f, ws}; REP_LOOP_GEMM { int l2_ = lane_id_fresh(); asm volatile("" : "+v"(l2_)); pg8::gemm_phase<pg8::EpiResT<I8_MID != 0, false>, I8_MID ? 2 : 0>(ldsL, gm, S, E, wave * 64 + l2_); }
        }
        SEAM();

        if (RUN() && EN(8)) { LOCAL_TID();
            const float* gv = A->in[I_RFG];
            for (int m = gw; m < TG; m += NGW) {
                const u32x2* xr = (const u32x2*)(P_X1 + (size_t)m * DM) + lane; f32x4 v[16]; float s = 0.f;
#pragma unroll
                for (int j = 0; j < 16; ++j) { const u32x2 w = xr[64 * j]; v[j] = (f32x4){bf_lo(w.x), bf_hi(w.x), bf_lo(w.y), bf_hi(w.y)}; s += (v[j].x * v[j].x + v[j].y * v[j].y) + (v[j].z * v[j].z + v[j].w * v[j].w); }
                const float rstd = 1.0f / sqrtf(wave_sum(s) * (1.f / DM) + EPS);
                if (I8_UP) { float mx = 0.f;
#pragma unroll
                    for (int j = 0; j < 16; ++j) { const f32x4 gg = ((const f32x4*)gv)[64 * j + lane]; v[j] = v[j] * rstd * gg; mx = __builtin_fmaxf(__builtin_fmaxf(mx, __builtin_fmaxf(__builtin_fabsf(v[j].x), __builtin_fabsf(v[j].y))), __builtin_fmaxf(__builtin_fabsf(v[j].z), __builtin_fabsf(v[j].w))); }
                    mx = wave_max(mx); const float inv = mx > 0.f ? 127.f / mx : 0.f; if (lane == 0) P_RSH[m] = mx * (1.f / 127.f);
                    unsigned* o4 = (unsigned*)((unsigned char*)P_H + (size_t)m * DM) + lane;
#pragma unroll
                    for (int j = 0; j < 16; ++j) o4[64 * j] = pack4_i8(v[j].x * inv, v[j].y * inv, v[j].z * inv, v[j].w * inv);
                } else {
                u32x2* o8 = (u32x2*)(P_H + (size_t)m * DM) + lane;
#pragma unroll
                for (int j = 0; j < 16; ++j) { const f32x4 gg = ((const f32x4*)gv)[64 * j + lane]; u32x2 w; w.x = cvt_pk_bf16(v[j].x * rstd * gg.x, v[j].y * rstd * gg.y); w.y = cvt_pk_bf16(v[j].z * rstd * gg.z, v[j].w * rstd * gg.w); o8[64 * j] = w; }
                }
            }
        }
        SEAM();

        if (RUN() && EN(9)) { LOCAL_TID();
            pg8::Gemm gm{P_H, I8_UP ? DM / 2 : DM, P_WUPT, TG, NUP, I8_UP ? DM / 2 : DM}; pg8::StaticOrder S; S.init(TG, NUP, G, bx);
#if CONV_FUSE
            static_assert(I8_UP, "CONV_FUSE needs the int8 up GEMM");
            pg8::EpiConv E{(unsigned char*)P_ACT, P_Y, A->in[I_CW], A->in[I_CB], ws, FP8_DOWN ? S_ACT8 : 1.f}; REP_LOOP_GEMM { int l2_ = lane_id_fresh(); asm volatile("" : "+v"(l2_)); pg8::gemm_phase<pg8::EpiConv, 2>(ldsL, gm, S, E, wave * 64 + l2_); }
#else
            pg8::EpiStoreT<I8_UP != 0, WS_RSH, WS_CSUP> E{P_Y, NUP, 0, 0, 1.f, ws}; REP_LOOP_GEMM { int l2_ = lane_id_fresh(); asm volatile("" : "+v"(l2_)); pg8::gemm_phase<pg8::EpiStoreT<I8_UP != 0, WS_RSH, WS_CSUP>, I8_UP ? 2 : 0>(ldsL, gm, S, E, wave * 64 + l2_); }
#endif
        }
        SEAM();

#if CONV_FUSE
        if (RUN() && EN(10)) { LOCAL_TID();
            const float* cw = A->in[I_CW]; const float* cb = A->in[I_CB];
            constexpr int NCB = DFF / 256, NITEM = NCB * (TG / 64) * 2;
            for (int it = gw; it < NITEM; it += NGW) {
                const int cbk = it % NCB, be = it / NCB, b = be >> 1, edge = be & 1, c0 = cbk * 256 + lane * 4, t = b * 64 + (edge ? 63 : 0);
                const int colg = (c0 >> 7) * 256 + (c0 & 127);
                const f32x4 wg0 = *(const f32x4*)(cw + c0), wg1 = *(const f32x4*)(cw + NUP + c0), wg2 = *(const f32x4*)(cw + 2 * NUP + c0), bg = *(const f32x4*)(cb + c0);
                const f32x4 wu0 = *(const f32x4*)(cw + DFF + c0), wu1 = *(const f32x4*)(cw + NUP + DFF + c0), wu2 = *(const f32x4*)(cw + 2 * NUP + DFF + c0), bu = *(const f32x4*)(cb + DFF + c0);
                auto ldyb = [&](int blk, int slot, f32x4& yg, f32x4& yu) {
                    const bf16* p = P_Y + ((size_t)blk * 4 + slot) * NUP + colg; const u32x2 a = *(const u32x2*)p, bb = *(const u32x2*)(p + 128);
                    yg = (f32x4){bf_lo(a.x), bf_hi(a.x), bf_lo(a.y), bf_hi(a.y)}; yu = (f32x4){bf_lo(bb.x), bf_hi(bb.x), bf_lo(bb.y), bf_hi(bb.y)}; };
                const f32x4 z = (f32x4){0.f, 0.f, 0.f, 0.f};
                f32x4 pg = z, pu = z, cg, cu, ng = z, nu = z;
                if (edge == 0) { ldyb(b, 0, cg, cu); ldyb(b, 1, ng, nu); if ((t & posmask) != 0) ldyb(b - 1, 3, pg, pu); }
                else { ldyb(b, 3, cg, cu); ldyb(b, 2, pg, pu); if (((t + 1) & posmask) != 0) ldyb(b + 1, 0, ng, nu); }
                const f32x4 ug = wg0 * pg + wg1 * cg + wg2 * ng + bg, uu = wu0 * pu + wu1 * cu + wu2 * nu + bu;
                float a[4];
#pragma unroll
                for (int j = 0; j < 4; ++j) a[j] = ug[j] * fast_sigmoid(ug[j]) * uu[j];
                if (FP8_DOWN) *(unsigned*)((unsigned char*)P_ACT + (size_t)t * DFF + c0) = pack4_fp8(a[0] * S_ACT8, a[1] * S_ACT8, a[2] * S_ACT8, a[3] * S_ACT8);
                else { u32x2 w; w.x = cvt_pk_bf16(a[0], a[1]); w.y = cvt_pk_bf16(a[2], a[3]); *(u32x2*)(P_ACT + (size_t)t * DFF + c0) = w; }
            }
        }
#else
        if (RUN() && EN(10)) { LOCAL_TID();
            const float* cw = A->in[I_CW]; const float* cb = A->in[I_CB];
            constexpr int RCH = 64, NCB = DFF / 256, NITEM = NCB * (TG / RCH);
            for (int it = gw; it < NITEM; it += NGW) {
                const int cbk = it % NCB, rc = it / NCB, c0 = cbk * 256 + lane * 4, t0 = rc * RCH;
                f32x4 wg0 = *(const f32x4*)(cw + c0), wg1 = *(const f32x4*)(cw + NUP + c0), wg2 = *(const f32x4*)(cw + 2 * NUP + c0), bg = *(const f32x4*)(cb + c0);
                f32x4 wu0 = *(const f32x4*)(cw + DFF + c0), wu1 = *(const f32x4*)(cw + NUP + DFF + c0), wu2 = *(const f32x4*)(cw + 2 * NUP + DFF + c0), bu = *(const f32x4*)(cb + DFF + c0);
                auto ldrow = [&](int t, f32x4& yg, f32x4& yu) {
                    const u32x2 a = *(const u32x2*)(P_Y + (size_t)t * NUP + c0), b = *(const u32x2*)(P_Y + (size_t)t * NUP + DFF + c0);
                    yg = (f32x4){bf_lo(a.x), bf_hi(a.x), bf_lo(a.y), bf_hi(a.y)}; yu = (f32x4){bf_lo(b.x), bf_hi(b.x), bf_lo(b.y), bf_hi(b.y)}; };
                const f32x4 z = (f32x4){0.f, 0.f, 0.f, 0.f};
                f32x4 pg = z, pu = z, cg, cu, ng, nu;
                if ((t0 & posmask) != 0) ldrow(t0 - 1, pg, pu);
                ldrow(t0, cg, cu);
#pragma unroll 4
                for (int t = t0; t < t0 + RCH; ++t) {
                    if (((t + 1) & posmask) != 0) ldrow(t + 1, ng, nu); else { ng = z; nu = z; }
                    const f32x4 ug = wg0 * pg + wg1 * cg + wg2 * ng + bg, uu = wu0 * pu + wu1 * cu + wu2 * nu + bu;
                    float a[4];
#pragma unroll
                    for (int j = 0; j < 4; ++j) a[j] = ug[j] * fast_sigmoid(ug[j]) * uu[j];
                    if (FP8_DOWN) *(unsigned*)((unsigned char*)P_ACT + (size_t)t * DFF + c0) = pack4_fp8(a[0] * S_ACT8, a[1] * S_ACT8, a[2] * S_ACT8, a[3] * S_ACT8);
                    else { u32x2 w; w.x = cvt_pk_bf16(a[0], a[1]); w.y = cvt_pk_bf16(a[2], a[3]); *(u32x2*)(P_ACT + (size_t)t * DFF + c0) = w; }
                    pg = cg; pu = cu; cg = ng; cu = nu;
                }
            }
        }
#endif
        SEAM();

        if (RUN() && EN(11)) { LOCAL_TID();
            pg8::Gemm gm{P_ACT, FP8_DOWN ? DFF / 2 : DFF, P_WDT, TG, DM, FP8_DOWN ? DFF / 2 : DFF}; pg8::StaticOrder S; S.init(TG, DM, G, bx);
            pg8::EpiResT<false, true> E{P_X1, P_X1, DM, FP8_DOWN ? 1.f / (S_WD * S_ACT8) : 1.f, ws}; { int l2_ = lane_id_fresh(); asm volatile("" : "+v"(l2_)); pg8::gemm_phase<pg8::EpiResT<false, true>, FP8_DOWN ? 1 : 0>(ldsL, gm, S, E, wave * 64 + l2_); }
        }
        SEAM();

        if (RUN() && EN(12)) { LOCAL_TID();
            const float* gv = A->in[I_FNG];
            for (int m = gw; m < TG; m += NGW) {
                const u32x2* xr = (const u32x2*)(P_X1 + (size_t)m * DM) + lane; f32x4* orow = (f32x4*)(OG() + (size_t)m * DM) + lane; f32x4 v[16]; float s = 0.f;
#pragma unroll
                for (int j = 0; j < 16; ++j) { const u32x2 w = xr[64 * j]; v[j] = (f32x4){bf_lo(w.x), bf_hi(w.x), bf_lo(w.y), bf_hi(w.y)}; s += (v[j].x * v[j].x + v[j].y * v[j].y) + (v[j].z * v[j].z + v[j].w * v[j].w); }
                const float rstd = 1.0f / sqrtf(wave_sum(s) * (1.f / DM) + EPS);
#pragma unroll
                for (int j = 0; j < 16; ++j) { const f32x4 gg = ((const f32x4*)gv)[64 * j + lane]; orow[64 * j] = v[j] * rstd * gg; }
            }
        }
        SEAM();
    }
#undef RUN
#undef SEAM
}

extern "C" void kernel_launch(void* const* d_in, const int* in_sizes, int n_in, void* d_out, int out_size, void* d_ws, size_t ws_size, hipStream_t stream) {
    static int grid = 0;
    if (grid == 0) {
        if (n_in != 23 || out_size != NTOK * DM || ws_size < WS_END) { fprintf(stderr, "kernel_launch: unexpected shapes: n_in %d out %d ws %zu (need %zu)\n", n_in, out_size, ws_size, (size_t)WS_END); grid = -1; return; }
        int dev = 0, cus = 0, per_cu = 0;
        if (hipGetDevice(&dev) != hipSuccess || hipDeviceGetAttribute(&cus, hipDeviceAttributeMultiprocessorCount, dev) != hipSuccess) { grid = -1; return; }
        if (hipFuncSetAttribute((const void*)enc_fwd, hipFuncAttributeMaxDynamicSharedMemorySize, LDS_BYTES) != hipSuccess) { fprintf(stderr, "kernel_launch: hipFuncSetAttribute failed\n"); grid = -1; return; }
        if (hipOccupancyMaxActiveBlocksPerMultiprocessor(&per_cu, (const void*)enc_fwd, NWAVES * 64, LDS_BYTES) != hipSuccess || per_cu < 1) { fprintf(stderr, "kernel_launch: occupancy query says %d\n", per_cu); per_cu = 1; }
        (void)hipGetLastError();
        grid = cus;
    }
    if (grid < 0) return;
    (void)hipMemsetAsync((char*)d_ws + WS_CTL, 0, CTL_ZERO_BYTES, stream);
    Args a{};
    for (int i = 0; i < 23; ++i) a.in[i] = (const float*)d_in[i];
    a.out = (float*)d_out; a.ws = (unsigned char*)d_ws;
    for (int i = 0; i < 32; ++i) a.invf[i] = powf(10000.0f, -(float)(2 * i) / 64.0f);
#if MK_PER_STEP_LAUNCH
    for (int s = 0; s < NSTEPS; ++s) { a.lo = s; a.hi = s + 1; hipLaunchKernelGGL(enc_fwd, dim3(grid), dim3(NWAVES * 64), LDS_BYTES, stream, a); }
#else
    a.lo = 0; a.hi = NSTEPS;
    hipLaunchKernelGGL(enc_fwd, dim3(grid), dim3(NWAVES * 64), LDS_BYTES, stream, a);
#endif
    const hipError_t le = hipPeekAtLastError();
    if (le != hipSuccess) fprintf(stderr, "kernel_launch: launch failed: %s\n", hipGetErrorName(le));
}
```

```cpp
#include <hip/hip_runtime.h>
#include <cstdio>
#include <cstdint>
#include <cmath>

#ifndef I8_IN
#define I8_IN 1
#endif
#ifndef ATT_CINIT
#define ATT_CINIT 1
#endif
constexpr float CS_DIFF = 0.125f * 1.4426950408889634f;
#ifndef CONV_FUSE
#define CONV_FUSE 1
#endif
#ifndef I8_MID
#define I8_MID 1
#endif
#ifndef I8_UP
#define I8_UP 1
#endif
#ifndef FP8_DOWN
#define FP8_DOWN 1
#endif
constexpr float S_WD = 1024.f, S_ACT8 = 8.f;
#ifndef REP_GEMM
#define REP_GEMM 1
#endif
#ifndef REP_DIFF
#define REP_DIFF 1
#endif
#ifndef REP_MLA
#define REP_MLA 1
#endif
#if REP_GEMM == 1
#define REP_LOOP_GEMM
#else
#define REP_LOOP_GEMM _Pragma("unroll 1") for (int rep = 0; rep < REP_GEMM; ++rep)
#endif
#ifndef MK_PER_STEP_LAUNCH
#define MK_PER_STEP_LAUNCH 0
#endif

typedef unsigned short bf16;
typedef short bf16x8 __attribute__((ext_vector_type(8)));
typedef short s16x4 __attribute__((ext_vector_type(4)));
typedef float f32x4 __attribute__((ext_vector_type(4)));
typedef float f32x2 __attribute__((ext_vector_type(2)));
typedef float f32x16 __attribute__((ext_vector_type(16)));
typedef unsigned u32x4 __attribute__((ext_vector_type(4)));
typedef unsigned u32x2 __attribute__((ext_vector_type(2)));
typedef int i32x4 __attribute__((ext_vector_type(4)));
typedef int i32x8 __attribute__((ext_vector_type(8)));
#define LAS __attribute__((address_space(3)))

__device__ __forceinline__ unsigned cvt_pk_bf16(float lo, float hi) { unsigned r; asm volatile("v_cvt_pk_bf16_f32 %0, %1, %2" : "=v"(r) : "v"(lo), "v"(hi)); return r; }
__device__ __forceinline__ float bf_lo(unsigned w) { return __uint_as_float(w << 16); }
__device__ __forceinline__ float bf_hi(unsigned w) { return __uint_as_float(w & 0xffff0000u); }
__device__ __forceinline__ float clamp448(float x) { return __builtin_fminf(__builtin_fmaxf(x, -448.f), 448.f); }
__device__ __forceinline__ unsigned pack4_fp8(float a, float b, float c, float d) { int w = 0; w = __builtin_amdgcn_cvt_pk_fp8_f32(clamp448(a), clamp448(b), w, false); w = __builtin_amdgcn_cvt_pk_fp8_f32(clamp448(c), clamp448(d), w, true); return (unsigned)w; }
__device__ __forceinline__ unsigned pack4_i8(float a, float b, float c, float d) { const int ia = (int)__builtin_rintf(a), ib = (int)__builtin_rintf(b), ic = (int)__builtin_rintf(c), id = (int)__builtin_rintf(d);
    return (unsigned)(ia & 255) | ((unsigned)(ib & 255) << 8) | ((unsigned)(ic & 255) << 16) | ((unsigned)id << 24); }
__device__ __forceinline__ float fast_sigmoid(float x) { return __builtin_amdgcn_rcpf(1.0f + __builtin_amdgcn_exp2f(-1.4426950408889634f * x)); }

__device__ __forceinline__ int lane_id_fresh() { unsigned ones = ~0u; asm volatile("" : "+s"(ones)); return (int)__builtin_amdgcn_mbcnt_hi(ones, __builtin_amdgcn_mbcnt_lo(ones, 0u)); }

constexpr int DM = 4096, NTOK = 32768, TG = 8192, NGRP = 4;
constexpr int NIN = 16128;
constexpr int C_DQ = 0, C_DK = 2048, C_DV = 4096, C_QLAT = 6144, C_KVLAT = 7168, C_GATE = 7680, C_KPE = 15872;
constexpr int DFF = 11008, NUP = 22016, NQ = 3072, NKV = 4096;
constexpr float EPS = 1e-6f;

constexpr size_t MiB = 1u << 20;
constexpr size_t WS_CTL = 0, CTL_ZERO_BYTES = 1 * MiB;
constexpr size_t WS_COS = 1 * MiB, WS_SIN = 2 * MiB, WS_BIAS = 3 * MiB, WS_LAM = 3 * MiB + 32768;
constexpr size_t WS_CSIN = 3 * MiB + 65536, WS_CSUP = 3 * MiB + 131072, WS_RSH = 3 * MiB + 262144;
constexpr size_t WS_CSQ = 3 * MiB + 320 * 1024, WS_CSKV = 3 * MiB + 336 * 1024, WS_CSA = 3 * MiB + 352 * 1024, WS_CSB = 3 * MiB + 368 * 1024, WS_CSO = 3 * MiB + 384 * 1024;
constexpr size_t WS_RSQL = 3 * MiB + 400 * 1024, WS_RSKVL = 3 * MiB + 432 * 1024, WS_RSA = 3 * MiB + 464 * 1024, WS_RSB = 3 * MiB + 496 * 1024, WS_RSM = 3 * MiB + 528 * 1024;
constexpr size_t EB_IN = I8_IN ? 1 : 2, EB_UP = I8_UP ? 1 : 2, EB_MID = I8_MID ? 1 : 2, EB_DN = FP8_DOWN ? 1 : 2;
constexpr size_t WS_WIN = 4 * MiB, WS_WQ = WS_WIN + (size_t)NIN * DM * EB_IN, WS_WKV = WS_WQ + (size_t)NQ * 1024 * EB_MID, WS_WA = WS_WKV + (size_t)NKV * 512 * EB_MID, WS_WB = WS_WA + (size_t)DM * 2048 * EB_MID,
                 WS_WO = WS_WB + (size_t)DM * 2048 * EB_MID, WS_WUP = WS_WO + (size_t)DM * DM * EB_MID, WS_WD = WS_WUP + (size_t)NUP * DM * EB_UP, WS_WEND = WS_WD + (size_t)DM * DFF * EB_DN;
constexpr size_t WS_ACT = (WS_WEND + MiB - 1) / MiB * MiB;
constexpr size_t WS_H = WS_ACT, WS_P = WS_ACT + 64 * MiB, WS_Q = WS_ACT + 316 * MiB, WS_KV = WS_ACT + 364 * MiB, WS_AO = WS_ACT + 428 * MiB, WS_BO = WS_ACT + 460 * MiB, WS_MG = WS_ACT + 492 * MiB, WS_STASH = WS_ACT + 556 * MiB;
constexpr size_t WS_QL8 = WS_ACT + 588 * MiB, WS_KVL8 = WS_ACT + 596 * MiB, WS_AO8 = WS_ACT + 600 * MiB, WS_BO8 = WS_ACT + 616 * MiB, WS_MG8 = WS_ACT + 632 * MiB;
constexpr size_t WS_MIX_END = WS_ACT + 664 * MiB;
static_assert(WS_P + (size_t)TG * NIN * 2 <= WS_Q, "mixer map");
constexpr size_t WS_HF = WS_ACT, WS_Y = WS_HF + (size_t)NTOK * DM * EB_UP, WS_ACTV = WS_Y + (size_t)(NTOK / 64) * 4 * NUP * 2, WS_FFN_END = WS_ACTV + (size_t)NTOK * DFF * EB_DN;
constexpr size_t WS_X1 = ((WS_MIX_END > WS_FFN_END ? WS_MIX_END : WS_FFN_END) + MiB - 1) / MiB * MiB;
constexpr size_t WS_END = WS_X1 + (size_t)NTOK * DM * 2;
constexpr size_t WS_RSHF = 3 * MiB + 576 * 1024;
static_assert(WS_RSM + 32768 <= WS_RSHF && WS_RSHF + (size_t)NTOK * 4 <= 4 * MiB, "scale arrays");

namespace pg8 {
constexpr int BM = 256, BK = 64, HALF = 128, HTB = HALF * BK * 2, STAGE_BYTES = 8 * HTB, NXCD = 8, WGM = 8;
__host__ __device__ __forceinline__ int lds_byte(int r, int c) { const int st = (r >> 4) * 2 + (c >> 5), rr = r & 15, cc = c & 31, ob = rr * 64 + cc * 2; return st * 1024 + (ob ^ (((ob >> 9) & 1) << 5)); }
__host__ __device__ __forceinline__ void stage_rc(int b, int& R, int& C) { const int st = b / 1024, sb = b % 1024, swz = sb ^ (((sb >> 9) & 1) << 5); R = (st >> 1) * 16 + swz / 64; C = (st & 1) * 32 + (swz % 64) / 2; }
__host__ __device__ __forceinline__ int perm32(int rho) { const int n = rho >> 4, i = rho & 15; return 8 * (i >> 2) + 4 * n + (i & 3); }

struct Unit { int pm, pn; };
struct Gemm { const bf16* A; int lda; const bf16* Bt; int M, N, K; };

struct StaticOrder {
    int nM, nN, nwg, G, c;
    __device__ void init(int M, int N, int G_, int c_) { nM = M / BM; nN = N / BM; nwg = nM * nN; G = G_; c = c_; }
    __device__ bool next(int i, Unit& u) const {
        const long L = (long)i * G + c; if (L >= nwg) return false;
        int wgid = (int)L; { const int q = nwg / NXCD, r = nwg % NXCD, xcd = wgid % NXCD, off = wgid / NXCD; wgid = (xcd < r ? xcd * (q + 1) : r * (q + 1) + (xcd - r) * q) + off; }
        const int nig = WGM * nN, gid = wgid / nig, fm = gid * WGM, gsz = (nM - fm) < WGM ? (nM - fm) : WGM;
        u.pm = fm + ((wgid % nig) % gsz); u.pn = (wgid % nig) / gsz; return true;
    }
};

template <int MODE> struct AccSel { typedef f32x4 T; }; template <> struct AccSel<2> { typedef i32x4 T; };
__device__ __forceinline__ f32x4 tof(f32x4 v) { return v; }
__device__ __forceinline__ f32x4 tof(i32x4 v) { return __builtin_convertvector(v, f32x4); }

template <class Epi, int MODE = 0>
__device__ __forceinline__ void gemm_phase(LAS unsigned char* lds, const Gemm g, const StaticOrder& S, const Epi& E, int tid_in) {
    int tid = tid_in; asm volatile("" : "+v"(tid));
    const int wid = __builtin_amdgcn_readfirstlane(tid >> 6), lane = tid & 63, wr = wid >> 2, wc = wid & 3, fr = lane & 15, fq = lane >> 4;
    int K = g.K, lda = g.lda; asm volatile("" : "+s"(K), "+s"(lda));
    const int nt = K / BK;
    unsigned voffA[2], voffB[2];
#pragma unroll
    for (int i = 0; i < 2; ++i) { int R, C; stage_rc(tid * 16 + i * 8192, R, C); const int Rb = (R & ~31) + perm32(R & 31);
        voffA[i] = (unsigned)(R * lda + C) * 2u; voffB[i] = (unsigned)(Rb * K + C) * 2u; }
    const size_t kstep = (size_t)(BK * 2);
    const size_t hstepA = (size_t)HALF * lda * 2, hstepB = (size_t)HALF * K * 2;
    const size_t tstepA = 2 * hstepA, tstepB = 2 * hstepB;
    const unsigned ldsw = (unsigned)wid * 1024u;
    const int aoff = lds_byte(wr * 64 + fr, fq * 8), boff = lds_byte(wc * 32 + fr, fq * 8);
#define PG8_SA(b, h) (((b) * 2 + (h)) * HTB)
#define PG8_SB(b, h) ((4 + (b) * 2 + (h)) * HTB)
#define PG8_STAGE(bufoff, gbase, voff) do { _Pragma("unroll") for (int _i = 0; _i < 2; ++_i) \
        __builtin_amdgcn_global_load_lds((const unsigned*)((const char*)(gbase) + (voff)[_i]), (LAS unsigned*)(lds + (bufoff) + ldsw + _i * 8192), 16, 0, 0); } while (0)
#define PG8_CAT(x, y) __builtin_shufflevector(__builtin_bit_cast(i32x4, x), __builtin_bit_cast(i32x4, y), 0, 1, 2, 3, 4, 5, 6, 7)
#define PG8_LDA(dst, b, h) do { _Pragma("unroll") for (int m = 0; m < 4; ++m) dst[m] = PG8_CAT(*(const LAS bf16x8*)(lds + PG8_SA(b, h) + aoff + m * 2048), *(const LAS bf16x8*)(lds + PG8_SA(b, h) + aoff + m * 2048 + 1024)); } while (0)
#define PG8_LDB(dst, b, h) do { _Pragma("unroll") for (int n = 0; n < 2; ++n) dst[n] = PG8_CAT(*(const LAS bf16x8*)(lds + PG8_SB(b, h) + boff + n * 2048), *(const LAS bf16x8*)(lds + PG8_SB(b, h) + boff + n * 2048 + 1024)); } while (0)
#define PG8_LO4(v) __builtin_shufflevector(v, v, 0, 1, 2, 3)
#define PG8_HI4(v) __builtin_shufflevector(v, v, 4, 5, 6, 7)
#define PG8_LO(v) __builtin_bit_cast(bf16x8, __builtin_shufflevector(v, v, 0, 1, 2, 3))
#define PG8_HI(v) __builtin_bit_cast(bf16x8, __builtin_shufflevector(v, v, 4, 5, 6, 7))
#define PG8_MMA(ai, bj, At, Bt) do { __builtin_amdgcn_s_setprio(1); _Pragma("unroll") for (int m = 0; m < 4; ++m) _Pragma("unroll") for (int n = 0; n < 2; ++n) { \
        if constexpr (F8) asm volatile("v_mfma_f32_16x16x128_f8f6f4 %0, %1, %2, %0" : "+v"(acc[ai][bj][m][n]) : "v"(Bt[n]), "v"(At[m]));   \
        else if constexpr (MODE == 2) { acc[ai][bj][m][n] = __builtin_amdgcn_mfma_i32_16x16x64_i8(PG8_LO4(Bt[n]), PG8_LO4(At[m]), acc[ai][bj][m][n], 0, 0, 0); \
               acc[ai][bj][m][n] = __builtin_amdgcn_mfma_i32_16x16x64_i8(PG8_HI4(Bt[n]), PG8_HI4(At[m]), acc[ai][bj][m][n], 0, 0, 0); } \
        else { acc[ai][bj][m][n] = __builtin_amdgcn_mfma_f32_16x16x32_bf16(PG8_LO(Bt[n]), PG8_LO(At[m]), acc[ai][bj][m][n], 0, 0, 0); \
               acc[ai][bj][m][n] = __builtin_amdgcn_mfma_f32_16x16x32_bf16(PG8_HI(Bt[n]), PG8_HI(At[m]), acc[ai][bj][m][n], 0, 0, 0); } } __builtin_amdgcn_s_setprio(0); } while (0)
#define PG8_WAIT_V(n) asm volatile("s_waitcnt vmcnt(" #n ")" ::: "memory")
#define PG8_WAIT_L(n) asm volatile("s_waitcnt lgkmcnt(" #n ")" ::: "memory")
#define PG8_BAR __builtin_amdgcn_s_barrier()
#define PG8_SCHED __builtin_amdgcn_sched_barrier(0)
    Unit cur, nxt; int ui = 0;
    if (!S.next(0, cur)) return;
    constexpr bool F8 = (MODE == 1); typedef typename AccSel<MODE>::T AccT; AccT acc[2][2][4][2];
#pragma unroll
    for (int a = 0; a < 2; ++a)
#pragma unroll
        for (int b = 0; b < 2; ++b)
#pragma unroll
            for (int m = 0; m < 4; ++m)
#pragma unroll
                for (int n = 0; n < 2; ++n) acc[a][b][m][n] = AccT{};
    i32x8 At[4], B0[2], B1[2];
    const char* cA = (const char*)g.A + (size_t)cur.pm * tstepA; const char* cB = (const char*)g.Bt + (size_t)cur.pn * tstepB;
    PG8_STAGE(PG8_SB(0, 0), cB, voffB); PG8_STAGE(PG8_SB(0, 1), cB + hstepB, voffB); PG8_STAGE(PG8_SA(0, 0), cA, voffA); PG8_STAGE(PG8_SA(0, 1), cA + hstepA, voffA);
    if (wr == 1) PG8_BAR;
    PG8_WAIT_V(2); PG8_BAR;
    PG8_STAGE(PG8_SB(1, 0), cB + kstep, voffB); PG8_STAGE(PG8_SA(1, 0), cA + kstep, voffA); PG8_STAGE(PG8_SB(1, 1), cB + hstepB + kstep, voffB);
    PG8_WAIT_V(6); PG8_BAR;
    for (;;) {
        const bool has_next = S.next(ui + 1, nxt);
        const char* nA = has_next ? (const char*)g.A + (size_t)nxt.pm * tstepA : cA; const char* nB = has_next ? (const char*)g.Bt + (size_t)nxt.pn * tstepB : cB;
        for (int t = 0; t < nt; t += 2) {
            const bool last = (t == nt - 2);
            const char* a1 = cA + (size_t)(t + 1) * kstep;
            const char* a2 = last ? nA : cA + (size_t)(t + 2) * kstep; const char* b2 = last ? nB : cB + (size_t)(t + 2) * kstep;
            const char* a3 = a2 + kstep; const char* b3 = b2 + kstep;
            PG8_LDB(B0, 0, 0); PG8_LDB(B1, 0, 1); PG8_SCHED; PG8_LDA(At, 0, 0); PG8_STAGE(PG8_SA(1, 1), a1 + hstepA, voffA);
            PG8_WAIT_V(8); PG8_WAIT_L(0); PG8_BAR; PG8_MMA(0, 0, At, B0); PG8_MMA(0, 1, At, B1); PG8_BAR; PG8_SCHED;
            PG8_LDA(At, 0, 1); PG8_STAGE(PG8_SB(0, 0), b2, voffB); PG8_STAGE(PG8_SB(0, 1), b2 + hstepB, voffB); PG8_STAGE(PG8_SA(0, 0), a2, voffA);
            PG8_WAIT_V(8); PG8_WAIT_L(0); PG8_BAR; PG8_MMA(1, 0, At, B0); PG8_MMA(1, 1, At, B1); PG8_BAR; PG8_SCHED;
            PG8_LDB(B0, 1, 0); PG8_LDB(B1, 1, 1); PG8_SCHED; PG8_LDA(At, 1, 0); PG8_STAGE(PG8_SA(0, 1), a2 + hstepA, voffA);
            PG8_WAIT_V(8); PG8_WAIT_L(0); PG8_BAR; PG8_MMA(0, 0, At, B0); PG8_MMA(0, 1, At, B1); PG8_BAR; PG8_SCHED;
            PG8_LDA(At, 1, 1); PG8_STAGE(PG8_SB(1, 0), b3, voffB); PG8_STAGE(PG8_SB(1, 1), b3 + hstepB, voffB); PG8_STAGE(PG8_SA(1, 0), a3, voffA);
            PG8_WAIT_V(8); PG8_WAIT_L(0); PG8_BAR; PG8_MMA(1, 0, At, B0); PG8_MMA(1, 1, At, B1); PG8_BAR; PG8_SCHED;
        }
        if (wr == 0) PG8_BAR;
        if constexpr (F8) asm volatile("s_nop 15\n\ts_nop 15" ::: "memory");
        { int l3_ = lane_id_fresh(); asm volatile("" : "+v"(l3_)); E(acc, cur, wr, wc, l3_ & 15, l3_ >> 4); }
        if (!has_next) break;
#pragma unroll
        for (int a = 0; a < 2; ++a)
#pragma unroll
            for (int b = 0; b < 2; ++b)
#pragma unroll
                for (int m = 0; m < 4; ++m)
#pragma unroll
                    for (int n = 0; n < 2; ++n) acc[a][b][m][n] = AccT{};
        cur = nxt; cA = nA; cB = nB; ++ui;
        if (wr == 1) PG8_BAR;
    }
    PG8_WAIT_V(0);
    PG8_BAR;
#undef PG8_SA
#undef PG8_SB
#undef PG8_STAGE
#undef PG8_LDA
#undef PG8_LDB
#undef PG8_MMA
#undef PG8_CAT
#undef PG8_LO
#undef PG8_LO4
#undef PG8_HI4
#undef PG8_HI
#undef PG8_WAIT_V
#undef PG8_WAIT_L
#undef PG8_BAR
#undef PG8_SCHED
}

template <bool SC, size_t RSOFF = 0, size_t CSOFF = 0> struct EpiStoreT {
    bf16* O; int ldc; int sig_lo, sig_hi; float scale; const unsigned char* wsb;
    template <class AccT> __device__ __forceinline__ void operator()(const AccT (&acc)[2][2][4][2], const Unit& u, int wr, int wc, int fr, int fq) const {
        const bool sig = (u.pn >= sig_lo && u.pn < sig_hi);
        const int row0 = u.pm * BM + wr * 64 + fr, col0 = u.pn * BM + wc * 32 + 8 * fq;
        const float* rs = (const float*)(wsb + RSOFF); const float* cs = (const float*)(wsb + CSOFF);
        const float tsc = (u.pn < 8) ? scale : 1.f;
        f32x4 cv[2][2];
#pragma unroll
        for (int bj = 0; bj < 2; ++bj) { if constexpr (SC) { cv[bj][0] = *(const f32x4*)(cs + col0 + bj * HALF) * tsc; cv[bj][1] = *(const f32x4*)(cs + col0 + bj * HALF + 4) * tsc; } else { cv[bj][0] = (f32x4){tsc, tsc, tsc, tsc}; cv[bj][1] = cv[bj][0]; } }
#pragma unroll
        for (int ai = 0; ai < 2; ++ai)
#pragma unroll
            for (int m = 0; m < 4; ++m) { bf16* rowp = O + (size_t)(row0 + ai * HALF + m * 16) * ldc + col0; float rsv = 1.f; if constexpr (SC) rsv = rs[row0 + ai * HALF + m * 16];
#pragma unroll
                for (int bj = 0; bj < 2; ++bj) { f32x4 v0 = tof(acc[ai][bj][m][0]) * (cv[bj][0] * rsv), v1 = tof(acc[ai][bj][m][1]) * (cv[bj][1] * rsv);
                    if (sig) {
#pragma unroll
                        for (int j = 0; j < 4; ++j) { v0[j] = fast_sigmoid(v0[j]); v1[j] = fast_sigmoid(v1[j]); } }
                    u32x4 w; w.x = cvt_pk_bf16(v0[0], v0[1]); w.y = cvt_pk_bf16(v0[2], v0[3]); w.z = cvt_pk_bf16(v1[0], v1[1]); w.w = cvt_pk_bf16(v1[2], v1[3]);
                    *(u32x4*)(rowp + bj * HALF) = w; }
                asm volatile("" ::: "memory"); }
    }
};
template <bool SC> struct EpiQT {
    bf16* O; int ldc; const unsigned char* wsb; int posmask;
    template <class AccT> __device__ __forceinline__ void operator()(const AccT (&acc)[2][2][4][2], const Unit& u, int wr, int wc, int fr, int fq) const {
        const bool rope = (u.pn >= 8);
        const int row0 = u.pm * BM + wr * 64 + fr, col0 = u.pn * BM + wc * 32 + 8 * fq;
        const float* cosT = (const float*)(wsb + WS_COS); const float* sinT = (const float*)(wsb + WS_SIN); const float* rs = (const float*)(wsb + WS_RSQL); const float* cs = (const float*)(wsb + WS_CSQ);
        f32x4 cv[2][2];
#pragma unroll
        for (int bj = 0; bj < 2; ++bj) { if constexpr (SC) { cv[bj][0] = *(const f32x4*)(cs + col0 + bj * HALF); cv[bj][1] = *(const f32x4*)(cs + col0 + bj * HALF + 4); } else { cv[bj][0] = (f32x4){1.f, 1.f, 1.f, 1.f}; cv[bj][1] = cv[bj][0]; } }
#pragma unroll
        for (int ai = 0; ai < 2; ++ai)
#pragma unroll
            for (int m = 0; m < 4; ++m) { const int row = row0 + ai * HALF + m * 16; bf16* rowp = O + (size_t)row * ldc + col0; const int pos = row & posmask; float rsv = 1.f; if constexpr (SC) rsv = rs[row];
#pragma unroll
                for (int bj = 0; bj < 2; ++bj) { f32x4 v0 = tof(acc[ai][bj][m][0]) * (cv[bj][0] * rsv), v1 = tof(acc[ai][bj][m][1]) * (cv[bj][1] * rsv);
                    if (rope) { const int i0 = (((col0 + bj * HALF) & 63) >> 1);
                        const f32x4 c = *(const f32x4*)(cosT + (size_t)pos * 32 + i0), s = *(const f32x4*)(sinT + (size_t)pos * 32 + i0);
                        f32x4 a, b;
                        a[0] = v0[0] * c[0] - v0[1] * s[0]; a[1] = v0[0] * s[0] + v0[1] * c[0]; a[2] = v0[2] * c[1] - v0[3] * s[1]; a[3] = v0[2] * s[1] + v0[3] * c[1];
                        b[0] = v1[0] * c[2] - v1[1] * s[2]; b[1] = v1[0] * s[2] + v1[1] * c[2]; b[2] = v1[2] * c[3] - v1[3] * s[3]; b[3] = v1[2] * s[3] + v1[3] * c[3];
                        v0 = a; v1 = b; }
                    u32x4 w; w.x = cvt_pk_bf16(v0[0], v0[1]); w.y = cvt_pk_bf16(v0[2], v0[3]); w.z = cvt_pk_bf16(v1[0], v1[1]); w.w = cvt_pk_bf16(v1[2], v1[3]);
                    *(u32x4*)(rowp + bj * HALF) = w; } }
    }
};
template <bool SC> struct EpiGateAT {
    bf16* part; int ldp; const bf16* gate; int ldg; const unsigned char* wsb;
    template <class AccT> __device__ __forceinline__ void operator()(const AccT (&acc)[2][2][4][2], const Unit& u, int wr, int wc, int fr, int fq) const {
        const int row0 = u.pm * BM + wr * 64 + fr, col0 = u.pn * BM + wc * 32 + 8 * fq;
        const float* rs = (const float*)(wsb + WS_RSA); const float* cs = (const float*)(wsb + WS_CSA);
        f32x4 cv[2][2];
#pragma unroll
        for (int bj = 0; bj < 2; ++bj) { if constexpr (SC) { cv[bj][0] = *(const f32x4*)(cs + col0 + bj * HALF); cv[bj][1] = *(const f32x4*)(cs + col0 + bj * HALF + 4); } else { cv[bj][0] = (f32x4){1.f, 1.f, 1.f, 1.f}; cv[bj][1] = cv[bj][0]; } }
#pragma unroll
        for (int ai = 0; ai < 2; ++ai) {
            u32x4 gw[4][2]; float rsv[4];
#pragma unroll
            for (int m = 0; m < 4; ++m) { const size_t row = (size_t)(row0 + ai * HALF + m * 16); rsv[m] = 1.f; if constexpr (SC) rsv[m] = rs[row];
#pragma unroll
                for (int bj = 0; bj < 2; ++bj) gw[m][bj] = *(const u32x4*)(gate + row * ldg + col0 + bj * HALF); }
#pragma unroll
            for (int m = 0; m < 4; ++m) { const size_t row = (size_t)(row0 + ai * HALF + m * 16);
#pragma unroll
                for (int bj = 0; bj < 2; ++bj) { const f32x4 v0 = tof(acc[ai][bj][m][0]) * (cv[bj][0] * rsv[m]), v1 = tof(acc[ai][bj][m][1]) * (cv[bj][1] * rsv[m]); const u32x4 g = gw[m][bj];
                    u32x4 w; w.x = cvt_pk_bf16(v0[0] * bf_lo(g.x), v0[1] * bf_hi(g.x)); w.y = cvt_pk_bf16(v0[2] * bf_lo(g.y), v0[3] * bf_hi(g.y)); w.z = cvt_pk_bf16(v1[0] * bf_lo(g.z), v1[1] * bf_hi(g.z)); w.w = cvt_pk_bf16(v1[2] * bf_lo(g.w), v1[3] * bf_hi(g.w));
                    *(u32x4*)(part + row * ldp + col0 + bj * HALF) = w; } }
            asm volatile("" ::: "memory");
        }
    }
};
template <bool SC> struct EpiGateBT {
    const bf16* part; int ldp; const bf16* gate; int ldg; bf16* O; int ldc; const unsigned char* wsb;
    template <class AccT> __device__ __forceinline__ void operator()(const AccT (&acc)[2][2][4][2], const Unit& u, int wr, int wc, int fr, int fq) const {
        const int row0 = u.pm * BM + wr * 64 + fr, col0 = u.pn * BM + wc * 32 + 8 * fq;
        const float* rs = (const float*)(wsb + WS_RSB); const float* cs = (const float*)(wsb + WS_CSB);
        f32x4 cv[2][2];
#pragma unroll
        for (int bj = 0; bj < 2; ++bj) { if constexpr (SC) { cv[bj][0] = *(const f32x4*)(cs + col0 + bj * HALF); cv[bj][1] = *(const f32x4*)(cs + col0 + bj * HALF + 4); } else { cv[bj][0] = (f32x4){1.f, 1.f, 1.f, 1.f}; cv[bj][1] = cv[bj][0]; } }
#pragma unroll
        for (int ai = 0; ai < 2; ++ai) {
            u32x4 gw[4][2], pw[4][2]; float rsv[4];
#pragma unroll
            for (int m = 0; m < 4; ++m) { const size_t row = (size_t)(row0 + ai * HALF + m * 16); rsv[m] = 1.f; if constexpr (SC) rsv[m] = rs[row];
#pragma unroll
                for (int bj = 0; bj < 2; ++bj) { gw[m][bj] = *(const u32x4*)(gate + row * ldg + col0 + bj * HALF); pw[m][bj] = *(const u32x4*)(part + row * ldp + col0 + bj * HALF); } }
#pragma unroll
            for (int m = 0; m < 4; ++m) { const size_t row = (size_t)(row0 + ai * HALF + m * 16);
#pragma unroll
                for (int bj = 0; bj < 2; ++bj) { const f32x4 v0 = tof(acc[ai][bj][m][0]) * (cv[bj][0] * rsv[m]), v1 = tof(acc[ai][bj][m][1]) * (cv[bj][1] * rsv[m]); const u32x4 g = gw[m][bj], p = pw[m][bj];
                    u32x4 w; w.x = cvt_pk_bf16(bf_lo(p.x) + v0[0] * bf_lo(g.x), bf_hi(p.x) + v0[1] * bf_hi(g.x)); w.y = cvt_pk_bf16(bf_lo(p.y) + v0[2] * bf_lo(g.y), bf_hi(p.y) + v0[3] * bf_hi(g.y));
                    w.z = cvt_pk_bf16(bf_lo(p.z) + v1[0] * bf_lo(g.z), bf_hi(p.z) + v1[1] * bf_hi(g.z)); w.w = cvt_pk_bf16(bf_lo(p.w) + v1[2] * bf_lo(g.w), bf_hi(p.w) + v1[3] * bf_hi(g.w));
                    *(u32x4*)(O + row * ldc + col0 + bj * HALF) = w; } }
            asm volatile("" ::: "memory");
        }
    }
};
template <bool SC, bool SRCB> struct EpiResT {
    const void* src; bf16* dst; int ld; float scale; const unsigned char* wsb;
    template <class AccT> __device__ __forceinline__ void operator()(const AccT (&acc)[2][2][4][2], const Unit& u, int wr, int wc, int fr, int fq) const {
        const int row0 = u.pm * BM + wr * 64 + fr, col0 = u.pn * BM + wc * 32 + 8 * fq;
        const float* rs = (const float*)(wsb + WS_RSM); const float* cs = (const float*)(wsb + WS_CSO);
        f32x4 cv[2][2];
#pragma unroll
        for (int bj = 0; bj < 2; ++bj) { if constexpr (SC) { cv[bj][0] = *(const f32x4*)(cs + col0 + bj * HALF); cv[bj][1] = *(const f32x4*)(cs + col0 + bj * HALF + 4); } else { cv[bj][0] = (f32x4){scale, scale, scale, scale}; cv[bj][1] = cv[bj][0]; } }
#pragma unroll
        for (int ai = 0; ai < 2; ++ai)
#pragma unroll
            for (int mh = 0; mh < 2; ++mh) {
                f32x4 sv[2][2][2]; float rsv[2];
#pragma unroll
                for (int mm = 0; mm < 2; ++mm) { const int m = 2 * mh + mm; const size_t off = (size_t)(row0 + ai * HALF + m * 16) * ld + col0; rsv[mm] = 1.f; if constexpr (SC) rsv[mm] = rs[row0 + ai * HALF + m * 16];
#pragma unroll
                    for (int bj = 0; bj < 2; ++bj) {
                        if constexpr (SRCB) { const u32x4 w = *(const u32x4*)((const bf16*)src + off + bj * HALF); sv[mm][bj][0] = (f32x4){bf_lo(w.x), bf_hi(w.x), bf_lo(w.y), bf_hi(w.y)}; sv[mm][bj][1] = (f32x4){bf_lo(w.z), bf_hi(w.z), bf_lo(w.w), bf_hi(w.w)}; }
                        else { const float* sp = (const float*)src + off + bj * HALF; sv[mm][bj][0] = *(const f32x4*)sp; sv[mm][bj][1] = *(const f32x4*)(sp + 4); } } }
#pragma unroll
                for (int mm = 0; mm < 2; ++mm) { const int m = 2 * mh + mm; const size_t off = (size_t)(row0 + ai * HALF + m * 16) * ld + col0;
#pragma unroll
                    for (int bj = 0; bj < 2; ++bj) { const f32x4 o0 = sv[mm][bj][0] + tof(acc[ai][bj][m][0]) * (cv[bj][0] * rsv[mm]), o1 = sv[mm][bj][1] + tof(acc[ai][bj][m][1]) * (cv[bj][1] * rsv[mm]);
                        u32x4 w; w.x = cvt_pk_bf16(o0[0], o0[1]); w.y = cvt_pk_bf16(o0[2], o0[3]); w.z = cvt_pk_bf16(o1[0], o1[1]); w.w = cvt_pk_bf16(o1[2], o1[3]); *(u32x4*)(dst + off + bj * HALF) = w; } }
                asm volatile("" ::: "memory");
            }
    }
};

__device__ __forceinline__ float dpp_from_prev_lane(float v) { return __builtin_bit_cast(float, __builtin_amdgcn_update_dpp(0, __builtin_bit_cast(int, v), 0x121, 0xF, 0xF, false)); }
__device__ __forceinline__ float dpp_from_next_lane(float v) { return __builtin_bit_cast(float, __builtin_amdgcn_update_dpp(0, __builtin_bit_cast(int, v), 0x12F, 0xF, 0xF, false)); }
struct EpiConv {
    unsigned char* act; bf16* yb; const float* cw; const float* cb; const unsigned char* wsb; float oscale;
    template <class AccT> __device__ __forceinline__ void operator()(const AccT (&acc)[2][2][4][2], const Unit& u, int wr, int wc, int fr, int fq) const {
        const float* rs = (const float*)(wsb + WS_RSHF); const float* cs = (const float*)(wsb + WS_CSUP);
#pragma unroll
        for (int n = 0; n < 2; ++n) {
            const int ch0 = wc * 32 + 8 * fq + 4 * n, cg = u.pn * 128 + ch0, colg = u.pn * BM + ch0;
            const f32x4 csg = *(const f32x4*)(cs + colg), csu = *(const f32x4*)(cs + colg + HALF), bg = *(const f32x4*)(cb + cg), bu = *(const f32x4*)(cb + DFF + cg);
            f32x4 wg[3], wu[3];
#pragma unroll
            for (int t = 0; t < 3; ++t) { wg[t] = *(const f32x4*)(cw + t * NUP + cg); wu[t] = *(const f32x4*)(cw + t * NUP + DFF + cg); }
#pragma unroll
            for (int ai = 0; ai < 2; ++ai) {
                const int rowb = u.pm * BM + ai * HALF + wr * 64;
                f32x4 yg[4], yu[4];
#pragma unroll
                for (int m = 0; m < 4; ++m) { const float rsv = rs[rowb + 16 * m + fr]; yg[m] = tof(acc[ai][0][m][n]) * (csg * rsv); yu[m] = tof(acc[ai][1][m][n]) * (csu * rsv); }
                if (fr < 2 || fr >= 14) { const bool lo = fr < 2; bf16* yr = yb + ((size_t)(rowb >> 6) * 4 + (lo ? fr : fr - 12)) * NUP + colg;
                    const f32x4 a0 = lo ? yg[0] : yg[3], b0 = lo ? yu[0] : yu[3];
                    u32x2 w; w.x = cvt_pk_bf16(a0[0], a0[1]); w.y = cvt_pk_bf16(a0[2], a0[3]); *(u32x2*)yr = w;
                    w.x = cvt_pk_bf16(b0[0], b0[1]); w.y = cvt_pk_bf16(b0[2], b0[3]); *(u32x2*)(yr + HALF) = w; }
#pragma unroll
                for (int m = 0; m < 4; ++m) {
                    float o[4];
#pragma unroll
                    for (int e = 0; e < 4; ++e) {
                        const float gc = yg[m][e], uc = yu[m][e];
                        const float gsp = (m > 0 && fr == 15) ? yg[m > 0 ? m - 1 : 0][e] : gc, usp = (m > 0 && fr == 15) ? yu[m > 0 ? m - 1 : 0][e] : uc;
                        const float gsn = (m < 3 && fr == 0) ? yg[m < 3 ? m + 1 : 3][e] : gc, usn = (m < 3 && fr == 0) ? yu[m < 3 ? m + 1 : 3][e] : uc;
                        const float gp = dpp_from_prev_lane(gsp), up = dpp_from_prev_lane(usp), gn = dpp_from_next_lane(gsn), un = dpp_from_next_lane(usn);
                        const float ug = wg[0][e] * gp + wg[1][e] * gc + wg[2][e] * gn + bg[e];
                        const float uu = wu[0][e] * up + wu[1][e] * uc + wu[2][e] * un + bu[e];
                        o[e] = ug * fast_sigmoid(ug) * uu * oscale; }
                    const bool edge = (m == 0 && fr == 0) || (m == 3 && fr == 15);
                    if (!edge) { const size_t row = (size_t)(rowb + 16 * m + fr);
                        if (FP8_DOWN) *(unsigned*)(act + row * DFF + cg) = pack4_fp8(o[0], o[1], o[2], o[3]);
                        else { u32x2 w; w.x = cvt_pk_bf16(o[0], o[1]); w.y = cvt_pk_bf16(o[2], o[3]); *(u32x2*)((bf16*)act + row * DFF + cg) = w; } }
                }
                asm volatile("" ::: "memory");
            }
        }
    }
};
}

namespace att {
constexpr int OFF_V = 0, SHM_V = 16384, OFF_K = 32768, KROW = 144  , SHM_KP = 64 * KROW, OFF_WS = 32768 + 2 * 3 * SHM_KP, OFF_TBL = OFF_WS + 2048, OFF_QR = OFF_TBL + 1056, LDS_END = OFF_QR + 256 * KROW;
#define SBAR() __builtin_amdgcn_sched_barrier(0)
__device__ __forceinline__ int crow(int r, int hi) { return (r & 3) + 8 * (r >> 2) + 4 * hi; }
__device__ __forceinline__ int kswz(int row, int colB) { return row * KROW + colB; }
__device__ __forceinline__ int v_st(int k, int c) { const int kk = (k & ~0xC) | ((k & 4) << 1) | ((k & 8) >> 1); return ((kk >> 3) * 4 + (c >> 5)) * 512 + ((kk & 7) * 32 + (c & 31)) * 2; }
__device__ __forceinline__ int v_rd_base(int lane) { return ((lane & 3) << 3) | (((lane >> 2) & 3) << 6) | (((lane >> 4) & 1) << 5) | (((lane >> 5) & 1) << 8); }
constexpr int v_rd_off(int d0, int ks, int half) { return d0 * 512 + ks * 4096 + half * 2048; }
template <int OFF> __device__ __forceinline__ s16x4 tr_read(int vb) { s16x4 r; asm volatile("ds_read_b64_tr_b16 %0, %1 offset:%2" : "=&v"(r) : "v"(vb), "i"(OFF) : "memory"); return r; }
template <int D0> __device__ __forceinline__ void pv_one(f32x16& od, int vb, bf16x8 pa0, bf16x8 pa1, bf16x8 pa2, bf16x8 pa3) {
    const s16x4 l0 = tr_read<v_rd_off(D0, 0, 0)>(vb), h0 = tr_read<v_rd_off(D0, 0, 1)>(vb), l1 = tr_read<v_rd_off(D0, 1, 0)>(vb), h1 = tr_read<v_rd_off(D0, 1, 1)>(vb);
    const s16x4 l2 = tr_read<v_rd_off(D0, 2, 0)>(vb), h2 = tr_read<v_rd_off(D0, 2, 1)>(vb), l3 = tr_read<v_rd_off(D0, 3, 0)>(vb), h3 = tr_read<v_rd_off(D0, 3, 1)>(vb);
    asm volatile("s_waitcnt lgkmcnt(0)" ::: "memory"); SBAR();
#define PK(L, H) (bf16x8){L[0], L[1], L[2], L[3], H[0], H[1], H[2], H[3]}
    od = __builtin_amdgcn_mfma_f32_32x32x16_bf16(pa0, PK(l0, h0), od, 0, 0, 0);
    od = __builtin_amdgcn_mfma_f32_32x32x16_bf16(pa1, PK(l1, h1), od, 0, 0, 0);
    od = __builtin_amdgcn_mfma_f32_32x32x16_bf16(pa2, PK(l2, h2), od, 0, 0, 0);
    od = __builtin_amdgcn_mfma_f32_32x32x16_bf16(pa3, PK(l3, h3), od, 0, 0, 0);
#undef PK
}
__device__ __forceinline__ void pv_d0(f32x16* o, int vb, bf16x8 pa0, bf16x8 pa1, bf16x8 pa2, bf16x8 pa3) {
    pv_one<0>(o[0], vb, pa0, pa1, pa2, pa3); pv_one<1>(o[1], vb, pa0, pa1, pa2, pa3); pv_one<2>(o[2], vb, pa0, pa1, pa2, pa3); pv_one<3>(o[3], vb, pa0, pa1, pa2, pa3);
}
__device__ __forceinline__ float fma_s(float a, float s_uniform, float c) { float d; asm("v_fma_f32 %0, %1, %2, %3" : "=v"(d) : "v"(a), "s"(s_uniform), "v"(c)); return d; }
constexpr float THR2 = 8.0f * 1.4426950408889634f;
template <bool BIAS>
__device__ __forceinline__ void partialSM(f32x16& p0, f32x16& p1, float& m_reg, float& mn, float& alpha, float Cs, bool near, float bconst, int relbase, int hi, const LAS float* tbl) {
    float pmax;
    if (BIAS && near) {
#pragma unroll
        for (int r = 0; r < 16; ++r) { const int k = relbase + crow(r, hi);
            const int i0 = min(max(k, 0), 256), i1 = min(max(k + 32, 0), 256);
            p0[r] = fma_s(p0[r], Cs, tbl[i0]); p1[r] = fma_s(p1[r], Cs, tbl[i1]); }
        pmax = p0[0];
#pragma unroll
        for (int r = 1; r < 16; ++r) pmax = fmaxf(pmax, p0[r]);
#pragma unroll
        for (int r = 0; r < 16; ++r) pmax = fmaxf(pmax, p1[r]);
        { auto rr = __builtin_amdgcn_permlane32_swap(__float_as_uint(pmax), __float_as_uint(pmax), false, false); pmax = fmaxf(__uint_as_float(rr[0]), __uint_as_float(rr[1])); }
        if (__builtin_expect(__all(pmax - m_reg <= THR2), 1)) { mn = m_reg; alpha = 1.f; }
        else { mn = fmaxf(m_reg, pmax); alpha = __builtin_amdgcn_exp2f(m_reg - mn); m_reg = mn; }
#pragma unroll
        for (int r = 0; r < 16; ++r) { p0[r] = p0[r] - mn; p1[r] = p1[r] - mn; }
    } else {
        pmax = p0[0];
#pragma unroll
        for (int r = 1; r < 16; ++r) pmax = fmaxf(pmax, p0[r]);
#pragma unroll
        for (int r = 0; r < 16; ++r) pmax = fmaxf(pmax, p1[r]);
        { auto rr = __builtin_amdgcn_permlane32_swap(__float_as_uint(pmax), __float_as_uint(pmax), false, false); pmax = fmaxf(__uint_as_float(rr[0]), __uint_as_float(rr[1])); }
        pmax = fmaf(pmax, Cs, bconst);
        if (__builtin_expect(__all(pmax - m_reg <= THR2), 1)) { mn = m_reg; alpha = 1.f; }
        else { mn = fmaxf(m_reg, pmax); alpha = __builtin_amdgcn_exp2f(m_reg - mn); m_reg = mn; }
        const float off = bconst - mn;
#pragma unroll
        for (int r = 0; r < 16; ++r) { p0[r] = fma_s(p0[r], Cs, off); p1[r] = fma_s(p1[r], Cs, off); }
    }
#pragma unroll
    for (int r = 0; r < 16; ++r) p0[r] = __builtin_amdgcn_exp2f(p0[r]);
}
__device__ __forceinline__ void partialSM_ci(f32x16& p0, f32x16& p1, float& m_reg, float& alpha, f32x16& csp, bool first, bool near, float bcur, int relbase, int hi, const LAS float* tbl) {
    if (near) {
#pragma unroll
        for (int r = 0; r < 16; ++r) { const int k = relbase + crow(r, hi); const int i0 = min(max(k, 0), 256), i1 = min(max(k + 32, 0), 256);
            p0[r] += tbl[i0] - bcur; p1[r] += tbl[i1] - bcur; }
    }
    float pmax = p0[0];
#pragma unroll
    for (int r = 1; r < 16; ++r) pmax = fmaxf(pmax, p0[r]);
#pragma unroll
    for (int r = 0; r < 16; ++r) pmax = fmaxf(pmax, p1[r]);
    { auto rr = __builtin_amdgcn_permlane32_swap(__float_as_uint(pmax), __float_as_uint(pmax), false, false); pmax = fmaxf(__uint_as_float(rr[0]), __uint_as_float(rr[1])); }
    if (__builtin_expect(!first && __all(pmax <= THR2), 1)) { alpha = 1.f; }
    else { const float d = first ? pmax : fmaxf(pmax, 0.f); alpha = __builtin_amdgcn_exp2f(-d); m_reg += d;
#pragma unroll
        for (int r = 0; r < 16; ++r) { p0[r] -= d; p1[r] -= d; csp[r] -= d; } }
#pragma unroll
    for (int r = 0; r < 16; ++r) p0[r] = __builtin_amdgcn_exp2f(p0[r]);
}
__device__ __forceinline__ void finishSM(f32x16& p0, f32x16& p1, float alpha, float& l_reg, bf16x8& pa0, bf16x8& pa1, bf16x8& pa2, bf16x8& pa3) {
#pragma unroll
    for (int r = 0; r < 16; ++r) p1[r] = __builtin_amdgcn_exp2f(p1[r]);
    float ps = 0;
#pragma unroll
    for (int r = 0; r < 16; ++r) ps += p0[r];
#pragma unroll
    for (int r = 0; r < 16; ++r) ps += p1[r];
    { auto rr = __builtin_amdgcn_permlane32_swap(__float_as_uint(ps), __float_as_uint(ps), false, false); ps = __uint_as_float(rr[0]) + __uint_as_float(rr[1]); }
    l_reg = l_reg * alpha + ps;
#define PK4(P, BASE, OUT) do { unsigned a0 = cvt_pk_bf16(P[BASE + 0], P[BASE + 1]), a1 = cvt_pk_bf16(P[BASE + 2], P[BASE + 3]);   \
    unsigned b0 = cvt_pk_bf16(P[BASE + 4], P[BASE + 5]), b1 = cvt_pk_bf16(P[BASE + 6], P[BASE + 7]);                              \
    auto r0 = __builtin_amdgcn_permlane32_swap(a0, b0, false, false); auto r1 = __builtin_amdgcn_permlane32_swap(a1, b1, false, false); \
    u32x4 w = {r0[0], r1[0], r0[1], r1[1]}; OUT = *reinterpret_cast<bf16x8*>(&w); } while (0)
    PK4(p0, 0, pa0); PK4(p0, 8, pa1); PK4(p1, 0, pa2); PK4(p1, 8, pa3);
#undef PK4
}
template <int NP>
__device__ __forceinline__ void qkt(f32x16& p0, f32x16& p1, const LAS char* Ks, const bf16x8* qr, const LAS char* qrl, int r32, int hi, const f32x16& cinit) {
    p0 = cinit; p1 = cinit;
#pragma unroll
    for (int p = 0; p < NP; ++p)
#pragma unroll
        for (int d0 = 0; d0 < 4; ++d0) { const int cb = d0 * 32 + hi * 16;
            bf16x8 b0 = *(const LAS bf16x8*)(Ks + p * SHM_KP + kswz(r32, cb));
            bf16x8 b1 = *(const LAS bf16x8*)(Ks + p * SHM_KP + kswz(32 + r32, cb));
            const bf16x8 qf = (NP == 3 && p == 2) ? *(const LAS bf16x8*)(qrl + d0 * 32) : qr[p * 4 + d0];
            p0 = __builtin_amdgcn_mfma_f32_32x32x16_bf16(b0, qf, p0, 0, 0, 0);
            p1 = __builtin_amdgcn_mfma_f32_32x32x16_bf16(b1, qf, p1, 0, 0, 0); }
}
struct Ptrs { const bf16* q[3]; const bf16* k[3]; const bf16* v; };
struct StrDiff { static constexpr int LDQ = NIN, LDK = NIN, LDK2 = NIN, LDV = NIN; };
struct StrMla { static constexpr int LDQ = NQ, LDK = NKV, LDK2 = NIN, LDV = NKV; };
template <int NP, bool BIAS, int SDEPTH, class STR>
__device__ __forceinline__ void attn_body(const Ptrs& P, int seq, int qpos0, float Cs, LAS char* lds, f32x16 (&o)[4], int tid_in) {
    int tid = tid_in; asm volatile("" : "+v"(tid));
    const int wid = __builtin_amdgcn_readfirstlane(tid >> 6), lane = tid & 63, r32 = lane & 31, hi = lane >> 5;
    LAS char* V_lds = lds + OFF_V; LAS char* K_lds = lds + OFF_K;
    LAS float* wsl = (LAS float*)(lds + OFF_WS) + wid * 64; LAS float* li_l = wsl; LAS float* al_l = wsl + 32;
    const LAS float* tbl = (const LAS float*)(lds + OFF_TBL);
    constexpr int KB = NP * SHM_KP;
    constexpr bool CI = BIAS && (ATT_CINIT != 0);
    float m_reg = CI ? 0.f : -1e30f, l_reg = 0;
#pragma unroll
    for (int d = 0; d < 4; ++d) o[d] = f32x16{};
    constexpr int NPR = (NP == 3) ? 2 : NP;
    bf16x8 qr[NPR * 4];
#pragma unroll
    for (int p = 0; p < NPR; ++p)
#pragma unroll
        for (int d0 = 0; d0 < 4; ++d0) qr[p * 4 + d0] = *reinterpret_cast<const bf16x8*>(P.q[p] + (long)(wid * 32 + r32) * STR::LDQ + hi * 8 + d0 * 16);
    LAS char* qrl = lds + OFF_QR + (wid * 32 + r32) * KROW + hi * 16;
    if constexpr (NP == 3) {
#pragma unroll
        for (int d0 = 0; d0 < 4; ++d0) *(LAS bf16x8*)(qrl + d0 * 32) = *reinterpret_cast<const bf16x8*>(P.q[2] + (long)(wid * 32 + r32) * STR::LDQ + hi * 8 + d0 * 16);
    }
    const int kr = tid >> 3, kc = tid & 7, kst = kswz(kr, kc * 16);
    const int sr = tid >> 4, sc = (tid & 15) * 8, vst0 = v_st(sr, sc), vst1 = v_st(32 + sr, sc);
    const int vb0 = (int)(uintptr_t)V_lds + v_rd_base(lane);
    const int qlo = qpos0 + wid * 32;
    const float bL = BIAS ? tbl[0] : 0.f, bR = BIAS ? tbl[256] : 0.f;
    f32x16 csp = f32x16{}; float bcur = bL;
    if constexpr (CI) {
#pragma unroll
        for (int r = 0; r < 16; ++r) csp[r] = bL; }
    struct { bf16x8 vs0, vs1, ks[NP]; } st_[SDEPTH];
#define SLOAD(i, k0) do { st_[i].vs0 = *reinterpret_cast<const bf16x8*>(P.v + (long)((k0) + sr) * STR::LDV + sc); st_[i].vs1 = *reinterpret_cast<const bf16x8*>(P.v + (long)((k0) + 32 + sr) * STR::LDV + sc); \
    _Pragma("unroll") for (int p_ = 0; p_ < NP; ++p_) st_[i].ks[p_] = *reinterpret_cast<const bf16x8*>(P.k[p_] + (long)((k0) + kr) * (p_ == 2 ? STR::LDK2 : STR::LDK) + kc * 8); } while (0)
#define SWRITE(b, i) do { *(LAS bf16x8*)(V_lds + (b) * SHM_V + vst0) = st_[i].vs0; *(LAS bf16x8*)(V_lds + (b) * SHM_V + vst1) = st_[i].vs1; \
    _Pragma("unroll") for (int p_ = 0; p_ < NP; ++p_) *(LAS bf16x8*)(K_lds + (b) * KB + p_ * SHM_KP + kst) = st_[i].ks[p_]; } while (0)
#define SWAIT() do { if constexpr (SDEPTH == 2) { if constexpr (NP == 1) asm volatile("s_waitcnt vmcnt(3)" ::: "memory"); else asm volatile("s_waitcnt vmcnt(5)" ::: "memory"); } else asm volatile("s_waitcnt vmcnt(0)" ::: "memory"); } while (0)
#define RESC(a) do { if (__any((a) < 1.f)) { if (hi == 0) al_l[r32] = (a); asm volatile("s_waitcnt lgkmcnt(0)" ::: "memory"); \
    _Pragma("unroll") for (int d = 0; d < 4; ++d) _Pragma("unroll") for (int r = 0; r < 16; ++r) o[d][r] *= al_l[crow(r, hi)]; } } while (0)
#define TILEB(j, nearv, bcv, rbv) const int _rh##j = (j) * 64 + 63 - qlo, _rl##j = (j) * 64 - (qlo + 31); \
    const bool nearv = BIAS && (_rh##j > -128) && (_rl##j < 128); const float bcv = (_rh##j <= -128) ? bL : bR; const int rbv = (j) * 64 - (qlo + r32) + 128
#define CLS(nearv, bcv) do { if constexpr (CI) { if (!(nearv) && (bcv) != bcur) { const float _dl = (bcv) - bcur; _Pragma("unroll") for (int r = 0; r < 16; ++r) csp[r] += _dl; bcur = (bcv); } } } while (0)
#define PSM(P0, P1, MN, AL, first, nearv, bcv, rbv) do { if constexpr (CI) { partialSM_ci(P0, P1, m_reg, AL, csp, first, nearv, bcur, rbv, hi, tbl); MN = 0.f; } \
        else partialSM<BIAS>(P0, P1, m_reg, MN, AL, Cs, nearv, bcv, rbv, hi, tbl); } while (0)
    f32x16 pA0, pA1, pB0, pB1; float mnA, mnB, alA, alB; bf16x8 pa0, pa1, pa2, pa3; const int NT = seq / 64;
    constexpr int SE = 0, SO = SDEPTH - 1;
    SLOAD(SE, 0); asm volatile("s_waitcnt vmcnt(0)" ::: "memory"); SWRITE(0, SE); __syncthreads();
    { const int jj = 0; TILEB(jj, nr, bc, rb); CLS(nr, bc); qkt<NP>(pA0, pA1, K_lds, qr, qrl, r32, hi, csp); PSM(pA0, pA1, mnA, alA, true, nr, bc, rb); }
    SLOAD(SO, 64); if constexpr (SDEPTH == 2) { if (2 < NT) SLOAD(SE, 128); }
    SWAIT(); SWRITE(1, SO); __syncthreads();
    for (int j = 1; j + 1 < NT; j += 2) {
        TILEB(j, nrB, bcB, rbB); CLS(nrB, bcB);
        SBAR(); qkt<NP>(pB0, pB1, K_lds + KB, qr, qrl, r32, hi, csp);
        finishSM(pA0, pA1, alA, l_reg, pa0, pa1, pa2, pa3); SBAR();
        SLOAD(SO, (j + SDEPTH) * 64); SBAR();
        pv_d0(o, vb0, pa0, pa1, pa2, pa3);
        PSM(pB0, pB1, mnB, alB, false, nrB, bcB, rbB);
        __syncthreads(); SWAIT(); SWRITE(0, SE);
        RESC(alB); __syncthreads();
        const int j1 = j + 1; TILEB(j1, nrA, bcA, rbA); CLS(nrA, bcA);
        SBAR(); qkt<NP>(pA0, pA1, K_lds, qr, qrl, r32, hi, csp);
        finishSM(pB0, pB1, alB, l_reg, pa0, pa1, pa2, pa3); SBAR();
        if (SDEPTH == 1 || j + 3 < NT) SLOAD(SE, (j + 1 + SDEPTH) * 64); SBAR();
        pv_d0(o, vb0 + SHM_V, pa0, pa1, pa2, pa3);
        PSM(pA0, pA1, mnA, alA, false, nrA, bcA, rbA);
        __syncthreads(); SWAIT(); SWRITE(1, SO);
        RESC(alA); __syncthreads();
    }
    const int jl = NT - 1; TILEB(jl, nrL, bcL, rbL); CLS(nrL, bcL);
    SBAR(); qkt<NP>(pB0, pB1, K_lds + KB, qr, qrl, r32, hi, csp);
    finishSM(pA0, pA1, alA, l_reg, pa0, pa1, pa2, pa3); SBAR();
    pv_d0(o, vb0, pa0, pa1, pa2, pa3);
    PSM(pB0, pB1, mnB, alB, false, nrL, bcL, rbL);
    __syncthreads(); RESC(alB);
    finishSM(pB0, pB1, alB, l_reg, pa0, pa1, pa2, pa3); SBAR();
    pv_d0(o, vb0 + SHM_V, pa0, pa1, pa2, pa3);
    if (hi == 0) li_l[r32] = l_reg; asm volatile("s_waitcnt lgkmcnt(0)" ::: "memory");
#pragma unroll
    for (int r = 0; r < 16; ++r) { const float rl = __builtin_amdgcn_rcpf(li_l[crow(r, hi)]);
#pragma unroll
        for (int d = 0; d < 4; ++d) o[d][r] *= rl; }
    __syncthreads();
#undef SLOAD
#undef SWRITE
#undef SWAIT
#undef RESC
#undef TILEB
#undef CLS
#undef PSM
}
}

constexpr int NWAVES = 8;
constexpr int CW_BAR = 4096;
constexpr int RING_BYTES = 131072, MISC_OFF = RING_BYTES + 320, LDS_BYTES = 147456;
static_assert(att::LDS_END <= RING_BYTES, "attention LDS");

#define XB_TMO      128
#define XB_XCNT(j)  (256  + 64 * (j))
#define XB_XSUB(j)  (1280 + 64 * (j))
#define XB_XGEN(j)  (2304 + 64 * (j))
#define XB_TOP      3328
#define XB_TOPGEN   3392
#define XCD_BAR_WORDS 3456
#define XB_SPIN_CAP (1u << 21)
__device__ __forceinline__ unsigned xb_ld(unsigned* p)              { return __hip_atomic_load(p, __ATOMIC_RELAXED, __HIP_MEMORY_SCOPE_AGENT); }
__device__ __forceinline__ unsigned xb_add(unsigned* p, unsigned v) { return __hip_atomic_fetch_add(p, v, __ATOMIC_RELAXED, __HIP_MEMORY_SCOPE_AGENT); }
__device__ __forceinline__ unsigned xb_xcc_id() { return (unsigned)__builtin_amdgcn_s_getreg((3 << 11) | 20) & 0xFu; }
#define XB_SPIN(cond, bar) do { unsigned _sp = 0; while (cond) { __builtin_amdgcn_s_sleep(1); \
    if ((++_sp & 255u) == 0u) { if (xb_ld(&(bar)[XB_TMO])) break; if (_sp > XB_SPIN_CAP) { atomicAdd(&(bar)[XB_TMO], 1u); break; } } } } while (0)
struct XcdBarrier { unsigned* bar; unsigned x; volatile LAS unsigned* st; };
__device__ __forceinline__ XcdBarrier xcd_barrier_post(unsigned* bar, volatile LAS unsigned* st, bool leader) {
    XcdBarrier b; b.bar = bar; b.x = xb_xcc_id(); b.st = st;
    if (leader) (void)xb_add(&bar[XB_XCNT(b.x)], 1u);
    return b;
}
__device__ __forceinline__ void xcd_barrier_complete(unsigned* bar, unsigned x, unsigned& nloc, unsigned& nx) {
    const unsigned G = gridDim.x * gridDim.y * gridDim.z;
    unsigned sum, cnt, mine, sp = 0u;
    for (;;) {
        sum = 0u; cnt = 0u; mine = 0u;
#pragma unroll
        for (unsigned j = 0; j < 16; ++j) { const unsigned c = xb_ld(&bar[XB_XCNT(j)]); sum += c; cnt += (c > 0u) ? 1u : 0u; mine = (j == x) ? c : mine; }
        if (sum == G) break;
        __builtin_amdgcn_s_sleep(1);
        if ((++sp & 255u) == 0u) { if (xb_ld(&bar[XB_TMO])) break; if (sp > XB_SPIN_CAP) { atomicAdd(&bar[XB_TMO], 1u); break; } }
    }
    nloc = mine > 0u ? mine : 1u; nx = cnt > 0u ? cnt : 1u;
}
__device__ __forceinline__ void xcd_barrier(const XcdBarrier& b, bool leader) {
    asm volatile("s_waitcnt vmcnt(0)" ::: "memory");
    __syncthreads();
    if (leader) {
        unsigned* bar = b.bar;
        __builtin_amdgcn_s_waitcnt(0);
        unsigned nloc = b.st[0], nx = b.st[1];
        if (nloc == 0u) { xcd_barrier_complete(bar, b.x, nloc, nx); b.st[0] = nloc; b.st[1] = nx; }
        const unsigned old = xb_add(&bar[XB_XSUB(b.x)], 1u);
        const unsigned gen = old / nloc;
        if (old + 1u == (gen + 1u) * nloc) {
            __builtin_amdgcn_fence(__ATOMIC_RELEASE, "agent");
            asm volatile("s_waitcnt vmcnt(0)" ::: "memory");
            const unsigned og = xb_add(&bar[XB_TOP], 1u);
            const unsigned tg = og / nx;
            if (og + 1u == (tg + 1u) * nx) xb_add(&bar[XB_TOPGEN], 1u);
            else XB_SPIN(xb_ld(&bar[XB_TOPGEN]) == tg, bar);
            __builtin_amdgcn_fence(__ATOMIC_ACQUIRE, "agent");
            xb_add(&bar[XB_XGEN(b.x)], 1u);
            asm volatile("s_waitcnt vmcnt(0)" ::: "memory");
        } else {
            XB_SPIN(xb_ld(&bar[XB_XGEN(b.x)]) == gen, bar);
            __builtin_amdgcn_fence(__ATOMIC_ACQUIRE, "agent");
            asm volatile("s_waitcnt vmcnt(0)" ::: "memory");
        }
    }
    __syncthreads();
}

#define LDS_WAIT() asm volatile("s_waitcnt lgkmcnt(0)" ::: "memory")
template <int X> __device__ __forceinline__ float swz_xor(float v) { return __int_as_float(__builtin_amdgcn_ds_swizzle(__float_as_int(v), (X << 10) | 0x1f)); }
__device__ __forceinline__ float half_sum(float v) { v += swz_xor<1>(v); v += swz_xor<2>(v); v += swz_xor<4>(v); v += swz_xor<8>(v); v += swz_xor<16>(v); return v; }
__device__ __forceinline__ float wave_max(float v) {
    v = __builtin_fmaxf(v, swz_xor<1>(v)); v = __builtin_fmaxf(v, swz_xor<2>(v)); v = __builtin_fmaxf(v, swz_xor<4>(v)); v = __builtin_fmaxf(v, swz_xor<8>(v)); v = __builtin_fmaxf(v, swz_xor<16>(v));
    auto rr = __builtin_amdgcn_permlane32_swap(__float_as_uint(v), __float_as_uint(v), false, false);
    return __builtin_fmaxf(__uint_as_float(rr[0]), __uint_as_float(rr[1]));
}
__device__ __forceinline__ float wave_sum(float v) {
    v = half_sum(v);
    auto rr = __builtin_amdgcn_permlane32_swap(__float_as_uint(v), __float_as_uint(v), false, false);
    return __uint_as_float(rr[0]) + __uint_as_float(rr[1]);
}

constexpr int NWAVES_ = 8;
template <int MODE, class SrcFn>
__device__ __forceinline__ void convert_strip(const float* W, int K, int N, unsigned char* WT, float* cs, int n0, float fscale, LAS float* lmax, int wave, int lane, SrcFn src) {
    const int rg = lane >> 3, cq = lane & 7, nchunk = K >> 7;
    int sc[4];
#pragma unroll
    for (int j = 0; j < 4; ++j) sc[j] = src(n0 + 4 * cq + j);
    const bool contig = __all(sc[0] >= 0 && (sc[0] & 3) == 0 && sc[1] == sc[0] + 1 && sc[2] == sc[0] + 2 && sc[3] == sc[0] + 3);
    auto ldrow = [&](int row) -> f32x4 {
        if (contig) return *(const f32x4*)(W + (size_t)row * N + sc[0]);
        f32x4 v;
#pragma unroll
        for (int j = 0; j < 4; ++j) v[j] = sc[j] >= 0 ? W[(size_t)row * N + sc[j]] : 0.f;
        return v; };
    f32x4 inv = (f32x4){fscale, fscale, fscale, fscale};
    if constexpr (MODE == 2) {
        f32x4 mx = (f32x4){0.f, 0.f, 0.f, 0.f};
        for (int c = wave; c < nchunk; c += NWAVES_) { f32x4 v[16];
#pragma unroll
            for (int i = 0; i < 16; ++i) v[i] = ldrow(c * 128 + 16 * rg + i);
#pragma unroll
            for (int i = 0; i < 16; ++i)
#pragma unroll
                for (int j = 0; j < 4; ++j) mx[j] = __builtin_fmaxf(mx[j], __builtin_fabsf(v[i][j])); }
#pragma unroll
        for (int j = 0; j < 4; ++j) { float m = mx[j]; m = __builtin_fmaxf(m, swz_xor<8>(m)); m = __builtin_fmaxf(m, swz_xor<16>(m));
            auto rr = __builtin_amdgcn_permlane32_swap(__float_as_uint(m), __float_as_uint(m), false, false); mx[j] = __builtin_fmaxf(__uint_as_float(rr[0]), __uint_as_float(rr[1])); }
        __syncthreads();
        if (lane < 8) *(LAS f32x4*)(lmax + wave * 32 + 4 * lane) = mx;
        __syncthreads();
        f32x4 cm = *(const LAS f32x4*)(lmax + 4 * cq);
#pragma unroll
        for (int w = 1; w < NWAVES_; ++w) { const f32x4 o = *(const LAS f32x4*)(lmax + w * 32 + 4 * cq);
#pragma unroll
            for (int j = 0; j < 4; ++j) cm[j] = __builtin_fmaxf(cm[j], o[j]); }
#pragma unroll
        for (int j = 0; j < 4; ++j) inv[j] = cm[j] > 0.f ? 127.f / cm[j] : 0.f;
        if (wave == 0 && lane < 8) *(f32x4*)(cs + n0 + 4 * lane) = cm * (1.f / 127.f);
    }
    constexpr int EB = (MODE == 0) ? 2 : 1; const size_t rowb = (size_t)K * EB;
    for (int c = wave; c < nchunk; c += NWAVES_) { f32x4 v[16];
#pragma unroll
        for (int i = 0; i < 16; ++i) v[i] = ldrow(c * 128 + 16 * rg + i) * inv;
#pragma unroll
        for (int j = 0; j < 4; ++j) { unsigned char* dst = WT + (size_t)(n0 + 4 * cq + j) * rowb + (size_t)(c * 128 + 16 * rg) * EB;
            if constexpr (MODE == 2) { u32x4 o; o.x = pack4_i8(v[0][j], v[1][j], v[2][j], v[3][j]); o.y = pack4_i8(v[4][j], v[5][j], v[6][j], v[7][j]); o.z = pack4_i8(v[8][j], v[9][j], v[10][j], v[11][j]); o.w = pack4_i8(v[12][j], v[13][j], v[14][j], v[15][j]); *(u32x4*)dst = o; }
            else if constexpr (MODE == 1) { u32x4 o; o.x = pack4_fp8(v[0][j], v[1][j], v[2][j], v[3][j]); o.y = pack4_fp8(v[4][j], v[5][j], v[6][j], v[7][j]); o.z = pack4_fp8(v[8][j], v[9][j], v[10][j], v[11][j]); o.w = pack4_fp8(v[12][j], v[13][j], v[14][j], v[15][j]); *(u32x4*)dst = o; }
            else { u32x4 o; o.x = cvt_pk_bf16(v[0][j], v[1][j]); o.y = cvt_pk_bf16(v[2][j], v[3][j]); o.z = cvt_pk_bf16(v[4][j], v[5][j]); o.w = cvt_pk_bf16(v[6][j], v[7][j]); *(u32x4*)dst = o;
                   o.x = cvt_pk_bf16(v[8][j], v[9][j]); o.y = cvt_pk_bf16(v[10][j], v[11][j]); o.z = cvt_pk_bf16(v[12][j], v[13][j]); o.w = cvt_pk_bf16(v[14][j], v[15][j]); *(u32x4*)(dst + 16) = o; } }
    }
}
__device__ __forceinline__ int t5_bucket(int rel) {
    const int ret = rel > 0 ? 16 : 0; const int n = rel < 0 ? -rel : rel;
    if (n < 8) return ret + n;
    int large = 2 + (31 - __builtin_clz((unsigned)(n * n)));
    large = large < 15 ? large : 15;
    return ret + large;
}
__device__ __forceinline__ void sincos_f32arg(float ang, float& c, float& s) {
    const double a = (double)ang; const double kq = __builtin_rint(a * 0.63661977236758134);
    double r = __builtin_fma(-kq, 1.5707963267948966, a); r = __builtin_fma(-kq, 6.123233995736766e-17, r);
    const int q = ((int)kq) & 3; const double r2 = r * r;
    const double sp = r * (1.0 + r2 * (-1.0 / 6 + r2 * (1.0 / 120 + r2 * (-1.0 / 5040 + r2 * (1.0 / 362880 + r2 * (-1.0 / 39916800))))));
    const double cp = 1.0 + r2 * (-0.5 + r2 * (1.0 / 24 + r2 * (-1.0 / 720 + r2 * (1.0 / 40320 + r2 * (-1.0 / 3628800 + r2 * (1.0 / 479001600))))));
    const double sv = (q == 0) ? sp : (q == 1) ? cp : (q == 2) ? -sp : -cp;
    const double cv = (q == 0) ? cp : (q == 1) ? -sp : (q == 2) ? -cp : sp;
    c = (float)cv; s = (float)sv;
}

struct Args { const float* in[23]; float* out; unsigned char* ws; float invf[32]; int lo, hi; };
typedef const __attribute__((address_space(4))) Args* ArgsP;

enum { I_XP = 0, I_XS, I_RELB, I_FNG, I_RAG, I_WIN, I_LQ1, I_LK1, I_LQ2, I_LK2, I_SUBG, I_QNG, I_WQUP, I_KVNG, I_WKVUP, I_WA, I_WB, I_WO, I_RFG, I_WUP, I_CW, I_CB, I_WD };

#define P_WINT ((bf16*)(ws + WS_WIN))
#define P_WQT ((bf16*)(ws + WS_WQ))
#define P_WKVT ((bf16*)(ws + WS_WKV))
#define P_WAT ((bf16*)(ws + WS_WA))
#define P_WBT ((bf16*)(ws + WS_WB))
#define P_WOT ((bf16*)(ws + WS_WO))
#define P_WUPT ((bf16*)(ws + WS_WUP))
#define P_WDT ((bf16*)(ws + WS_WD))
#define P_COS ((float*)(ws + WS_COS))
#define P_SIN ((float*)(ws + WS_SIN))
#define P_BIAS2 ((float*)(ws + WS_BIAS))
#define P_LAM ((float*)(ws + WS_LAM))
#define P_CSIN ((float*)(ws + WS_CSIN))
#define P_CSUP ((float*)(ws + WS_CSUP))
#define P_RSH ((float*)(ws + WS_RSH))
#define P_QL8 ((unsigned char*)(ws + WS_QL8))
#define P_KVL8 ((unsigned char*)(ws + WS_KVL8))
#define P_AO8 ((unsigned char*)(ws + WS_AO8))
#define P_BO8 ((unsigned char*)(ws + WS_BO8))
#define P_MG8 ((unsigned char*)(ws + WS_MG8))
#define P_X1 ((bf16*)(ws + WS_X1))
#define P_H ((bf16*)(ws + WS_H))
#define P_HF ((unsigned char*)(ws + WS_HF))
#define P_RSHF ((float*)(ws + WS_RSHF))
#define P_P ((bf16*)(ws + WS_P))
#define P_Q ((bf16*)(ws + WS_Q))
#define P_KV ((bf16*)(ws + WS_KV))
#define P_AO ((bf16*)(ws + WS_AO))
#define P_BO ((bf16*)(ws + WS_BO))
#define P_MG ((bf16*)(ws + WS_MG))
#define P_STASH ((float*)(ws + WS_STASH))
#define P_Y ((bf16*)(ws + WS_Y))
#define P_ACT ((bf16*)(ws + WS_ACTV))
#define XG() ((g < 2) ? A->in[I_XP] + (size_t)g * TG * DM : A->in[I_XS] + (size_t)(g - 2) * TG * DM)
#define OG() (A->out + (size_t)g * TG * DM)
constexpr int NSTEP_PER_GROUP = I8_MID ? 9 : 7, NSTEPS = NGRP * NSTEP_PER_GROUP + 5;

__global__ void __launch_bounds__(NWAVES * 64, 2) enc_fwd(Args args) {
    extern __shared__ __attribute__((aligned(16))) unsigned char lds[];
    LAS unsigned char* ldsL = (LAS unsigned char*)lds;
    volatile LAS unsigned* MISC = (volatile LAS unsigned*)(ldsL + MISC_OFF);
    const int wave = __builtin_amdgcn_readfirstlane((int)threadIdx.x >> 6);
    const int G = gridDim.x; const int bx = blockIdx.x; const int vcu0 = (G % 8 == 0) ? (bx % 8) * (G / 8) + bx / 8 : bx;
    unsigned char* ws = args.ws;
    unsigned* ctl = (unsigned*)(ws + WS_CTL);
    { const int tid0 = wave * 64 + lane_id_fresh(); for (int u = tid0; u < (LDS_BYTES - RING_BYTES) / 4; u += NWAVES * 64) ((LAS unsigned*)(ldsL + RING_BYTES))[u] = 0u; }
    __syncthreads();
    XcdBarrier bar; bar.bar = ctl + CW_BAR; bar.x = 0; bar.st = nullptr;
#if !MK_PER_STEP_LAUNCH
    bar = xcd_barrier_post(ctl + CW_BAR, MISC + 8, (wave * 64 + lane_id_fresh()) == 0);
#endif
    const int lo = args.lo, hi = args.hi;
    int step = 0;
#ifndef EN_MASK
#define EN_MASK 0xFFFFFF
#endif
#define EN(k) (((EN_MASK) >> (k)) & 1)
#define RUN() (step >= lo && step < hi)
#define LOCAL_TID() ArgsP A = (ArgsP)__builtin_amdgcn_kernarg_segment_ptr(); asm volatile("" : "+s"(A)); unsigned char* const ws = A->ws; (void)ws; int lane_ = lane_id_fresh(); asm volatile("" : "+v"(lane_)); const int lane = lane_; const int tid = wave * 64 + lane; (void)tid; int gw = gw0, vcu = vcu0; asm volatile("" : "+s"(gw), "+s"(vcu)); (void)gw; (void)vcu
#if MK_PER_STEP_LAUNCH
#define SEAM() do { ++step; } while (0)
#else
#define SEAM() do { if (RUN() && step + 1 < hi) xcd_barrier(bar, (wave * 64 + lane_id_fresh()) == 0); ++step; } while (0)
#endif
    const int gw0 = vcu0 * NWAVES + wave, NGW = G * NWAVES;

    if (RUN() && EN(0)) { LOCAL_TID();
        LAS float* lmax = (LAS float*)ldsL;
        auto ident = [](int n) -> int { return n; };
        auto srcIn = [](int n) -> int { if (n < C_GATE) return n; if (n < C_KPE) return n + 64; if (n < C_KPE + 64) { const int j = n - C_KPE; return 7680 + ((j & 1) ? 32 + (j >> 1) : (j >> 1)); } return -1; };
        auto srcQ = [](int n) -> int { if (n < 2048) return (n >> 7) * 192 + (n & 127); const int j = n - 2048, hh = j >> 6, jj = j & 63; return hh * 192 + 128 + ((jj & 1) ? 32 + (jj >> 1) : (jj >> 1)); };
        auto srcUp = [](int n) -> int { return CONV_FUSE ? ((n & 128) ? DFF : 0) + (n >> 8) * 128 + (n & 127) : n; };
        constexpr int T0 = DM / 32, T1 = T0 + NIN / 32, T2 = T1 + NUP / 32, T3 = T2 + DM / 32, T4 = T3 + DM / 32, T5 = T4 + DM / 32, T6 = T5 + NQ / 32, T7 = T6 + NKV / 32;
        for (int s = vcu; s < T7; s += G) {
            if (s < T0) { const int n0 = 32 * s;
                if (FP8_DOWN) convert_strip<1>(A->in[I_WD], DFF, DM, (unsigned char*)P_WDT, nullptr, n0, S_WD, lmax, wave, lane, ident); else convert_strip<0>(A->in[I_WD], DFF, DM, (unsigned char*)P_WDT, nullptr, n0, 1.f, lmax, wave, lane, ident); }
            else if (s < T1) { const int n0 = 32 * (s - T0);
                if (I8_IN) convert_strip<2>(A->in[I_WIN], DM, 15936, (unsigned char*)P_WINT, P_CSIN, n0, 1.f, lmax, wave, lane, srcIn); else convert_strip<0>(A->in[I_WIN], DM, 15936, (unsigned char*)P_WINT, nullptr, n0, 1.f, lmax, wave, lane, srcIn); }
            else if (s < T2) { const int n0 = 32 * (s - T1);
                if (I8_UP) convert_strip<2>(A->in[I_WUP], DM, NUP, (unsigned char*)P_WUPT, P_CSUP, n0, 1.f, lmax, wave, lane, srcUp); else convert_strip<0>(A->in[I_WUP], DM, NUP, (unsigned char*)P_WUPT, nullptr, n0, 1.f, lmax, wave, lane, srcUp); }
            else if (s < T3) { const int n0 = 32 * (s - T2);
                if (I8_MID) convert_strip<2>(A->in[I_WO], DM, DM, (unsigned char*)P_WOT, (float*)(ws + WS_CSO), n0, 1.f, lmax, wave, lane, ident); else convert_strip<0>(A->in[I_WO], DM, DM, (unsigned char*)P_WOT, nullptr, n0, 1.f, lmax, wave, lane, ident); }
            else if (s < T4) { const int n0 = 32 * (s - T3);
                if (I8_MID) convert_strip<2>(A->in[I_WA], 2048, DM, (unsigned char*)P_WAT, (float*)(ws + WS_CSA), n0, 1.f, lmax, wave, lane, ident); else convert_strip<0>(A->in[I_WA], 2048, DM, (unsigned char*)P_WAT, nullptr, n0, 1.f, lmax, wave, lane, ident); }
            else if (s < T5) { const int n0 = 32 * (s - T4);
                if (I8_MID) convert_strip<2>(A->in[I_WB], 2048, DM, (unsigned char*)P_WBT, (float*)(ws + WS_CSB), n0, 1.f, lmax, wave, lane, ident); else convert_strip<0>(A->in[I_WB], 2048, DM, (unsigned char*)P_WBT, nullptr, n0, 1.f, lmax, wave, lane, ident); }
            else if (s < T6) { const int n0 = 32 * (s - T5);
                if (I8_MID) convert_strip<2>(A->in[I_WQUP], 1024, NQ, (unsigned char*)P_WQT, (float*)(ws + WS_CSQ), n0, 1.f, lmax, wave, lane, srcQ); else convert_strip<0>(A->in[I_WQUP], 1024, NQ, (unsigned char*)P_WQT, nullptr, n0, 1.f, lmax, wave, lane, srcQ); }
            else { const int n0 = 32 * (s - T6);
                if (I8_MID) convert_strip<2>(A->in[I_WKVUP], 512, NKV, (unsigned char*)P_WKVT, (float*)(ws + WS_CSKV), n0, 1.f, lmax, wave, lane, ident); else convert_strip<0>(A->in[I_WKVUP], 512, NKV, (unsigned char*)P_WKVT, nullptr, n0, 1.f, lmax, wave, lane, ident); }
        }
        for (int i = bx * (NWAVES * 64) + tid; i < 8192 * 32; i += G * NWAVES * 64) { const int pos = i >> 5, k = i & 31; float c, s; sincos_f32arg((float)pos * A->invf[k], c, s); P_COS[i] = c; P_SIN[i] = s; }
        if (bx == 0) {
            for (int i = tid; i < 16 * 257; i += NWAVES * 64) { const int h = i / 257, j = i % 257; P_BIAS2[h * 260 + j] = A->in[I_RELB][t5_bucket(j - 128) * 16 + h] * 1.4426950408889634f; }
            if (wave == 0) { const float a = wave_sum(A->in[I_LQ1][lane] * A->in[I_LK1][lane]), b = wave_sum(A->in[I_LQ2][lane] * A->in[I_LK2][lane]);
                if (lane == 0) P_LAM[0] = expf(a) - expf(b) + 0.2f; }
        }
    }

    for (int g = 0; g < NGRP; ++g) {
        const int seqlen = (g < 2) ? 4096 : 8192, posmask = seqlen - 1;

        if (RUN() && EN(1)) { LOCAL_TID();
            const float* gv = A->in[I_RAG];
            for (int m = gw; m < TG; m += NGW) {
                const f32x4* xr = (const f32x4*)(XG() + (size_t)m * DM) + lane; f32x4 v[16]; float s = 0.f;
#pragma unroll
                for (int j = 0; j < 16; ++j) { v[j] = xr[64 * j]; s += (v[j].x * v[j].x + v[j].y * v[j].y) + (v[j].z * v[j].z + v[j].w * v[j].w); }
                const float rstd = 1.0f / sqrtf(wave_sum(s) * (1.f / DM) + EPS);
                if (I8_IN) { float mx = 0.f;
#pragma unroll
                    for (int j = 0; j < 16; ++j) { const f32x4 gg = ((const f32x4*)gv)[64 * j + lane]; v[j] = v[j] * rstd * gg; mx = __builtin_fmaxf(__builtin_fmaxf(mx, __builtin_fmaxf(__builtin_fabsf(v[j].x), __builtin_fabsf(v[j].y))), __builtin_fmaxf(__builtin_fabsf(v[j].z), __builtin_fabsf(v[j].w))); }
                    mx = wave_max(mx); const float inv = mx > 0.f ? 127.f / mx : 0.f; if (lane == 0) P_RSH[m] = mx * (1.f / 127.f);
                    unsigned* o4 = (unsigned*)((unsigned char*)P_H + (size_t)m * DM) + lane;
#pragma unroll
                    for (int j = 0; j < 16; ++j) o4[64 * j] = pack4_i8(v[j].x * inv, v[j].y * inv, v[j].z * inv, v[j].w * inv);
                } else {
                u32x2* o8 = (u32x2*)(P_H + (size_t)m * DM) + lane;
#pragma unroll
                for (int j = 0; j < 16; ++j) { const f32x4 gg = ((const f32x4*)gv)[64 * j + lane]; u32x2 w; w.x = cvt_pk_bf16(v[j].x * rstd * gg.x, v[j].y * rstd * gg.y); w.y = cvt_pk_bf16(v[j].z * rstd * gg.z, v[j].w * rstd * gg.w); o8[64 * j] = w; }
                }
            }
        }
        SEAM();

        if (RUN() && EN(2)) { LOCAL_TID();
            pg8::Gemm gm{P_H, I8_IN ? DM / 2 : DM, P_WINT, TG, NIN, I8_IN ? DM / 2 : DM}; pg8::StaticOrder S; S.init(TG, NIN, G, bx);
            pg8::EpiStoreT<I8_IN != 0, WS_RSH, WS_CSIN> E{P_P, NIN, C_GATE / 256, C_KPE / 256, ATT_CINIT ? CS_DIFF : 1.f, ws};
            REP_LOOP_GEMM { int l2_ = lane_id_fresh(); asm volatile("" : "+v"(l2_)); pg8::gemm_phase<pg8::EpiStoreT<I8_IN != 0, WS_RSH, WS_CSIN>, I8_IN ? 2 : 0>(ldsL, gm, S, E, wave * 64 + l2_); }
        }
        SEAM();

        if (RUN() && EN(3)) { LOCAL_TID();
            const float* gq = A->in[I_QNG]; const float* gkv = A->in[I_KVNG];
            for (int m = gw; m < TG; m += NGW) {
                bf16* prow = P_P + (size_t)m * NIN;
                { u32x4 a = *(const u32x4*)(prow + C_QLAT + lane * 8), b = *(const u32x4*)(prow + C_QLAT + 512 + lane * 8);
                  float x[16] = {bf_lo(a.x), bf_hi(a.x), bf_lo(a.y), bf_hi(a.y), bf_lo(a.z), bf_hi(a.z), bf_lo(a.w), bf_hi(a.w), bf_lo(b.x), bf_hi(b.x), bf_lo(b.y), bf_hi(b.y), bf_lo(b.z), bf_hi(b.z), bf_lo(b.w), bf_hi(b.w)};
                  float s = 0.f;
#pragma unroll
                  for (int j = 0; j < 16; ++j) s += x[j] * x[j];
                  const float rstd = 1.0f / sqrtf(wave_sum(s) * (1.f / 1024) + EPS);
                  const f32x4 g0 = *(const f32x4*)(gq + lane * 8), g1 = *(const f32x4*)(gq + lane * 8 + 4), g2 = *(const f32x4*)(gq + 512 + lane * 8), g3 = *(const f32x4*)(gq + 512 + lane * 8 + 4);
                  u32x4 oa, ob;
                  oa.x = cvt_pk_bf16(x[0] * rstd * g0.x, x[1] * rstd * g0.y); oa.y = cvt_pk_bf16(x[2] * rstd * g0.z, x[3] * rstd * g0.w); oa.z = cvt_pk_bf16(x[4] * rstd * g1.x, x[5] * rstd * g1.y); oa.w = cvt_pk_bf16(x[6] * rstd * g1.z, x[7] * rstd * g1.w);
                  ob.x = cvt_pk_bf16(x[8] * rstd * g2.x, x[9] * rstd * g2.y); ob.y = cvt_pk_bf16(x[10] * rstd * g2.z, x[11] * rstd * g2.w); ob.z = cvt_pk_bf16(x[12] * rstd * g3.x, x[13] * rstd * g3.y); ob.w = cvt_pk_bf16(x[14] * rstd * g3.z, x[15] * rstd * g3.w);
                  if (I8_MID) { float y[16]; float mx = 0.f; const float gg[16] = {g0.x, g0.y, g0.z, g0.w, g1.x, g1.y, g1.z, g1.w, g2.x, g2.y, g2.z, g2.w, g3.x, g3.y, g3.z, g3.w};
#pragma unroll
                      for (int j = 0; j < 16; ++j) { y[j] = x[j] * rstd * gg[j]; mx = __builtin_fmaxf(mx, __builtin_fabsf(y[j])); }
                      mx = wave_max(mx); const float inv = mx > 0.f ? 127.f / mx : 0.f; if (lane == 0) ((float*)(ws + WS_RSQL))[m] = mx * (1.f / 127.f);
                      u32x2 q0, q1; q0.x = pack4_i8(y[0] * inv, y[1] * inv, y[2] * inv, y[3] * inv); q0.y = pack4_i8(y[4] * inv, y[5] * inv, y[6] * inv, y[7] * inv);
                      q1.x = pack4_i8(y[8] * inv, y[9] * inv, y[10] * inv, y[11] * inv); q1.y = pack4_i8(y[12] * inv, y[13] * inv, y[14] * inv, y[15] * inv);
                      *(u32x2*)(P_QL8 + (size_t)m * 1024 + lane * 8) = q0; *(u32x2*)(P_QL8 + (size_t)m * 1024 + 512 + lane * 8) = q1;
                  } else { *(u32x4*)(prow + C_QLAT + lane * 8) = oa; *(u32x4*)(prow + C_QLAT + 512 + lane * 8) = ob; } }
                { u32x4 a = *(const u32x4*)(prow + C_KVLAT + lane * 8);
                  float x[8] = {bf_lo(a.x), bf_hi(a.x), bf_lo(a.y), bf_hi(a.y), bf_lo(a.z), bf_hi(a.z), bf_lo(a.w), bf_hi(a.w)};
                  float s = 0.f;
#pragma unroll
                  for (int j = 0; j < 8; ++j) s += x[j] * x[j];
                  const float rstd = 1.0f / sqrtf(wave_sum(s) * (1.f / 512) + EPS);
                  const f32x4 g0 = *(const f32x4*)(gkv + lane * 8), g1 = *(const f32x4*)(gkv + lane * 8 + 4);
                  u32x4 oa;
                  oa.x = cvt_pk_bf16(x[0] * rstd * g0.x, x[1] * rstd * g0.y); oa.y = cvt_pk_bf16(x[2] * rstd * g0.z, x[3] * rstd * g0.w); oa.z = cvt_pk_bf16(x[4] * rstd * g1.x, x[5] * rstd * g1.y); oa.w = cvt_pk_bf16(x[6] * rstd * g1.z, x[7] * rstd * g1.w);
                  if (I8_MID) { float y[8]; float mx = 0.f; const float gg[8] = {g0.x, g0.y, g0.z, g0.w, g1.x, g1.y, g1.z, g1.w};
#pragma unroll
                      for (int j = 0; j < 8; ++j) { y[j] = x[j] * rstd * gg[j]; mx = __builtin_fmaxf(mx, __builtin_fabsf(y[j])); }
                      mx = wave_max(mx); const float inv = mx > 0.f ? 127.f / mx : 0.f; if (lane == 0) ((float*)(ws + WS_RSKVL))[m] = mx * (1.f / 127.f);
                      u32x2 q0; q0.x = pack4_i8(y[0] * inv, y[1] * inv, y[2] * inv, y[3] * inv); q0.y = pack4_i8(y[4] * inv, y[5] * inv, y[6] * inv, y[7] * inv);
                      *(u32x2*)(P_KVL8 + (size_t)m * 512 + lane * 8) = q0;
                  } else *(u32x4*)(prow + C_KVLAT + lane * 8) = oa; }
                if (lane < 32) { const int pos = m & posmask; unsigned w = *(const unsigned*)(prow + C_KPE + 2 * lane); const float x1 = bf_lo(w), x2 = bf_hi(w);
                  const float c = P_COS[pos * 32 + lane], s = P_SIN[pos * 32 + lane];
                  *(unsigned*)(prow + C_KPE + 2 * lane) = cvt_pk_bf16(x1 * c - x2 * s, x1 * s + x2 * c); }
            }
        }
        SEAM();

        if (RUN() && EN(4)) { LOCAL_TID();
            if (EN(18)) { pg8::Gemm gm{I8_MID ? (const bf16*)P_QL8 : P_P + C_QLAT, I8_MID ? 512 : NIN, P_WQT, TG, NQ, I8_MID ? 512 : 1024}; pg8::StaticOrder S; S.init(TG, NQ, G, bx);
              pg8::EpiQT<I8_MID != 0> E{P_Q, NQ, ws, posmask}; REP_LOOP_GEMM { int l2_ = lane_id_fresh(); asm volatile("" : "+v"(l2_)); pg8::gemm_phase<pg8::EpiQT<I8_MID != 0>, I8_MID ? 2 : 0>(ldsL, gm, S, E, wave * 64 + l2_); } }
            if (EN(19)) { pg8::Gemm gm{I8_MID ? (const bf16*)P_KVL8 : P_P + C_KVLAT, I8_MID ? 256 : NIN, P_WKVT, TG, NKV, I8_MID ? 256 : 512}; pg8::StaticOrder S; S.init(TG, NKV, G, bx);
              pg8::EpiStoreT<I8_MID != 0, WS_RSKVL, WS_CSKV> E{P_KV, NKV, 0, 0, 1.f, ws}; REP_LOOP_GEMM { int l2_ = lane_id_fresh(); asm volatile("" : "+v"(l2_)); pg8::gemm_phase<pg8::EpiStoreT<I8_MID != 0, WS_RSKVL, WS_CSKV>, I8_MID ? 2 : 0>(ldsL, gm, S, E, wave * 64 + l2_); } }
        }
        SEAM();

        if (RUN() && EN(5)) { LOCAL_TID();
            const int wid = wave;
            const float lam = P_LAM[0];
            if (EN(16)) _Pragma("unroll 1") for (int rep = 0; rep < REP_DIFF; ++rep) for (int u = vcu; u < 512; u += G) {
                const int head = u >> 5, rb = u & 31, row0 = rb * 256, kbase = (seqlen == 4096) ? (rb >> 4) * 4096 : 0, qpos0 = row0 - kbase;
                __syncthreads();
                if (tid < 257) ((float*)(lds + att::OFF_TBL))[tid] = P_BIAS2[head * 260 + tid];
                __syncthreads();
#pragma unroll 1
                for (int c = 0; c < 2; ++c) {
                    att::Ptrs P;
                    P.q[0] = P_P + (size_t)row0 * NIN + C_DQ + head * 128 + c * 64; P.q[1] = P.q[0]; P.q[2] = P.q[0];
                    P.k[0] = P_P + (size_t)kbase * NIN + C_DK + head * 128 + c * 64; P.k[1] = P.k[0]; P.k[2] = P.k[0];
                    P.v = P_P + (size_t)kbase * NIN + C_DV + head * 128;
                    f32x16 o[4];
                    att::attn_body<1, true, 2, att::StrDiff>(P, seqlen, qpos0, 0.125f * 1.4426950408889634f, (LAS char*)ldsL, o, tid);
                    int tid_e = tid; asm volatile("" : "+v"(tid_e));
                    const int r32 = tid_e & 31, hh = (tid_e >> 5) & 1;
                    f32x4* myst = (f32x4*)(P_STASH + ((size_t)bx * 512 + tid_e) * 64);
                    if (c == 0) {
#pragma unroll
                        for (int d = 0; d < 4; ++d)
#pragma unroll
                            for (int r4 = 0; r4 < 4; ++r4) myst[d * 4 + r4] = (f32x4){o[d][4 * r4], o[d][4 * r4 + 1], o[d][4 * r4 + 2], o[d][4 * r4 + 3]};
                    } else {
                        float ss[16];
#pragma unroll
                        for (int r = 0; r < 16; ++r) ss[r] = 0.f;
#pragma unroll
                        for (int d = 0; d < 4; ++d)
#pragma unroll
                            for (int r4 = 0; r4 < 4; ++r4) { const f32x4 s0 = myst[d * 4 + r4];
#pragma unroll
                                for (int j = 0; j < 4; ++j) { const float a = s0[j] - lam * o[d][4 * r4 + j]; o[d][4 * r4 + j] = a; ss[4 * r4 + j] += a * a; } }
#pragma unroll
                        for (int r = 0; r < 16; ++r) ss[r] = 0.8f / sqrtf(half_sum(ss[r]) * (1.f / 128) + EPS);
                        const float* sg = A->in[I_SUBG];
                        float gsub[4];
#pragma unroll
                        for (int d = 0; d < 4; ++d) gsub[d] = sg[d * 32 + r32];
#pragma unroll
                        for (int r = 0; r < 16; ++r) { bf16* orow = P_AO + (size_t)(row0 + wid * 32 + att::crow(r, hh)) * 2048 + head * 128 + r32;
#pragma unroll
                            for (int d = 0; d < 4; ++d) orow[d * 32] = (bf16)(cvt_pk_bf16(o[d][r] * ss[r] * gsub[d], 0.f) & 0xffffu); }
                    }
                }
            }
            if (EN(17)) _Pragma("unroll 1") for (int rep = 0; rep < REP_MLA; ++rep) for (int u = vcu; u < 512; u += G) {
                const int head = u >> 5, rb = u & 31, row0 = rb * 256, kbase = (seqlen == 4096) ? (rb >> 4) * 4096 : 0;
                att::Ptrs P;
                P.q[0] = P_Q + (size_t)row0 * NQ + head * 128; P.q[1] = P.q[0] + 64; P.q[2] = P_Q + (size_t)row0 * NQ + 2048 + head * 64;
                P.k[0] = P_KV + (size_t)kbase * NKV + head * 256; P.k[1] = P.k[0] + 64; P.k[2] = P_P + (size_t)kbase * NIN + C_KPE;
                P.v = P_KV + (size_t)kbase * NKV + head * 256 + 128;
                f32x16 o[4];
                att::attn_body<3, false, 1, att::StrMla>(P, seqlen, 0, 0.07216878364870323f * 1.4426950408889634f, (LAS char*)ldsL, o, tid);
                int tid_e = tid; asm volatile("" : "+v"(tid_e));
                const int r32 = tid_e & 31, hh = (tid_e >> 5) & 1;
#pragma unroll
                for (int r = 0; r < 16; ++r) { bf16* orow = P_BO + (size_t)(row0 + wid * 32 + att::crow(r, hh)) * 2048 + head * 128 + r32;
#pragma unroll
                    for (int d = 0; d < 4; ++d) orow[d * 32] = (bf16)(cvt_pk_bf16(o[d][r], 0.f) & 0xffffu); }
            }
        }
        SEAM();

#if I8_MID
        if (RUN()) { LOCAL_TID();
            for (int m = gw; m < 2 * TG; m += NGW) { const int row = m >> 1; const bool isB = m & 1;
                const bf16* srow = (isB ? P_BO : P_AO) + (size_t)row * 2048 + lane * 8; u32x4 a[4]; float mx = 0.f;
#pragma unroll
                for (int j = 0; j < 4; ++j) { a[j] = *(const u32x4*)(srow + 512 * j);
                    mx = __builtin_fmaxf(mx, __builtin_fmaxf(__builtin_fmaxf(__builtin_fmaxf(__builtin_fabsf(bf_lo(a[j].x)), __builtin_fabsf(bf_hi(a[j].x))), __builtin_fmaxf(__builtin_fabsf(bf_lo(a[j].y)), __builtin_fabsf(bf_hi(a[j].y)))),
                                                      __builtin_fmaxf(__builtin_fmaxf(__builtin_fabsf(bf_lo(a[j].z)), __builtin_fabsf(bf_hi(a[j].z))), __builtin_fmaxf(__builtin_fabsf(bf_lo(a[j].w)), __builtin_fabsf(bf_hi(a[j].w)))))); }
                mx = wave_max(mx); const float inv = mx > 0.f ? 127.f / mx : 0.f; if (lane == 0) ((float*)(ws + (isB ? WS_RSB : WS_RSA)))[row] = mx * (1.f / 127.f);
                unsigned char* drow = (isB ? P_BO8 : P_AO8) + (size_t)row * 2048 + lane * 8;
#pragma unroll
                for (int j = 0; j < 4; ++j) { u32x2 q; q.x = pack4_i8(bf_lo(a[j].x) * inv, bf_hi(a[j].x) * inv, bf_lo(a[j].y) * inv, bf_hi(a[j].y) * inv); q.y = pack4_i8(bf_lo(a[j].z) * inv, bf_hi(a[j].z) * inv, bf_lo(a[j].w) * inv, bf_hi(a[j].w) * inv); *(u32x2*)(drow + 512 * j) = q; }
            }
        }
        SEAM();
#endif

        if (RUN() && EN(6)) { LOCAL_TID();
            if (EN(20)) { pg8::Gemm gm{I8_MID ? (const bf16*)P_AO8 : P_AO, I8_MID ? 1024 : 2048, P_WAT, TG, DM, I8_MID ? 1024 : 2048}; pg8::StaticOrder S; S.init(TG, DM, G, bx);
              pg8::EpiGateAT<I8_MID != 0> E{P_MG, DM, P_P + C_GATE, NIN, ws}; REP_LOOP_GEMM { int l2_ = lane_id_fresh(); asm volatile("" : "+v"(l2_)); pg8::gemm_phase<pg8::EpiGateAT<I8_MID != 0>, I8_MID ? 2 : 0>(ldsL, gm, S, E, wave * 64 + l2_); } }
            if (EN(21)) { pg8::Gemm gm{I8_MID ? (const bf16*)P_BO8 : P_BO, I8_MID ? 1024 : 2048, P_WBT, TG, DM, I8_MID ? 1024 : 2048}; pg8::StaticOrder S; S.init(TG, DM, G, bx);
              pg8::EpiGateBT<I8_MID != 0> E{P_MG, DM, P_P + C_GATE + DM, NIN, P_MG, DM, ws}; REP_LOOP_GEMM { int l2_ = lane_id_fresh(); asm volatile("" : "+v"(l2_)); pg8::gemm_phase<pg8::EpiGateBT<I8_MID != 0>, I8_MID ? 2 : 0>(ldsL, gm, S, E, wave * 64 + l2_); } }
        }
        SEAM();

#if I8_MID
        if (RUN()) { LOCAL_TID();
            for (int m = gw; m < TG; m += NGW) {
                const bf16* srow = P_MG + (size_t)m * DM + lane * 8; u32x4 a[8]; float mx = 0.f;
#pragma unroll
                for (int j = 0; j < 8; ++j) { a[j] = *(const u32x4*)(srow + 512 * j);
                    mx = __builtin_fmaxf(mx, __builtin_fmaxf(__builtin_fmaxf(__builtin_fmaxf(__builtin_fabsf(bf_lo(a[j].x)), __builtin_fabsf(bf_hi(a[j].x))), __builtin_fmaxf(__builtin_fabsf(bf_lo(a[j].y)), __builtin_fabsf(bf_hi(a[j].y)))),
                                                      __builtin_fmaxf(__builtin_fmaxf(__builtin_fabsf(bf_lo(a[j].z)), __builtin_fabsf(bf_hi(a[j].z))), __builtin_fmaxf(__builtin_fabsf(bf_lo(a[j].w)), __builtin_fabsf(bf_hi(a[j].w)))))); }
                mx = wave_max(mx); const float inv = mx > 0.f ? 127.f / mx : 0.f; if (lane == 0) ((float*)(ws + WS_RSM))[m] = mx * (1.f / 127.f);
                unsigned char* drow = P_MG8 + (size_t)m * DM + lane * 8;
#pragma unroll
                for (int j = 0; j < 8; ++j) { u32x2 q; q.x = pack4_i8(bf_lo(a[j].x) * inv, bf_hi(a[j].x) * inv, bf_lo(a[j].y) * inv, bf_hi(a[j].y) * inv); q.y = pack4_i8(bf_lo(a[j].z) * inv, bf_hi(a[j].z) * inv, bf_lo(a[j].w) * inv, bf_hi(a[j].w) * inv); *(u32x2*)(drow + 512 * j) = q; }
            }
        }
        SEAM();
#endif

        if (RUN() && EN(7)) { LOCAL_TID();
            pg8::Gemm gm{I8_MID ? (const bf16*)P_MG8 : P_MG, I8_MID ? DM / 2 : DM, P_WOT, TG, DM, I8_MID ? DM / 2 : DM}; pg8::StaticOrder S; S.init(TG, DM, G, bx);
            pg8::EpiResT<I8_MID != 0, false> E{XG(), P_X1 + (size_t)g * TG * DM, DM, 1.f, ws}; REP_LOOP_GEMM { int l2_ = lane_id_fresh(); asm volatile("" : "+v"(l2_)); pg8::gemm_phase<pg8::EpiResT<I8_MID != 0, false>, I8_MID ? 2 : 0>(ldsL, gm, S, E, wave * 64 + l2_); }
        }
        SEAM();

    }

    if (RUN() && EN(8)) { LOCAL_TID();
        const float* gv = A->in[I_RFG];
        for (int m = gw; m < NTOK; m += NGW) {
            const u32x2* xr = (const u32x2*)(P_X1 + (size_t)m * DM) + lane; f32x4 v[16]; float s = 0.f;
#pragma unroll
            for (int j = 0; j < 16; ++j) { const u32x2 w = xr[64 * j]; v[j] = (f32x4){bf_lo(w.x), bf_hi(w.x), bf_lo(w.y), bf_hi(w.y)}; s += (v[j].x * v[j].x + v[j].y * v[j].y) + (v[j].z * v[j].z + v[j].w * v[j].w); }
            const float rstd = 1.0f / sqrtf(wave_sum(s) * (1.f / DM) + EPS);
            if (I8_UP) { float mx = 0.f;
#pragma unroll
                for (int j = 0; j < 16; ++j) { const f32x4 gg = ((const f32x4*)gv)[64 * j + lane]; v[j] = v[j] * rstd * gg; mx = __builtin_fmaxf(__builtin_fmaxf(mx, __builtin_fmaxf(__builtin_fabsf(v[j].x), __builtin_fabsf(v[j].y))), __builtin_fmaxf(__builtin_fabsf(v[j].z), __builtin_fabsf(v[j].w))); }
                mx = wave_max(mx); const float inv = mx > 0.f ? 127.f / mx : 0.f; if (lane == 0) P_RSHF[m] = mx * (1.f / 127.f);
                unsigned* o4 = (unsigned*)(P_HF + (size_t)m * DM) + lane;
#pragma unroll
                for (int j = 0; j < 16; ++j) o4[64 * j] = pack4_i8(v[j].x * inv, v[j].y * inv, v[j].z * inv, v[j].w * inv);
            } else {
            u32x2* o8 = (u32x2*)(P_H + (size_t)m * DM) + lane;
#pragma unroll
            for (int j = 0; j < 16; ++j) { const f32x4 gg = ((const f32x4*)gv)[64 * j + lane]; u32x2 w; w.x = cvt_pk_bf16(v[j].x * rstd * gg.x, v[j].y * rstd * gg.y); w.y = cvt_pk_bf16(v[j].z * rstd * gg.z, v[j].w * rstd * gg.w); o8[64 * j] = w; }
            }
        }
    }
    SEAM();

    if (RUN() && EN(9)) { LOCAL_TID();
        pg8::Gemm gm{(const bf16*)P_HF, DM / 2, P_WUPT, NTOK, NUP, DM / 2}; pg8::StaticOrder S; S.init(NTOK, NUP, G, bx);
#if CONV_FUSE
        static_assert(I8_UP && CONV_FUSE, "the all-token FFN stage needs the fused conv epilogue (int8 up GEMM)");
        pg8::EpiConv E{(unsigned char*)P_ACT, P_Y, A->in[I_CW], A->in[I_CB], ws, FP8_DOWN ? S_ACT8 : 1.f}; REP_LOOP_GEMM { int l2_ = lane_id_fresh(); asm volatile("" : "+v"(l2_)); pg8::gemm_phase<pg8::EpiConv, 2>(ldsL, gm, S, E, wave * 64 + l2_); }
#else
        pg8::EpiStoreT<I8_UP != 0, WS_RSH, WS_CSUP> E{P_Y, NUP, 0, 0, 1.f, ws}; REP_LOOP_GEMM { int l2_ = lane_id_fresh(); asm volatile("" : "+v"(l2_)); pg8::gemm_phase<pg8::EpiStoreT<I8_UP != 0, WS_RSH, WS_CSUP>, I8_UP ? 2 : 0>(ldsL, gm, S, E, wave * 64 + l2_); }
#endif
    }
    SEAM();

#if CONV_FUSE
    if (RUN() && EN(10)) { LOCAL_TID();
        const float* cw = A->in[I_CW]; const float* cb = A->in[I_CB];
        constexpr int NCB = DFF / 256, NITEM = NCB * (NTOK / 64) * 2;
        for (int it = gw; it < NITEM; it += NGW) {
            const int cbk = it % NCB, be = it / NCB, b = be >> 1, edge = be & 1, c0 = cbk * 256 + lane * 4, t = b * 64 + (edge ? 63 : 0);
            const int posmask = (t < NTOK / 2) ? 4095 : 8191;
            const int colg = (c0 >> 7) * 256 + (c0 & 127);
            const f32x4 wg0 = *(const f32x4*)(cw + c0), wg1 = *(const f32x4*)(cw + NUP + c0), wg2 = *(const f32x4*)(cw + 2 * NUP + c0), bg = *(const f32x4*)(cb + c0);
            const f32x4 wu0 = *(const f32x4*)(cw + DFF + c0), wu1 = *(const f32x4*)(cw + NUP + DFF + c0), wu2 = *(const f32x4*)(cw + 2 * NUP + DFF + c0), bu = *(const f32x4*)(cb + DFF + c0);
            auto ldyb = [&](int blk, int slot, f32x4& yg, f32x4& yu) {
                const bf16* p = P_Y + ((size_t)blk * 4 + slot) * NUP + colg; const u32x2 a = *(const u32x2*)p, bb = *(const u32x2*)(p + 128);
                yg = (f32x4){bf_lo(a.x), bf_hi(a.x), bf_lo(a.y), bf_hi(a.y)}; yu = (f32x4){bf_lo(bb.x), bf_hi(bb.x), bf_lo(bb.y), bf_hi(bb.y)}; };
            const f32x4 z = (f32x4){0.f, 0.f, 0.f, 0.f};
            f32x4 pg = z, pu = z, cg, cu, ng = z, nu = z;
            if (edge == 0) { ldyb(b, 0, cg, cu); ldyb(b, 1, ng, nu); if ((t & posmask) != 0) ldyb(b - 1, 3, pg, pu); }
            else { ldyb(b, 3, cg, cu); ldyb(b, 2, pg, pu); if (((t + 1) & posmask) != 0) ldyb(b + 1, 0, ng, nu); }
            const f32x4 ug = wg0 * pg + wg1 * cg + wg2 * ng + bg, uu = wu0 * pu + wu1 * cu + wu2 * nu + bu;
            float a[4];
#pragma unroll
            for (int j = 0; j < 4; ++j) a[j] = ug[j] * fast_sigmoid(ug[j]) * uu[j];
            if (FP8_DOWN) *(unsigned*)((unsigned char*)P_ACT + (size_t)t * DFF + c0) = pack4_fp8(a[0] * S_ACT8, a[1] * S_ACT8, a[2] * S_ACT8, a[3] * S_ACT8);
            else { u32x2 w; w.x = cvt_pk_bf16(a[0], a[1]); w.y = cvt_pk_bf16(a[2], a[3]); *(u32x2*)(P_ACT + (size_t)t * DFF + c0) = w; }
        }
    }
#else
    if (RUN() && EN(10)) { LOCAL_TID();
        const float* cw = A->in[I_CW]; const float* cb = A->in[I_CB];
        constexpr int RCH = 64, NCB = DFF / 256, NITEM = NCB * (TG / RCH);
        for (int it = gw; it < NITEM; it += NGW) {
            const int cbk = it % NCB, rc = it / NCB, c0 = cbk * 256 + lane * 4, t0 = rc * RCH;
            f32x4 wg0 = *(const f32x4*)(cw + c0), wg1 = *(const f32x4*)(cw + NUP + c0), wg2 = *(const f32x4*)(cw + 2 * NUP + c0), bg = *(const f32x4*)(cb + c0);
            f32x4 wu0 = *(const f32x4*)(cw + DFF + c0), wu1 = *(const f32x4*)(cw + NUP + DFF + c0), wu2 = *(const f32x4*)(cw + 2 * NUP + DFF + c0), bu = *(const f32x4*)(cb + DFF + c0);
            auto ldrow = [&](int t, f32x4& yg, f32x4& yu) {
                const u32x2 a = *(const u32x2*)(P_Y + (size_t)t * NUP + c0), b = *(const u32x2*)(P_Y + (size_t)t * NUP + DFF + c0);
                yg = (f32x4){bf_lo(a.x), bf_hi(a.x), bf_lo(a.y), bf_hi(a.y)}; yu = (f32x4){bf_lo(b.x), bf_hi(b.x), bf_lo(b.y), bf_hi(b.y)}; };
            const f32x4 z = (f32x4){0.f, 0.f, 0.f, 0.f};
            f32x4 pg = z, pu = z, cg, cu, ng, nu;
            if ((t0 & posmask) != 0) ldrow(t0 - 1, pg, pu);
            ldrow(t0, cg, cu);
#pragma unroll 4
            for (int t = t0; t < t0 + RCH; ++t) {
                if (((t + 1) & posmask) != 0) ldrow(t + 1, ng, nu); else { ng = z; nu = z; }
                const f32x4 ug = wg0 * pg + wg1 * cg + wg2 * ng + bg, uu = wu0 * pu + wu1 * cu + wu2 * nu + bu;
                float a[4];
#pragma unroll
                for (int j = 0; j < 4; ++j) a[j] = ug[j] * fast_sigmoid(ug[j]) * uu[j];
                if (FP8_DOWN) *(unsigned*)((unsigned char*)P_ACT + (size_t)t * DFF + c0) = pack4_fp8(a[0] * S_ACT8, a[1] * S_ACT8, a[2] * S_ACT8, a[3] * S_ACT8);
                else { u32x2 w; w.x = cvt_pk_bf16(a[0], a[1]); w.y = cvt_pk_bf16(a[2], a[3]); *(u32x2*)(P_ACT + (size_t)t * DFF + c0) = w; }
                pg = cg; pu = cu; cg = ng; cu = nu;
            }
        }
    }
#endif
    SEAM();

    if (RUN() && EN(11)) { LOCAL_TID();
        pg8::Gemm gm{P_ACT, FP8_DOWN ? DFF / 2 : DFF, P_WDT, NTOK, DM, FP8_DOWN ? DFF / 2 : DFF}; pg8::StaticOrder S; S.init(NTOK, DM, G, bx);
        pg8::EpiResT<false, true> E{P_X1, P_X1, DM, FP8_DOWN ? 1.f / (S_WD * S_ACT8) : 1.f, ws}; { int l2_ = lane_id_fresh(); asm volatile("" : "+v"(l2_)); pg8::gemm_phase<pg8::EpiResT<false, true>, FP8_DOWN ? 1 : 0>(ldsL, gm, S, E, wave * 64 + l2_); }
    }
    SEAM();

    if (RUN() && EN(12)) { LOCAL_TID();
        const float* gv = A->in[I_FNG];
        for (int m = gw; m < NTOK; m += NGW) {
            const u32x2* xr = (const u32x2*)(P_X1 + (size_t)m * DM) + lane; f32x4* orow = (f32x4*)(A->out + (size_t)m * DM) + lane; f32x4 v[16]; float s = 0.f;
#pragma unroll
            for (int j = 0; j < 16; ++j) { const u32x2 w = xr[64 * j]; v[j] = (f32x4){bf_lo(w.x), bf_hi(w.x), bf_lo(w.y), bf_hi(w.y)}; s += (v[j].x * v[j].x + v[j].y * v[j].y) + (v[j].z * v[j].z + v[j].w * v[j].w); }
            const float rstd = 1.0f / sqrtf(wave_sum(s) * (1.f / DM) + EPS);
#pragma unroll
            for (int j = 0; j < 16; ++j) { const f32x4 gg = ((const f32x4*)gv)[64 * j + lane]; orow[64 * j] = v[j] * rstd * gg; }
        }
    }
    SEAM();
#undef RUN
#undef SEAM
}

extern "C" void kernel_launch(void* const* d_in, const int* in_sizes, int n_in, void* d_out, int out_size, void* d_ws, size_t ws_size, hipStream_t stream) {
    static int grid = 0;
    if (grid == 0) {
        if (n_in != 23 || out_size != NTOK * DM || ws_size < WS_END) { fprintf(stderr, "kernel_launch: unexpected shapes: n_in %d out %d ws %zu (need %zu)\n", n_in, out_size, ws_size, (size_t)WS_END); grid = -1; return; }
        int dev = 0, cus = 0, per_cu = 0;
        if (hipGetDevice(&dev) != hipSuccess || hipDeviceGetAttribute(&cus, hipDeviceAttributeMultiprocessorCount, dev) != hipSuccess) { grid = -1; return; }
        if (hipFuncSetAttribute((const void*)enc_fwd, hipFuncAttributeMaxDynamicSharedMemorySize, LDS_BYTES) != hipSuccess) { fprintf(stderr, "kernel_launch: hipFuncSetAttribute failed\n"); grid = -1; return; }
        if (hipOccupancyMaxActiveBlocksPerMultiprocessor(&per_cu, (const void*)enc_fwd, NWAVES * 64, LDS_BYTES) != hipSuccess || per_cu < 1) { fprintf(stderr, "kernel_launch: occupancy query says %d\n", per_cu); per_cu = 1; }
        (void)hipGetLastError();
        grid = cus;
    }
    if (grid < 0) return;
    (void)hipMemsetAsync((char*)d_ws + WS_CTL, 0, CTL_ZERO_BYTES, stream);
    Args a{};
    for (int i = 0; i < 23; ++i) a.in[i] = (const float*)d_in[i];
    a.out = (float*)d_out; a.ws = (unsigned char*)d_ws;
    for (int i = 0; i < 32; ++i) a.invf[i] = powf(10000.0f, -(float)(2 * i) / 64.0f);
#if MK_PER_STEP_LAUNCH
    for (int s = 0; s < NSTEPS; ++s) { a.lo = s; a.hi = s + 1; hipLaunchKernelGGL(enc_fwd, dim3(grid), dim3(NWAVES * 64), LDS_BYTES, stream, a); }
#else
    a.lo = 0; a.hi = NSTEPS;
    hipLaunchKernelGGL(enc_fwd, dim3(grid), dim3(NWAVES * 64), LDS_BYTES, stream, a);
#endif
    const hipError_t le = hipPeekAtLastError();
    if (le != hipSuccess) fprintf(stderr, "kernel_launch: launch failed: %s\n", hipGetErrorName(le));
}
```

```cpp
#include <hip/hip_runtime.h>
#include <cstdio>
#include <cstdint>
#include <cmath>

#ifndef I8_IN
#define I8_IN 1
#endif
#ifndef ATT_CINIT
#define ATT_CINIT 1
#endif
constexpr float CS_DIFF = 0.125f * 1.4426950408889634f;
#ifndef CONV_FUSE
#define CONV_FUSE 1
#endif
#ifndef I8_MID
#define I8_MID 1
#endif
#ifndef I8_UP
#define I8_UP 1
#endif
#ifndef FP8_DOWN
#define FP8_DOWN 1
#endif
constexpr float S_WD = 1024.f, S_ACT8 = 8.f;
#ifndef REP_GEMM
#define REP_GEMM 1
#endif
#ifndef REP_DIFF
#define REP_DIFF 1
#endif
#ifndef REP_MLA
#define REP_MLA 1
#endif
#if REP_GEMM == 1
#define REP_LOOP_GEMM
#else
#define REP_LOOP_GEMM _Pragma("unroll 1") for (int rep = 0; rep < REP_GEMM; ++rep)
#endif
#ifndef MK_PER_STEP_LAUNCH
#define MK_PER_STEP_LAUNCH 0
#endif

typedef unsigned short bf16;
typedef short bf16x8 __attribute__((ext_vector_type(8)));
typedef short s16x4 __attribute__((ext_vector_type(4)));
typedef float f32x4 __attribute__((ext_vector_type(4)));
typedef float f32x2 __attribute__((ext_vector_type(2)));
typedef float f32x16 __attribute__((ext_vector_type(16)));
typedef unsigned u32x4 __attribute__((ext_vector_type(4)));
typedef unsigned u32x2 __attribute__((ext_vector_type(2)));
typedef int i32x4 __attribute__((ext_vector_type(4)));
typedef int i32x8 __attribute__((ext_vector_type(8)));
#define LAS __attribute__((address_space(3)))

__device__ __forceinline__ unsigned cvt_pk_bf16(float lo, float hi) { unsigned r; asm volatile("v_cvt_pk_bf16_f32 %0, %1, %2" : "=v"(r) : "v"(lo), "v"(hi)); return r; }
__device__ __forceinline__ float bf_lo(unsigned w) { return __uint_as_float(w << 16); }
__device__ __forceinline__ float bf_hi(unsigned w) { return __uint_as_float(w & 0xffff0000u); }
__device__ __forceinline__ float clamp448(float x) { return __builtin_fminf(__builtin_fmaxf(x, -448.f), 448.f); }
__device__ __forceinline__ unsigned pack4_fp8(float a, float b, float c, float d) { int w = 0; w = __builtin_amdgcn_cvt_pk_fp8_f32(clamp448(a), clamp448(b), w, false); w = __builtin_amdgcn_cvt_pk_fp8_f32(clamp448(c), clamp448(d), w, true); return (unsigned)w; }
__device__ __forceinline__ unsigned pack4_i8(float a, float b, float c, float d) { const int ia = (int)__builtin_rintf(a), ib = (int)__builtin_rintf(b), ic = (int)__builtin_rintf(c), id = (int)__builtin_rintf(d);
    return (unsigned)(ia & 255) | ((unsigned)(ib & 255) << 8) | ((unsigned)(ic & 255) << 16) | ((unsigned)id << 24); }
__device__ __forceinline__ float fast_sigmoid(float x) { return __builtin_amdgcn_rcpf(1.0f + __builtin_amdgcn_exp2f(-1.4426950408889634f * x)); }

__device__ __forceinline__ int lane_id_fresh() { unsigned ones = ~0u; asm volatile("" : "+s"(ones)); return (int)__builtin_amdgcn_mbcnt_hi(ones, __builtin_amdgcn_mbcnt_lo(ones, 0u)); }

constexpr int DM = 4096, NTOK = 32768, TG = 8192, NGRP = 4;
constexpr int NIN = 16128;
constexpr int C_DQ = 0, C_DK = 2048, C_DV = 4096, C_QLAT = 6144, C_KVLAT = 7168, C_GATE = 7680, C_KPE = 15872;
constexpr int DFF = 11008, NUP = 22016, NQ = 3072, NKV = 4096;
constexpr float EPS = 1e-6f;

constexpr size_t MiB = 1u << 20;
constexpr size_t WS_CTL = 0, CTL_ZERO_BYTES = 1 * MiB;
constexpr size_t WS_COS = 1 * MiB, WS_SIN = 2 * MiB, WS_BIAS = 3 * MiB, WS_LAM = 3 * MiB + 32768;
constexpr size_t WS_CSIN = 3 * MiB + 65536, WS_CSUP = 3 * MiB + 131072, WS_RSH = 3 * MiB + 262144;
constexpr size_t WS_CSQ = 3 * MiB + 320 * 1024, WS_CSKV = 3 * MiB + 336 * 1024, WS_CSA = 3 * MiB + 352 * 1024, WS_CSB = 3 * MiB + 368 * 1024, WS_CSO = 3 * MiB + 384 * 1024;
constexpr size_t WS_RSQL = 3 * MiB + 400 * 1024, WS_RSKVL = 3 * MiB + 432 * 1024, WS_RSA = 3 * MiB + 464 * 1024, WS_RSB = 3 * MiB + 496 * 1024, WS_RSM = 3 * MiB + 528 * 1024;
constexpr size_t EB_IN = I8_IN ? 1 : 2, EB_UP = I8_UP ? 1 : 2, EB_MID = I8_MID ? 1 : 2, EB_DN = FP8_DOWN ? 1 : 2;
constexpr size_t WS_WIN = 4 * MiB, WS_WQ = WS_WIN + (size_t)NIN * DM * EB_IN, WS_WKV = WS_WQ + (size_t)NQ * 1024 * EB_MID, WS_WA = WS_WKV + (size_t)NKV * 512 * EB_MID, WS_WB = WS_WA + (size_t)DM * 2048 * EB_MID,
                 WS_WO = WS_WB + (size_t)DM * 2048 * EB_MID, WS_WUP = WS_WO + (size_t)DM * DM * EB_MID, WS_WD = WS_WUP + (size_t)NUP * DM * EB_UP, WS_WEND = WS_WD + (size_t)DM * DFF * EB_DN;
constexpr size_t WS_ACT = (WS_WEND + MiB - 1) / MiB * MiB;
constexpr size_t WS_P = WS_ACT, WS_Q = WS_P + 252 * MiB, WS_KV = WS_Q + 48 * MiB, WS_AO = WS_KV + 64 * MiB, WS_BO = WS_AO + 32 * MiB, WS_MG = WS_BO + 32 * MiB, WS_STASH = WS_MG + 64 * MiB;
constexpr size_t WS_QL8 = WS_STASH + 32 * MiB, WS_KVL8 = WS_QL8 + 8 * MiB, WS_AO8 = WS_KVL8 + 4 * MiB, WS_BO8 = WS_AO8 + 16 * MiB, WS_MIX_END = WS_BO8 + 16 * MiB;
static_assert(WS_P + (size_t)TG * NIN * 2 <= WS_Q && (size_t)TG * NQ * 2 <= 48 * MiB && (size_t)TG * NKV * 2 <= 64 * MiB && (size_t)TG * DM * 2 <= 64 * MiB, "mixer map");
constexpr size_t WS_Y = WS_ACT, WS_ACTV = WS_Y + (size_t)(NTOK / 64) * 4 * NUP * 2, WS_FFN_END = WS_ACTV + (size_t)NTOK * DFF * EB_DN;
constexpr size_t WS_X1 = ((WS_MIX_END > WS_FFN_END ? WS_MIX_END : WS_FFN_END) + MiB - 1) / MiB * MiB;
constexpr size_t WS_HF = WS_X1 + (size_t)NTOK * DM * 2, WS_MG8 = WS_HF + (size_t)NTOK * DM, WS_END = WS_MG8 + (size_t)NTOK * DM;
static_assert(EB_IN == 1 && EB_UP == 1 && EB_MID == 1, "the all-token row buffers are int8");
constexpr size_t WS_RSHF = 3 * MiB + 576 * 1024, WS_RSMA = 3 * MiB + 704 * 1024;
static_assert(WS_RSM + 32768 <= WS_RSHF && WS_RSMA + (size_t)NTOK * 4 <= 4 * MiB, "scale arrays");

namespace pg8 {
constexpr int BM = 256, BK = 64, HALF = 128, HTB = HALF * BK * 2, STAGE_BYTES = 8 * HTB, NXCD = 8, WGM = 8;
__host__ __device__ __forceinline__ int lds_byte(int r, int c) { const int st = (r >> 4) * 2 + (c >> 5), rr = r & 15, cc = c & 31, ob = rr * 64 + cc * 2; return st * 1024 + (ob ^ (((ob >> 9) & 1) << 5)); }
__host__ __device__ __forceinline__ void stage_rc(int b, int& R, int& C) { const int st = b / 1024, sb = b % 1024, swz = sb ^ (((sb >> 9) & 1) << 5); R = (st >> 1) * 16 + swz / 64; C = (st & 1) * 32 + (swz % 64) / 2; }
__host__ __device__ __forceinline__ int perm32(int rho) { const int n = rho >> 4, i = rho & 15; return 8 * (i >> 2) + 4 * n + (i & 3); }

struct Unit { int pm, pn; };
struct Gemm { const bf16* A; int lda; const bf16* Bt; int M, N, K; };

struct StaticOrder {
    int nM, nN, nwg, G, c;
    __device__ void init(int M, int N, int G_, int c_) { nM = M / BM; nN = N / BM; nwg = nM * nN; G = G_; c = c_; }
    __device__ bool next(int i, Unit& u) const {
        const long L = (long)i * G + c; if (L >= nwg) return false;
        int wgid = (int)L; { const int q = nwg / NXCD, r = nwg % NXCD, xcd = wgid % NXCD, off = wgid / NXCD; wgid = (xcd < r ? xcd * (q + 1) : r * (q + 1) + (xcd - r) * q) + off; }
        const int nig = WGM * nN, gid = wgid / nig, fm = gid * WGM, gsz = (nM - fm) < WGM ? (nM - fm) : WGM;
        u.pm = fm + ((wgid % nig) % gsz); u.pn = (wgid % nig) / gsz; return true;
    }
};

template <int MODE> struct AccSel { typedef f32x4 T; }; template <> struct AccSel<2> { typedef i32x4 T; };
__device__ __forceinline__ f32x4 tof(f32x4 v) { return v; }
__device__ __forceinline__ f32x4 tof(i32x4 v) { return __builtin_convertvector(v, f32x4); }

template <class Epi, int MODE = 0>
__device__ __forceinline__ void gemm_phase(LAS unsigned char* lds, const Gemm g, const StaticOrder& S, const Epi& E, int tid_in) {
    int tid = tid_in; asm volatile("" : "+v"(tid));
    const int wid = __builtin_amdgcn_readfirstlane(tid >> 6), lane = tid & 63, wr = wid >> 2, wc = wid & 3, fr = lane & 15, fq = lane >> 4;
    int K = g.K, lda = g.lda; asm volatile("" : "+s"(K), "+s"(lda));
    const int nt = K / BK;
    unsigned voffA[2], voffB[2];
#pragma unroll
    for (int i = 0; i < 2; ++i) { int R, C; stage_rc(tid * 16 + i * 8192, R, C); const int Rb = (R & ~31) + perm32(R & 31);
        voffA[i] = (unsigned)(R * lda + C) * 2u; voffB[i] = (unsigned)(Rb * K + C) * 2u; }
    const size_t kstep = (size_t)(BK * 2);
    const size_t hstepA = (size_t)HALF * lda * 2, hstepB = (size_t)HALF * K * 2;
    const size_t tstepA = 2 * hstepA, tstepB = 2 * hstepB;
    const unsigned ldsw = (unsigned)wid * 1024u;
    const int aoff = lds_byte(wr * 64 + fr, fq * 8), boff = lds_byte(wc * 32 + fr, fq * 8);
#define PG8_SA(b, h) (((b) * 2 + (h)) * HTB)
#define PG8_SB(b, h) ((4 + (b) * 2 + (h)) * HTB)
#define PG8_STAGE(bufoff, gbase, voff) do { _Pragma("unroll") for (int _i = 0; _i < 2; ++_i) \
        __builtin_amdgcn_global_load_lds((const unsigned*)((const char*)(gbase) + (voff)[_i]), (LAS unsigned*)(lds + (bufoff) + ldsw + _i * 8192), 16, 0, 0); } while (0)
#define PG8_CAT(x, y) __builtin_shufflevector(__builtin_bit_cast(i32x4, x), __builtin_bit_cast(i32x4, y), 0, 1, 2, 3, 4, 5, 6, 7)
#define PG8_LDA(dst, b, h) do { _Pragma("unroll") for (int m = 0; m < 4; ++m) dst[m] = PG8_CAT(*(const LAS bf16x8*)(lds + PG8_SA(b, h) + aoff + m * 2048), *(const LAS bf16x8*)(lds + PG8_SA(b, h) + aoff + m * 2048 + 1024)); } while (0)
#define PG8_LDB(dst, b, h) do { _Pragma("unroll") for (int n = 0; n < 2; ++n) dst[n] = PG8_CAT(*(const LAS bf16x8*)(lds + PG8_SB(b, h) + boff + n * 2048), *(const LAS bf16x8*)(lds + PG8_SB(b, h) + boff + n * 2048 + 1024)); } while (0)
#define PG8_LO4(v) __builtin_shufflevector(v, v, 0, 1, 2, 3)
#define PG8_HI4(v) __builtin_shufflevector(v, v, 4, 5, 6, 7)
#define PG8_LO(v) __builtin_bit_cast(bf16x8, __builtin_shufflevector(v, v, 0, 1, 2, 3))
#define PG8_HI(v) __builtin_bit_cast(bf16x8, __builtin_shufflevector(v, v, 4, 5, 6, 7))
#define PG8_MMA(ai, bj, At, Bt) do { __builtin_amdgcn_s_setprio(1); _Pragma("unroll") for (int m = 0; m < 4; ++m) _Pragma("unroll") for (int n = 0; n < 2; ++n) { \
        if constexpr (F8) asm volatile("v_mfma_f32_16x16x128_f8f6f4 %0, %1, %2, %0" : "+v"(acc[ai][bj][m][n]) : "v"(Bt[n]), "v"(At[m]));   \
        else if constexpr (MODE == 2) { acc[ai][bj][m][n] = __builtin_amdgcn_mfma_i32_16x16x64_i8(PG8_LO4(Bt[n]), PG8_LO4(At[m]), acc[ai][bj][m][n], 0, 0, 0); \
               acc[ai][bj][m][n] = __builtin_amdgcn_mfma_i32_16x16x64_i8(PG8_HI4(Bt[n]), PG8_HI4(At[m]), acc[ai][bj][m][n], 0, 0, 0); } \
        else { acc[ai][bj][m][n] = __builtin_amdgcn_mfma_f32_16x16x32_bf16(PG8_LO(Bt[n]), PG8_LO(At[m]), acc[ai][bj][m][n], 0, 0, 0); \
               acc[ai][bj][m][n] = __builtin_amdgcn_mfma_f32_16x16x32_bf16(PG8_HI(Bt[n]), PG8_HI(At[m]), acc[ai][bj][m][n], 0, 0, 0); } } __builtin_amdgcn_s_setprio(0); } while (0)
#define PG8_WAIT_V(n) asm volatile("s_waitcnt vmcnt(" #n ")" ::: "memory")
#define PG8_WAIT_L(n) asm volatile("s_waitcnt lgkmcnt(" #n ")" ::: "memory")
#define PG8_BAR __builtin_amdgcn_s_barrier()
#define PG8_SCHED __builtin_amdgcn_sched_barrier(0)
    Unit cur, nxt; int ui = 0;
    if (!S.next(0, cur)) return;
    constexpr bool F8 = (MODE == 1); typedef typename AccSel<MODE>::T AccT; AccT acc[2][2][4][2];
#pragma unroll
    for (int a = 0; a < 2; ++a)
#pragma unroll
        for (int b = 0; b < 2; ++b)
#pragma unroll
            for (int m = 0; m < 4; ++m)
#pragma unroll
                for (int n = 0; n < 2; ++n) acc[a][b][m][n] = AccT{};
    i32x8 At[4], B0[2], B1[2];
    const char* cA = (const char*)g.A + (size_t)cur.pm * tstepA; const char* cB = (const char*)g.Bt + (size_t)cur.pn * tstepB;
    PG8_STAGE(PG8_SB(0, 0), cB, voffB); PG8_STAGE(PG8_SB(0, 1), cB + hstepB, voffB); PG8_STAGE(PG8_SA(0, 0), cA, voffA); PG8_STAGE(PG8_SA(0, 1), cA + hstepA, voffA);
    if (wr == 1) PG8_BAR;
    PG8_WAIT_V(2); PG8_BAR;
    PG8_STAGE(PG8_SB(1, 0), cB + kstep, voffB); PG8_STAGE(PG8_SA(1, 0), cA + kstep, voffA); PG8_STAGE(PG8_SB(1, 1), cB + hstepB + kstep, voffB);
    PG8_WAIT_V(6); PG8_BAR;
    for (;;) {
        const bool has_next = S.next(ui + 1, nxt);
        const char* nA = has_next ? (const char*)g.A + (size_t)nxt.pm * tstepA : cA; const char* nB = has_next ? (const char*)g.Bt + (size_t)nxt.pn * tstepB : cB;
        for (int t = 0; t < nt; t += 2) {
            const bool last = (t == nt - 2);
            const char* a1 = cA + (size_t)(t + 1) * kstep;
            const char* a2 = last ? nA : cA + (size_t)(t + 2) * kstep; const char* b2 = last ? nB : cB + (size_t)(t + 2) * kstep;
            const char* a3 = a2 + kstep; const char* b3 = b2 + kstep;
            PG8_LDB(B0, 0, 0); PG8_LDB(B1, 0, 1); PG8_SCHED; PG8_LDA(At, 0, 0); PG8_STAGE(PG8_SA(1, 1), a1 + hstepA, voffA);
            PG8_WAIT_V(8); PG8_WAIT_L(0); PG8_BAR; PG8_MMA(0, 0, At, B0); PG8_MMA(0, 1, At, B1); PG8_BAR; PG8_SCHED;
            PG8_LDA(At, 0, 1); PG8_STAGE(PG8_SB(0, 0), b2, voffB); PG8_STAGE(PG8_SB(0, 1), b2 + hstepB, voffB); PG8_STAGE(PG8_SA(0, 0), a2, voffA);
            PG8_WAIT_V(8); PG8_WAIT_L(0); PG8_BAR; PG8_MMA(1, 0, At, B0); PG8_MMA(1, 1, At, B1); PG8_BAR; PG8_SCHED;
            PG8_LDB(B0, 1, 0); PG8_LDB(B1, 1, 1); PG8_SCHED; PG8_LDA(At, 1, 0); PG8_STAGE(PG8_SA(0, 1), a2 + hstepA, voffA);
            PG8_WAIT_V(8); PG8_WAIT_L(0); PG8_BAR; PG8_MMA(0, 0, At, B0); PG8_MMA(0, 1, At, B1); PG8_BAR; PG8_SCHED;
            PG8_LDA(At, 1, 1); PG8_STAGE(PG8_SB(1, 0), b3, voffB); PG8_STAGE(PG8_SB(1, 1), b3 + hstepB, voffB); PG8_STAGE(PG8_SA(1, 0), a3, voffA);
            PG8_WAIT_V(8); PG8_WAIT_L(0); PG8_BAR; PG8_MMA(1, 0, At, B0); PG8_MMA(1, 1, At, B1); PG8_BAR; PG8_SCHED;
        }
        if (wr == 0) PG8_BAR;
        if constexpr (F8) asm volatile("s_nop 15\n\ts_nop 15" ::: "memory");
        { int l3_ = lane_id_fresh(); asm volatile("" : "+v"(l3_)); E(acc, cur, wr, wc, l3_ & 15, l3_ >> 4); }
        if (!has_next) break;
#pragma unroll
        for (int a = 0; a < 2; ++a)
#pragma unroll
            for (int b = 0; b < 2; ++b)
#pragma unroll
                for (int m = 0; m < 4; ++m)
#pragma unroll
                    for (int n = 0; n < 2; ++n) acc[a][b][m][n] = AccT{};
        cur = nxt; cA = nA; cB = nB; ++ui;
        if (wr == 1) PG8_BAR;
    }
    PG8_WAIT_V(0);
    PG8_BAR;
#undef PG8_SA
#undef PG8_SB
#undef PG8_STAGE
#undef PG8_LDA
#undef PG8_LDB
#undef PG8_MMA
#undef PG8_CAT
#undef PG8_LO
#undef PG8_LO4
#undef PG8_HI4
#undef PG8_HI
#undef PG8_WAIT_V
#undef PG8_WAIT_L
#undef PG8_BAR
#undef PG8_SCHED
}

template <bool SC, size_t RSOFF = 0, size_t CSOFF = 0> struct EpiStoreT {
    bf16* O; int ldc; int sig_lo, sig_hi; float scale; const unsigned char* wsb; int rsrow;
    template <class AccT> __device__ __forceinline__ void operator()(const AccT (&acc)[2][2][4][2], const Unit& u, int wr, int wc, int fr, int fq) const {
        const bool sig = (u.pn >= sig_lo && u.pn < sig_hi);
        const int row0 = u.pm * BM + wr * 64 + fr, col0 = u.pn * BM + wc * 32 + 8 * fq;
        const float* rs = (const float*)(wsb + RSOFF) + rsrow; const float* cs = (const float*)(wsb + CSOFF);
        const float tsc = (u.pn < 8) ? scale : 1.f;
        f32x4 cv[2][2];
#pragma unroll
        for (int bj = 0; bj < 2; ++bj) { if constexpr (SC) { cv[bj][0] = *(const f32x4*)(cs + col0 + bj * HALF) * tsc; cv[bj][1] = *(const f32x4*)(cs + col0 + bj * HALF + 4) * tsc; } else { cv[bj][0] = (f32x4){tsc, tsc, tsc, tsc}; cv[bj][1] = cv[bj][0]; } }
#pragma unroll
        for (int ai = 0; ai < 2; ++ai)
#pragma unroll
            for (int m = 0; m < 4; ++m) { bf16* rowp = O + (size_t)(row0 + ai * HALF + m * 16) * ldc + col0; float rsv = 1.f; if constexpr (SC) rsv = rs[row0 + ai * HALF + m * 16];
#pragma unroll
                for (int bj = 0; bj < 2; ++bj) { f32x4 v0 = tof(acc[ai][bj][m][0]) * (cv[bj][0] * rsv), v1 = tof(acc[ai][bj][m][1]) * (cv[bj][1] * rsv);
                    if (sig) {
#pragma unroll
                        for (int j = 0; j < 4; ++j) { v0[j] = fast_sigmoid(v0[j]); v1[j] = fast_sigmoid(v1[j]); } }
                    u32x4 w; w.x = cvt_pk_bf16(v0[0], v0[1]); w.y = cvt_pk_bf16(v0[2], v0[3]); w.z = cvt_pk_bf16(v1[0], v1[1]); w.w = cvt_pk_bf16(v1[2], v1[3]);
                    *(u32x4*)(rowp + bj * HALF) = w; }
                asm volatile("" ::: "memory"); }
    }
};
template <bool SC> struct EpiQT {
    bf16* O; int ldc; const unsigned char* wsb; int posmask;
    template <class AccT> __device__ __forceinline__ void operator()(const AccT (&acc)[2][2][4][2], const Unit& u, int wr, int wc, int fr, int fq) const {
        const bool rope = (u.pn >= 8);
        const int row0 = u.pm * BM + wr * 64 + fr, col0 = u.pn * BM + wc * 32 + 8 * fq;
        const float* cosT = (const float*)(wsb + WS_COS); const float* sinT = (const float*)(wsb + WS_SIN); const float* rs = (const float*)(wsb + WS_RSQL); const float* cs = (const float*)(wsb + WS_CSQ);
        f32x4 cv[2][2];
#pragma unroll
        for (int bj = 0; bj < 2; ++bj) { if constexpr (SC) { cv[bj][0] = *(const f32x4*)(cs + col0 + bj * HALF); cv[bj][1] = *(const f32x4*)(cs + col0 + bj * HALF + 4); } else { cv[bj][0] = (f32x4){1.f, 1.f, 1.f, 1.f}; cv[bj][1] = cv[bj][0]; } }
#pragma unroll
        for (int ai = 0; ai < 2; ++ai)
#pragma unroll
            for (int m = 0; m < 4; ++m) { const int row = row0 + ai * HALF + m * 16; bf16* rowp = O + (size_t)row * ldc + col0; const int pos = row & posmask; float rsv = 1.f; if constexpr (SC) rsv = rs[row];
#pragma unroll
                for (int bj = 0; bj < 2; ++bj) { f32x4 v0 = tof(acc[ai][bj][m][0]) * (cv[bj][0] * rsv), v1 = tof(acc[ai][bj][m][1]) * (cv[bj][1] * rsv);
                    if (rope) { const int i0 = (((col0 + bj * HALF) & 63) >> 1);
                        const f32x4 c = *(const f32x4*)(cosT + (size_t)pos * 32 + i0), s = *(const f32x4*)(sinT + (size_t)pos * 32 + i0);
                        f32x4 a, b;
                        a[0] = v0[0] * c[0] - v0[1] * s[0]; a[1] = v0[0] * s[0] + v0[1] * c[0]; a[2] = v0[2] * c[1] - v0[3] * s[1]; a[3] = v0[2] * s[1] + v0[3] * c[1];
                        b[0] = v1[0] * c[2] - v1[1] * s[2]; b[1] = v1[0] * s[2] + v1[1] * c[2]; b[2] = v1[2] * c[3] - v1[3] * s[3]; b[3] = v1[2] * s[3] + v1[3] * c[3];
                        v0 = a; v1 = b; }
                    u32x4 w; w.x = cvt_pk_bf16(v0[0], v0[1]); w.y = cvt_pk_bf16(v0[2], v0[3]); w.z = cvt_pk_bf16(v1[0], v1[1]); w.w = cvt_pk_bf16(v1[2], v1[3]);
                    *(u32x4*)(rowp + bj * HALF) = w; } }
    }
};
template <bool SC> struct EpiGateAT {
    bf16* part; int ldp; const bf16* gate; int ldg; const unsigned char* wsb;
    template <class AccT> __device__ __forceinline__ void operator()(const AccT (&acc)[2][2][4][2], const Unit& u, int wr, int wc, int fr, int fq) const {
        const int row0 = u.pm * BM + wr * 64 + fr, col0 = u.pn * BM + wc * 32 + 8 * fq;
        const float* rs = (const float*)(wsb + WS_RSA); const float* cs = (const float*)(wsb + WS_CSA);
        f32x4 cv[2][2];
#pragma unroll
        for (int bj = 0; bj < 2; ++bj) { if constexpr (SC) { cv[bj][0] = *(const f32x4*)(cs + col0 + bj * HALF); cv[bj][1] = *(const f32x4*)(cs + col0 + bj * HALF + 4); } else { cv[bj][0] = (f32x4){1.f, 1.f, 1.f, 1.f}; cv[bj][1] = cv[bj][0]; } }
#pragma unroll
        for (int ai = 0; ai < 2; ++ai) {
            u32x4 gw[4][2]; float rsv[4];
#pragma unroll
            for (int m = 0; m < 4; ++m) { const size_t row = (size_t)(row0 + ai * HALF + m * 16); rsv[m] = 1.f; if constexpr (SC) rsv[m] = rs[row];
#pragma unroll
                for (int bj = 0; bj < 2; ++bj) gw[m][bj] = *(const u32x4*)(gate + row * ldg + col0 + bj * HALF); }
#pragma unroll
            for (int m = 0; m < 4; ++m) { const size_t row = (size_t)(row0 + ai * HALF + m * 16);
#pragma unroll
                for (int bj = 0; bj < 2; ++bj) { const f32x4 v0 = tof(acc[ai][bj][m][0]) * (cv[bj][0] * rsv[m]), v1 = tof(acc[ai][bj][m][1]) * (cv[bj][1] * rsv[m]); const u32x4 g = gw[m][bj];
                    u32x4 w; w.x = cvt_pk_bf16(v0[0] * bf_lo(g.x), v0[1] * bf_hi(g.x)); w.y = cvt_pk_bf16(v0[2] * bf_lo(g.y), v0[3] * bf_hi(g.y)); w.z = cvt_pk_bf16(v1[0] * bf_lo(g.z), v1[1] * bf_hi(g.z)); w.w = cvt_pk_bf16(v1[2] * bf_lo(g.w), v1[3] * bf_hi(g.w));
                    *(u32x4*)(part + row * ldp + col0 + bj * HALF) = w; } }
            asm volatile("" ::: "memory");
        }
    }
};
template <bool SC> struct EpiGateBT {
    const bf16* part; int ldp; const bf16* gate; int ldg; bf16* O; int ldc; const unsigned char* wsb;
    template <class AccT> __device__ __forceinline__ void operator()(const AccT (&acc)[2][2][4][2], const Unit& u, int wr, int wc, int fr, int fq) const {
        const int row0 = u.pm * BM + wr * 64 + fr, col0 = u.pn * BM + wc * 32 + 8 * fq;
        const float* rs = (const float*)(wsb + WS_RSB); const float* cs = (const float*)(wsb + WS_CSB);
        f32x4 cv[2][2];
#pragma unroll
        for (int bj = 0; bj < 2; ++bj) { if constexpr (SC) { cv[bj][0] = *(const f32x4*)(cs + col0 + bj * HALF); cv[bj][1] = *(const f32x4*)(cs + col0 + bj * HALF + 4); } else { cv[bj][0] = (f32x4){1.f, 1.f, 1.f, 1.f}; cv[bj][1] = cv[bj][0]; } }
#pragma unroll
        for (int ai = 0; ai < 2; ++ai) {
            u32x4 gw[4][2], pw[4][2]; float rsv[4];
#pragma unroll
            for (int m = 0; m < 4; ++m) { const size_t row = (size_t)(row0 + ai * HALF + m * 16); rsv[m] = 1.f; if constexpr (SC) rsv[m] = rs[row];
#pragma unroll
                for (int bj = 0; bj < 2; ++bj) { gw[m][bj] = *(const u32x4*)(gate + row * ldg + col0 + bj * HALF); pw[m][bj] = *(const u32x4*)(part + row * ldp + col0 + bj * HALF); } }
#pragma unroll
            for (int m = 0; m < 4; ++m) { const size_t row = (size_t)(row0 + ai * HALF + m * 16);
#pragma unroll
                for (int bj = 0; bj < 2; ++bj) { const f32x4 v0 = tof(acc[ai][bj][m][0]) * (cv[bj][0] * rsv[m]), v1 = tof(acc[ai][bj][m][1]) * (cv[bj][1] * rsv[m]); const u32x4 g = gw[m][bj], p = pw[m][bj];
                    u32x4 w; w.x = cvt_pk_bf16(bf_lo(p.x) + v0[0] * bf_lo(g.x), bf_hi(p.x) + v0[1] * bf_hi(g.x)); w.y = cvt_pk_bf16(bf_lo(p.y) + v0[2] * bf_lo(g.y), bf_hi(p.y) + v0[3] * bf_hi(g.y));
                    w.z = cvt_pk_bf16(bf_lo(p.z) + v1[0] * bf_lo(g.z), bf_hi(p.z) + v1[1] * bf_hi(g.z)); w.w = cvt_pk_bf16(bf_lo(p.w) + v1[2] * bf_lo(g.w), bf_hi(p.w) + v1[3] * bf_hi(g.w));
                    *(u32x4*)(O + row * ldc + col0 + bj * HALF) = w; } }
            asm volatile("" ::: "memory");
        }
    }
};
template <bool SC, bool SRCB> struct EpiResT {
    const void* src; const void* src2; int split_pm; bf16* dst; int ld; float scale; const unsigned char* wsb;
    template <class AccT> __device__ __forceinline__ void operator()(const AccT (&acc)[2][2][4][2], const Unit& u, int wr, int wc, int fr, int fq) const {
        const int row0 = u.pm * BM + wr * 64 + fr, col0 = u.pn * BM + wc * 32 + 8 * fq;
        const float* rs = (const float*)(wsb + WS_RSMA); const float* cs = (const float*)(wsb + WS_CSO);
        const char* sbase = (u.pm < split_pm) ? (const char*)src : (const char*)src2 - (size_t)split_pm * BM * ld * (SRCB ? 2 : 4);
        f32x4 cv[2][2];
#pragma unroll
        for (int bj = 0; bj < 2; ++bj) { if constexpr (SC) { cv[bj][0] = *(const f32x4*)(cs + col0 + bj * HALF); cv[bj][1] = *(const f32x4*)(cs + col0 + bj * HALF + 4); } else { cv[bj][0] = (f32x4){scale, scale, scale, scale}; cv[bj][1] = cv[bj][0]; } }
#pragma unroll
        for (int ai = 0; ai < 2; ++ai)
#pragma unroll
            for (int mh = 0; mh < 2; ++mh) {
                f32x4 sv[2][2][2]; float rsv[2];
#pragma unroll
                for (int mm = 0; mm < 2; ++mm) { const int m = 2 * mh + mm; const size_t off = (size_t)(row0 + ai * HALF + m * 16) * ld + col0; rsv[mm] = 1.f; if constexpr (SC) rsv[mm] = rs[row0 + ai * HALF + m * 16];
#pragma unroll
                    for (int bj = 0; bj < 2; ++bj) {
                        if constexpr (SRCB) { const u32x4 w = *(const u32x4*)((const bf16*)sbase + off + bj * HALF); sv[mm][bj][0] = (f32x4){bf_lo(w.x), bf_hi(w.x), bf_lo(w.y), bf_hi(w.y)}; sv[mm][bj][1] = (f32x4){bf_lo(w.z), bf_hi(w.z), bf_lo(w.w), bf_hi(w.w)}; }
                        else { const float* sp = (const float*)sbase + off + bj * HALF; sv[mm][bj][0] = *(const f32x4*)sp; sv[mm][bj][1] = *(const f32x4*)(sp + 4); } } }
#pragma unroll
                for (int mm = 0; mm < 2; ++mm) { const int m = 2 * mh + mm; const size_t off = (size_t)(row0 + ai * HALF + m * 16) * ld + col0;
#pragma unroll
                    for (int bj = 0; bj < 2; ++bj) { const f32x4 o0 = sv[mm][bj][0] + tof(acc[ai][bj][m][0]) * (cv[bj][0] * rsv[mm]), o1 = sv[mm][bj][1] + tof(acc[ai][bj][m][1]) * (cv[bj][1] * rsv[mm]);
                        u32x4 w; w.x = cvt_pk_bf16(o0[0], o0[1]); w.y = cvt_pk_bf16(o0[2], o0[3]); w.z = cvt_pk_bf16(o1[0], o1[1]); w.w = cvt_pk_bf16(o1[2], o1[3]); *(u32x4*)(dst + off + bj * HALF) = w; } }
                asm volatile("" ::: "memory");
            }
    }
};

__device__ __forceinline__ float dpp_from_prev_lane(float v) { return __builtin_bit_cast(float, __builtin_amdgcn_update_dpp(0, __builtin_bit_cast(int, v), 0x121, 0xF, 0xF, false)); }
__device__ __forceinline__ float dpp_from_next_lane(float v) { return __builtin_bit_cast(float, __builtin_amdgcn_update_dpp(0, __builtin_bit_cast(int, v), 0x12F, 0xF, 0xF, false)); }
struct EpiConv {
    unsigned char* act; bf16* yb; const float* cw; const float* cb; const unsigned char* wsb; float oscale;
    template <class AccT> __device__ __forceinline__ void operator()(const AccT (&acc)[2][2][4][2], const Unit& u, int wr, int wc, int fr, int fq) const {
        const float* rs = (const float*)(wsb + WS_RSHF); const float* cs = (const float*)(wsb + WS_CSUP);
#pragma unroll
        for (int n = 0; n < 2; ++n) {
            const int ch0 = wc * 32 + 8 * fq + 4 * n, cg = u.pn * 128 + ch0, colg = u.pn * BM + ch0;
            const f32x4 csg = *(const f32x4*)(cs + colg), csu = *(const f32x4*)(cs + colg + HALF), bg = *(const f32x4*)(cb + cg), bu = *(const f32x4*)(cb + DFF + cg);
            f32x4 wg[3], wu[3];
#pragma unroll
            for (int t = 0; t < 3; ++t) { wg[t] = *(const f32x4*)(cw + t * NUP + cg); wu[t] = *(const f32x4*)(cw + t * NUP + DFF + cg); }
#pragma unroll
            for (int ai = 0; ai < 2; ++ai) {
                const int rowb = u.pm * BM + ai * HALF + wr * 64;
                f32x4 yg[4], yu[4];
#pragma unroll
                for (int m = 0; m < 4; ++m) { const float rsv = rs[rowb + 16 * m + fr]; yg[m] = tof(acc[ai][0][m][n]) * (csg * rsv); yu[m] = tof(acc[ai][1][m][n]) * (csu * rsv); }
                if (fr < 2 || fr >= 14) { const bool lo = fr < 2; bf16* yr = yb + ((size_t)(rowb >> 6) * 4 + (lo ? fr : fr - 12)) * NUP + colg;
                    const f32x4 a0 = lo ? yg[0] : yg[3], b0 = lo ? yu[0] : yu[3];
                    u32x2 w; w.x = cvt_pk_bf16(a0[0], a0[1]); w.y = cvt_pk_bf16(a0[2], a0[3]); *(u32x2*)yr = w;
                    w.x = cvt_pk_bf16(b0[0], b0[1]); w.y = cvt_pk_bf16(b0[2], b0[3]); *(u32x2*)(yr + HALF) = w; }
#pragma unroll
                for (int m = 0; m < 4; ++m) {
                    float o[4];
#pragma unroll
                    for (int e = 0; e < 4; ++e) {
                        const float gc = yg[m][e], uc = yu[m][e];
                        const float gsp = (m > 0 && fr == 15) ? yg[m > 0 ? m - 1 : 0][e] : gc, usp = (m > 0 && fr == 15) ? yu[m > 0 ? m - 1 : 0][e] : uc;
                        const float gsn = (m < 3 && fr == 0) ? yg[m < 3 ? m + 1 : 3][e] : gc, usn = (m < 3 && fr == 0) ? yu[m < 3 ? m + 1 : 3][e] : uc;
                        const float gp = dpp_from_prev_lane(gsp), up = dpp_from_prev_lane(usp), gn = dpp_from_next_lane(gsn), un = dpp_from_next_lane(usn);
                        const float ug = wg[0][e] * gp + wg[1][e] * gc + wg[2][e] * gn + bg[e];
                        const float uu = wu[0][e] * up + wu[1][e] * uc + wu[2][e] * un + bu[e];
                        o[e] = ug * fast_sigmoid(ug) * uu * oscale; }
                    const bool edge = (m == 0 && fr == 0) || (m == 3 && fr == 15);
                    if (!edge) { const size_t row = (size_t)(rowb + 16 * m + fr);
                        if (FP8_DOWN) *(unsigned*)(act + row * DFF + cg) = pack4_fp8(o[0], o[1], o[2], o[3]);
                        else { u32x2 w; w.x = cvt_pk_bf16(o[0], o[1]); w.y = cvt_pk_bf16(o[2], o[3]); *(u32x2*)((bf16*)act + row * DFF + cg) = w; } }
                }
                asm volatile("" ::: "memory");
            }
        }
    }
};
}

namespace att {
constexpr int OFF_V = 0, SHM_V = 16384, OFF_K = 32768, KROW = 144  , SHM_KP = 64 * KROW, OFF_WS = 32768 + 2 * 3 * SHM_KP, OFF_TBL = OFF_WS + 2048, OFF_QR = OFF_TBL + 1056, LDS_END = OFF_QR + 256 * KROW;
#define SBAR() __builtin_amdgcn_sched_barrier(0)
__device__ __forceinline__ int crow(int r, int hi) { return (r & 3) + 8 * (r >> 2) + 4 * hi; }
__device__ __forceinline__ int kswz(int row, int colB) { return row * KROW + colB; }
__device__ __forceinline__ int v_st(int k, int c) { const int kk = (k & ~0xC) | ((k & 4) << 1) | ((k & 8) >> 1); return ((kk >> 3) * 4 + (c >> 5)) * 512 + ((kk & 7) * 32 + (c & 31)) * 2; }
__device__ __forceinline__ int v_rd_base(int lane) { return ((lane & 3) << 3) | (((lane >> 2) & 3) << 6) | (((lane >> 4) & 1) << 5) | (((lane >> 5) & 1) << 8); }
constexpr int v_rd_off(int d0, int ks, int half) { return d0 * 512 + ks * 4096 + half * 2048; }
template <int OFF> __device__ __forceinline__ s16x4 tr_read(int vb) { s16x4 r; asm volatile("ds_read_b64_tr_b16 %0, %1 offset:%2" : "=&v"(r) : "v"(vb), "i"(OFF) : "memory"); return r; }
template <int D0> __device__ __forceinline__ void pv_one(f32x16& od, int vb, bf16x8 pa0, bf16x8 pa1, bf16x8 pa2, bf16x8 pa3) {
    const s16x4 l0 = tr_read<v_rd_off(D0, 0, 0)>(vb), h0 = tr_read<v_rd_off(D0, 0, 1)>(vb), l1 = tr_read<v_rd_off(D0, 1, 0)>(vb), h1 = tr_read<v_rd_off(D0, 1, 1)>(vb);
    const s16x4 l2 = tr_read<v_rd_off(D0, 2, 0)>(vb), h2 = tr_read<v_rd_off(D0, 2, 1)>(vb), l3 = tr_read<v_rd_off(D0, 3, 0)>(vb), h3 = tr_read<v_rd_off(D0, 3, 1)>(vb);
    asm volatile("s_waitcnt lgkmcnt(0)" ::: "memory"); SBAR();
#define PK(L, H) (bf16x8){L[0], L[1], L[2], L[3], H[0], H[1], H[2], H[3]}
    od = __builtin_amdgcn_mfma_f32_32x32x16_bf16(pa0, PK(l0, h0), od, 0, 0, 0);
    od = __builtin_amdgcn_mfma_f32_32x32x16_bf16(pa1, PK(l1, h1), od, 0, 0, 0);
    od = __builtin_amdgcn_mfma_f32_32x32x16_bf16(pa2, PK(l2, h2), od, 0, 0, 0);
    od = __builtin_amdgcn_mfma_f32_32x32x16_bf16(pa3, PK(l3, h3), od, 0, 0, 0);
#undef PK
}
__device__ __forceinline__ void pv_d0(f32x16* o, int vb, bf16x8 pa0, bf16x8 pa1, bf16x8 pa2, bf16x8 pa3) {
    pv_one<0>(o[0], vb, pa0, pa1, pa2, pa3); pv_one<1>(o[1], vb, pa0, pa1, pa2, pa3); pv_one<2>(o[2], vb, pa0, pa1, pa2, pa3); pv_one<3>(o[3], vb, pa0, pa1, pa2, pa3);
}
__device__ __forceinline__ float fma_s(float a, float s_uniform, float c) { float d; asm("v_fma_f32 %0, %1, %2, %3" : "=v"(d) : "v"(a), "s"(s_uniform), "v"(c)); return d; }
constexpr float THR2 = 8.0f * 1.4426950408889634f;
template <bool BIAS>
__device__ __forceinline__ void partialSM(f32x16& p0, f32x16& p1, float& m_reg, float& mn, float& alpha, float Cs, bool near, float bconst, int relbase, int hi, const LAS float* tbl) {
    float pmax;
    if (BIAS && near) {
#pragma unroll
        for (int r = 0; r < 16; ++r) { const int k = relbase + crow(r, hi);
            const int i0 = min(max(k, 0), 256), i1 = min(max(k + 32, 0), 256);
            p0[r] = fma_s(p0[r], Cs, tbl[i0]); p1[r] = fma_s(p1[r], Cs, tbl[i1]); }
        pmax = p0[0];
#pragma unroll
        for (int r = 1; r < 16; ++r) pmax = fmaxf(pmax, p0[r]);
#pragma unroll
        for (int r = 0; r < 16; ++r) pmax = fmaxf(pmax, p1[r]);
        { auto rr = __builtin_amdgcn_permlane32_swap(__float_as_uint(pmax), __float_as_uint(pmax), false, false); pmax = fmaxf(__uint_as_float(rr[0]), __uint_as_float(rr[1])); }
        if (__builtin_expect(__all(pmax - m_reg <= THR2), 1)) { mn = m_reg; alpha = 1.f; }
        else { mn = fmaxf(m_reg, pmax); alpha = __builtin_amdgcn_exp2f(m_reg - mn); m_reg = mn; }
#pragma unroll
        for (int r = 0; r < 16; ++r) { p0[r] = p0[r] - mn; p1[r] = p1[r] - mn; }
    } else {
        pmax = p0[0];
#pragma unroll
        for (int r = 1; r < 16; ++r) pmax = fmaxf(pmax, p0[r]);
#pragma unroll
        for (int r = 0; r < 16; ++r) pmax = fmaxf(pmax, p1[r]);
        { auto rr = __builtin_amdgcn_permlane32_swap(__float_as_uint(pmax), __float_as_uint(pmax), false, false); pmax = fmaxf(__uint_as_float(rr[0]), __uint_as_float(rr[1])); }
        pmax = fmaf(pmax, Cs, bconst);
        if (__builtin_expect(__all(pmax - m_reg <= THR2), 1)) { mn = m_reg; alpha = 1.f; }
        else { mn = fmaxf(m_reg, pmax); alpha = __builtin_amdgcn_exp2f(m_reg - mn); m_reg = mn; }
        const float off = bconst - mn;
#pragma unroll
        for (int r = 0; r < 16; ++r) { p0[r] = fma_s(p0[r], Cs, off); p1[r] = fma_s(p1[r], Cs, off); }
    }
#pragma unroll
    for (int r = 0; r < 16; ++r) p0[r] = __builtin_amdgcn_exp2f(p0[r]);
}
__device__ __forceinline__ void partialSM_ci(f32x16& p0, f32x16& p1, float& m_reg, float& alpha, f32x16& csp, bool first, bool near, float bcur, int relbase, int hi, const LAS float* tbl) {
    if (near) {
#pragma unroll
        for (int r = 0; r < 16; ++r) { const int k = relbase + crow(r, hi); const int i0 = min(max(k, 0), 256), i1 = min(max(k + 32, 0), 256);
            p0[r] += tbl[i0] - bcur; p1[r] += tbl[i1] - bcur; }
    }
    float pmax = p0[0];
#pragma unroll
    for (int r = 1; r < 16; ++r) pmax = fmaxf(pmax, p0[r]);
#pragma unroll
    for (int r = 0; r < 16; ++r) pmax = fmaxf(pmax, p1[r]);
    { auto rr = __builtin_amdgcn_permlane32_swap(__float_as_uint(pmax), __float_as_uint(pmax), false, false); pmax = fmaxf(__uint_as_float(rr[0]), __uint_as_float(rr[1])); }
    if (__builtin_expect(!first && __all(pmax <= THR2), 1)) { alpha = 1.f; }
    else { const float d = first ? pmax : fmaxf(pmax, 0.f); alpha = __builtin_amdgcn_exp2f(-d); m_reg += d;
#pragma unroll
        for (int r = 0; r < 16; ++r) { p0[r] -= d; p1[r] -= d; csp[r] -= d; } }
#pragma unroll
    for (int r = 0; r < 16; ++r) p0[r] = __builtin_amdgcn_exp2f(p0[r]);
}
__device__ __forceinline__ void finishSM(f32x16& p0, f32x16& p1, float alpha, float& l_reg, bf16x8& pa0, bf16x8& pa1, bf16x8& pa2, bf16x8& pa3) {
#pragma unroll
    for (int r = 0; r < 16; ++r) p1[r] = __builtin_amdgcn_exp2f(p1[r]);
    float ps = 0;
#pragma unroll
    for (int r = 0; r < 16; ++r) ps += p0[r];
#pragma unroll
    for (int r = 0; r < 16; ++r) ps += p1[r];
    { auto rr = __builtin_amdgcn_permlane32_swap(__float_as_uint(ps), __float_as_uint(ps), false, false); ps = __uint_as_float(rr[0]) + __uint_as_float(rr[1]); }
    l_reg = l_reg * alpha + ps;
#define PK4(P, BASE, OUT) do { unsigned a0 = cvt_pk_bf16(P[BASE + 0], P[BASE + 1]), a1 = cvt_pk_bf16(P[BASE + 2], P[BASE + 3]);   \
    unsigned b0 = cvt_pk_bf16(P[BASE + 4], P[BASE + 5]), b1 = cvt_pk_bf16(P[BASE + 6], P[BASE + 7]);                              \
    auto r0 = __builtin_amdgcn_permlane32_swap(a0, b0, false, false); auto r1 = __builtin_amdgcn_permlane32_swap(a1, b1, false, false); \
    u32x4 w = {r0[0], r1[0], r0[1], r1[1]}; OUT = *reinterpret_cast<bf16x8*>(&w); } while (0)
    PK4(p0, 0, pa0); PK4(p0, 8, pa1); PK4(p1, 0, pa2); PK4(p1, 8, pa3);
#undef PK4
}
template <int NP>
__device__ __forceinline__ void qkt(f32x16& p0, f32x16& p1, const LAS char* Ks, const bf16x8* qr, const LAS char* qrl, int r32, int hi, const f32x16& cinit) {
    p0 = cinit; p1 = cinit;
#pragma unroll
    for (int p = 0; p < NP; ++p)
#pragma unroll
        for (int d0 = 0; d0 < 4; ++d0) { const int cb = d0 * 32 + hi * 16;
            bf16x8 b0 = *(const LAS bf16x8*)(Ks + p * SHM_KP + kswz(r32, cb));
            bf16x8 b1 = *(const LAS bf16x8*)(Ks + p * SHM_KP + kswz(32 + r32, cb));
            const bf16x8 qf = (NP == 3 && p == 2) ? *(const LAS bf16x8*)(qrl + d0 * 32) : qr[p * 4 + d0];
            p0 = __builtin_amdgcn_mfma_f32_32x32x16_bf16(b0, qf, p0, 0, 0, 0);
            p1 = __builtin_amdgcn_mfma_f32_32x32x16_bf16(b1, qf, p1, 0, 0, 0); }
}
struct Ptrs { const bf16* q[3]; const bf16* k[3]; const bf16* v; };
struct StrDiff { static constexpr int LDQ = NIN, LDK = NIN, LDK2 = NIN, LDV = NIN; };
struct StrMla { static constexpr int LDQ = NQ, LDK = NKV, LDK2 = NIN, LDV = NKV; };
template <int NP, bool BIAS, int SDEPTH, class STR>
__device__ __forceinline__ void attn_body(const Ptrs& P, int seq, int qpos0, float Cs, LAS char* lds, f32x16 (&o)[4], int tid_in) {
    int tid = tid_in; asm volatile("" : "+v"(tid));
    const int wid = __builtin_amdgcn_readfirstlane(tid >> 6), lane = tid & 63, r32 = lane & 31, hi = lane >> 5;
    LAS char* V_lds = lds + OFF_V; LAS char* K_lds = lds + OFF_K;
    LAS float* wsl = (LAS float*)(lds + OFF_WS) + wid * 64; LAS float* li_l = wsl; LAS float* al_l = wsl + 32;
    const LAS float* tbl = (const LAS float*)(lds + OFF_TBL);
    constexpr int KB = NP * SHM_KP;
    constexpr bool CI = BIAS && (ATT_CINIT != 0);
    float m_reg = CI ? 0.f : -1e30f, l_reg = 0;
#pragma unroll
    for (int d = 0; d < 4; ++d) o[d] = f32x16{};
    constexpr int NPR = (NP == 3) ? 2 : NP;
    bf16x8 qr[NPR * 4];
#pragma unroll
    for (int p = 0; p < NPR; ++p)
#pragma unroll
        for (int d0 = 0; d0 < 4; ++d0) qr[p * 4 + d0] = *reinterpret_cast<const bf16x8*>(P.q[p] + (long)(wid * 32 + r32) * STR::LDQ + hi * 8 + d0 * 16);
    LAS char* qrl = lds + OFF_QR + (wid * 32 + r32) * KROW + hi * 16;
    if constexpr (NP == 3) {
#pragma unroll
        for (int d0 = 0; d0 < 4; ++d0) *(LAS bf16x8*)(qrl + d0 * 32) = *reinterpret_cast<const bf16x8*>(P.q[2] + (long)(wid * 32 + r32) * STR::LDQ + hi * 8 + d0 * 16);
    }
    const int kr = tid >> 3, kc = tid & 7, kst = kswz(kr, kc * 16);
    const int sr = tid >> 4, sc = (tid & 15) * 8, vst0 = v_st(sr, sc), vst1 = v_st(32 + sr, sc);
    const int vb0 = (int)(uintptr_t)V_lds + v_rd_base(lane);
    const int qlo = qpos0 + wid * 32;
    const float bL = BIAS ? tbl[0] : 0.f, bR = BIAS ? tbl[256] : 0.f;
    f32x16 csp = f32x16{}; float bcur = bL;
    if constexpr (CI) {
#pragma unroll
        for (int r = 0; r < 16; ++r) csp[r] = bL; }
    struct { bf16x8 vs0, vs1, ks[NP]; } st_[SDEPTH];
#define SLOAD(i, k0) do { st_[i].vs0 = *reinterpret_cast<const bf16x8*>(P.v + (long)((k0) + sr) * STR::LDV + sc); st_[i].vs1 = *reinterpret_cast<const bf16x8*>(P.v + (long)((k0) + 32 + sr) * STR::LDV + sc); \
    _Pragma("unroll") for (int p_ = 0; p_ < NP; ++p_) st_[i].ks[p_] = *reinterpret_cast<const bf16x8*>(P.k[p_] + (long)((k0) + kr) * (p_ == 2 ? STR::LDK2 : STR::LDK) + kc * 8); } while (0)
#define SWRITE(b, i) do { *(LAS bf16x8*)(V_lds + (b) * SHM_V + vst0) = st_[i].vs0; *(LAS bf16x8*)(V_lds + (b) * SHM_V + vst1) = st_[i].vs1; \
    _Pragma("unroll") for (int p_ = 0; p_ < NP; ++p_) *(LAS bf16x8*)(K_lds + (b) * KB + p_ * SHM_KP + kst) = st_[i].ks[p_]; } while (0)
#define SWAIT() do { if constexpr (SDEPTH == 2) { if constexpr (NP == 1) asm volatile("s_waitcnt vmcnt(3)" ::: "memory"); else asm volatile("s_waitcnt vmcnt(5)" ::: "memory"); } else asm volatile("s_waitcnt vmcnt(0)" ::: "memory"); } while (0)
#define RESC(a) do { if (__any((a) < 1.f)) { if (hi == 0) al_l[r32] = (a); asm volatile("s_waitcnt lgkmcnt(0)" ::: "memory"); \
    _Pragma("unroll") for (int d = 0; d < 4; ++d) _Pragma("unroll") for (int r = 0; r < 16; ++r) o[d][r] *= al_l[crow(r, hi)]; } } while (0)
#define TILEB(j, nearv, bcv, rbv) const int _rh##j = (j) * 64 + 63 - qlo, _rl##j = (j) * 64 - (qlo + 31); \
    const bool nearv = BIAS && (_rh##j > -128) && (_rl##j < 128); const float bcv = (_rh##j <= -128) ? bL : bR; const int rbv = (j) * 64 - (qlo + r32) + 128
#define CLS(nearv, bcv) do { if constexpr (CI) { if (!(nearv) && (bcv) != bcur) { const float _dl = (bcv) - bcur; _Pragma("unroll") for (int r = 0; r < 16; ++r) csp[r] += _dl; bcur = (bcv); } } } while (0)
#define PSM(P0, P1, MN, AL, first, nearv, bcv, rbv) do { if constexpr (CI) { partialSM_ci(P0, P1, m_reg, AL, csp, first, nearv, bcur, rbv, hi, tbl); MN = 0.f; } \
        else partialSM<BIAS>(P0, P1, m_reg, MN, AL, Cs, nearv, bcv, rbv, hi, tbl); } while (0)
    f32x16 pA0, pA1, pB0, pB1; float mnA, mnB, alA, alB; bf16x8 pa0, pa1, pa2, pa3; const int NT = seq / 64;
    constexpr int SE = 0, SO = SDEPTH - 1;
    SLOAD(SE, 0); asm volatile("s_waitcnt vmcnt(0)" ::: "memory"); SWRITE(0, SE); __syncthreads();
    { const int jj = 0; TILEB(jj, nr, bc, rb); CLS(nr, bc); qkt<NP>(pA0, pA1, K_lds, qr, qrl, r32, hi, csp); PSM(pA0, pA1, mnA, alA, true, nr, bc, rb); }
    SLOAD(SO, 64); if constexpr (SDEPTH == 2) { if (2 < NT) SLOAD(SE, 128); }
    SWAIT(); SWRITE(1, SO); __syncthreads();
    for (int j = 1; j + 1 < NT; j += 2) {
        TILEB(j, nrB, bcB, rbB); CLS(nrB, bcB);
        SBAR(); qkt<NP>(pB0, pB1, K_lds + KB, qr, qrl, r32, hi, csp);
        finishSM(pA0, pA1, alA, l_reg, pa0, pa1, pa2, pa3); SBAR();
        SLOAD(SO, (j + SDEPTH) * 64); SBAR();
        pv_d0(o, vb0, pa0, pa1, pa2, pa3);
        PSM(pB0, pB1, mnB, alB, false, nrB, bcB, rbB);
        __syncthreads(); SWAIT(); SWRITE(0, SE);
        RESC(alB); __syncthreads();
        const int j1 = j + 1; TILEB(j1, nrA, bcA, rbA); CLS(nrA, bcA);
        SBAR(); qkt<NP>(pA0, pA1, K_lds, qr, qrl, r32, hi, csp);
        finishSM(pB0, pB1, alB, l_reg, pa0, pa1, pa2, pa3); SBAR();
        if (SDEPTH == 1 || j + 3 < NT) SLOAD(SE, (j + 1 + SDEPTH) * 64); SBAR();
        pv_d0(o, vb0 + SHM_V, pa0, pa1, pa2, pa3);
        PSM(pA0, pA1, mnA, alA, false, nrA, bcA, rbA);
        __syncthreads(); SWAIT(); SWRITE(1, SO);
        RESC(alA); __syncthreads();
    }
    const int jl = NT - 1; TILEB(jl, nrL, bcL, rbL); CLS(nrL, bcL);
    SBAR(); qkt<NP>(pB0, pB1, K_lds + KB, qr, qrl, r32, hi, csp);
    finishSM(pA0, pA1, alA, l_reg, pa0, pa1, pa2, pa3); SBAR();
    pv_d0(o, vb0, pa0, pa1, pa2, pa3);
    PSM(pB0, pB1, mnB, alB, false, nrL, bcL, rbL);
    __syncthreads(); RESC(alB);
    finishSM(pB0, pB1, alB, l_reg, pa0, pa1, pa2, pa3); SBAR();
    pv_d0(o, vb0 + SHM_V, pa0, pa1, pa2, pa3);
    if (hi == 0) li_l[r32] = l_reg; asm volatile("s_waitcnt lgkmcnt(0)" ::: "memory");
#pragma unroll
    for (int r = 0; r < 16; ++r) { const float rl = __builtin_amdgcn_rcpf(li_l[crow(r, hi)]);
#pragma unroll
        for (int d = 0; d < 4; ++d) o[d][r] *= rl; }
    __syncthreads();
#undef SLOAD
#undef SWRITE
#undef SWAIT
#undef RESC
#undef TILEB
#undef CLS
#undef PSM
}
}

constexpr int NWAVES = 8;
constexpr int CW_BAR = 4096;
constexpr int RING_BYTES = 131072, MISC_OFF = RING_BYTES + 320, LDS_BYTES = 147456;
static_assert(att::LDS_END <= RING_BYTES, "attention LDS");

#define XB_TMO      128
#define XB_XCNT(j)  (256  + 64 * (j))
#define XB_XSUB(j)  (1280 + 64 * (j))
#define XB_XGEN(j)  (2304 + 64 * (j))
#define XB_TOP      3328
#define XB_TOPGEN   3392
#define XCD_BAR_WORDS 3456
#define XB_SPIN_CAP (1u << 21)
__device__ __forceinline__ unsigned xb_ld(unsigned* p)              { return __hip_atomic_load(p, __ATOMIC_RELAXED, __HIP_MEMORY_SCOPE_AGENT); }
__device__ __forceinline__ unsigned xb_add(unsigned* p, unsigned v) { return __hip_atomic_fetch_add(p, v, __ATOMIC_RELAXED, __HIP_MEMORY_SCOPE_AGENT); }
__device__ __forceinline__ unsigned xb_xcc_id() { return (unsigned)__builtin_amdgcn_s_getreg((3 << 11) | 20) & 0xFu; }
#define XB_SPIN(cond, bar) do { unsigned _sp = 0; while (cond) { __builtin_amdgcn_s_sleep(1); \
    if ((++_sp & 255u) == 0u) { if (xb_ld(&(bar)[XB_TMO])) break; if (_sp > XB_SPIN_CAP) { atomicAdd(&(bar)[XB_TMO], 1u); break; } } } } while (0)
struct XcdBarrier { unsigned* bar; unsigned x; volatile LAS unsigned* st; };
__device__ __forceinline__ XcdBarrier xcd_barrier_post(unsigned* bar, volatile LAS unsigned* st, bool leader) {
    XcdBarrier b; b.bar = bar; b.x = xb_xcc_id(); b.st = st;
    if (leader) (void)xb_add(&bar[XB_XCNT(b.x)], 1u);
    return b;
}
__device__ __forceinline__ void xcd_barrier_complete(unsigned* bar, unsigned x, unsigned& nloc, unsigned& nx) {
    const unsigned G = gridDim.x * gridDim.y * gridDim.z;
    unsigned sum, cnt, mine, sp = 0u;
    for (;;) {
        sum = 0u; cnt = 0u; mine = 0u;
#pragma unroll
        for (unsigned j = 0; j < 16; ++j) { const unsigned c = xb_ld(&bar[XB_XCNT(j)]); sum += c; cnt += (c > 0u) ? 1u : 0u; mine = (j == x) ? c : mine; }
        if (sum == G) break;
        __builtin_amdgcn_s_sleep(1);
        if ((++sp & 255u) == 0u) { if (xb_ld(&bar[XB_TMO])) break; if (sp > XB_SPIN_CAP) { atomicAdd(&bar[XB_TMO], 1u); break; } }
    }
    nloc = mine > 0u ? mine : 1u; nx = cnt > 0u ? cnt : 1u;
}
__device__ __forceinline__ void xcd_barrier(const XcdBarrier& b, bool leader) {
    asm volatile("s_waitcnt vmcnt(0)" ::: "memory");
    __syncthreads();
    if (leader) {
        unsigned* bar = b.bar;
        __builtin_amdgcn_s_waitcnt(0);
        unsigned nloc = b.st[0], nx = b.st[1];
        if (nloc == 0u) { xcd_barrier_complete(bar, b.x, nloc, nx); b.st[0] = nloc; b.st[1] = nx; }
        const unsigned old = xb_add(&bar[XB_XSUB(b.x)], 1u);
        const unsigned gen = old / nloc;
        if (old + 1u == (gen + 1u) * nloc) {
            __builtin_amdgcn_fence(__ATOMIC_RELEASE, "agent");
            asm volatile("s_waitcnt vmcnt(0)" ::: "memory");
            const unsigned og = xb_add(&bar[XB_TOP], 1u);
            const unsigned tg = og / nx;
            if (og + 1u == (tg + 1u) * nx) xb_add(&bar[XB_TOPGEN], 1u);
            else XB_SPIN(xb_ld(&bar[XB_TOPGEN]) == tg, bar);
            __builtin_amdgcn_fence(__ATOMIC_ACQUIRE, "agent");
            xb_add(&bar[XB_XGEN(b.x)], 1u);
            asm volatile("s_waitcnt vmcnt(0)" ::: "memory");
        } else {
            XB_SPIN(xb_ld(&bar[XB_XGEN(b.x)]) == gen, bar);
            __builtin_amdgcn_fence(__ATOMIC_ACQUIRE, "agent");
            asm volatile("s_waitcnt vmcnt(0)" ::: "memory");
        }
    }
    __syncthreads();
}

#define LDS_WAIT() asm volatile("s_waitcnt lgkmcnt(0)" ::: "memory")
template <int X> __device__ __forceinline__ float swz_xor(float v) { return __int_as_float(__builtin_amdgcn_ds_swizzle(__float_as_int(v), (X << 10) | 0x1f)); }
__device__ __forceinline__ float half_sum(float v) { v += swz_xor<1>(v); v += swz_xor<2>(v); v += swz_xor<4>(v); v += swz_xor<8>(v); v += swz_xor<16>(v); return v; }
__device__ __forceinline__ float wave_max(float v) {
    v = __builtin_fmaxf(v, swz_xor<1>(v)); v = __builtin_fmaxf(v, swz_xor<2>(v)); v = __builtin_fmaxf(v, swz_xor<4>(v)); v = __builtin_fmaxf(v, swz_xor<8>(v)); v = __builtin_fmaxf(v, swz_xor<16>(v));
    auto rr = __builtin_amdgcn_permlane32_swap(__float_as_uint(v), __float_as_uint(v), false, false);
    return __builtin_fmaxf(__uint_as_float(rr[0]), __uint_as_float(rr[1]));
}
__device__ __forceinline__ float wave_sum(float v) {
    v = half_sum(v);
    auto rr = __builtin_amdgcn_permlane32_swap(__float_as_uint(v), __float_as_uint(v), false, false);
    return __uint_as_float(rr[0]) + __uint_as_float(rr[1]);
}

constexpr int NWAVES_ = 8;
template <int MODE, class SrcFn>
__device__ __forceinline__ void convert_strip(const float* W, int K, int N, unsigned char* WT, float* cs, int n0, float fscale, LAS float* lmax, int wave, int lane, SrcFn src) {
    const int rg = lane >> 3, cq = lane & 7, nchunk = K >> 7;
    int sc[4];
#pragma unroll
    for (int j = 0; j < 4; ++j) sc[j] = src(n0 + 4 * cq + j);
    const bool contig = __all(sc[0] >= 0 && (sc[0] & 3) == 0 && sc[1] == sc[0] + 1 && sc[2] == sc[0] + 2 && sc[3] == sc[0] + 3);
    auto ldrow = [&](int row) -> f32x4 {
        if (contig) return *(const f32x4*)(W + (size_t)row * N + sc[0]);
        f32x4 v;
#pragma unroll
        for (int j = 0; j < 4; ++j) v[j] = sc[j] >= 0 ? W[(size_t)row * N + sc[j]] : 0.f;
        return v; };
    f32x4 inv = (f32x4){fscale, fscale, fscale, fscale};
    if constexpr (MODE == 2) {
        f32x4 mx = (f32x4){0.f, 0.f, 0.f, 0.f};
        for (int c = wave; c < nchunk; c += NWAVES_) { f32x4 v[16];
#pragma unroll
            for (int i = 0; i < 16; ++i) v[i] = ldrow(c * 128 + 16 * rg + i);
#pragma unroll
            for (int i = 0; i < 16; ++i)
#pragma unroll
                for (int j = 0; j < 4; ++j) mx[j] = __builtin_fmaxf(mx[j], __builtin_fabsf(v[i][j])); }
#pragma unroll
        for (int j = 0; j < 4; ++j) { float m = mx[j]; m = __builtin_fmaxf(m, swz_xor<8>(m)); m = __builtin_fmaxf(m, swz_xor<16>(m));
            auto rr = __builtin_amdgcn_permlane32_swap(__float_as_uint(m), __float_as_uint(m), false, false); mx[j] = __builtin_fmaxf(__uint_as_float(rr[0]), __uint_as_float(rr[1])); }
        __syncthreads();
        if (lane < 8) *(LAS f32x4*)(lmax + wave * 32 + 4 * lane) = mx;
        __syncthreads();
        f32x4 cm = *(const LAS f32x4*)(lmax + 4 * cq);
#pragma unroll
        for (int w = 1; w < NWAVES_; ++w) { const f32x4 o = *(const LAS f32x4*)(lmax + w * 32 + 4 * cq);
#pragma unroll
            for (int j = 0; j < 4; ++j) cm[j] = __builtin_fmaxf(cm[j], o[j]); }
#pragma unroll
        for (int j = 0; j < 4; ++j) inv[j] = cm[j] > 0.f ? 127.f / cm[j] : 0.f;
        if (wave == 0 && lane < 8) *(f32x4*)(cs + n0 + 4 * lane) = cm * (1.f / 127.f);
    }
    constexpr int EB = (MODE == 0) ? 2 : 1; const size_t rowb = (size_t)K * EB;
    for (int c = wave; c < nchunk; c += NWAVES_) { f32x4 v[16];
#pragma unroll
        for (int i = 0; i < 16; ++i) v[i] = ldrow(c * 128 + 16 * rg + i) * inv;
#pragma unroll
        for (int j = 0; j < 4; ++j) { unsigned char* dst = WT + (size_t)(n0 + 4 * cq + j) * rowb + (size_t)(c * 128 + 16 * rg) * EB;
            if constexpr (MODE == 2) { u32x4 o; o.x = pack4_i8(v[0][j], v[1][j], v[2][j], v[3][j]); o.y = pack4_i8(v[4][j], v[5][j], v[6][j], v[7][j]); o.z = pack4_i8(v[8][j], v[9][j], v[10][j], v[11][j]); o.w = pack4_i8(v[12][j], v[13][j], v[14][j], v[15][j]); *(u32x4*)dst = o; }
            else if constexpr (MODE == 1) { u32x4 o; o.x = pack4_fp8(v[0][j], v[1][j], v[2][j], v[3][j]); o.y = pack4_fp8(v[4][j], v[5][j], v[6][j], v[7][j]); o.z = pack4_fp8(v[8][j], v[9][j], v[10][j], v[11][j]); o.w = pack4_fp8(v[12][j], v[13][j], v[14][j], v[15][j]); *(u32x4*)dst = o; }
            else { u32x4 o; o.x = cvt_pk_bf16(v[0][j], v[1][j]); o.y = cvt_pk_bf16(v[2][j], v[3][j]); o.z = cvt_pk_bf16(v[4][j], v[5][j]); o.w = cvt_pk_bf16(v[6][j], v[7][j]); *(u32x4*)dst = o;
                   o.x = cvt_pk_bf16(v[8][j], v[9][j]); o.y = cvt_pk_bf16(v[10][j], v[11][j]); o.z = cvt_pk_bf16(v[12][j], v[13][j]); o.w = cvt_pk_bf16(v[14][j], v[15][j]); *(u32x4*)(dst + 16) = o; } }
    }
}
__device__ __forceinline__ int t5_bucket(int rel) {
    const int ret = rel > 0 ? 16 : 0; const int n = rel < 0 ? -rel : rel;
    if (n < 8) return ret + n;
    int large = 2 + (31 - __builtin_clz((unsigned)(n * n)));
    large = large < 15 ? large : 15;
    return ret + large;
}
__device__ __forceinline__ void sincos_f32arg(float ang, float& c, float& s) {
    const double a = (double)ang; const double kq = __builtin_rint(a * 0.63661977236758134);
    double r = __builtin_fma(-kq, 1.5707963267948966, a); r = __builtin_fma(-kq, 6.123233995736766e-17, r);
    const int q = ((int)kq) & 3; const double r2 = r * r;
    const double sp = r * (1.0 + r2 * (-1.0 / 6 + r2 * (1.0 / 120 + r2 * (-1.0 / 5040 + r2 * (1.0 / 362880 + r2 * (-1.0 / 39916800))))));
    const double cp = 1.0 + r2 * (-0.5 + r2 * (1.0 / 24 + r2 * (-1.0 / 720 + r2 * (1.0 / 40320 + r2 * (-1.0 / 3628800 + r2 * (1.0 / 479001600))))));
    const double sv = (q == 0) ? sp : (q == 1) ? cp : (q == 2) ? -sp : -cp;
    const double cv = (q == 0) ? cp : (q == 1) ? -sp : (q == 2) ? -cp : sp;
    c = (float)cv; s = (float)sv;
}

struct Args { const float* in[23]; float* out; unsigned char* ws; float invf[32]; int lo, hi; };
typedef const __attribute__((address_space(4))) Args* ArgsP;

enum { I_XP = 0, I_XS, I_RELB, I_FNG, I_RAG, I_WIN, I_LQ1, I_LK1, I_LQ2, I_LK2, I_SUBG, I_QNG, I_WQUP, I_KVNG, I_WKVUP, I_WA, I_WB, I_WO, I_RFG, I_WUP, I_CW, I_CB, I_WD };

#define P_WINT ((bf16*)(ws + WS_WIN))
#define P_WQT ((bf16*)(ws + WS_WQ))
#define P_WKVT ((bf16*)(ws + WS_WKV))
#define P_WAT ((bf16*)(ws + WS_WA))
#define P_WBT ((bf16*)(ws + WS_WB))
#define P_WOT ((bf16*)(ws + WS_WO))
#define P_WUPT ((bf16*)(ws + WS_WUP))
#define P_WDT ((bf16*)(ws + WS_WD))
#define P_COS ((float*)(ws + WS_COS))
#define P_SIN ((float*)(ws + WS_SIN))
#define P_BIAS2 ((float*)(ws + WS_BIAS))
#define P_LAM ((float*)(ws + WS_LAM))
#define P_CSIN ((float*)(ws + WS_CSIN))
#define P_CSUP ((float*)(ws + WS_CSUP))
#define P_RSH ((float*)(ws + WS_RSH))
#define P_QL8 ((unsigned char*)(ws + WS_QL8))
#define P_KVL8 ((unsigned char*)(ws + WS_KVL8))
#define P_AO8 ((unsigned char*)(ws + WS_AO8))
#define P_BO8 ((unsigned char*)(ws + WS_BO8))
#define P_MG8 ((unsigned char*)(ws + WS_MG8))
#define P_X1 ((bf16*)(ws + WS_X1))
#define P_HF ((unsigned char*)(ws + WS_HF))
#define P_RSHF ((float*)(ws + WS_RSHF))
#define P_P ((bf16*)(ws + WS_P))
#define P_Q ((bf16*)(ws + WS_Q))
#define P_KV ((bf16*)(ws + WS_KV))
#define P_AO ((bf16*)(ws + WS_AO))
#define P_BO ((bf16*)(ws + WS_BO))
#define P_MG ((bf16*)(ws + WS_MG))
#define P_STASH ((float*)(ws + WS_STASH))
#define P_Y ((bf16*)(ws + WS_Y))
#define P_ACT ((bf16*)(ws + WS_ACTV))
#define XG() ((g < 2) ? A->in[I_XP] + (size_t)g * TG * DM : A->in[I_XS] + (size_t)(g - 2) * TG * DM)
#define OG() (A->out + (size_t)g * TG * DM)
constexpr int NSTEP_PER_GROUP = 7, NSTEPS = 1 + NGRP * NSTEP_PER_GROUP + 6;
static_assert(I8_MID, "step program written for the int8 mixer path");

__global__ void __launch_bounds__(NWAVES * 64, 2) enc_fwd(Args args) {
    extern __shared__ __attribute__((aligned(16))) unsigned char lds[];
    LAS unsigned char* ldsL = (LAS unsigned char*)lds;
    volatile LAS unsigned* MISC = (volatile LAS unsigned*)(ldsL + MISC_OFF);
    const int wave = __builtin_amdgcn_readfirstlane((int)threadIdx.x >> 6);
    const int G = gridDim.x; const int bx = blockIdx.x; const int vcu0 = (G % 8 == 0) ? (bx % 8) * (G / 8) + bx / 8 : bx;
    unsigned char* ws = args.ws;
    unsigned* ctl = (unsigned*)(ws + WS_CTL);
    { const int tid0 = wave * 64 + lane_id_fresh(); for (int u = tid0; u < (LDS_BYTES - RING_BYTES) / 4; u += NWAVES * 64) ((LAS unsigned*)(ldsL + RING_BYTES))[u] = 0u; }
    __syncthreads();
    XcdBarrier bar; bar.bar = ctl + CW_BAR; bar.x = 0; bar.st = nullptr;
#if !MK_PER_STEP_LAUNCH
    bar = xcd_barrier_post(ctl + CW_BAR, MISC + 8, (wave * 64 + lane_id_fresh()) == 0);
#endif
    const int lo = args.lo, hi = args.hi;
    int step = 0;
#ifndef EN_MASK
#define EN_MASK 0xFFFFFF
#endif
#define EN(k) (((EN_MASK) >> (k)) & 1)
#define RUN() (step >= lo && step < hi)
#define LOCAL_TID() ArgsP A = (ArgsP)__builtin_amdgcn_kernarg_segment_ptr(); asm volatile("" : "+s"(A)); unsigned char* const ws = A->ws; (void)ws; int lane_ = lane_id_fresh(); asm volatile("" : "+v"(lane_)); const int lane = lane_; const int tid = wave * 64 + lane; (void)tid; int gw = gw0, vcu = vcu0; asm volatile("" : "+s"(gw), "+s"(vcu)); (void)gw; (void)vcu
#if MK_PER_STEP_LAUNCH
#define SEAM() do { ++step; } while (0)
#else
#define SEAM() do { if (RUN() && step + 1 < hi) xcd_barrier(bar, (wave * 64 + lane_id_fresh()) == 0); ++step; } while (0)
#endif
    const int gw0 = vcu0 * NWAVES + wave, NGW = G * NWAVES;

    if (RUN() && EN(0)) { LOCAL_TID();
        LAS float* lmax = (LAS float*)ldsL;
        auto ident = [](int n) -> int { return n; };
        auto srcIn = [](int n) -> int { if (n < C_GATE) return n; if (n < C_KPE) return n + 64; if (n < C_KPE + 64) { const int j = n - C_KPE; return 7680 + ((j & 1) ? 32 + (j >> 1) : (j >> 1)); } return -1; };
        auto srcQ = [](int n) -> int { if (n < 2048) return (n >> 7) * 192 + (n & 127); const int j = n - 2048, hh = j >> 6, jj = j & 63; return hh * 192 + 128 + ((jj & 1) ? 32 + (jj >> 1) : (jj >> 1)); };
        auto srcUp = [](int n) -> int { return CONV_FUSE ? ((n & 128) ? DFF : 0) + (n >> 8) * 128 + (n & 127) : n; };
        constexpr int T0 = DM / 32, T1 = T0 + NIN / 32, T2 = T1 + NUP / 32, T3 = T2 + DM / 32, T4 = T3 + DM / 32, T5 = T4 + DM / 32, T6 = T5 + NQ / 32, T7 = T6 + NKV / 32;
        for (int s = vcu; s < T7; s += G) {
            if (s < T0) { const int n0 = 32 * s;
                if (FP8_DOWN) convert_strip<1>(A->in[I_WD], DFF, DM, (unsigned char*)P_WDT, nullptr, n0, S_WD, lmax, wave, lane, ident); else convert_strip<0>(A->in[I_WD], DFF, DM, (unsigned char*)P_WDT, nullptr, n0, 1.f, lmax, wave, lane, ident); }
            else if (s < T1) { const int n0 = 32 * (s - T0);
                if (I8_IN) convert_strip<2>(A->in[I_WIN], DM, 15936, (unsigned char*)P_WINT, P_CSIN, n0, 1.f, lmax, wave, lane, srcIn); else convert_strip<0>(A->in[I_WIN], DM, 15936, (unsigned char*)P_WINT, nullptr, n0, 1.f, lmax, wave, lane, srcIn); }
            else if (s < T2) { const int n0 = 32 * (s - T1);
                if (I8_UP) convert_strip<2>(A->in[I_WUP], DM, NUP, (unsigned char*)P_WUPT, P_CSUP, n0, 1.f, lmax, wave, lane, srcUp); else convert_strip<0>(A->in[I_WUP], DM, NUP, (unsigned char*)P_WUPT, nullptr, n0, 1.f, lmax, wave, lane, srcUp); }
            else if (s < T3) { const int n0 = 32 * (s - T2);
                if (I8_MID) convert_strip<2>(A->in[I_WO], DM, DM, (unsigned char*)P_WOT, (float*)(ws + WS_CSO), n0, 1.f, lmax, wave, lane, ident); else convert_strip<0>(A->in[I_WO], DM, DM, (unsigned char*)P_WOT, nullptr, n0, 1.f, lmax, wave, lane, ident); }
            else if (s < T4) { const int n0 = 32 * (s - T3);
                if (I8_MID) convert_strip<2>(A->in[I_WA], 2048, DM, (unsigned char*)P_WAT, (float*)(ws + WS_CSA), n0, 1.f, lmax, wave, lane, ident); else convert_strip<0>(A->in[I_WA], 2048, DM, (unsigned char*)P_WAT, nullptr, n0, 1.f, lmax, wave, lane, ident); }
            else if (s < T5) { const int n0 = 32 * (s - T4);
                if (I8_MID) convert_strip<2>(A->in[I_WB], 2048, DM, (unsigned char*)P_WBT, (float*)(ws + WS_CSB), n0, 1.f, lmax, wave, lane, ident); else convert_strip<0>(A->in[I_WB], 2048, DM, (unsigned char*)P_WBT, nullptr, n0, 1.f, lmax, wave, lane, ident); }
            else if (s < T6) { const int n0 = 32 * (s - T5);
                if (I8_MID) convert_strip<2>(A->in[I_WQUP], 1024, NQ, (unsigned char*)P_WQT, (float*)(ws + WS_CSQ), n0, 1.f, lmax, wave, lane, srcQ); else convert_strip<0>(A->in[I_WQUP], 1024, NQ, (unsigned char*)P_WQT, nullptr, n0, 1.f, lmax, wave, lane, srcQ); }
            else { const int n0 = 32 * (s - T6);
                if (I8_MID) convert_strip<2>(A->in[I_WKVUP], 512, NKV, (unsigned char*)P_WKVT, (float*)(ws + WS_CSKV), n0, 1.f, lmax, wave, lane, ident); else convert_strip<0>(A->in[I_WKVUP], 512, NKV, (unsigned char*)P_WKVT, nullptr, n0, 1.f, lmax, wave, lane, ident); }
        }
        for (int i = bx * (NWAVES * 64) + tid; i < 8192 * 32; i += G * NWAVES * 64) { const int pos = i >> 5, k = i & 31; float c, s; sincos_f32arg((float)pos * A->invf[k], c, s); P_COS[i] = c; P_SIN[i] = s; }
        if (bx == 0) {
            for (int i = tid; i < 16 * 257; i += NWAVES * 64) { const int h = i / 257, j = i % 257; P_BIAS2[h * 260 + j] = A->in[I_RELB][t5_bucket(j - 128) * 16 + h] * 1.4426950408889634f; }
            if (wave == 0) { const float a = wave_sum(A->in[I_LQ1][lane] * A->in[I_LK1][lane]), b = wave_sum(A->in[I_LQ2][lane] * A->in[I_LK2][lane]);
                if (lane == 0) P_LAM[0] = expf(a) - expf(b) + 0.2f; }
        }
    }

    if (RUN() && EN(1)) { LOCAL_TID();
        const float* gv = A->in[I_RAG];
        for (int m = gw; m < NTOK; m += NGW) {
            const f32x4* xr = (const f32x4*)((m < NTOK / 2 ? A->in[I_XP] + (size_t)m * DM : A->in[I_XS] + (size_t)(m - NTOK / 2) * DM)) + lane; f32x4 v[16]; float s = 0.f;
#pragma unroll
            for (int j = 0; j < 16; ++j) { v[j] = xr[64 * j]; s += (v[j].x * v[j].x + v[j].y * v[j].y) + (v[j].z * v[j].z + v[j].w * v[j].w); }
            const float rstd = 1.0f / sqrtf(wave_sum(s) * (1.f / DM) + EPS);
            if (I8_IN) { float mx = 0.f;
#pragma unroll
                for (int j = 0; j < 16; ++j) { const f32x4 gg = ((const f32x4*)gv)[64 * j + lane]; v[j] = v[j] * rstd * gg; mx = __builtin_fmaxf(__builtin_fmaxf(mx, __builtin_fmaxf(__builtin_fabsf(v[j].x), __builtin_fabsf(v[j].y))), __builtin_fmaxf(__builtin_fabsf(v[j].z), __builtin_fabsf(v[j].w))); }
                mx = wave_max(mx); const float inv = mx > 0.f ? 127.f / mx : 0.f; if (lane == 0) P_RSHF[m] = mx * (1.f / 127.f);
                unsigned* o4 = (unsigned*)(P_HF + (size_t)m * DM) + lane;
#pragma unroll
                for (int j = 0; j < 16; ++j) o4[64 * j] = pack4_i8(v[j].x * inv, v[j].y * inv, v[j].z * inv, v[j].w * inv);
            } else {
            u32x2* o8 = (u32x2*)((bf16*)P_HF + (size_t)m * DM) + lane;
#pragma unroll
            for (int j = 0; j < 16; ++j) { const f32x4 gg = ((const f32x4*)gv)[64 * j + lane]; u32x2 w; w.x = cvt_pk_bf16(v[j].x * rstd * gg.x, v[j].y * rstd * gg.y); w.y = cvt_pk_bf16(v[j].z * rstd * gg.z, v[j].w * rstd * gg.w); o8[64 * j] = w; }
            }
        }
    }
    SEAM();

    for (int g = 0; g < NGRP; ++g) {
        const int seqlen = (g < 2) ? 4096 : 8192, posmask = seqlen - 1;

        if (RUN() && EN(2)) { LOCAL_TID();
            pg8::Gemm gm{(const bf16*)(P_HF + (size_t)g * TG * DM), DM / 2, P_WINT, TG, NIN, DM / 2}; pg8::StaticOrder S; S.init(TG, NIN, G, bx);
            pg8::EpiStoreT<I8_IN != 0, WS_RSHF, WS_CSIN> E{P_P, NIN, C_GATE / 256, C_KPE / 256, ATT_CINIT ? CS_DIFF : 1.f, ws, g * TG};
            REP_LOOP_GEMM { int l2_ = lane_id_fresh(); asm volatile("" : "+v"(l2_)); pg8::gemm_phase<pg8::EpiStoreT<I8_IN != 0, WS_RSHF, WS_CSIN>, I8_IN ? 2 : 0>(ldsL, gm, S, E, wave * 64 + l2_); }
        }
        SEAM();

        if (RUN() && EN(3)) { LOCAL_TID();
            const float* gq = A->in[I_QNG]; const float* gkv = A->in[I_KVNG];
            for (int m = gw; m < TG; m += NGW) {
                bf16* prow = P_P + (size_t)m * NIN;
                { u32x4 a = *(const u32x4*)(prow + C_QLAT + lane * 8), b = *(const u32x4*)(prow + C_QLAT + 512 + lane * 8);
                  float x[16] = {bf_lo(a.x), bf_hi(a.x), bf_lo(a.y), bf_hi(a.y), bf_lo(a.z), bf_hi(a.z), bf_lo(a.w), bf_hi(a.w), bf_lo(b.x), bf_hi(b.x), bf_lo(b.y), bf_hi(b.y), bf_lo(b.z), bf_hi(b.z), bf_lo(b.w), bf_hi(b.w)};
                  float s = 0.f;
#pragma unroll
                  for (int j = 0; j < 16; ++j) s += x[j] * x[j];
                  const float rstd = 1.0f / sqrtf(wave_sum(s) * (1.f / 1024) + EPS);
                  const f32x4 g0 = *(const f32x4*)(gq + lane * 8), g1 = *(const f32x4*)(gq + lane * 8 + 4), g2 = *(const f32x4*)(gq + 512 + lane * 8), g3 = *(const f32x4*)(gq + 512 + lane * 8 + 4);
                  u32x4 oa, ob;
                  oa.x = cvt_pk_bf16(x[0] * rstd * g0.x, x[1] * rstd * g0.y); oa.y = cvt_pk_bf16(x[2] * rstd * g0.z, x[3] * rstd * g0.w); oa.z = cvt_pk_bf16(x[4] * rstd * g1.x, x[5] * rstd * g1.y); oa.w = cvt_pk_bf16(x[6] * rstd * g1.z, x[7] * rstd * g1.w);
                  ob.x = cvt_pk_bf16(x[8] * rstd * g2.x, x[9] * rstd * g2.y); ob.y = cvt_pk_bf16(x[10] * rstd * g2.z, x[11] * rstd * g2.w); ob.z = cvt_pk_bf16(x[12] * rstd * g3.x, x[13] * rstd * g3.y); ob.w = cvt_pk_bf16(x[14] * rstd * g3.z, x[15] * rstd * g3.w);
                  if (I8_MID) { float y[16]; float mx = 0.f; const float gg[16] = {g0.x, g0.y, g0.z, g0.w, g1.x, g1.y, g1.z, g1.w, g2.x, g2.y, g2.z, g2.w, g3.x, g3.y, g3.z, g3.w};
#pragma unroll
                      for (int j = 0; j < 16; ++j) { y[j] = x[j] * rstd * gg[j]; mx = __builtin_fmaxf(mx, __builtin_fabsf(y[j])); }
                      mx = wave_max(mx); const float inv = mx > 0.f ? 127.f / mx : 0.f; if (lane == 0) ((float*)(ws + WS_RSQL))[m] = mx * (1.f / 127.f);
                      u32x2 q0, q1; q0.x = pack4_i8(y[0] * inv, y[1] * inv, y[2] * inv, y[3] * inv); q0.y = pack4_i8(y[4] * inv, y[5] * inv, y[6] * inv, y[7] * inv);
                      q1.x = pack4_i8(y[8] * inv, y[9] * inv, y[10] * inv, y[11] * inv); q1.y = pack4_i8(y[12] * inv, y[13] * inv, y[14] * inv, y[15] * inv);
                      *(u32x2*)(P_QL8 + (size_t)m * 1024 + lane * 8) = q0; *(u32x2*)(P_QL8 + (size_t)m * 1024 + 512 + lane * 8) = q1;
                  } else { *(u32x4*)(prow + C_QLAT + lane * 8) = oa; *(u32x4*)(prow + C_QLAT + 512 + lane * 8) = ob; } }
                { u32x4 a = *(const u32x4*)(prow + C_KVLAT + lane * 8);
                  float x[8] = {bf_lo(a.x), bf_hi(a.x), bf_lo(a.y), bf_hi(a.y), bf_lo(a.z), bf_hi(a.z), bf_lo(a.w), bf_hi(a.w)};
                  float s = 0.f;
#pragma unroll
                  for (int j = 0; j < 8; ++j) s += x[j] * x[j];
                  const float rstd = 1.0f / sqrtf(wave_sum(s) * (1.f / 512) + EPS);
                  const f32x4 g0 = *(const f32x4*)(gkv + lane * 8), g1 = *(const f32x4*)(gkv + lane * 8 + 4);
                  u32x4 oa;
                  oa.x = cvt_pk_bf16(x[0] * rstd * g0.x, x[1] * rstd * g0.y); oa.y = cvt_pk_bf16(x[2] * rstd * g0.z, x[3] * rstd * g0.w); oa.z = cvt_pk_bf16(x[4] * rstd * g1.x, x[5] * rstd * g1.y); oa.w = cvt_pk_bf16(x[6] * rstd * g1.z, x[7] * rstd * g1.w);
                  if (I8_MID) { float y[8]; float mx = 0.f; const float gg[8] = {g0.x, g0.y, g0.z, g0.w, g1.x, g1.y, g1.z, g1.w};
#pragma unroll
                      for (int j = 0; j < 8; ++j) { y[j] = x[j] * rstd * gg[j]; mx = __builtin_fmaxf(mx, __builtin_fabsf(y[j])); }
                      mx = wave_max(mx); const float inv = mx > 0.f ? 127.f / mx : 0.f; if (lane == 0) ((float*)(ws + WS_RSKVL))[m] = mx * (1.f / 127.f);
                      u32x2 q0; q0.x = pack4_i8(y[0] * inv, y[1] * inv, y[2] * inv, y[3] * inv); q0.y = pack4_i8(y[4] * inv, y[5] * inv, y[6] * inv, y[7] * inv);
                      *(u32x2*)(P_KVL8 + (size_t)m * 512 + lane * 8) = q0;
                  } else *(u32x4*)(prow + C_KVLAT + lane * 8) = oa; }
                if (lane < 32) { const int pos = m & posmask; unsigned w = *(const unsigned*)(prow + C_KPE + 2 * lane); const float x1 = bf_lo(w), x2 = bf_hi(w);
                  const float c = P_COS[pos * 32 + lane], s = P_SIN[pos * 32 + lane];
                  *(unsigned*)(prow + C_KPE + 2 * lane) = cvt_pk_bf16(x1 * c - x2 * s, x1 * s + x2 * c); }
            }
        }
        SEAM();

        if (RUN() && EN(4)) { LOCAL_TID();
            if (EN(18)) { pg8::Gemm gm{I8_MID ? (const bf16*)P_QL8 : P_P + C_QLAT, I8_MID ? 512 : NIN, P_WQT, TG, NQ, I8_MID ? 512 : 1024}; pg8::StaticOrder S; S.init(TG, NQ, G, bx);
              pg8::EpiQT<I8_MID != 0> E{P_Q, NQ, ws, posmask}; REP_LOOP_GEMM { int l2_ = lane_id_fresh(); asm volatile("" : "+v"(l2_)); pg8::gemm_phase<pg8::EpiQT<I8_MID != 0>, I8_MID ? 2 : 0>(ldsL, gm, S, E, wave * 64 + l2_); } }
            if (EN(19)) { pg8::Gemm gm{I8_MID ? (const bf16*)P_KVL8 : P_P + C_KVLAT, I8_MID ? 256 : NIN, P_WKVT, TG, NKV, I8_MID ? 256 : 512}; pg8::StaticOrder S; S.init(TG, NKV, G, bx);
              pg8::EpiStoreT<I8_MID != 0, WS_RSKVL, WS_CSKV> E{P_KV, NKV, 0, 0, 1.f, ws, 0}; REP_LOOP_GEMM { int l2_ = lane_id_fresh(); asm volatile("" : "+v"(l2_)); pg8::gemm_phase<pg8::EpiStoreT<I8_MID != 0, WS_RSKVL, WS_CSKV>, I8_MID ? 2 : 0>(ldsL, gm, S, E, wave * 64 + l2_); } }
        }
        SEAM();

        if (RUN() && EN(5)) { LOCAL_TID();
            const int wid = wave;
            const float lam = P_LAM[0];
            if (EN(16)) _Pragma("unroll 1") for (int rep = 0; rep < REP_DIFF; ++rep) for (int u = vcu; u < 512; u += G) {
                const int head = u >> 5, rb = u & 31, row0 = rb * 256, kbase = (seqlen == 4096) ? (rb >> 4) * 4096 : 0, qpos0 = row0 - kbase;
                __syncthreads();
                if (tid < 257) ((float*)(lds + att::OFF_TBL))[tid] = P_BIAS2[head * 260 + tid];
                __syncthreads();
#pragma unroll 1
                for (int c = 0; c < 2; ++c) {
                    att::Ptrs P;
                    P.q[0] = P_P + (size_t)row0 * NIN + C_DQ + head * 128 + c * 64; P.q[1] = P.q[0]; P.q[2] = P.q[0];
                    P.k[0] = P_P + (size_t)kbase * NIN + C_DK + head * 128 + c * 64; P.k[1] = P.k[0]; P.k[2] = P.k[0];
                    P.v = P_P + (size_t)kbase * NIN + C_DV + head * 128;
                    f32x16 o[4];
                    att::attn_body<1, true, 2, att::StrDiff>(P, seqlen, qpos0, 0.125f * 1.4426950408889634f, (LAS char*)ldsL, o, tid);
                    int tid_e = tid; asm volatile("" : "+v"(tid_e));
                    const int r32 = tid_e & 31, hh = (tid_e >> 5) & 1;
                    f32x4* myst = (f32x4*)(P_STASH + ((size_t)bx * 512 + tid_e) * 64);
                    if (c == 0) {
#pragma unroll
                        for (int d = 0; d < 4; ++d)
#pragma unroll
                            for (int r4 = 0; r4 < 4; ++r4) myst[d * 4 + r4] = (f32x4){o[d][4 * r4], o[d][4 * r4 + 1], o[d][4 * r4 + 2], o[d][4 * r4 + 3]};
                    } else {
                        float ss[16];
#pragma unroll
                        for (int r = 0; r < 16; ++r) ss[r] = 0.f;
#pragma unroll
                        for (int d = 0; d < 4; ++d)
#pragma unroll
                            for (int r4 = 0; r4 < 4; ++r4) { const f32x4 s0 = myst[d * 4 + r4];
#pragma unroll
                                for (int j = 0; j < 4; ++j) { const float a = s0[j] - lam * o[d][4 * r4 + j]; o[d][4 * r4 + j] = a; ss[4 * r4 + j] += a * a; } }
#pragma unroll
                        for (int r = 0; r < 16; ++r) ss[r] = 0.8f / sqrtf(half_sum(ss[r]) * (1.f / 128) + EPS);
                        const float* sg = A->in[I_SUBG];
                        float gsub[4];
#pragma unroll
                        for (int d = 0; d < 4; ++d) gsub[d] = sg[d * 32 + r32];
#pragma unroll
                        for (int r = 0; r < 16; ++r) { bf16* orow = P_AO + (size_t)(row0 + wid * 32 + att::crow(r, hh)) * 2048 + head * 128 + r32;
#pragma unroll
                            for (int d = 0; d < 4; ++d) orow[d * 32] = (bf16)(cvt_pk_bf16(o[d][r] * ss[r] * gsub[d], 0.f) & 0xffffu); }
                    }
                }
            }
            if (EN(17)) _Pragma("unroll 1") for (int rep = 0; rep < REP_MLA; ++rep) for (int u = vcu; u < 512; u += G) {
                const int head = u >> 5, rb = u & 31, row0 = rb * 256, kbase = (seqlen == 4096) ? (rb >> 4) * 4096 : 0;
                att::Ptrs P;
                P.q[0] = P_Q + (size_t)row0 * NQ + head * 128; P.q[1] = P.q[0] + 64; P.q[2] = P_Q + (size_t)row0 * NQ + 2048 + head * 64;
                P.k[0] = P_KV + (size_t)kbase * NKV + head * 256; P.k[1] = P.k[0] + 64; P.k[2] = P_P + (size_t)kbase * NIN + C_KPE;
                P.v = P_KV + (size_t)kbase * NKV + head * 256 + 128;
                f32x16 o[4];
                att::attn_body<3, false, 1, att::StrMla>(P, seqlen, 0, 0.07216878364870323f * 1.4426950408889634f, (LAS char*)ldsL, o, tid);
                int tid_e = tid; asm volatile("" : "+v"(tid_e));
                const int r32 = tid_e & 31, hh = (tid_e >> 5) & 1;
#pragma unroll
                for (int r = 0; r < 16; ++r) { bf16* orow = P_BO + (size_t)(row0 + wid * 32 + att::crow(r, hh)) * 2048 + head * 128 + r32;
#pragma unroll
                    for (int d = 0; d < 4; ++d) orow[d * 32] = (bf16)(cvt_pk_bf16(o[d][r], 0.f) & 0xffffu); }
            }
        }
        SEAM();

#if I8_MID
        if (RUN()) { LOCAL_TID();
            for (int m = gw; m < 2 * TG; m += NGW) { const int row = m >> 1; const bool isB = m & 1;
                const bf16* srow = (isB ? P_BO : P_AO) + (size_t)row * 2048 + lane * 8; u32x4 a[4]; float mx = 0.f;
#pragma unroll
                for (int j = 0; j < 4; ++j) { a[j] = *(const u32x4*)(srow + 512 * j);
                    mx = __builtin_fmaxf(mx, __builtin_fmaxf(__builtin_fmaxf(__builtin_fmaxf(__builtin_fabsf(bf_lo(a[j].x)), __builtin_fabsf(bf_hi(a[j].x))), __builtin_fmaxf(__builtin_fabsf(bf_lo(a[j].y)), __builtin_fabsf(bf_hi(a[j].y)))),
                                                      __builtin_fmaxf(__builtin_fmaxf(__builtin_fabsf(bf_lo(a[j].z)), __builtin_fabsf(bf_hi(a[j].z))), __builtin_fmaxf(__builtin_fabsf(bf_lo(a[j].w)), __builtin_fabsf(bf_hi(a[j].w)))))); }
                mx = wave_max(mx); const float inv = mx > 0.f ? 127.f / mx : 0.f; if (lane == 0) ((float*)(ws + (isB ? WS_RSB : WS_RSA)))[row] = mx * (1.f / 127.f);
                unsigned char* drow = (isB ? P_BO8 : P_AO8) + (size_t)row * 2048 + lane * 8;
#pragma unroll
                for (int j = 0; j < 4; ++j) { u32x2 q; q.x = pack4_i8(bf_lo(a[j].x) * inv, bf_hi(a[j].x) * inv, bf_lo(a[j].y) * inv, bf_hi(a[j].y) * inv); q.y = pack4_i8(bf_lo(a[j].z) * inv, bf_hi(a[j].z) * inv, bf_lo(a[j].w) * inv, bf_hi(a[j].w) * inv); *(u32x2*)(drow + 512 * j) = q; }
            }
        }
        SEAM();
#endif

        if (RUN() && EN(6)) { LOCAL_TID();
            if (EN(20)) { pg8::Gemm gm{I8_MID ? (const bf16*)P_AO8 : P_AO, I8_MID ? 1024 : 2048, P_WAT, TG, DM, I8_MID ? 1024 : 2048}; pg8::StaticOrder S; S.init(TG, DM, G, bx);
              pg8::EpiGateAT<I8_MID != 0> E{P_MG, DM, P_P + C_GATE, NIN, ws}; REP_LOOP_GEMM { int l2_ = lane_id_fresh(); asm volatile("" : "+v"(l2_)); pg8::gemm_phase<pg8::EpiGateAT<I8_MID != 0>, I8_MID ? 2 : 0>(ldsL, gm, S, E, wave * 64 + l2_); } }
            if (EN(21)) { pg8::Gemm gm{I8_MID ? (const bf16*)P_BO8 : P_BO, I8_MID ? 1024 : 2048, P_WBT, TG, DM, I8_MID ? 1024 : 2048}; pg8::StaticOrder S; S.init(TG, DM, G, bx);
              pg8::EpiGateBT<I8_MID != 0> E{P_MG, DM, P_P + C_GATE + DM, NIN, P_MG, DM, ws}; REP_LOOP_GEMM { int l2_ = lane_id_fresh(); asm volatile("" : "+v"(l2_)); pg8::gemm_phase<pg8::EpiGateBT<I8_MID != 0>, I8_MID ? 2 : 0>(ldsL, gm, S, E, wave * 64 + l2_); } }
        }
        SEAM();

#if I8_MID
        if (RUN()) { LOCAL_TID();
            for (int m = gw; m < TG; m += NGW) {
                const bf16* srow = P_MG + (size_t)m * DM + lane * 8; u32x4 a[8]; float mx = 0.f;
#pragma unroll
                for (int j = 0; j < 8; ++j) { a[j] = *(const u32x4*)(srow + 512 * j);
                    mx = __builtin_fmaxf(mx, __builtin_fmaxf(__builtin_fmaxf(__builtin_fmaxf(__builtin_fabsf(bf_lo(a[j].x)), __builtin_fabsf(bf_hi(a[j].x))), __builtin_fmaxf(__builtin_fabsf(bf_lo(a[j].y)), __builtin_fabsf(bf_hi(a[j].y)))),
                                                      __builtin_fmaxf(__builtin_fmaxf(__builtin_fabsf(bf_lo(a[j].z)), __builtin_fabsf(bf_hi(a[j].z))), __builtin_fmaxf(__builtin_fabsf(bf_lo(a[j].w)), __builtin_fabsf(bf_hi(a[j].w)))))); }
                mx = wave_max(mx); const float inv = mx > 0.f ? 127.f / mx : 0.f; if (lane == 0) ((float*)(ws + WS_RSMA))[g * TG + m] = mx * (1.f / 127.f);
                unsigned char* drow = P_MG8 + (size_t)(g * TG + m) * DM + lane * 8;
#pragma unroll
                for (int j = 0; j < 8; ++j) { u32x2 q; q.x = pack4_i8(bf_lo(a[j].x) * inv, bf_hi(a[j].x) * inv, bf_lo(a[j].y) * inv, bf_hi(a[j].y) * inv); q.y = pack4_i8(bf_lo(a[j].z) * inv, bf_hi(a[j].z) * inv, bf_lo(a[j].w) * inv, bf_hi(a[j].w) * inv); *(u32x2*)(drow + 512 * j) = q; }
            }
        }
        SEAM();
#endif

    }

    if (RUN() && EN(7)) { LOCAL_TID();
        pg8::Gemm gm{(const bf16*)P_MG8, DM / 2, P_WOT, NTOK, DM, DM / 2}; pg8::StaticOrder S; S.init(NTOK, DM, G, bx);
        pg8::EpiResT<I8_MID != 0, false> E{A->in[I_XP], A->in[I_XS], NTOK / 2 / 256, P_X1, DM, 1.f, ws}; REP_LOOP_GEMM { int l2_ = lane_id_fresh(); asm volatile("" : "+v"(l2_)); pg8::gemm_phase<pg8::EpiResT<I8_MID != 0, false>, I8_MID ? 2 : 0>(ldsL, gm, S, E, wave * 64 + l2_); }
    }
    SEAM();

    if (RUN() && EN(8)) { LOCAL_TID();
        const float* gv = A->in[I_RFG];
        for (int m = gw; m < NTOK; m += NGW) {
            const u32x2* xr = (const u32x2*)(P_X1 + (size_t)m * DM) + lane; f32x4 v[16]; float s = 0.f;
#pragma unroll
            for (int j = 0; j < 16; ++j) { const u32x2 w = xr[64 * j]; v[j] = (f32x4){bf_lo(w.x), bf_hi(w.x), bf_lo(w.y), bf_hi(w.y)}; s += (v[j].x * v[j].x + v[j].y * v[j].y) + (v[j].z * v[j].z + v[j].w * v[j].w); }
            const float rstd = 1.0f / sqrtf(wave_sum(s) * (1.f / DM) + EPS);
            if (I8_UP) { float mx = 0.f;
#pragma unroll
                for (int j = 0; j < 16; ++j) { const f32x4 gg = ((const f32x4*)gv)[64 * j + lane]; v[j] = v[j] * rstd * gg; mx = __builtin_fmaxf(__builtin_fmaxf(mx, __builtin_fmaxf(__builtin_fabsf(v[j].x), __builtin_fabsf(v[j].y))), __builtin_fmaxf(__builtin_fabsf(v[j].z), __builtin_fabsf(v[j].w))); }
                mx = wave_max(mx); const float inv = mx > 0.f ? 127.f / mx : 0.f; if (lane == 0) P_RSHF[m] = mx * (1.f / 127.f);
                unsigned* o4 = (unsigned*)(P_HF + (size_t)m * DM) + lane;
#pragma unroll
                for (int j = 0; j < 16; ++j) o4[64 * j] = pack4_i8(v[j].x * inv, v[j].y * inv, v[j].z * inv, v[j].w * inv);
            } else {
            u32x2* o8 = (u32x2*)((bf16*)P_HF + (size_t)m * DM) + lane;
#pragma unroll
            for (int j = 0; j < 16; ++j) { const f32x4 gg = ((const f32x4*)gv)[64 * j + lane]; u32x2 w; w.x = cvt_pk_bf16(v[j].x * rstd * gg.x, v[j].y * rstd * gg.y); w.y = cvt_pk_bf16(v[j].z * rstd * gg.z, v[j].w * rstd * gg.w); o8[64 * j] = w; }
            }
        }
    }
    SEAM();

    if (RUN() && EN(9)) { LOCAL_TID();
        pg8::Gemm gm{(const bf16*)P_HF, DM / 2, P_WUPT, NTOK, NUP, DM / 2}; pg8::StaticOrder S; S.init(NTOK, NUP, G, bx);
#if CONV_FUSE
        static_assert(I8_UP && CONV_FUSE, "the all-token FFN stage needs the fused conv epilogue (int8 up GEMM)");
        pg8::EpiConv E{(unsigned char*)P_ACT, P_Y, A->in[I_CW], A->in[I_CB], ws, FP8_DOWN ? S_ACT8 : 1.f}; REP_LOOP_GEMM { int l2_ = lane_id_fresh(); asm volatile("" : "+v"(l2_)); pg8::gemm_phase<pg8::EpiConv, 2>(ldsL, gm, S, E, wave * 64 + l2_); }
#else
        pg8::EpiStoreT<I8_UP != 0, WS_RSHF, WS_CSUP> E{P_Y, NUP, 0, 0, 1.f, ws, 0}; REP_LOOP_GEMM { int l2_ = lane_id_fresh(); asm volatile("" : "+v"(l2_)); pg8::gemm_phase<pg8::EpiStoreT<I8_UP != 0, WS_RSHF, WS_CSUP>, I8_UP ? 2 : 0>(ldsL, gm, S, E, wave * 64 + l2_); }
#endif
    }
    SEAM();

#if CONV_FUSE
    if (RUN() && EN(10)) { LOCAL_TID();
        const float* cw = A->in[I_CW]; const float* cb = A->in[I_CB];
        constexpr int NCB = DFF / 256, NITEM = NCB * (NTOK / 64) * 2;
        for (int it = gw; it < NITEM; it += NGW) {
            const int cbk = it % NCB, be = it / NCB, b = be >> 1, edge = be & 1, c0 = cbk * 256 + lane * 4, t = b * 64 + (edge ? 63 : 0);
            const int posmask = (t < NTOK / 2) ? 4095 : 8191;
            const int colg = (c0 >> 7) * 256 + (c0 & 127);
            const f32x4 wg0 = *(const f32x4*)(cw + c0), wg1 = *(const f32x4*)(cw + NUP + c0), wg2 = *(const f32x4*)(cw + 2 * NUP + c0), bg = *(const f32x4*)(cb + c0);
            const f32x4 wu0 = *(const f32x4*)(cw + DFF + c0), wu1 = *(const f32x4*)(cw + NUP + DFF + c0), wu2 = *(const f32x4*)(cw + 2 * NUP + DFF + c0), bu = *(const f32x4*)(cb + DFF + c0);
            auto ldyb = [&](int blk, int slot, f32x4& yg, f32x4& yu) {
                const bf16* p = P_Y + ((size_t)blk * 4 + slot) * NUP + colg; const u32x2 a = *(const u32x2*)p, bb = *(const u32x2*)(p + 128);
                yg = (f32x4){bf_lo(a.x), bf_hi(a.x), bf_lo(a.y), bf_hi(a.y)}; yu = (f32x4){bf_lo(bb.x), bf_hi(bb.x), bf_lo(bb.y), bf_hi(bb.y)}; };
            const f32x4 z = (f32x4){0.f, 0.f, 0.f, 0.f};
            f32x4 pg = z, pu = z, cg, cu, ng = z, nu = z;
            if (edge == 0) { ldyb(b, 0, cg, cu); ldyb(b, 1, ng, nu); if ((t & posmask) != 0) ldyb(b - 1, 3, pg, pu); }
            else { ldyb(b, 3, cg, cu); ldyb(b, 2, pg, pu); if (((t + 1) & posmask) != 0) ldyb(b + 1, 0, ng, nu); }
            const f32x4 ug = wg0 * pg + wg1 * cg + wg2 * ng + bg, uu = wu0 * pu + wu1 * cu + wu2 * nu + bu;
            float a[4];
#pragma unroll
            for (int j = 0; j < 4; ++j) a[j] = ug[j] * fast_sigmoid(ug[j]) * uu[j];
            if (FP8_DOWN) *(unsigned*)((unsigned char*)P_ACT + (size_t)t * DFF + c0) = pack4_fp8(a[0] * S_ACT8, a[1] * S_ACT8, a[2] * S_ACT8, a[3] * S_ACT8);
            else { u32x2 w; w.x = cvt_pk_bf16(a[0], a[1]); w.y = cvt_pk_bf16(a[2], a[3]); *(u32x2*)(P_ACT + (size_t)t * DFF + c0) = w; }
        }
    }
#else
    if (RUN() && EN(10)) { LOCAL_TID();
        const float* cw = A->in[I_CW]; const float* cb = A->in[I_CB];
        constexpr int RCH = 64, NCB = DFF / 256, NITEM = NCB * (TG / RCH);
        for (int it = gw; it < NITEM; it += NGW) {
            const int cbk = it % NCB, rc = it / NCB, c0 = cbk * 256 + lane * 4, t0 = rc * RCH;
            f32x4 wg0 = *(const f32x4*)(cw + c0), wg1 = *(const f32x4*)(cw + NUP + c0), wg2 = *(const f32x4*)(cw + 2 * NUP + c0), bg = *(const f32x4*)(cb + c0);
            f32x4 wu0 = *(const f32x4*)(cw + DFF + c0), wu1 = *(const f32x4*)(cw + NUP + DFF + c0), wu2 = *(const f32x4*)(cw + 2 * NUP + DFF + c0), bu = *(const f32x4*)(cb + DFF + c0);
            auto ldrow = [&](int t, f32x4& yg, f32x4& yu) {
                const u32x2 a = *(const u32x2*)(P_Y + (size_t)t * NUP + c0), b = *(const u32x2*)(P_Y + (size_t)t * NUP + DFF + c0);
                yg = (f32x4){bf_lo(a.x), bf_hi(a.x), bf_lo(a.y), bf_hi(a.y)}; yu = (f32x4){bf_lo(b.x), bf_hi(b.x), bf_lo(b.y), bf_hi(b.y)}; };
            const f32x4 z = (f32x4){0.f, 0.f, 0.f, 0.f};
            f32x4 pg = z, pu = z, cg, cu, ng, nu;
            if ((t0 & posmask) != 0) ldrow(t0 - 1, pg, pu);
            ldrow(t0, cg, cu);
#pragma unroll 4
            for (int t = t0; t < t0 + RCH; ++t) {
                if (((t + 1) & posmask) != 0) ldrow(t + 1, ng, nu); else { ng = z; nu = z; }
                const f32x4 ug = wg0 * pg + wg1 * cg + wg2 * ng + bg, uu = wu0 * pu + wu1 * cu + wu2 * nu + bu;
                float a[4];
#pragma unroll
                for (int j = 0; j < 4; ++j) a[j] = ug[j] * fast_sigmoid(ug[j]) * uu[j];
                if (FP8_DOWN) *(unsigned*)((unsigned char*)P_ACT + (size_t)t * DFF + c0) = pack4_fp8(a[0] * S_ACT8, a[1] * S_ACT8, a[2] * S_ACT8, a[3] * S_ACT8);
                else { u32x2 w; w.x = cvt_pk_bf16(a[0], a[1]); w.y = cvt_pk_bf16(a[2], a[3]); *(u32x2*)(P_ACT + (size_t)t * DFF + c0) = w; }
                pg = cg; pu = cu; cg = ng; cu = nu;
            }
        }
    }
#endif
    SEAM();

    if (RUN() && EN(11)) { LOCAL_TID();
        pg8::Gemm gm{P_ACT, FP8_DOWN ? DFF / 2 : DFF, P_WDT, NTOK, DM, FP8_DOWN ? DFF / 2 : DFF}; pg8::StaticOrder S; S.init(NTOK, DM, G, bx);
        pg8::EpiResT<false, true> E{P_X1, P_X1, 1 << 30, P_X1, DM, FP8_DOWN ? 1.f / (S_WD * S_ACT8) : 1.f, ws}; { int l2_ = lane_id_fresh(); asm volatile("" : "+v"(l2_)); pg8::gemm_phase<pg8::EpiResT<false, true>, FP8_DOWN ? 1 : 0>(ldsL, gm, S, E, wave * 64 + l2_); }
    }
    SEAM();

    if (RUN() && EN(12)) { LOCAL_TID();
        const float* gv = A->in[I_FNG];
        for (int m = gw; m < NTOK; m += NGW) {
            const u32x2* xr = (const u32x2*)(P_X1 + (size_t)m * DM) + lane; f32x4* orow = (f32x4*)(A->out + (size_t)m * DM) + lane; f32x4 v[16]; float s = 0.f;
#pragma unroll
            for (int j = 0; j < 16; ++j) { const u32x2 w = xr[64 * j]; v[j] = (f32x4){bf_lo(w.x), bf_hi(w.x), bf_lo(w.y), bf_hi(w.y)}; s += (v[j].x * v[j].x + v[j].y * v[j].y) + (v[j].z * v[j].z + v[j].w * v[j].w); }
            const float rstd = 1.0f / sqrtf(wave_sum(s) * (1.f / DM) + EPS);
#pragma unroll
            for (int j = 0; j < 16; ++j) { const f32x4 gg = ((const f32x4*)gv)[64 * j + lane]; orow[64 * j] = v[j] * rstd * gg; }
        }
    }
    SEAM();
#undef RUN
#undef SEAM
}

extern "C" void kernel_launch(void* const* d_in, const int* in_sizes, int n_in, void* d_out, int out_size, void* d_ws, size_t ws_size, hipStream_t stream) {
    static int grid = 0;
    if (grid == 0) {
        if (n_in != 23 || out_size != NTOK * DM || ws_size < WS_END) { fprintf(stderr, "kernel_launch: unexpected shapes: n_in %d out %d ws %zu (need %zu)\n", n_in, out_size, ws_size, (size_t)WS_END); grid = -1; return; }
        int dev = 0, cus = 0, per_cu = 0;
        if (hipGetDevice(&dev) != hipSuccess || hipDeviceGetAttribute(&cus, hipDeviceAttributeMultiprocessorCount, dev) != hipSuccess) { grid = -1; return; }
        if (hipFuncSetAttribute((const void*)enc_fwd, hipFuncAttributeMaxDynamicSharedMemorySize, LDS_BYTES) != hipSuccess) { fprintf(stderr, "kernel_launch: hipFuncSetAttribute failed\n"); grid = -1; return; }
        if (hipOccupancyMaxActiveBlocksPerMultiprocessor(&per_cu, (const void*)enc_fwd, NWAVES * 64, LDS_BYTES) != hipSuccess || per_cu < 1) { fprintf(stderr, "kernel_launch: occupancy query says %d\n", per_cu); per_cu = 1; }
        (void)hipGetLastError();
        grid = cus;
    }
    if (grid < 0) return;
    (void)hipMemsetAsync((char*)d_ws + WS_CTL, 0, CTL_ZERO_BYTES, stream);
    Args a{};
    for (int i = 0; i < 23; ++i) a.in[i] = (const float*)d_in[i];
    a.out = (float*)d_out; a.ws = (unsigned char*)d_ws;
    for (int i = 0; i < 32; ++i) a.invf[i] = powf(10000.0f, -(float)(2 * i) / 64.0f);
#if MK_PER_STEP_LAUNCH
    for (int s = 0; s < NSTEPS; ++s) { a.lo = s; a.hi = s + 1; hipLaunchKernelGGL(enc_fwd, dim3(grid), dim3(NWAVES * 64), LDS_BYTES, stream, a); }
#else
    a.lo = 0; a.hi = NSTEPS;
    hipLaunchKernelGGL(enc_fwd, dim3(grid), dim3(NWAVES * 64), LDS_BYTES, stream, a);
#endif
    const hipError_t le = hipPeekAtLastError();
    if (le != hipSuccess) fprintf(stderr, "kernel_launch: launch failed: %s\n", hipGetErrorName(le));
}
```

```cpp
#include <hip/hip_runtime.h>
#include <cstdio>
#include <cstdint>
#include <cmath>

#ifndef I8_IN
#define I8_IN 1
#endif
#ifndef ATT_CINIT
#define ATT_CINIT 1
#endif
constexpr float CS_DIFF = 0.125f * 1.4426950408889634f;
#ifndef CONV_FUSE
#define CONV_FUSE 1
#endif
#ifndef I8_MID
#define I8_MID 1
#endif
#ifndef I8_UP
#define I8_UP 1
#endif
#ifndef FP8_DOWN
#define FP8_DOWN 1
#endif
constexpr float S_WD = 1024.f, S_ACT8 = 8.f;
#ifndef REP_GEMM
#define REP_GEMM 1
#endif
#ifndef REP_DIFF
#define REP_DIFF 1
#endif
#ifndef REP_MLA
#define REP_MLA 1
#endif
#if REP_GEMM == 1
#define REP_LOOP_GEMM
#else
#define REP_LOOP_GEMM _Pragma("unroll 1") for (int rep = 0; rep < REP_GEMM; ++rep)
#endif
#ifndef MK_PER_STEP_LAUNCH
#define MK_PER_STEP_LAUNCH 0
#endif

typedef unsigned short bf16;
typedef short bf16x8 __attribute__((ext_vector_type(8)));
typedef short s16x4 __attribute__((ext_vector_type(4)));
typedef float f32x4 __attribute__((ext_vector_type(4)));
typedef float f32x2 __attribute__((ext_vector_type(2)));
typedef float f32x16 __attribute__((ext_vector_type(16)));
typedef unsigned u32x4 __attribute__((ext_vector_type(4)));
typedef unsigned u32x2 __attribute__((ext_vector_type(2)));
typedef int i32x4 __attribute__((ext_vector_type(4)));
typedef int i32x8 __attribute__((ext_vector_type(8)));
#define LAS __attribute__((address_space(3)))

__device__ __forceinline__ unsigned cvt_pk_bf16(float lo, float hi) { unsigned r; asm volatile("v_cvt_pk_bf16_f32 %0, %1, %2" : "=v"(r) : "v"(lo), "v"(hi)); return r; }
__device__ __forceinline__ float bf_lo(unsigned w) { return __uint_as_float(w << 16); }
__device__ __forceinline__ float bf_hi(unsigned w) { return __uint_as_float(w & 0xffff0000u); }
__device__ __forceinline__ float clamp448(float x) { return __builtin_fminf(__builtin_fmaxf(x, -448.f), 448.f); }
__device__ __forceinline__ unsigned pack4_fp8(float a, float b, float c, float d) { int w = 0; w = __builtin_amdgcn_cvt_pk_fp8_f32(clamp448(a), clamp448(b), w, false); w = __builtin_amdgcn_cvt_pk_fp8_f32(clamp448(c), clamp448(d), w, true); return (unsigned)w; }
__device__ __forceinline__ unsigned pack4_i8(float a, float b, float c, float d) { const int ia = (int)__builtin_rintf(a), ib = (int)__builtin_rintf(b), ic = (int)__builtin_rintf(c), id = (int)__builtin_rintf(d);
    return (unsigned)(ia & 255) | ((unsigned)(ib & 255) << 8) | ((unsigned)(ic & 255) << 16) | ((unsigned)id << 24); }
__device__ __forceinline__ float fast_sigmoid(float x) { return __builtin_amdgcn_rcpf(1.0f + __builtin_amdgcn_exp2f(-1.4426950408889634f * x)); }

__device__ __forceinline__ int lane_id_fresh() { unsigned ones = ~0u; asm volatile("" : "+s"(ones)); return (int)__builtin_amdgcn_mbcnt_hi(ones, __builtin_amdgcn_mbcnt_lo(ones, 0u)); }

constexpr int DM = 4096, NTOK = 32768, TG = 8192, NGRP = 4;
constexpr int NIN = 16128;
constexpr int C_DQ = 0, C_DK = 2048, C_DV = 4096, C_QLAT = 6144, C_KVLAT = 7168, C_GATE = 7680, C_KPE = 15872;
constexpr int DFF = 11008, NUP = 22016, NQ = 3072, NKV = 4096;
constexpr float EPS = 1e-6f;

constexpr size_t MiB = 1u << 20;
constexpr size_t WS_CTL = 0, CTL_ZERO_BYTES = 1 * MiB;
constexpr size_t WS_COS = 1 * MiB, WS_SIN = 2 * MiB, WS_BIAS = 3 * MiB, WS_LAM = 3 * MiB + 32768;
constexpr size_t WS_CSIN = 3 * MiB + 65536, WS_CSUP = 3 * MiB + 131072, WS_RSH = 3 * MiB + 262144;
constexpr size_t WS_CSQ = 3 * MiB + 320 * 1024, WS_CSKV = 3 * MiB + 336 * 1024, WS_CSA = 3 * MiB + 352 * 1024, WS_CSB = 3 * MiB + 368 * 1024, WS_CSO = 3 * MiB + 384 * 1024;
constexpr size_t WS_RSQL = 3 * MiB + 400 * 1024, WS_RSKVL = 3 * MiB + 432 * 1024, WS_RSA = 3 * MiB + 464 * 1024, WS_RSB = 3 * MiB + 496 * 1024, WS_RSM = 3 * MiB + 528 * 1024;
constexpr size_t EB_IN = I8_IN ? 1 : 2, EB_UP = I8_UP ? 1 : 2, EB_MID = I8_MID ? 1 : 2, EB_DN = FP8_DOWN ? 1 : 2;
constexpr size_t WS_WIN = 4 * MiB, WS_WQ = WS_WIN + (size_t)NIN * DM * EB_IN, WS_WKV = WS_WQ + (size_t)NQ * 1024 * EB_MID, WS_WA = WS_WKV + (size_t)NKV * 512 * EB_MID, WS_WB = WS_WA + (size_t)DM * 2048 * EB_MID,
                 WS_WO = WS_WB + (size_t)DM * 2048 * EB_MID, WS_WUP = WS_WO + (size_t)DM * DM * EB_MID, WS_WD = WS_WUP + (size_t)NUP * DM * EB_UP, WS_WEND = WS_WD + (size_t)DM * DFF * EB_DN;
constexpr size_t WS_ACT = (WS_WEND + MiB - 1) / MiB * MiB;
constexpr size_t WS_P = WS_ACT, WS_Q = WS_P + 252 * MiB, WS_KV = WS_Q + 48 * MiB, WS_AO = WS_KV + 64 * MiB, WS_BO = WS_AO + 32 * MiB, WS_MG = WS_BO + 32 * MiB, WS_STASH = WS_MG + 64 * MiB;
constexpr size_t WS_QL8 = WS_STASH + 32 * MiB, WS_KVL8 = WS_QL8 + 8 * MiB, WS_AO8 = WS_KVL8 + 4 * MiB, WS_BO8 = WS_AO8 + 16 * MiB, WS_MIX_END = WS_BO8 + 16 * MiB;
static_assert(WS_P + (size_t)TG * NIN * 2 <= WS_Q && (size_t)TG * NQ * 2 <= 48 * MiB && (size_t)TG * NKV * 2 <= 64 * MiB && (size_t)TG * DM * 2 <= 64 * MiB, "mixer map");
constexpr size_t WS_Y = WS_ACT, WS_ACTV = WS_Y + (size_t)(NTOK / 64) * 4 * NUP * 2, WS_FFN_END = WS_ACTV + (size_t)NTOK * DFF * EB_DN;
constexpr size_t WS_X1 = ((WS_MIX_END > WS_FFN_END ? WS_MIX_END : WS_FFN_END) + MiB - 1) / MiB * MiB;
constexpr size_t WS_HF = WS_X1 + (size_t)NTOK * DM * 2, WS_MG8 = WS_HF + (size_t)NTOK * DM, WS_END = WS_MG8 + (size_t)NTOK * DM;
static_assert(EB_IN == 1 && EB_UP == 1 && EB_MID == 1, "the all-token row buffers are int8");
constexpr size_t WS_RSHF = 3 * MiB + 576 * 1024, WS_RSMA = 3 * MiB + 704 * 1024;
static_assert(WS_RSM + 32768 <= WS_RSHF && WS_RSMA + (size_t)NTOK * 4 <= 4 * MiB, "scale arrays");

namespace pg8 {
constexpr int BM = 256, BK = 64, HALF = 128, HTB = HALF * BK * 2, STAGE_BYTES = 8 * HTB, NXCD = 8, WGM = 8;
__host__ __device__ __forceinline__ int lds_byte(int r, int c) { const int st = (r >> 4) * 2 + (c >> 5), rr = r & 15, cc = c & 31, ob = rr * 64 + cc * 2; return st * 1024 + (ob ^ (((ob >> 9) & 1) << 5)); }
__host__ __device__ __forceinline__ void stage_rc(int b, int& R, int& C) { const int st = b / 1024, sb = b % 1024, swz = sb ^ (((sb >> 9) & 1) << 5); R = (st >> 1) * 16 + swz / 64; C = (st & 1) * 32 + (swz % 64) / 2; }
__host__ __device__ __forceinline__ int perm32(int rho) { const int n = rho >> 4, i = rho & 15; return 8 * (i >> 2) + 4 * n + (i & 3); }

struct Unit { int pm, pn; };
struct Gemm { const bf16* A; int lda; const bf16* Bt; int M, N, K; };

struct StaticOrder {
    int nM, nN, nwg, G, c;
    __device__ void init(int M, int N, int G_, int c_) { nM = M / BM; nN = N / BM; nwg = nM * nN; G = G_; c = c_; }
    __device__ bool next(int i, Unit& u) const {
        const long L = (long)i * G + c; if (L >= nwg) return false;
        int wgid = (int)L; { const int q = nwg / NXCD, r = nwg % NXCD, xcd = wgid % NXCD, off = wgid / NXCD; wgid = (xcd < r ? xcd * (q + 1) : r * (q + 1) + (xcd - r) * q) + off; }
        const int nig = WGM * nN, gid = wgid / nig, fm = gid * WGM, gsz = (nM - fm) < WGM ? (nM - fm) : WGM;
        u.pm = fm + ((wgid % nig) % gsz); u.pn = (wgid % nig) / gsz; return true;
    }
};

template <int MODE> struct AccSel { typedef f32x4 T; }; template <> struct AccSel<2> { typedef i32x4 T; };
__device__ __forceinline__ f32x4 tof(f32x4 v) { return v; }
__device__ __forceinline__ f32x4 tof(i32x4 v) { return __builtin_convertvector(v, f32x4); }

template <class Epi, int MODE = 0>
__device__ __forceinline__ void gemm_phase(LAS unsigned char* lds, const Gemm g, const StaticOrder& S, const Epi& E, int tid_in) {
    int tid = tid_in; asm volatile("" : "+v"(tid));
    const int wid = __builtin_amdgcn_readfirstlane(tid >> 6), lane = tid & 63, wr = wid >> 2, wc = wid & 3, fr = lane & 15, fq = lane >> 4;
    int K = g.K, lda = g.lda; asm volatile("" : "+s"(K), "+s"(lda));
    const int nt = K / BK;
    unsigned voffA[2], voffB[2];
#pragma unroll
    for (int i = 0; i < 2; ++i) { int R, C; stage_rc(tid * 16 + i * 8192, R, C); const int Rb = (R & ~31) + perm32(R & 31);
        voffA[i] = (unsigned)(R * lda + C) * 2u; voffB[i] = (unsigned)(Rb * K + C) * 2u; }
    const size_t kstep = (size_t)(BK * 2);
    const size_t hstepA = (size_t)HALF * lda * 2, hstepB = (size_t)HALF * K * 2;
    const size_t tstepA = 2 * hstepA, tstepB = 2 * hstepB;
    const unsigned ldsw = (unsigned)wid * 1024u;
    const int aoff = lds_byte(wr * 64 + fr, fq * 8), boff = lds_byte(wc * 32 + fr, fq * 8);
#define PG8_SA(b, h) (((b) * 2 + (h)) * HTB)
#define PG8_SB(b, h) ((4 + (b) * 2 + (h)) * HTB)
#define PG8_STAGE(bufoff, gbase, voff) do { _Pragma("unroll") for (int _i = 0; _i < 2; ++_i) \
        __builtin_amdgcn_global_load_lds((const unsigned*)((const char*)(gbase) + (voff)[_i]), (LAS unsigned*)(lds + (bufoff) + ldsw + _i * 8192), 16, 0, 0); } while (0)
#define PG8_CAT(x, y) __builtin_shufflevector(__builtin_bit_cast(i32x4, x), __builtin_bit_cast(i32x4, y), 0, 1, 2, 3, 4, 5, 6, 7)
#define PG8_LDA(dst, b, h) do { _Pragma("unroll") for (int m = 0; m < 4; ++m) dst[m] = PG8_CAT(*(const LAS bf16x8*)(lds + PG8_SA(b, h) + aoff + m * 2048), *(const LAS bf16x8*)(lds + PG8_SA(b, h) + aoff + m * 2048 + 1024)); } while (0)
#define PG8_LDB(dst, b, h) do { _Pragma("unroll") for (int n = 0; n < 2; ++n) dst[n] = PG8_CAT(*(const LAS bf16x8*)(lds + PG8_SB(b, h) + boff + n * 2048), *(const LAS bf16x8*)(lds + PG8_SB(b, h) + boff + n * 2048 + 1024)); } while (0)
#define PG8_LO4(v) __builtin_shufflevector(v, v, 0, 1, 2, 3)
#define PG8_HI4(v) __builtin_shufflevector(v, v, 4, 5, 6, 7)
#define PG8_LO(v) __builtin_bit_cast(bf16x8, __builtin_shufflevector(v, v, 0, 1, 2, 3))
#define PG8_HI(v) __builtin_bit_cast(bf16x8, __builtin_shufflevector(v, v, 4, 5, 6, 7))
#define PG8_MMA(ai, bj, At, Bt) do { __builtin_amdgcn_s_setprio(1); _Pragma("unroll") for (int m = 0; m < 4; ++m) _Pragma("unroll") for (int n = 0; n < 2; ++n) { \
        if constexpr (F8) asm volatile("v_mfma_f32_16x16x128_f8f6f4 %0, %1, %2, %0" : "+v"(acc[ai][bj][m][n]) : "v"(Bt[n]), "v"(At[m]));   \
        else if constexpr (MODE == 2) { acc[ai][bj][m][n] = __builtin_amdgcn_mfma_i32_16x16x64_i8(PG8_LO4(Bt[n]), PG8_LO4(At[m]), acc[ai][bj][m][n], 0, 0, 0); \
               acc[ai][bj][m][n] = __builtin_amdgcn_mfma_i32_16x16x64_i8(PG8_HI4(Bt[n]), PG8_HI4(At[m]), acc[ai][bj][m][n], 0, 0, 0); } \
        else { acc[ai][bj][m][n] = __builtin_amdgcn_mfma_f32_16x16x32_bf16(PG8_LO(Bt[n]), PG8_LO(At[m]), acc[ai][bj][m][n], 0, 0, 0); \
               acc[ai][bj][m][n] = __builtin_amdgcn_mfma_f32_16x16x32_bf16(PG8_HI(Bt[n]), PG8_HI(At[m]), acc[ai][bj][m][n], 0, 0, 0); } } __builtin_amdgcn_s_setprio(0); } while (0)
#define PG8_WAIT_V(n) asm volatile("s_waitcnt vmcnt(" #n ")" ::: "memory")
#define PG8_WAIT_L(n) asm volatile("s_waitcnt lgkmcnt(" #n ")" ::: "memory")
#define PG8_BAR __builtin_amdgcn_s_barrier()
#define PG8_SCHED __builtin_amdgcn_sched_barrier(0)
    Unit cur, nxt; int ui = 0;
    if (!S.next(0, cur)) return;
    constexpr bool F8 = (MODE == 1); typedef typename AccSel<MODE>::T AccT; AccT acc[2][2][4][2];
#pragma unroll
    for (int a = 0; a < 2; ++a)
#pragma unroll
        for (int b = 0; b < 2; ++b)
#pragma unroll
            for (int m = 0; m < 4; ++m)
#pragma unroll
                for (int n = 0; n < 2; ++n) acc[a][b][m][n] = AccT{};
    i32x8 At[4], B0[2], B1[2];
    const char* cA = (const char*)g.A + (size_t)cur.pm * tstepA; const char* cB = (const char*)g.Bt + (size_t)cur.pn * tstepB;
    PG8_STAGE(PG8_SB(0, 0), cB, voffB); PG8_STAGE(PG8_SB(0, 1), cB + hstepB, voffB); PG8_STAGE(PG8_SA(0, 0), cA, voffA); PG8_STAGE(PG8_SA(0, 1), cA + hstepA, voffA);
    if (wr == 1) PG8_BAR;
    PG8_WAIT_V(2); PG8_BAR;
    PG8_STAGE(PG8_SB(1, 0), cB + kstep, voffB); PG8_STAGE(PG8_SA(1, 0), cA + kstep, voffA); PG8_STAGE(PG8_SB(1, 1), cB + hstepB + kstep, voffB);
    PG8_WAIT_V(6); PG8_BAR;
    for (;;) {
        const bool has_next = S.next(ui + 1, nxt);
        const char* nA = has_next ? (const char*)g.A + (size_t)nxt.pm * tstepA : cA; const char* nB = has_next ? (const char*)g.Bt + (size_t)nxt.pn * tstepB : cB;
        for (int t = 0; t < nt; t += 2) {
            const bool last = (t == nt - 2);
            const char* a1 = cA + (size_t)(t + 1) * kstep;
            const char* a2 = last ? nA : cA + (size_t)(t + 2) * kstep; const char* b2 = last ? nB : cB + (size_t)(t + 2) * kstep;
            const char* a3 = a2 + kstep; const char* b3 = b2 + kstep;
            PG8_LDB(B0, 0, 0); PG8_LDB(B1, 0, 1); PG8_SCHED; PG8_LDA(At, 0, 0); PG8_STAGE(PG8_SA(1, 1), a1 + hstepA, voffA);
            PG8_WAIT_V(8); PG8_WAIT_L(0); PG8_BAR; PG8_MMA(0, 0, At, B0); PG8_MMA(0, 1, At, B1); PG8_BAR; PG8_SCHED;
            PG8_LDA(At, 0, 1); PG8_STAGE(PG8_SB(0, 0), b2, voffB); PG8_STAGE(PG8_SB(0, 1), b2 + hstepB, voffB); PG8_STAGE(PG8_SA(0, 0), a2, voffA);
            PG8_WAIT_V(8); PG8_WAIT_L(0); PG8_BAR; PG8_MMA(1, 0, At, B0); PG8_MMA(1, 1, At, B1); PG8_BAR; PG8_SCHED;
            PG8_LDB(B0, 1, 0); PG8_LDB(B1, 1, 1); PG8_SCHED; PG8_LDA(At, 1, 0); PG8_STAGE(PG8_SA(0, 1), a2 + hstepA, voffA);
            PG8_WAIT_V(8); PG8_WAIT_L(0); PG8_BAR; PG8_MMA(0, 0, At, B0); PG8_MMA(0, 1, At, B1); PG8_BAR; PG8_SCHED;
            PG8_LDA(At, 1, 1); PG8_STAGE(PG8_SB(1, 0), b3, voffB); PG8_STAGE(PG8_SB(1, 1), b3 + hstepB, voffB); PG8_STAGE(PG8_SA(1, 0), a3, voffA);
            PG8_WAIT_V(8); PG8_WAIT_L(0); PG8_BAR; PG8_MMA(1, 0, At, B0); PG8_MMA(1, 1, At, B1); PG8_BAR; PG8_SCHED;
        }
        if (wr == 0) PG8_BAR;
        if constexpr (F8) asm volatile("s_nop 15\n\ts_nop 15" ::: "memory");
        { int l3_ = lane_id_fresh(); asm volatile("" : "+v"(l3_)); E(acc, cur, wr, wc, l3_ & 15, l3_ >> 4); }
        if (!has_next) break;
#pragma unroll
        for (int a = 0; a < 2; ++a)
#pragma unroll
            for (int b = 0; b < 2; ++b)
#pragma unroll
                for (int m = 0; m < 4; ++m)
#pragma unroll
                    for (int n = 0; n < 2; ++n) acc[a][b][m][n] = AccT{};
        cur = nxt; cA = nA; cB = nB; ++ui;
        if (wr == 1) PG8_BAR;
    }
    PG8_WAIT_V(0);
    PG8_BAR;
#undef PG8_SA
#undef PG8_SB
#undef PG8_STAGE
#undef PG8_LDA
#undef PG8_LDB
#undef PG8_MMA
#undef PG8_CAT
#undef PG8_LO
#undef PG8_LO4
#undef PG8_HI4
#undef PG8_HI
#undef PG8_WAIT_V
#undef PG8_WAIT_L
#undef PG8_BAR
#undef PG8_SCHED
}

template <bool SC, size_t RSOFF = 0, size_t CSOFF = 0> struct EpiStoreT {
    bf16* O; int ldc; int sig_lo, sig_hi; float scale; const unsigned char* wsb; int rsrow;
    template <class AccT> __device__ __forceinline__ void operator()(const AccT (&acc)[2][2][4][2], const Unit& u, int wr, int wc, int fr, int fq) const {
        const bool sig = (u.pn >= sig_lo && u.pn < sig_hi);
        const int row0 = u.pm * BM + wr * 64 + fr, col0 = u.pn * BM + wc * 32 + 8 * fq;
        const float* rs = (const float*)(wsb + RSOFF) + rsrow; const float* cs = (const float*)(wsb + CSOFF);
        const float tsc = (u.pn < 8) ? scale : 1.f;
        f32x4 cv[2][2];
#pragma unroll
        for (int bj = 0; bj < 2; ++bj) { if constexpr (SC) { cv[bj][0] = *(const f32x4*)(cs + col0 + bj * HALF) * tsc; cv[bj][1] = *(const f32x4*)(cs + col0 + bj * HALF + 4) * tsc; } else { cv[bj][0] = (f32x4){tsc, tsc, tsc, tsc}; cv[bj][1] = cv[bj][0]; } }
#pragma unroll
        for (int ai = 0; ai < 2; ++ai)
#pragma unroll
            for (int m = 0; m < 4; ++m) { bf16* rowp = O + (size_t)(row0 + ai * HALF + m * 16) * ldc + col0; float rsv = 1.f; if constexpr (SC) rsv = rs[row0 + ai * HALF + m * 16];
#pragma unroll
                for (int bj = 0; bj < 2; ++bj) { f32x4 v0 = tof(acc[ai][bj][m][0]) * (cv[bj][0] * rsv), v1 = tof(acc[ai][bj][m][1]) * (cv[bj][1] * rsv);
                    if (sig) {
#pragma unroll
                        for (int j = 0; j < 4; ++j) { v0[j] = fast_sigmoid(v0[j]); v1[j] = fast_sigmoid(v1[j]); } }
                    u32x4 w; w.x = cvt_pk_bf16(v0[0], v0[1]); w.y = cvt_pk_bf16(v0[2], v0[3]); w.z = cvt_pk_bf16(v1[0], v1[1]); w.w = cvt_pk_bf16(v1[2], v1[3]);
                    *(u32x4*)(rowp + bj * HALF) = w; }
                asm volatile("" ::: "memory"); }
    }
};
template <bool SC> struct EpiQT {
    bf16* O; int ldc; const unsigned char* wsb; int posmask;
    template <class AccT> __device__ __forceinline__ void operator()(const AccT (&acc)[2][2][4][2], const Unit& u, int wr, int wc, int fr, int fq) const {
        const bool rope = (u.pn >= 8);
        const int row0 = u.pm * BM + wr * 64 + fr, col0 = u.pn * BM + wc * 32 + 8 * fq;
        const float* cosT = (const float*)(wsb + WS_COS); const float* sinT = (const float*)(wsb + WS_SIN); const float* rs = (const float*)(wsb + WS_RSQL); const float* cs = (const float*)(wsb + WS_CSQ);
        f32x4 cv[2][2];
#pragma unroll
        for (int bj = 0; bj < 2; ++bj) { if constexpr (SC) { cv[bj][0] = *(const f32x4*)(cs + col0 + bj * HALF); cv[bj][1] = *(const f32x4*)(cs + col0 + bj * HALF + 4); } else { cv[bj][0] = (f32x4){1.f, 1.f, 1.f, 1.f}; cv[bj][1] = cv[bj][0]; } }
#pragma unroll
        for (int ai = 0; ai < 2; ++ai)
#pragma unroll
            for (int m = 0; m < 4; ++m) { const int row = row0 + ai * HALF + m * 16; bf16* rowp = O + (size_t)row * ldc + col0; const int pos = row & posmask; float rsv = 1.f; if constexpr (SC) rsv = rs[row];
#pragma unroll
                for (int bj = 0; bj < 2; ++bj) { f32x4 v0 = tof(acc[ai][bj][m][0]) * (cv[bj][0] * rsv), v1 = tof(acc[ai][bj][m][1]) * (cv[bj][1] * rsv);
                    if (rope) { const int i0 = (((col0 + bj * HALF) & 63) >> 1);
                        const f32x4 c = *(const f32x4*)(cosT + (size_t)pos * 32 + i0), s = *(const f32x4*)(sinT + (size_t)pos * 32 + i0);
                        f32x4 a, b;
                        a[0] = v0[0] * c[0] - v0[1] * s[0]; a[1] = v0[0] * s[0] + v0[1] * c[0]; a[2] = v0[2] * c[1] - v0[3] * s[1]; a[3] = v0[2] * s[1] + v0[3] * c[1];
                        b[0] = v1[0] * c[2] - v1[1] * s[2]; b[1] = v1[0] * s[2] + v1[1] * c[2]; b[2] = v1[2] * c[3] - v1[3] * s[3]; b[3] = v1[2] * s[3] + v1[3] * c[3];
                        v0 = a; v1 = b; }
                    u32x4 w; w.x = cvt_pk_bf16(v0[0], v0[1]); w.y = cvt_pk_bf16(v0[2], v0[3]); w.z = cvt_pk_bf16(v1[0], v1[1]); w.w = cvt_pk_bf16(v1[2], v1[3]);
                    *(u32x4*)(rowp + bj * HALF) = w; } }
    }
};
template <bool SC> struct EpiGateAT {
    bf16* part; int ldp; const bf16* gate; int ldg; const unsigned char* wsb;
    template <class AccT> __device__ __forceinline__ void operator()(const AccT (&acc)[2][2][4][2], const Unit& u, int wr, int wc, int fr, int fq) const {
        const int row0 = u.pm * BM + wr * 64 + fr, col0 = u.pn * BM + wc * 32 + 8 * fq;
        const float* rs = (const float*)(wsb + WS_RSA); const float* cs = (const float*)(wsb + WS_CSA);
        f32x4 cv[2][2];
#pragma unroll
        for (int bj = 0; bj < 2; ++bj) { if constexpr (SC) { cv[bj][0] = *(const f32x4*)(cs + col0 + bj * HALF); cv[bj][1] = *(const f32x4*)(cs + col0 + bj * HALF + 4); } else { cv[bj][0] = (f32x4){1.f, 1.f, 1.f, 1.f}; cv[bj][1] = cv[bj][0]; } }
#pragma unroll
        for (int ai = 0; ai < 2; ++ai) {
            u32x4 gw[4][2]; float rsv[4];
#pragma unroll
            for (int m = 0; m < 4; ++m) { const size_t row = (size_t)(row0 + ai * HALF + m * 16); rsv[m] = 1.f; if constexpr (SC) rsv[m] = rs[row];
#pragma unroll
                for (int bj = 0; bj < 2; ++bj) gw[m][bj] = *(const u32x4*)(gate + row * ldg + col0 + bj * HALF); }
#pragma unroll
            for (int m = 0; m < 4; ++m) { const size_t row = (size_t)(row0 + ai * HALF + m * 16);
#pragma unroll
                for (int bj = 0; bj < 2; ++bj) { const f32x4 v0 = tof(acc[ai][bj][m][0]) * (cv[bj][0] * rsv[m]), v1 = tof(acc[ai][bj][m][1]) * (cv[bj][1] * rsv[m]); const u32x4 g = gw[m][bj];
                    u32x4 w; w.x = cvt_pk_bf16(v0[0] * bf_lo(g.x), v0[1] * bf_hi(g.x)); w.y = cvt_pk_bf16(v0[2] * bf_lo(g.y), v0[3] * bf_hi(g.y)); w.z = cvt_pk_bf16(v1[0] * bf_lo(g.z), v1[1] * bf_hi(g.z)); w.w = cvt_pk_bf16(v1[2] * bf_lo(g.w), v1[3] * bf_hi(g.w));
                    *(u32x4*)(part + row * ldp + col0 + bj * HALF) = w; } }
            asm volatile("" ::: "memory");
        }
    }
};
template <bool SC> struct EpiGateBT {
    const bf16* part; int ldp; const bf16* gate; int ldg; bf16* O; int ldc; const unsigned char* wsb;
    template <class AccT> __device__ __forceinline__ void operator()(const AccT (&acc)[2][2][4][2], const Unit& u, int wr, int wc, int fr, int fq) const {
        const int row0 = u.pm * BM + wr * 64 + fr, col0 = u.pn * BM + wc * 32 + 8 * fq;
        const float* rs = (const float*)(wsb + WS_RSB); const float* cs = (const float*)(wsb + WS_CSB);
        f32x4 cv[2][2];
#pragma unroll
        for (int bj = 0; bj < 2; ++bj) { if constexpr (SC) { cv[bj][0] = *(const f32x4*)(cs + col0 + bj * HALF); cv[bj][1] = *(const f32x4*)(cs + col0 + bj * HALF + 4); } else { cv[bj][0] = (f32x4){1.f, 1.f, 1.f, 1.f}; cv[bj][1] = cv[bj][0]; } }
#pragma unroll
        for (int ai = 0; ai < 2; ++ai) {
            u32x4 gw[4][2], pw[4][2]; float rsv[4];
#pragma unroll
            for (int m = 0; m < 4; ++m) { const size_t row = (size_t)(row0 + ai * HALF + m * 16); rsv[m] = 1.f; if constexpr (SC) rsv[m] = rs[row];
#pragma unroll
                for (int bj = 0; bj < 2; ++bj) { gw[m][bj] = *(const u32x4*)(gate + row * ldg + col0 + bj * HALF); pw[m][bj] = *(const u32x4*)(part + row * ldp + col0 + bj * HALF); } }
#pragma unroll
            for (int m = 0; m < 4; ++m) { const size_t row = (size_t)(row0 + ai * HALF + m * 16);
#pragma unroll
                for (int bj = 0; bj < 2; ++bj) { const f32x4 v0 = tof(acc[ai][bj][m][0]) * (cv[bj][0] * rsv[m]), v1 = tof(acc[ai][bj][m][1]) * (cv[bj][1] * rsv[m]); const u32x4 g = gw[m][bj], p = pw[m][bj];
                    u32x4 w; w.x = cvt_pk_bf16(bf_lo(p.x) + v0[0] * bf_lo(g.x), bf_hi(p.x) + v0[1] * bf_hi(g.x)); w.y = cvt_pk_bf16(bf_lo(p.y) + v0[2] * bf_lo(g.y), bf_hi(p.y) + v0[3] * bf_hi(g.y));
                    w.z = cvt_pk_bf16(bf_lo(p.z) + v1[0] * bf_lo(g.z), bf_hi(p.z) + v1[1] * bf_hi(g.z)); w.w = cvt_pk_bf16(bf_lo(p.w) + v1[2] * bf_lo(g.w), bf_hi(p.w) + v1[3] * bf_hi(g.w));
                    *(u32x4*)(O + row * ldc + col0 + bj * HALF) = w; } }
            asm volatile("" ::: "memory");
        }
    }
};
template <bool SC, bool SRCB> struct EpiResT {
    const void* src; const void* src2; int split_pm; bf16* dst; int ld; float scale; const unsigned char* wsb;
    template <class AccT> __device__ __forceinline__ void operator()(const AccT (&acc)[2][2][4][2], const Unit& u, int wr, int wc, int fr, int fq) const {
        const int row0 = u.pm * BM + wr * 64 + fr, col0 = u.pn * BM + wc * 32 + 8 * fq;
        const float* rs = (const float*)(wsb + WS_RSMA); const float* cs = (const float*)(wsb + WS_CSO);
        const char* sbase = (u.pm < split_pm) ? (const char*)src : (const char*)src2 - (size_t)split_pm * BM * ld * (SRCB ? 2 : 4);
        f32x4 cv[2][2];
#pragma unroll
        for (int bj = 0; bj < 2; ++bj) { if constexpr (SC) { cv[bj][0] = *(const f32x4*)(cs + col0 + bj * HALF); cv[bj][1] = *(const f32x4*)(cs + col0 + bj * HALF + 4); } else { cv[bj][0] = (f32x4){scale, scale, scale, scale}; cv[bj][1] = cv[bj][0]; } }
#pragma unroll
        for (int ai = 0; ai < 2; ++ai)
#pragma unroll
            for (int mh = 0; mh < 2; ++mh) {
                f32x4 sv[2][2][2]; float rsv[2];
#pragma unroll
                for (int mm = 0; mm < 2; ++mm) { const int m = 2 * mh + mm; const size_t off = (size_t)(row0 + ai * HALF + m * 16) * ld + col0; rsv[mm] = 1.f; if constexpr (SC) rsv[mm] = rs[row0 + ai * HALF + m * 16];
#pragma unroll
                    for (int bj = 0; bj < 2; ++bj) {
                        if constexpr (SRCB) { const u32x4 w = *(const u32x4*)((const bf16*)sbase + off + bj * HALF); sv[mm][bj][0] = (f32x4){bf_lo(w.x), bf_hi(w.x), bf_lo(w.y), bf_hi(w.y)}; sv[mm][bj][1] = (f32x4){bf_lo(w.z), bf_hi(w.z), bf_lo(w.w), bf_hi(w.w)}; }
                        else { const float* sp = (const float*)sbase + off + bj * HALF; sv[mm][bj][0] = *(const f32x4*)sp; sv[mm][bj][1] = *(const f32x4*)(sp + 4); } } }
#pragma unroll
                for (int mm = 0; mm < 2; ++mm) { const int m = 2 * mh + mm; const size_t off = (size_t)(row0 + ai * HALF + m * 16) * ld + col0;
#pragma unroll
                    for (int bj = 0; bj < 2; ++bj) { const f32x4 o0 = sv[mm][bj][0] + tof(acc[ai][bj][m][0]) * (cv[bj][0] * rsv[mm]), o1 = sv[mm][bj][1] + tof(acc[ai][bj][m][1]) * (cv[bj][1] * rsv[mm]);
                        u32x4 w; w.x = cvt_pk_bf16(o0[0], o0[1]); w.y = cvt_pk_bf16(o0[2], o0[3]); w.z = cvt_pk_bf16(o1[0], o1[1]); w.w = cvt_pk_bf16(o1[2], o1[3]); *(u32x4*)(dst + off + bj * HALF) = w; } }
                asm volatile("" ::: "memory");
            }
    }
};

__device__ __forceinline__ float dpp_from_prev_lane(float v) { return __builtin_bit_cast(float, __builtin_amdgcn_update_dpp(0, __builtin_bit_cast(int, v), 0x121, 0xF, 0xF, true)); }
__device__ __forceinline__ float dpp_from_next_lane(float v) { return __builtin_bit_cast(float, __builtin_amdgcn_update_dpp(0, __builtin_bit_cast(int, v), 0x12F, 0xF, 0xF, true)); }
struct EpiConv {
    unsigned char* act; bf16* yb; const float* cw; const float* cb; const unsigned char* wsb; float oscale;
    template <class AccT> __device__ __forceinline__ void operator()(const AccT (&acc)[2][2][4][2], const Unit& u, int wr, int wc, int fr, int fq) const {
        const float* rs = (const float*)(wsb + WS_RSHF); const float* cs = (const float*)(wsb + WS_CSUP);
#pragma unroll
        for (int n = 0; n < 2; ++n) {
            const int ch0 = wc * 32 + 8 * fq + 4 * n, cg = u.pn * 128 + ch0, colg = u.pn * BM + ch0;
            const f32x4 csg = *(const f32x4*)(cs + colg), csu = *(const f32x4*)(cs + colg + HALF), bg = *(const f32x4*)(cb + cg), bu = *(const f32x4*)(cb + DFF + cg);
            f32x4 wg[3], wu[3];
#pragma unroll
            for (int t = 0; t < 3; ++t) { wg[t] = *(const f32x4*)(cw + t * NUP + cg); wu[t] = *(const f32x4*)(cw + t * NUP + DFF + cg); }
#pragma unroll
            for (int ai = 0; ai < 2; ++ai) {
                const int rowb = u.pm * BM + ai * HALF + wr * 64;
                f32x4 yg[4], yu[4];
#pragma unroll
                for (int m = 0; m < 4; ++m) { const float rsv = rs[rowb + 16 * m + fr]; yg[m] = tof(acc[ai][0][m][n]) * (csg * rsv); yu[m] = tof(acc[ai][1][m][n]) * (csu * rsv); }
                if (fr < 2 || fr >= 14) { const bool lo = fr < 2; bf16* yr = yb + ((size_t)(rowb >> 6) * 4 + (lo ? fr : fr - 12)) * NUP + colg;
                    const f32x4 a0 = lo ? yg[0] : yg[3], b0 = lo ? yu[0] : yu[3];
                    u32x2 w; w.x = cvt_pk_bf16(a0[0], a0[1]); w.y = cvt_pk_bf16(a0[2], a0[3]); *(u32x2*)yr = w;
                    w.x = cvt_pk_bf16(b0[0], b0[1]); w.y = cvt_pk_bf16(b0[2], b0[3]); *(u32x2*)(yr + HALF) = w; }
#pragma unroll
                for (int m = 0; m < 4; ++m) {
                    float o[4];
#pragma unroll
                    for (int e = 0; e < 4; ++e) {
                        const float gc = yg[m][e], uc = yu[m][e];
                        const float gsp = (m > 0 && fr == 15) ? yg[m > 0 ? m - 1 : 0][e] : gc, usp = (m > 0 && fr == 15) ? yu[m > 0 ? m - 1 : 0][e] : uc;
                        const float gsn = (m < 3 && fr == 0) ? yg[m < 3 ? m + 1 : 3][e] : gc, usn = (m < 3 && fr == 0) ? yu[m < 3 ? m + 1 : 3][e] : uc;
                        const float gp = dpp_from_prev_lane(gsp), up = dpp_from_prev_lane(usp), gn = dpp_from_next_lane(gsn), un = dpp_from_next_lane(usn);
                        const float ug = wg[0][e] * gp + wg[1][e] * gc + wg[2][e] * gn + bg[e];
                        const float uu = wu[0][e] * up + wu[1][e] * uc + wu[2][e] * un + bu[e];
                        o[e] = ug * fast_sigmoid(ug) * uu * oscale; }
                    const bool edge = (m == 0 && fr == 0) || (m == 3 && fr == 15);
                    if (!edge) { const size_t row = (size_t)(rowb + 16 * m + fr);
                        if (FP8_DOWN) *(unsigned*)(act + row * DFF + cg) = pack4_fp8(o[0], o[1], o[2], o[3]);
                        else { u32x2 w; w.x = cvt_pk_bf16(o[0], o[1]); w.y = cvt_pk_bf16(o[2], o[3]); *(u32x2*)((bf16*)act + row * DFF + cg) = w; } }
                }
                asm volatile("" ::: "memory");
            }
        }
    }
};
}

namespace att {
constexpr int OFF_V = 0, SHM_V = 16384, OFF_K = 32768, KROW = 144  , SHM_KP = 64 * KROW, OFF_WS = 32768 + 2 * 3 * SHM_KP, OFF_TBL = OFF_WS + 2048, OFF_QR = OFF_TBL + 2064  , LDS_END = OFF_QR + 256 * KROW;
#define SBAR() __builtin_amdgcn_sched_barrier(0)
__device__ __forceinline__ int crow(int r, int hi) { return (r & 3) + 8 * (r >> 2) + 4 * hi; }
__device__ __forceinline__ int kswz(int row, int colB) { return row * KROW + colB; }
__device__ __forceinline__ int v_st(int k, int c) { const int kk = (k & ~0xC) | ((k & 4) << 1) | ((k & 8) >> 1); return ((kk >> 3) * 4 + (c >> 5)) * 512 + ((kk & 7) * 32 + (c & 31)) * 2; }
__device__ __forceinline__ int v_rd_base(int lane) { return ((lane & 3) << 3) | (((lane >> 2) & 3) << 6) | (((lane >> 4) & 1) << 5) | (((lane >> 5) & 1) << 8); }
constexpr int v_rd_off(int d0, int ks, int half) { return d0 * 512 + ks * 4096 + half * 2048; }
template <int OFF> __device__ __forceinline__ s16x4 tr_read(int vb) { s16x4 r; asm volatile("ds_read_b64_tr_b16 %0, %1 offset:%2" : "=&v"(r) : "v"(vb), "i"(OFF) : "memory"); return r; }
template <int D0> __device__ __forceinline__ void pv_one(f32x16& od, int vb, bf16x8 pa0, bf16x8 pa1, bf16x8 pa2, bf16x8 pa3) {
    const s16x4 l0 = tr_read<v_rd_off(D0, 0, 0)>(vb), h0 = tr_read<v_rd_off(D0, 0, 1)>(vb), l1 = tr_read<v_rd_off(D0, 1, 0)>(vb), h1 = tr_read<v_rd_off(D0, 1, 1)>(vb);
    const s16x4 l2 = tr_read<v_rd_off(D0, 2, 0)>(vb), h2 = tr_read<v_rd_off(D0, 2, 1)>(vb), l3 = tr_read<v_rd_off(D0, 3, 0)>(vb), h3 = tr_read<v_rd_off(D0, 3, 1)>(vb);
    asm volatile("s_waitcnt lgkmcnt(0)" ::: "memory"); SBAR();
#define PK(L, H) (bf16x8){L[0], L[1], L[2], L[3], H[0], H[1], H[2], H[3]}
    od = __builtin_amdgcn_mfma_f32_32x32x16_bf16(pa0, PK(l0, h0), od, 0, 0, 0);
    od = __builtin_amdgcn_mfma_f32_32x32x16_bf16(pa1, PK(l1, h1), od, 0, 0, 0);
    od = __builtin_amdgcn_mfma_f32_32x32x16_bf16(pa2, PK(l2, h2), od, 0, 0, 0);
    od = __builtin_amdgcn_mfma_f32_32x32x16_bf16(pa3, PK(l3, h3), od, 0, 0, 0);
#undef PK
}
__device__ __forceinline__ void pv_d0(f32x16* o, int vb, bf16x8 pa0, bf16x8 pa1, bf16x8 pa2, bf16x8 pa3) {
    pv_one<0>(o[0], vb, pa0, pa1, pa2, pa3); pv_one<1>(o[1], vb, pa0, pa1, pa2, pa3); pv_one<2>(o[2], vb, pa0, pa1, pa2, pa3); pv_one<3>(o[3], vb, pa0, pa1, pa2, pa3);
}
__device__ __forceinline__ float fma_s(float a, float s_uniform, float c) { float d; asm("v_fma_f32 %0, %1, %2, %3" : "=v"(d) : "v"(a), "s"(s_uniform), "v"(c)); return d; }
constexpr float THR2 = 8.0f * 1.4426950408889634f;
template <bool BIAS>
__device__ __forceinline__ void partialSM(f32x16& p0, f32x16& p1, float& m_reg, float& mn, float& alpha, float Cs, bool near, float bconst, int relbase, int hi, const LAS float* tbl) {
    float pmax;
    if (BIAS && near) {
#pragma unroll
        for (int r = 0; r < 16; ++r) { const int k = relbase + crow(r, hi);
            const int i0 = min(max(k, 0), 256), i1 = min(max(k + 32, 0), 256);
            p0[r] = fma_s(p0[r], Cs, tbl[i0]); p1[r] = fma_s(p1[r], Cs, tbl[i1]); }
        pmax = p0[0];
#pragma unroll
        for (int r = 1; r < 16; ++r) pmax = fmaxf(pmax, p0[r]);
#pragma unroll
        for (int r = 0; r < 16; ++r) pmax = fmaxf(pmax, p1[r]);
        { auto rr = __builtin_amdgcn_permlane32_swap(__float_as_uint(pmax), __float_as_uint(pmax), false, false); pmax = fmaxf(__uint_as_float(rr[0]), __uint_as_float(rr[1])); }
        if (__builtin_expect(__all(pmax - m_reg <= THR2), 1)) { mn = m_reg; alpha = 1.f; }
        else { mn = fmaxf(m_reg, pmax); alpha = __builtin_amdgcn_exp2f(m_reg - mn); m_reg = mn; }
#pragma unroll
        for (int r = 0; r < 16; ++r) { p0[r] = p0[r] - mn; p1[r] = p1[r] - mn; }
    } else {
        pmax = p0[0];
#pragma unroll
        for (int r = 1; r < 16; ++r) pmax = fmaxf(pmax, p0[r]);
#pragma unroll
        for (int r = 0; r < 16; ++r) pmax = fmaxf(pmax, p1[r]);
        { auto rr = __builtin_amdgcn_permlane32_swap(__float_as_uint(pmax), __float_as_uint(pmax), false, false); pmax = fmaxf(__uint_as_float(rr[0]), __uint_as_float(rr[1])); }
        pmax = fmaf(pmax, Cs, bconst);
        if (__builtin_expect(__all(pmax - m_reg <= THR2), 1)) { mn = m_reg; alpha = 1.f; }
        else { mn = fmaxf(m_reg, pmax); alpha = __builtin_amdgcn_exp2f(m_reg - mn); m_reg = mn; }
        const float off = bconst - mn;
#pragma unroll
        for (int r = 0; r < 16; ++r) { p0[r] = fma_s(p0[r], Cs, off); p1[r] = fma_s(p1[r], Cs, off); }
    }
#pragma unroll
    for (int r = 0; r < 16; ++r) p0[r] = __builtin_amdgcn_exp2f(p0[r]);
}
__device__ __forceinline__ void partialSM_ci(f32x16& p0, f32x16& p1, float& m_reg, float& alpha, f32x16& csp, bool first, bool near, float bcur, int relbase, int hi, const LAS float* tbl) {
    if (near) {
        const LAS float* tb = tbl + relbase + 4 * hi;
#pragma unroll
        for (int r = 0; r < 16; ++r) { p0[r] += tb[(r & 3) + 8 * (r >> 2)]; p1[r] += tb[32 + (r & 3) + 8 * (r >> 2)]; }
    }
    float pmax = p0[0];
#pragma unroll
    for (int r = 1; r < 16; ++r) pmax = fmaxf(pmax, p0[r]);
#pragma unroll
    for (int r = 0; r < 16; ++r) pmax = fmaxf(pmax, p1[r]);
    { auto rr = __builtin_amdgcn_permlane32_swap(__float_as_uint(pmax), __float_as_uint(pmax), false, false); pmax = fmaxf(__uint_as_float(rr[0]), __uint_as_float(rr[1])); }
    if (__builtin_expect(!first && __all(pmax <= THR2), 1)) { alpha = 1.f; }
    else { const float d = first ? pmax : fmaxf(pmax, 0.f); alpha = __builtin_amdgcn_exp2f(-d); m_reg += d;
#pragma unroll
        for (int r = 0; r < 16; ++r) { p0[r] -= d; p1[r] -= d; csp[r] -= d; } }
#pragma unroll
    for (int r = 0; r < 16; ++r) p0[r] = __builtin_amdgcn_exp2f(p0[r]);
}
__device__ __forceinline__ void finishSM(f32x16& p0, f32x16& p1, float alpha, float& l_reg, bf16x8& pa0, bf16x8& pa1, bf16x8& pa2, bf16x8& pa3) {
#pragma unroll
    for (int r = 0; r < 16; ++r) p1[r] = __builtin_amdgcn_exp2f(p1[r]);
    float ps = 0;
#pragma unroll
    for (int r = 0; r < 16; ++r) ps += p0[r];
#pragma unroll
    for (int r = 0; r < 16; ++r) ps += p1[r];
    { auto rr = __builtin_amdgcn_permlane32_swap(__float_as_uint(ps), __float_as_uint(ps), false, false); ps = __uint_as_float(rr[0]) + __uint_as_float(rr[1]); }
    l_reg = l_reg * alpha + ps;
#define PK4(P, BASE, OUT) do { unsigned a0 = cvt_pk_bf16(P[BASE + 0], P[BASE + 1]), a1 = cvt_pk_bf16(P[BASE + 2], P[BASE + 3]);   \
    unsigned b0 = cvt_pk_bf16(P[BASE + 4], P[BASE + 5]), b1 = cvt_pk_bf16(P[BASE + 6], P[BASE + 7]);                              \
    auto r0 = __builtin_amdgcn_permlane32_swap(a0, b0, false, false); auto r1 = __builtin_amdgcn_permlane32_swap(a1, b1, false, false); \
    u32x4 w = {r0[0], r1[0], r0[1], r1[1]}; OUT = *reinterpret_cast<bf16x8*>(&w); } while (0)
    PK4(p0, 0, pa0); PK4(p0, 8, pa1); PK4(p1, 0, pa2); PK4(p1, 8, pa3);
#undef PK4
}
template <int NP>
__device__ __forceinline__ void qkt(f32x16& p0, f32x16& p1, const LAS char* Ks, const bf16x8* qr, const LAS char* qrl, int r32, int hi, const f32x16& cinit) {
    p0 = cinit; p1 = cinit;
#pragma unroll
    for (int p = 0; p < NP; ++p)
#pragma unroll
        for (int d0 = 0; d0 < 4; ++d0) { const int cb = d0 * 32 + hi * 16;
            bf16x8 b0 = *(const LAS bf16x8*)(Ks + p * SHM_KP + kswz(r32, cb));
            bf16x8 b1 = *(const LAS bf16x8*)(Ks + p * SHM_KP + kswz(32 + r32, cb));
            const bf16x8 qf = (NP == 3 && p == 2) ? *(const LAS bf16x8*)(qrl + d0 * 32) : qr[p * 4 + d0];
            p0 = __builtin_amdgcn_mfma_f32_32x32x16_bf16(b0, qf, p0, 0, 0, 0);
            p1 = __builtin_amdgcn_mfma_f32_32x32x16_bf16(b1, qf, p1, 0, 0, 0); }
}
struct Ptrs { const bf16* q[3]; const bf16* k[3]; const bf16* v; };
struct StrDiff { static constexpr int LDQ = NIN, LDK = NIN, LDK2 = NIN, LDV = NIN; };
struct StrMla { static constexpr int LDQ = NQ, LDK = NKV, LDK2 = NIN, LDV = NKV; };
template <int NP, bool BIAS, int SDEPTH, class STR>
__device__ __forceinline__ void attn_body(const Ptrs& P, int seq, int qpos0, float Cs, LAS char* lds, f32x16 (&o)[4], int tid_in) {
    int tid = tid_in; asm volatile("" : "+v"(tid));
    const int wid = __builtin_amdgcn_readfirstlane(tid >> 6), lane = tid & 63, r32 = lane & 31, hi = lane >> 5;
    LAS char* V_lds = lds + OFF_V; LAS char* K_lds = lds + OFF_K;
    LAS float* wsl = (LAS float*)(lds + OFF_WS) + wid * 64; LAS float* li_l = wsl; LAS float* al_l = wsl + 32;
    const LAS float* tbl = (const LAS float*)(lds + OFF_TBL);
    constexpr int KB = NP * SHM_KP;
    constexpr bool CI = BIAS && (ATT_CINIT != 0);
    float m_reg = CI ? 0.f : -1e30f, l_reg = 0;
#pragma unroll
    for (int d = 0; d < 4; ++d) o[d] = f32x16{};
    constexpr int NPR = (NP == 3) ? 2 : NP;
    bf16x8 qr[NPR * 4];
#pragma unroll
    for (int p = 0; p < NPR; ++p)
#pragma unroll
        for (int d0 = 0; d0 < 4; ++d0) qr[p * 4 + d0] = *reinterpret_cast<const bf16x8*>(P.q[p] + (long)(wid * 32 + r32) * STR::LDQ + hi * 8 + d0 * 16);
    LAS char* qrl = lds + OFF_QR + (wid * 32 + r32) * KROW + hi * 16;
    if constexpr (NP == 3) {
#pragma unroll
        for (int d0 = 0; d0 < 4; ++d0) *(LAS bf16x8*)(qrl + d0 * 32) = *reinterpret_cast<const bf16x8*>(P.q[2] + (long)(wid * 32 + r32) * STR::LDQ + hi * 8 + d0 * 16);
    }
    const int kr = tid >> 3, kc = tid & 7, kst = kswz(kr, kc * 16);
    const int sr = tid >> 4, sc = (tid & 15) * 8, vst0 = v_st(sr, sc), vst1 = v_st(32 + sr, sc);
    const int vb0 = (int)(uintptr_t)V_lds + v_rd_base(lane);
    const int qlo = qpos0 + wid * 32;
    const float bL = BIAS ? tbl[0] : 0.f, bR = BIAS ? tbl[CI ? 512 : 256] : 0.f;
    f32x16 csp = f32x16{}; float bcur = bL;
    if constexpr (CI) {
#pragma unroll
        for (int r = 0; r < 16; ++r) csp[r] = bL; }
    struct { bf16x8 vs0, vs1, ks[NP]; } st_[SDEPTH];
#define SLOAD(i, k0) do { st_[i].vs0 = *reinterpret_cast<const bf16x8*>(P.v + (long)((k0) + sr) * STR::LDV + sc); st_[i].vs1 = *reinterpret_cast<const bf16x8*>(P.v + (long)((k0) + 32 + sr) * STR::LDV + sc); \
    _Pragma("unroll") for (int p_ = 0; p_ < NP; ++p_) st_[i].ks[p_] = *reinterpret_cast<const bf16x8*>(P.k[p_] + (long)((k0) + kr) * (p_ == 2 ? STR::LDK2 : STR::LDK) + kc * 8); } while (0)
#define SWRITE(b, i) do { *(LAS bf16x8*)(V_lds + (b) * SHM_V + vst0) = st_[i].vs0; *(LAS bf16x8*)(V_lds + (b) * SHM_V + vst1) = st_[i].vs1; \
    _Pragma("unroll") for (int p_ = 0; p_ < NP; ++p_) *(LAS bf16x8*)(K_lds + (b) * KB + p_ * SHM_KP + kst) = st_[i].ks[p_]; } while (0)
#define SWAIT() do { if constexpr (SDEPTH == 2) { if constexpr (NP == 1) asm volatile("s_waitcnt vmcnt(3)" ::: "memory"); else asm volatile("s_waitcnt vmcnt(5)" ::: "memory"); } else asm volatile("s_waitcnt vmcnt(0)" ::: "memory"); } while (0)
#define RESC(a) do { if (__any((a) < 1.f)) { if (hi == 0) al_l[r32] = (a); asm volatile("s_waitcnt lgkmcnt(0)" ::: "memory"); \
    _Pragma("unroll") for (int d = 0; d < 4; ++d) _Pragma("unroll") for (int r = 0; r < 16; ++r) o[d][r] *= al_l[crow(r, hi)]; } } while (0)
#define TILEB(j, nearv, bcv, rbv) const int _rh##j = (j) * 64 + 63 - qlo, _rl##j = (j) * 64 - (qlo + 31); \
    const bool nearv = BIAS && (_rh##j > -128) && (_rl##j < 128); const float bcv = (_rh##j <= -128) ? bL : bR; const int rbv = (j) * 64 - (qlo + r32) + (CI ? 256 : 128)
#define CLS(nearv, bcv) do { if constexpr (CI) { const float _bt = (nearv) ? 0.f : (bcv); if (_bt != bcur) { const float _dl = _bt - bcur; _Pragma("unroll") for (int r = 0; r < 16; ++r) csp[r] += _dl; bcur = _bt; } } } while (0)
#define PSM(P0, P1, MN, AL, first, nearv, bcv, rbv) do { if constexpr (CI) { partialSM_ci(P0, P1, m_reg, AL, csp, first, nearv, bcur, rbv, hi, tbl); MN = 0.f; } \
        else partialSM<BIAS>(P0, P1, m_reg, MN, AL, Cs, nearv, bcv, rbv, hi, tbl); } while (0)
    f32x16 pA0, pA1, pB0, pB1; float mnA, mnB, alA, alB; bf16x8 pa0, pa1, pa2, pa3; const int NT = seq / 64;
    constexpr int SE = 0, SO = SDEPTH - 1;
    SLOAD(SE, 0); asm volatile("s_waitcnt vmcnt(0)" ::: "memory"); SWRITE(0, SE); __syncthreads();
    { const int jj = 0; TILEB(jj, nr, bc, rb); CLS(nr, bc); qkt<NP>(pA0, pA1, K_lds, qr, qrl, r32, hi, csp); PSM(pA0, pA1, mnA, alA, true, nr, bc, rb); }
    SLOAD(SO, 64); if constexpr (SDEPTH == 2) { if (2 < NT) SLOAD(SE, 128); }
    SWAIT(); SWRITE(1, SO); __syncthreads();
    for (int j = 1; j + 1 < NT; j += 2) {
        TILEB(j, nrB, bcB, rbB); CLS(nrB, bcB);
        SBAR(); qkt<NP>(pB0, pB1, K_lds + KB, qr, qrl, r32, hi, csp);
        finishSM(pA0, pA1, alA, l_reg, pa0, pa1, pa2, pa3); SBAR();
        SLOAD(SO, (j + SDEPTH) * 64); SBAR();
        pv_d0(o, vb0, pa0, pa1, pa2, pa3);
        PSM(pB0, pB1, mnB, alB, false, nrB, bcB, rbB);
        __syncthreads(); SWAIT(); SWRITE(0, SE);
        RESC(alB); __syncthreads();
        const int j1 = j + 1; TILEB(j1, nrA, bcA, rbA); CLS(nrA, bcA);
        SBAR(); qkt<NP>(pA0, pA1, K_lds, qr, qrl, r32, hi, csp);
        finishSM(pB0, pB1, alB, l_reg, pa0, pa1, pa2, pa3); SBAR();
        if (SDEPTH == 1 || j + 3 < NT) SLOAD(SE, (j + 1 + SDEPTH) * 64); SBAR();
        pv_d0(o, vb0 + SHM_V, pa0, pa1, pa2, pa3);
        PSM(pA0, pA1, mnA, alA, false, nrA, bcA, rbA);
        __syncthreads(); SWAIT(); SWRITE(1, SO);
        RESC(alA); __syncthreads();
    }
    const int jl = NT - 1; TILEB(jl, nrL, bcL, rbL); CLS(nrL, bcL);
    SBAR(); qkt<NP>(pB0, pB1, K_lds + KB, qr, qrl, r32, hi, csp);
    finishSM(pA0, pA1, alA, l_reg, pa0, pa1, pa2, pa3); SBAR();
    pv_d0(o, vb0, pa0, pa1, pa2, pa3);
    PSM(pB0, pB1, mnB, alB, false, nrL, bcL, rbL);
    __syncthreads(); RESC(alB);
    finishSM(pB0, pB1, alB, l_reg, pa0, pa1, pa2, pa3); SBAR();
    pv_d0(o, vb0 + SHM_V, pa0, pa1, pa2, pa3);
    if (hi == 0) li_l[r32] = l_reg; asm volatile("s_waitcnt lgkmcnt(0)" ::: "memory");
#pragma unroll
    for (int r = 0; r < 16; ++r) { const float rl = __builtin_amdgcn_rcpf(li_l[crow(r, hi)]);
#pragma unroll
        for (int d = 0; d < 4; ++d) o[d][r] *= rl; }
    __syncthreads();
#undef SLOAD
#undef SWRITE
#undef SWAIT
#undef RESC
#undef TILEB
#undef CLS
#undef PSM
}
}

constexpr int NWAVES = 8;
constexpr int CW_BAR = 4096;
constexpr int RING_BYTES = 131072, MISC_OFF = RING_BYTES + 320, LDS_BYTES = 147456;
static_assert(att::LDS_END <= RING_BYTES, "attention LDS");

#define XB_TMO      128
#define XB_XCNT(j)  (256  + 64 * (j))
#define XB_XSUB(j)  (1280 + 64 * (j))
#define XB_XGEN(j)  (2304 + 64 * (j))
#define XB_TOP      3328
#define XB_TOPGEN   3392
#define XCD_BAR_WORDS 3456
#define XB_SPIN_CAP (1u << 21)
__device__ __forceinline__ unsigned xb_ld(unsigned* p)              { return __hip_atomic_load(p, __ATOMIC_RELAXED, __HIP_MEMORY_SCOPE_AGENT); }
__device__ __forceinline__ unsigned xb_add(unsigned* p, unsigned v) { return __hip_atomic_fetch_add(p, v, __ATOMIC_RELAXED, __HIP_MEMORY_SCOPE_AGENT); }
__device__ __forceinline__ unsigned xb_xcc_id() { return (unsigned)__builtin_amdgcn_s_getreg((3 << 11) | 20) & 0xFu; }
#define XB_SPIN(cond, bar) do { unsigned _sp = 0; while (cond) { __builtin_amdgcn_s_sleep(1); \
    if ((++_sp & 255u) == 0u) { if (xb_ld(&(bar)[XB_TMO])) break; if (_sp > XB_SPIN_CAP) { atomicAdd(&(bar)[XB_TMO], 1u); break; } } } } while (0)
struct XcdBarrier { unsigned* bar; unsigned x; volatile LAS unsigned* st; };
__device__ __forceinline__ XcdBarrier xcd_barrier_post(unsigned* bar, volatile LAS unsigned* st, bool leader) {
    XcdBarrier b; b.bar = bar; b.x = xb_xcc_id(); b.st = st;
    if (leader) (void)xb_add(&bar[XB_XCNT(b.x)], 1u);
    return b;
}
__device__ __forceinline__ void xcd_barrier_complete(unsigned* bar, unsigned x, unsigned& nloc, unsigned& nx) {
    const unsigned G = gridDim.x * gridDim.y * gridDim.z;
    unsigned sum, cnt, mine, sp = 0u;
    for (;;) {
        sum = 0u; cnt = 0u; mine = 0u;
#pragma unroll
        for (unsigned j = 0; j < 16; ++j) { const unsigned c = xb_ld(&bar[XB_XCNT(j)]); sum += c; cnt += (c > 0u) ? 1u : 0u; mine = (j == x) ? c : mine; }
        if (sum == G) break;
        __builtin_amdgcn_s_sleep(1);
        if ((++sp & 255u) == 0u) { if (xb_ld(&bar[XB_TMO])) break; if (sp > XB_SPIN_CAP) { atomicAdd(&bar[XB_TMO], 1u); break; } }
    }
    nloc = mine > 0u ? mine : 1u; nx = cnt > 0u ? cnt : 1u;
}
__device__ __forceinline__ void xcd_barrier(const XcdBarrier& b, bool leader) {
    asm volatile("s_waitcnt vmcnt(0)" ::: "memory");
    __syncthreads();
    if (leader) {
        unsigned* bar = b.bar;
        __builtin_amdgcn_s_waitcnt(0);
        unsigned nloc = b.st[0], nx = b.st[1];
        if (nloc == 0u) { xcd_barrier_complete(bar, b.x, nloc, nx); b.st[0] = nloc; b.st[1] = nx; }
        const unsigned old = xb_add(&bar[XB_XSUB(b.x)], 1u);
        const unsigned gen = old / nloc;
        if (old + 1u == (gen + 1u) * nloc) {
            __builtin_amdgcn_fence(__ATOMIC_RELEASE, "agent");
            asm volatile("s_waitcnt vmcnt(0)" ::: "memory");
            const unsigned og = xb_add(&bar[XB_TOP], 1u);
            const unsigned tg = og / nx;
            if (og + 1u == (tg + 1u) * nx) xb_add(&bar[XB_TOPGEN], 1u);
            else XB_SPIN(xb_ld(&bar[XB_TOPGEN]) == tg, bar);
            __builtin_amdgcn_fence(__ATOMIC_ACQUIRE, "agent");
            xb_add(&bar[XB_XGEN(b.x)], 1u);
            asm volatile("s_waitcnt vmcnt(0)" ::: "memory");
        } else {
            XB_SPIN(xb_ld(&bar[XB_XGEN(b.x)]) == gen, bar);
            __builtin_amdgcn_fence(__ATOMIC_ACQUIRE, "agent");
            asm volatile("s_waitcnt vmcnt(0)" ::: "memory");
        }
    }
    __syncthreads();
}

#define LDS_WAIT() asm volatile("s_waitcnt lgkmcnt(0)" ::: "memory")
template <int X> __device__ __forceinline__ float swz_xor(float v) { return __int_as_float(__builtin_amdgcn_ds_swizzle(__float_as_int(v), (X << 10) | 0x1f)); }
__device__ __forceinline__ float half_sum(float v) { v += swz_xor<1>(v); v += swz_xor<2>(v); v += swz_xor<4>(v); v += swz_xor<8>(v); v += swz_xor<16>(v); return v; }
__device__ __forceinline__ float wave_max(float v) {
    v = __builtin_fmaxf(v, swz_xor<1>(v)); v = __builtin_fmaxf(v, swz_xor<2>(v)); v = __builtin_fmaxf(v, swz_xor<4>(v)); v = __builtin_fmaxf(v, swz_xor<8>(v)); v = __builtin_fmaxf(v, swz_xor<16>(v));
    auto rr = __builtin_amdgcn_permlane32_swap(__float_as_uint(v), __float_as_uint(v), false, false);
    return __builtin_fmaxf(__uint_as_float(rr[0]), __uint_as_float(rr[1]));
}
__device__ __forceinline__ float wave_sum(float v) {
    v = half_sum(v);
    auto rr = __builtin_amdgcn_permlane32_swap(__float_as_uint(v), __float_as_uint(v), false, false);
    return __uint_as_float(rr[0]) + __uint_as_float(rr[1]);
}

constexpr int NWAVES_ = 8;
template <int MODE, class SrcFn>
__device__ __forceinline__ void convert_strip(const float* W, int K, int N, unsigned char* WT, float* cs, int n0, float fscale, LAS float* lmax, int wave, int lane, SrcFn src) {
    const int rg = lane >> 3, cq = lane & 7, nchunk = K >> 7;
    int sc[4];
#pragma unroll
    for (int j = 0; j < 4; ++j) sc[j] = src(n0 + 4 * cq + j);
    const bool contig = __all(sc[0] >= 0 && (sc[0] & 3) == 0 && sc[1] == sc[0] + 1 && sc[2] == sc[0] + 2 && sc[3] == sc[0] + 3);
    auto ldrow = [&](int row) -> f32x4 {
        if (contig) return *(const f32x4*)(W + (size_t)row * N + sc[0]);
        f32x4 v;
#pragma unroll
        for (int j = 0; j < 4; ++j) v[j] = sc[j] >= 0 ? W[(size_t)row * N + sc[j]] : 0.f;
        return v; };
    f32x4 inv = (f32x4){fscale, fscale, fscale, fscale};
    if constexpr (MODE == 2) {
        f32x4 mx = (f32x4){0.f, 0.f, 0.f, 0.f};
        for (int c = wave; c < nchunk; c += NWAVES_) { f32x4 v[16];
#pragma unroll
            for (int i = 0; i < 16; ++i) v[i] = ldrow(c * 128 + 16 * rg + i);
#pragma unroll
            for (int i = 0; i < 16; ++i)
#pragma unroll
                for (int j = 0; j < 4; ++j) mx[j] = __builtin_fmaxf(mx[j], __builtin_fabsf(v[i][j])); }
#pragma unroll
        for (int j = 0; j < 4; ++j) { float m = mx[j]; m = __builtin_fmaxf(m, swz_xor<8>(m)); m = __builtin_fmaxf(m, swz_xor<16>(m));
            auto rr = __builtin_amdgcn_permlane32_swap(__float_as_uint(m), __float_as_uint(m), false, false); mx[j] = __builtin_fmaxf(__uint_as_float(rr[0]), __uint_as_float(rr[1])); }
        __syncthreads();
        if (lane < 8) *(LAS f32x4*)(lmax + wave * 32 + 4 * lane) = mx;
        __syncthreads();
        f32x4 cm = *(const LAS f32x4*)(lmax + 4 * cq);
#pragma unroll
        for (int w = 1; w < NWAVES_; ++w) { const f32x4 o = *(const LAS f32x4*)(lmax + w * 32 + 4 * cq);
#pragma unroll
            for (int j = 0; j < 4; ++j) cm[j] = __builtin_fmaxf(cm[j], o[j]); }
#pragma unroll
        for (int j = 0; j < 4; ++j) inv[j] = cm[j] > 0.f ? 127.f / cm[j] : 0.f;
        if (wave == 0 && lane < 8) *(f32x4*)(cs + n0 + 4 * lane) = cm * (1.f / 127.f);
    }
    constexpr int EB = (MODE == 0) ? 2 : 1; const size_t rowb = (size_t)K * EB;
    for (int c = wave; c < nchunk; c += NWAVES_) { f32x4 v[16];
#pragma unroll
        for (int i = 0; i < 16; ++i) v[i] = ldrow(c * 128 + 16 * rg + i) * inv;
#pragma unroll
        for (int j = 0; j < 4; ++j) { unsigned char* dst = WT + (size_t)(n0 + 4 * cq + j) * rowb + (size_t)(c * 128 + 16 * rg) * EB;
            if constexpr (MODE == 2) { u32x4 o; o.x = pack4_i8(v[0][j], v[1][j], v[2][j], v[3][j]); o.y = pack4_i8(v[4][j], v[5][j], v[6][j], v[7][j]); o.z = pack4_i8(v[8][j], v[9][j], v[10][j], v[11][j]); o.w = pack4_i8(v[12][j], v[13][j], v[14][j], v[15][j]); *(u32x4*)dst = o; }
            else if constexpr (MODE == 1) { u32x4 o; o.x = pack4_fp8(v[0][j], v[1][j], v[2][j], v[3][j]); o.y = pack4_fp8(v[4][j], v[5][j], v[6][j], v[7][j]); o.z = pack4_fp8(v[8][j], v[9][j], v[10][j], v[11][j]); o.w = pack4_fp8(v[12][j], v[13][j], v[14][j], v[15][j]); *(u32x4*)dst = o; }
            else { u32x4 o; o.x = cvt_pk_bf16(v[0][j], v[1][j]); o.y = cvt_pk_bf16(v[2][j], v[3][j]); o.z = cvt_pk_bf16(v[4][j], v[5][j]); o.w = cvt_pk_bf16(v[6][j], v[7][j]); *(u32x4*)dst = o;
                   o.x = cvt_pk_bf16(v[8][j], v[9][j]); o.y = cvt_pk_bf16(v[10][j], v[11][j]); o.z = cvt_pk_bf16(v[12][j], v[13][j]); o.w = cvt_pk_bf16(v[14][j], v[15][j]); *(u32x4*)(dst + 16) = o; } }
    }
}
__device__ __forceinline__ int t5_bucket(int rel) {
    const int ret = rel > 0 ? 16 : 0; const int n = rel < 0 ? -rel : rel;
    if (n < 8) return ret + n;
    int large = 2 + (31 - __builtin_clz((unsigned)(n * n)));
    large = large < 15 ? large : 15;
    return ret + large;
}
__device__ __forceinline__ void sincos_f32arg(float ang, float& c, float& s) {
    const double a = (double)ang; const double kq = __builtin_rint(a * 0.63661977236758134);
    double r = __builtin_fma(-kq, 1.5707963267948966, a); r = __builtin_fma(-kq, 6.123233995736766e-17, r);
    const int q = ((int)kq) & 3; const double r2 = r * r;
    const double sp = r * (1.0 + r2 * (-1.0 / 6 + r2 * (1.0 / 120 + r2 * (-1.0 / 5040 + r2 * (1.0 / 362880 + r2 * (-1.0 / 39916800))))));
    const double cp = 1.0 + r2 * (-0.5 + r2 * (1.0 / 24 + r2 * (-1.0 / 720 + r2 * (1.0 / 40320 + r2 * (-1.0 / 3628800 + r2 * (1.0 / 479001600))))));
    const double sv = (q == 0) ? sp : (q == 1) ? cp : (q == 2) ? -sp : -cp;
    const double cv = (q == 0) ? cp : (q == 1) ? -sp : (q == 2) ? -cp : sp;
    c = (float)cv; s = (float)sv;
}

struct Args { const float* in[23]; float* out; unsigned char* ws; float invf[32]; int lo, hi; };
typedef const __attribute__((address_space(4))) Args* ArgsP;

enum { I_XP = 0, I_XS, I_RELB, I_FNG, I_RAG, I_WIN, I_LQ1, I_LK1, I_LQ2, I_LK2, I_SUBG, I_QNG, I_WQUP, I_KVNG, I_WKVUP, I_WA, I_WB, I_WO, I_RFG, I_WUP, I_CW, I_CB, I_WD };

#define P_WINT ((bf16*)(ws + WS_WIN))
#define P_WQT ((bf16*)(ws + WS_WQ))
#define P_WKVT ((bf16*)(ws + WS_WKV))
#define P_WAT ((bf16*)(ws + WS_WA))
#define P_WBT ((bf16*)(ws + WS_WB))
#define P_WOT ((bf16*)(ws + WS_WO))
#define P_WUPT ((bf16*)(ws + WS_WUP))
#define P_WDT ((bf16*)(ws + WS_WD))
#define P_COS ((float*)(ws + WS_COS))
#define P_SIN ((float*)(ws + WS_SIN))
#define P_BIAS2 ((float*)(ws + WS_BIAS))
#define P_LAM ((float*)(ws + WS_LAM))
#define P_CSIN ((float*)(ws + WS_CSIN))
#define P_CSUP ((float*)(ws + WS_CSUP))
#define P_RSH ((float*)(ws + WS_RSH))
#define P_QL8 ((unsigned char*)(ws + WS_QL8))
#define P_KVL8 ((unsigned char*)(ws + WS_KVL8))
#define P_AO8 ((unsigned char*)(ws + WS_AO8))
#define P_BO8 ((unsigned char*)(ws + WS_BO8))
#define P_MG8 ((unsigned char*)(ws + WS_MG8))
#define P_X1 ((bf16*)(ws + WS_X1))
#define P_HF ((unsigned char*)(ws + WS_HF))
#define P_RSHF ((float*)(ws + WS_RSHF))
#define P_P ((bf16*)(ws + WS_P))
#define P_Q ((bf16*)(ws + WS_Q))
#define P_KV ((bf16*)(ws + WS_KV))
#define P_AO ((bf16*)(ws + WS_AO))
#define P_BO ((bf16*)(ws + WS_BO))
#define P_MG ((bf16*)(ws + WS_MG))
#define P_STASH ((float*)(ws + WS_STASH))
#define P_Y ((bf16*)(ws + WS_Y))
#define P_ACT ((bf16*)(ws + WS_ACTV))
#define XG() ((g < 2) ? A->in[I_XP] + (size_t)g * TG * DM : A->in[I_XS] + (size_t)(g - 2) * TG * DM)
#define OG() (A->out + (size_t)g * TG * DM)
constexpr int NSTEP_PER_GROUP = 7, NSTEPS = 1 + NGRP * NSTEP_PER_GROUP + 6;
static_assert(I8_MID, "step program written for the int8 mixer path");

__global__ void __launch_bounds__(NWAVES * 64, 2) enc_fwd(Args args) {
    extern __shared__ __attribute__((aligned(16))) unsigned char lds[];
    LAS unsigned char* ldsL = (LAS unsigned char*)lds;
    volatile LAS unsigned* MISC = (volatile LAS unsigned*)(ldsL + MISC_OFF);
    const int wave = __builtin_amdgcn_readfirstlane((int)threadIdx.x >> 6);
    const int G = gridDim.x; const int bx = blockIdx.x; const int vcu0 = (G % 8 == 0) ? (bx % 8) * (G / 8) + bx / 8 : bx;
    unsigned char* ws = args.ws;
    unsigned* ctl = (unsigned*)(ws + WS_CTL);
    { const int tid0 = wave * 64 + lane_id_fresh(); for (int u = tid0; u < (LDS_BYTES - RING_BYTES) / 4; u += NWAVES * 64) ((LAS unsigned*)(ldsL + RING_BYTES))[u] = 0u; }
    __syncthreads();
    XcdBarrier bar; bar.bar = ctl + CW_BAR; bar.x = 0; bar.st = nullptr;
#if !MK_PER_STEP_LAUNCH
    bar = xcd_barrier_post(ctl + CW_BAR, MISC + 8, (wave * 64 + lane_id_fresh()) == 0);
#endif
    const int lo = args.lo, hi = args.hi;
    int step = 0;
#ifndef EN_MASK
#define EN_MASK 0xFFFFFF
#endif
#define EN(k) (((EN_MASK) >> (k)) & 1)
#define RUN() (step >= lo && step < hi)
#define LOCAL_TID() ArgsP A = (ArgsP)__builtin_amdgcn_kernarg_segment_ptr(); asm volatile("" : "+s"(A)); unsigned char* const ws = A->ws; (void)ws; int lane_ = lane_id_fresh(); asm volatile("" : "+v"(lane_)); const int lane = lane_; const int tid = wave * 64 + lane; (void)tid; int gw = gw0, vcu = vcu0; asm volatile("" : "+s"(gw), "+s"(vcu)); (void)gw; (void)vcu
#if MK_PER_STEP_LAUNCH
#define SEAM() do { ++step; } while (0)
#else
#define SEAM() do { if (RUN() && step + 1 < hi) xcd_barrier(bar, (wave * 64 + lane_id_fresh()) == 0); ++step; } while (0)
#endif
    const int gw0 = vcu0 * NWAVES + wave, NGW = G * NWAVES;

    if (RUN() && EN(0)) { LOCAL_TID();
        LAS float* lmax = (LAS float*)ldsL;
        auto ident = [](int n) -> int { return n; };
        auto srcIn = [](int n) -> int { if (n < C_GATE) return n; if (n < C_KPE) return n + 64; if (n < C_KPE + 64) { const int j = n - C_KPE; return 7680 + ((j & 1) ? 32 + (j >> 1) : (j >> 1)); } return -1; };
        auto srcQ = [](int n) -> int { if (n < 2048) return (n >> 7) * 192 + (n & 127); const int j = n - 2048, hh = j >> 6, jj = j & 63; return hh * 192 + 128 + ((jj & 1) ? 32 + (jj >> 1) : (jj >> 1)); };
        auto srcUp = [](int n) -> int { return CONV_FUSE ? ((n & 128) ? DFF : 0) + (n >> 8) * 128 + (n & 127) : n; };
        constexpr int T0 = DM / 32, T1 = T0 + NIN / 32, T2 = T1 + NUP / 32, T3 = T2 + DM / 32, T4 = T3 + DM / 32, T5 = T4 + DM / 32, T6 = T5 + NQ / 32, T7 = T6 + NKV / 32;
        for (int s = vcu; s < T7; s += G) {
            if (s < T0) { const int n0 = 32 * s;
                if (FP8_DOWN) convert_strip<1>(A->in[I_WD], DFF, DM, (unsigned char*)P_WDT, nullptr, n0, S_WD, lmax, wave, lane, ident); else convert_strip<0>(A->in[I_WD], DFF, DM, (unsigned char*)P_WDT, nullptr, n0, 1.f, lmax, wave, lane, ident); }
            else if (s < T1) { const int n0 = 32 * (s - T0);
                if (I8_IN) convert_strip<2>(A->in[I_WIN], DM, 15936, (unsigned char*)P_WINT, P_CSIN, n0, 1.f, lmax, wave, lane, srcIn); else convert_strip<0>(A->in[I_WIN], DM, 15936, (unsigned char*)P_WINT, nullptr, n0, 1.f, lmax, wave, lane, srcIn); }
            else if (s < T2) { const int n0 = 32 * (s - T1);
                if (I8_UP) convert_strip<2>(A->in[I_WUP], DM, NUP, (unsigned char*)P_WUPT, P_CSUP, n0, 1.f, lmax, wave, lane, srcUp); else convert_strip<0>(A->in[I_WUP], DM, NUP, (unsigned char*)P_WUPT, nullptr, n0, 1.f, lmax, wave, lane, srcUp); }
            else if (s < T3) { const int n0 = 32 * (s - T2);
                if (I8_MID) convert_strip<2>(A->in[I_WO], DM, DM, (unsigned char*)P_WOT, (float*)(ws + WS_CSO), n0, 1.f, lmax, wave, lane, ident); else convert_strip<0>(A->in[I_WO], DM, DM, (unsigned char*)P_WOT, nullptr, n0, 1.f, lmax, wave, lane, ident); }
            else if (s < T4) { const int n0 = 32 * (s - T3);
                if (I8_MID) convert_strip<2>(A->in[I_WA], 2048, DM, (unsigned char*)P_WAT, (float*)(ws + WS_CSA), n0, 1.f, lmax, wave, lane, ident); else convert_strip<0>(A->in[I_WA], 2048, DM, (unsigned char*)P_WAT, nullptr, n0, 1.f, lmax, wave, lane, ident); }
            else if (s < T5) { const int n0 = 32 * (s - T4);
                if (I8_MID) convert_strip<2>(A->in[I_WB], 2048, DM, (unsigned char*)P_WBT, (float*)(ws + WS_CSB), n0, 1.f, lmax, wave, lane, ident); else convert_strip<0>(A->in[I_WB], 2048, DM, (unsigned char*)P_WBT, nullptr, n0, 1.f, lmax, wave, lane, ident); }
            else if (s < T6) { const int n0 = 32 * (s - T5);
                if (I8_MID) convert_strip<2>(A->in[I_WQUP], 1024, NQ, (unsigned char*)P_WQT, (float*)(ws + WS_CSQ), n0, 1.f, lmax, wave, lane, srcQ); else convert_strip<0>(A->in[I_WQUP], 1024, NQ, (unsigned char*)P_WQT, nullptr, n0, 1.f, lmax, wave, lane, srcQ); }
            else { const int n0 = 32 * (s - T6);
                if (I8_MID) convert_strip<2>(A->in[I_WKVUP], 512, NKV, (unsigned char*)P_WKVT, (float*)(ws + WS_CSKV), n0, 1.f, lmax, wave, lane, ident); else convert_strip<0>(A->in[I_WKVUP], 512, NKV, (unsigned char*)P_WKVT, nullptr, n0, 1.f, lmax, wave, lane, ident); }
        }
        for (int i = bx * (NWAVES * 64) + tid; i < 8192 * 32; i += G * NWAVES * 64) { const int pos = i >> 5, k = i & 31; float c, s; sincos_f32arg((float)pos * A->invf[k], c, s); P_COS[i] = c; P_SIN[i] = s; }
        if (bx == 0) {
            for (int i = tid; i < 16 * 257; i += NWAVES * 64) { const int h = i / 257, j = i % 257; P_BIAS2[h * 260 + j] = A->in[I_RELB][t5_bucket(j - 128) * 16 + h] * 1.4426950408889634f; }
            if (wave == 0) { const float a = wave_sum(A->in[I_LQ1][lane] * A->in[I_LK1][lane]), b = wave_sum(A->in[I_LQ2][lane] * A->in[I_LK2][lane]);
                if (lane == 0) P_LAM[0] = expf(a) - expf(b) + 0.2f; }
        }
    }

    if (RUN() && EN(1)) { LOCAL_TID();
        const float* gv = A->in[I_RAG];
        for (int m = gw; m < NTOK; m += NGW) {
            const f32x4* xr = (const f32x4*)((m < NTOK / 2 ? A->in[I_XP] + (size_t)m * DM : A->in[I_XS] + (size_t)(m - NTOK / 2) * DM)) + lane; f32x4 v[16]; float s = 0.f;
#pragma unroll
            for (int j = 0; j < 16; ++j) { v[j] = xr[64 * j]; s += (v[j].x * v[j].x + v[j].y * v[j].y) + (v[j].z * v[j].z + v[j].w * v[j].w); }
            const float rstd = 1.0f / sqrtf(wave_sum(s) * (1.f / DM) + EPS);
            if (I8_IN) { float mx = 0.f;
#pragma unroll
                for (int j = 0; j < 16; ++j) { const f32x4 gg = ((const f32x4*)gv)[64 * j + lane]; v[j] = v[j] * rstd * gg; mx = __builtin_fmaxf(__builtin_fmaxf(mx, __builtin_fmaxf(__builtin_fabsf(v[j].x), __builtin_fabsf(v[j].y))), __builtin_fmaxf(__builtin_fabsf(v[j].z), __builtin_fabsf(v[j].w))); }
                mx = wave_max(mx); const float inv = mx > 0.f ? 127.f / mx : 0.f; if (lane == 0) P_RSHF[m] = mx * (1.f / 127.f);
                unsigned* o4 = (unsigned*)(P_HF + (size_t)m * DM) + lane;
#pragma unroll
                for (int j = 0; j < 16; ++j) o4[64 * j] = pack4_i8(v[j].x * inv, v[j].y * inv, v[j].z * inv, v[j].w * inv);
            } else {
            u32x2* o8 = (u32x2*)((bf16*)P_HF + (size_t)m * DM) + lane;
#pragma unroll
            for (int j = 0; j < 16; ++j) { const f32x4 gg = ((const f32x4*)gv)[64 * j + lane]; u32x2 w; w.x = cvt_pk_bf16(v[j].x * rstd * gg.x, v[j].y * rstd * gg.y); w.y = cvt_pk_bf16(v[j].z * rstd * gg.z, v[j].w * rstd * gg.w); o8[64 * j] = w; }
            }
        }
    }
    SEAM();

    for (int g = 0; g < NGRP; ++g) {
        const int seqlen = (g < 2) ? 4096 : 8192, posmask = seqlen - 1;

        if (RUN() && EN(2)) { LOCAL_TID();
            pg8::Gemm gm{(const bf16*)(P_HF + (size_t)g * TG * DM), DM / 2, P_WINT, TG, NIN, DM / 2}; pg8::StaticOrder S; S.init(TG, NIN, G, bx);
            pg8::EpiStoreT<I8_IN != 0, WS_RSHF, WS_CSIN> E{P_P, NIN, C_GATE / 256, C_KPE / 256, ATT_CINIT ? CS_DIFF : 1.f, ws, g * TG};
            REP_LOOP_GEMM { int l2_ = lane_id_fresh(); asm volatile("" : "+v"(l2_)); pg8::gemm_phase<pg8::EpiStoreT<I8_IN != 0, WS_RSHF, WS_CSIN>, I8_IN ? 2 : 0>(ldsL, gm, S, E, wave * 64 + l2_); }
        }
        SEAM();

        if (RUN() && EN(3)) { LOCAL_TID();
            const float* gq = A->in[I_QNG]; const float* gkv = A->in[I_KVNG];
            for (int m = gw; m < TG; m += NGW) {
                bf16* prow = P_P + (size_t)m * NIN;
                { u32x4 a = *(const u32x4*)(prow + C_QLAT + lane * 8), b = *(const u32x4*)(prow + C_QLAT + 512 + lane * 8);
                  float x[16] = {bf_lo(a.x), bf_hi(a.x), bf_lo(a.y), bf_hi(a.y), bf_lo(a.z), bf_hi(a.z), bf_lo(a.w), bf_hi(a.w), bf_lo(b.x), bf_hi(b.x), bf_lo(b.y), bf_hi(b.y), bf_lo(b.z), bf_hi(b.z), bf_lo(b.w), bf_hi(b.w)};
                  float s = 0.f;
#pragma unroll
                  for (int j = 0; j < 16; ++j) s += x[j] * x[j];
                  const float rstd = 1.0f / sqrtf(wave_sum(s) * (1.f / 1024) + EPS);
                  const f32x4 g0 = *(const f32x4*)(gq + lane * 8), g1 = *(const f32x4*)(gq + lane * 8 + 4), g2 = *(const f32x4*)(gq + 512 + lane * 8), g3 = *(const f32x4*)(gq + 512 + lane * 8 + 4);
                  u32x4 oa, ob;
                  oa.x = cvt_pk_bf16(x[0] * rstd * g0.x, x[1] * rstd * g0.y); oa.y = cvt_pk_bf16(x[2] * rstd * g0.z, x[3] * rstd * g0.w); oa.z = cvt_pk_bf16(x[4] * rstd * g1.x, x[5] * rstd * g1.y); oa.w = cvt_pk_bf16(x[6] * rstd * g1.z, x[7] * rstd * g1.w);
                  ob.x = cvt_pk_bf16(x[8] * rstd * g2.x, x[9] * rstd * g2.y); ob.y = cvt_pk_bf16(x[10] * rstd * g2.z, x[11] * rstd * g2.w); ob.z = cvt_pk_bf16(x[12] * rstd * g3.x, x[13] * rstd * g3.y); ob.w = cvt_pk_bf16(x[14] * rstd * g3.z, x[15] * rstd * g3.w);
                  if (I8_MID) { float y[16]; float mx = 0.f; const float gg[16] = {g0.x, g0.y, g0.z, g0.w, g1.x, g1.y, g1.z, g1.w, g2.x, g2.y, g2.z, g2.w, g3.x, g3.y, g3.z, g3.w};
#pragma unroll
                      for (int j = 0; j < 16; ++j) { y[j] = x[j] * rstd * gg[j]; mx = __builtin_fmaxf(mx, __builtin_fabsf(y[j])); }
                      mx = wave_max(mx); const float inv = mx > 0.f ? 127.f / mx : 0.f; if (lane == 0) ((float*)(ws + WS_RSQL))[m] = mx * (1.f / 127.f);
                      u32x2 q0, q1; q0.x = pack4_i8(y[0] * inv, y[1] * inv, y[2] * inv, y[3] * inv); q0.y = pack4_i8(y[4] * inv, y[5] * inv, y[6] * inv, y[7] * inv);
                      q1.x = pack4_i8(y[8] * inv, y[9] * inv, y[10] * inv, y[11] * inv); q1.y = pack4_i8(y[12] * inv, y[13] * inv, y[14] * inv, y[15] * inv);
                      *(u32x2*)(P_QL8 + (size_t)m * 1024 + lane * 8) = q0; *(u32x2*)(P_QL8 + (size_t)m * 1024 + 512 + lane * 8) = q1;
                  } else { *(u32x4*)(prow + C_QLAT + lane * 8) = oa; *(u32x4*)(prow + C_QLAT + 512 + lane * 8) = ob; } }
                { u32x4 a = *(const u32x4*)(prow + C_KVLAT + lane * 8);
                  float x[8] = {bf_lo(a.x), bf_hi(a.x), bf_lo(a.y), bf_hi(a.y), bf_lo(a.z), bf_hi(a.z), bf_lo(a.w), bf_hi(a.w)};
                  float s = 0.f;
#pragma unroll
                  for (int j = 0; j < 8; ++j) s += x[j] * x[j];
                  const float rstd = 1.0f / sqrtf(wave_sum(s) * (1.f / 512) + EPS);
                  const f32x4 g0 = *(const f32x4*)(gkv + lane * 8), g1 = *(const f32x4*)(gkv + lane * 8 + 4);
                  u32x4 oa;
                  oa.x = cvt_pk_bf16(x[0] * rstd * g0.x, x[1] * rstd * g0.y); oa.y = cvt_pk_bf16(x[2] * rstd * g0.z, x[3] * rstd * g0.w); oa.z = cvt_pk_bf16(x[4] * rstd * g1.x, x[5] * rstd * g1.y); oa.w = cvt_pk_bf16(x[6] * rstd * g1.z, x[7] * rstd * g1.w);
                  if (I8_MID) { float y[8]; float mx = 0.f; const float gg[8] = {g0.x, g0.y, g0.z, g0.w, g1.x, g1.y, g1.z, g1.w};
#pragma unroll
                      for (int j = 0; j < 8; ++j) { y[j] = x[j] * rstd * gg[j]; mx = __builtin_fmaxf(mx, __builtin_fabsf(y[j])); }
                      mx = wave_max(mx); const float inv = mx > 0.f ? 127.f / mx : 0.f; if (lane == 0) ((float*)(ws + WS_RSKVL))[m] = mx * (1.f / 127.f);
                      u32x2 q0; q0.x = pack4_i8(y[0] * inv, y[1] * inv, y[2] * inv, y[3] * inv); q0.y = pack4_i8(y[4] * inv, y[5] * inv, y[6] * inv, y[7] * inv);
                      *(u32x2*)(P_KVL8 + (size_t)m * 512 + lane * 8) = q0;
                  } else *(u32x4*)(prow + C_KVLAT + lane * 8) = oa; }
                if (lane < 32) { const int pos = m & posmask; unsigned w = *(const unsigned*)(prow + C_KPE + 2 * lane); const float x1 = bf_lo(w), x2 = bf_hi(w);
                  const float c = P_COS[pos * 32 + lane], s = P_SIN[pos * 32 + lane];
                  *(unsigned*)(prow + C_KPE + 2 * lane) = cvt_pk_bf16(x1 * c - x2 * s, x1 * s + x2 * c); }
            }
        }
        SEAM();

        if (RUN() && EN(4)) { LOCAL_TID();
            if (EN(18)) { pg8::Gemm gm{I8_MID ? (const bf16*)P_QL8 : P_P + C_QLAT, I8_MID ? 512 : NIN, P_WQT, TG, NQ, I8_MID ? 512 : 1024}; pg8::StaticOrder S; S.init(TG, NQ, G, bx);
              pg8::EpiQT<I8_MID != 0> E{P_Q, NQ, ws, posmask}; REP_LOOP_GEMM { int l2_ = lane_id_fresh(); asm volatile("" : "+v"(l2_)); pg8::gemm_phase<pg8::EpiQT<I8_MID != 0>, I8_MID ? 2 : 0>(ldsL, gm, S, E, wave * 64 + l2_); } }
            if (EN(19)) { pg8::Gemm gm{I8_MID ? (const bf16*)P_KVL8 : P_P + C_KVLAT, I8_MID ? 256 : NIN, P_WKVT, TG, NKV, I8_MID ? 256 : 512}; pg8::StaticOrder S; S.init(TG, NKV, G, bx);
              pg8::EpiStoreT<I8_MID != 0, WS_RSKVL, WS_CSKV> E{P_KV, NKV, 0, 0, 1.f, ws, 0}; REP_LOOP_GEMM { int l2_ = lane_id_fresh(); asm volatile("" : "+v"(l2_)); pg8::gemm_phase<pg8::EpiStoreT<I8_MID != 0, WS_RSKVL, WS_CSKV>, I8_MID ? 2 : 0>(ldsL, gm, S, E, wave * 64 + l2_); } }
        }
        SEAM();

        if (RUN() && EN(5)) { LOCAL_TID();
            const int wid = wave;
            const float lam = P_LAM[0];
            if (EN(16)) _Pragma("unroll 1") for (int rep = 0; rep < REP_DIFF; ++rep) for (int u = vcu; u < 512; u += G) {
                const int head = u >> 5, rb = u & 31, row0 = rb * 256, kbase = (seqlen == 4096) ? (rb >> 4) * 4096 : 0, qpos0 = row0 - kbase;
                __syncthreads();
                if (ATT_CINIT) { for (int i = tid; i < 513; i += NWAVES * 64) { const int rel = min(max(i - 256, -128), 128); ((float*)(lds + att::OFF_TBL))[i] = P_BIAS2[head * 260 + rel + 128]; } }
                else if (tid < 257) ((float*)(lds + att::OFF_TBL))[tid] = P_BIAS2[head * 260 + tid];
                __syncthreads();
#pragma unroll 1
                for (int c = 0; c < 2; ++c) {
                    att::Ptrs P;
                    P.q[0] = P_P + (size_t)row0 * NIN + C_DQ + head * 128 + c * 64; P.q[1] = P.q[0]; P.q[2] = P.q[0];
                    P.k[0] = P_P + (size_t)kbase * NIN + C_DK + head * 128 + c * 64; P.k[1] = P.k[0]; P.k[2] = P.k[0];
                    P.v = P_P + (size_t)kbase * NIN + C_DV + head * 128;
                    f32x16 o[4];
                    att::attn_body<1, true, 2, att::StrDiff>(P, seqlen, qpos0, 0.125f * 1.4426950408889634f, (LAS char*)ldsL, o, tid);
                    int tid_e = tid; asm volatile("" : "+v"(tid_e));
                    const int r32 = tid_e & 31, hh = (tid_e >> 5) & 1;
                    f32x4* myst = (f32x4*)(P_STASH + ((size_t)bx * 512 + tid_e) * 64);
                    if (c == 0) {
#pragma unroll
                        for (int d = 0; d < 4; ++d)
#pragma unroll
                            for (int r4 = 0; r4 < 4; ++r4) myst[d * 4 + r4] = (f32x4){o[d][4 * r4], o[d][4 * r4 + 1], o[d][4 * r4 + 2], o[d][4 * r4 + 3]};
                    } else {
                        float ss[16];
#pragma unroll
                        for (int r = 0; r < 16; ++r) ss[r] = 0.f;
#pragma unroll
                        for (int d = 0; d < 4; ++d)
#pragma unroll
                            for (int r4 = 0; r4 < 4; ++r4) { const f32x4 s0 = myst[d * 4 + r4];
#pragma unroll
                                for (int j = 0; j < 4; ++j) { const float a = s0[j] - lam * o[d][4 * r4 + j]; o[d][4 * r4 + j] = a; ss[4 * r4 + j] += a * a; } }
#pragma unroll
                        for (int r = 0; r < 16; ++r) ss[r] = 0.8f / sqrtf(half_sum(ss[r]) * (1.f / 128) + EPS);
                        const float* sg = A->in[I_SUBG];
                        float gsub[4];
#pragma unroll
                        for (int d = 0; d < 4; ++d) gsub[d] = sg[d * 32 + r32];
#pragma unroll
                        for (int r = 0; r < 16; ++r) { bf16* orow = P_AO + (size_t)(row0 + wid * 32 + att::crow(r, hh)) * 2048 + head * 128 + r32;
#pragma unroll
                            for (int d = 0; d < 4; ++d) orow[d * 32] = (bf16)(cvt_pk_bf16(o[d][r] * ss[r] * gsub[d], 0.f) & 0xffffu); }
                    }
                }
            }
            if (EN(17)) _Pragma("unroll 1") for (int rep = 0; rep < REP_MLA; ++rep) for (int u = vcu; u < 512; u += G) {
                const int head = u >> 5, rb = u & 31, row0 = rb * 256, kbase = (seqlen == 4096) ? (rb >> 4) * 4096 : 0;
                att::Ptrs P;
                P.q[0] = P_Q + (size_t)row0 * NQ + head * 128; P.q[1] = P.q[0] + 64; P.q[2] = P_Q + (size_t)row0 * NQ + 2048 + head * 64;
                P.k[0] = P_KV + (size_t)kbase * NKV + head * 256; P.k[1] = P.k[0] + 64; P.k[2] = P_P + (size_t)kbase * NIN + C_KPE;
                P.v = P_KV + (size_t)kbase * NKV + head * 256 + 128;
                f32x16 o[4];
                att::attn_body<3, false, 1, att::StrMla>(P, seqlen, 0, 0.07216878364870323f * 1.4426950408889634f, (LAS char*)ldsL, o, tid);
                int tid_e = tid; asm volatile("" : "+v"(tid_e));
                const int r32 = tid_e & 31, hh = (tid_e >> 5) & 1;
#pragma unroll
                for (int r = 0; r < 16; ++r) { bf16* orow = P_BO + (size_t)(row0 + wid * 32 + att::crow(r, hh)) * 2048 + head * 128 + r32;
#pragma unroll
                    for (int d = 0; d < 4; ++d) orow[d * 32] = (bf16)(cvt_pk_bf16(o[d][r], 0.f) & 0xffffu); }
            }
        }
        SEAM();

#if I8_MID
        if (RUN()) { LOCAL_TID();
            for (int m = gw; m < 2 * TG; m += NGW) { const int row = m >> 1; const bool isB = m & 1;
                const bf16* srow = (isB ? P_BO : P_AO) + (size_t)row * 2048 + lane * 8; u32x4 a[4]; float mx = 0.f;
#pragma unroll
                for (int j = 0; j < 4; ++j) { a[j] = *(const u32x4*)(srow + 512 * j);
                    mx = __builtin_fmaxf(mx, __builtin_fmaxf(__builtin_fmaxf(__builtin_fmaxf(__builtin_fabsf(bf_lo(a[j].x)), __builtin_fabsf(bf_hi(a[j].x))), __builtin_fmaxf(__builtin_fabsf(bf_lo(a[j].y)), __builtin_fabsf(bf_hi(a[j].y)))),
                                                      __builtin_fmaxf(__builtin_fmaxf(__builtin_fabsf(bf_lo(a[j].z)), __builtin_fabsf(bf_hi(a[j].z))), __builtin_fmaxf(__builtin_fabsf(bf_lo(a[j].w)), __builtin_fabsf(bf_hi(a[j].w)))))); }
                mx = wave_max(mx); const float inv = mx > 0.f ? 127.f / mx : 0.f; if (lane == 0) ((float*)(ws + (isB ? WS_RSB : WS_RSA)))[row] = mx * (1.f / 127.f);
                unsigned char* drow = (isB ? P_BO8 : P_AO8) + (size_t)row * 2048 + lane * 8;
#pragma unroll
                for (int j = 0; j < 4; ++j) { u32x2 q; q.x = pack4_i8(bf_lo(a[j].x) * inv, bf_hi(a[j].x) * inv, bf_lo(a[j].y) * inv, bf_hi(a[j].y) * inv); q.y = pack4_i8(bf_lo(a[j].z) * inv, bf_hi(a[j].z) * inv, bf_lo(a[j].w) * inv, bf_hi(a[j].w) * inv); *(u32x2*)(drow + 512 * j) = q; }
            }
        }
        SEAM();
#endif

        if (RUN() && EN(6)) { LOCAL_TID();
            if (EN(20)) { pg8::Gemm gm{I8_MID ? (const bf16*)P_AO8 : P_AO, I8_MID ? 1024 : 2048, P_WAT, TG, DM, I8_MID ? 1024 : 2048}; pg8::StaticOrder S; S.init(TG, DM, G, bx);
              pg8::EpiGateAT<I8_MID != 0> E{P_MG, DM, P_P + C_GATE, NIN, ws}; REP_LOOP_GEMM { int l2_ = lane_id_fresh(); asm volatile("" : "+v"(l2_)); pg8::gemm_phase<pg8::EpiGateAT<I8_MID != 0>, I8_MID ? 2 : 0>(ldsL, gm, S, E, wave * 64 + l2_); } }
            if (EN(21)) { pg8::Gemm gm{I8_MID ? (const bf16*)P_BO8 : P_BO, I8_MID ? 1024 : 2048, P_WBT, TG, DM, I8_MID ? 1024 : 2048}; pg8::StaticOrder S; S.init(TG, DM, G, bx);
              pg8::EpiGateBT<I8_MID != 0> E{P_MG, DM, P_P + C_GATE + DM, NIN, P_MG, DM, ws}; REP_LOOP_GEMM { int l2_ = lane_id_fresh(); asm volatile("" : "+v"(l2_)); pg8::gemm_phase<pg8::EpiGateBT<I8_MID != 0>, I8_MID ? 2 : 0>(ldsL, gm, S, E, wave * 64 + l2_); } }
        }
        SEAM();

#if I8_MID
        if (RUN()) { LOCAL_TID();
            for (int m = gw; m < TG; m += NGW) {
                const bf16* srow = P_MG + (size_t)m * DM + lane * 8; u32x4 a[8]; float mx = 0.f;
#pragma unroll
                for (int j = 0; j < 8; ++j) { a[j] = *(const u32x4*)(srow + 512 * j);
                    mx = __builtin_fmaxf(mx, __builtin_fmaxf(__builtin_fmaxf(__builtin_fmaxf(__builtin_fabsf(bf_lo(a[j].x)), __builtin_fabsf(bf_hi(a[j].x))), __builtin_fmaxf(__builtin_fabsf(bf_lo(a[j].y)), __builtin_fabsf(bf_hi(a[j].y)))),
                                                      __builtin_fmaxf(__builtin_fmaxf(__builtin_fabsf(bf_lo(a[j].z)), __builtin_fabsf(bf_hi(a[j].z))), __builtin_fmaxf(__builtin_fabsf(bf_lo(a[j].w)), __builtin_fabsf(bf_hi(a[j].w)))))); }
                mx = wave_max(mx); const float inv = mx > 0.f ? 127.f / mx : 0.f; if (lane == 0) ((float*)(ws + WS_RSMA))[g * TG + m] = mx * (1.f / 127.f);
                unsigned char* drow = P_MG8 + (size_t)(g * TG + m) * DM + lane * 8;
#pragma unroll
                for (int j = 0; j < 8; ++j) { u32x2 q; q.x = pack4_i8(bf_lo(a[j].x) * inv, bf_hi(a[j].x) * inv, bf_lo(a[j].y) * inv, bf_hi(a[j].y) * inv); q.y = pack4_i8(bf_lo(a[j].z) * inv, bf_hi(a[j].z) * inv, bf_lo(a[j].w) * inv, bf_hi(a[j].w) * inv); *(u32x2*)(drow + 512 * j) = q; }
            }
        }
        SEAM();
#endif

    }

    if (RUN() && EN(7)) { LOCAL_TID();
        pg8::Gemm gm{(const bf16*)P_MG8, DM / 2, P_WOT, NTOK, DM, DM / 2}; pg8::StaticOrder S; S.init(NTOK, DM, G, bx);
        pg8::EpiResT<I8_MID != 0, false> E{A->in[I_XP], A->in[I_XS], NTOK / 2 / 256, P_X1, DM, 1.f, ws}; REP_LOOP_GEMM { int l2_ = lane_id_fresh(); asm volatile("" : "+v"(l2_)); pg8::gemm_phase<pg8::EpiResT<I8_MID != 0, false>, I8_MID ? 2 : 0>(ldsL, gm, S, E, wave * 64 + l2_); }
    }
    SEAM();

    if (RUN() && EN(8)) { LOCAL_TID();
        const float* gv = A->in[I_RFG];
        for (int m = gw; m < NTOK; m += NGW) {
            const u32x2* xr = (const u32x2*)(P_X1 + (size_t)m * DM) + lane; f32x4 v[16]; float s = 0.f;
#pragma unroll
            for (int j = 0; j < 16; ++j) { const u32x2 w = xr[64 * j]; v[j] = (f32x4){bf_lo(w.x), bf_hi(w.x), bf_lo(w.y), bf_hi(w.y)}; s += (v[j].x * v[j].x + v[j].y * v[j].y) + (v[j].z * v[j].z + v[j].w * v[j].w); }
            const float rstd = 1.0f / sqrtf(wave_sum(s) * (1.f / DM) + EPS);
            if (I8_UP) { float mx = 0.f;
#pragma unroll
                for (int j = 0; j < 16; ++j) { const f32x4 gg = ((const f32x4*)gv)[64 * j + lane]; v[j] = v[j] * rstd * gg; mx = __builtin_fmaxf(__builtin_fmaxf(mx, __builtin_fmaxf(__builtin_fabsf(v[j].x), __builtin_fabsf(v[j].y))), __builtin_fmaxf(__builtin_fabsf(v[j].z), __builtin_fabsf(v[j].w))); }
                mx = wave_max(mx); const float inv = mx > 0.f ? 127.f / mx : 0.f; if (lane == 0) P_RSHF[m] = mx * (1.f / 127.f);
                unsigned* o4 = (unsigned*)(P_HF + (size_t)m * DM) + lane;
#pragma unroll
                for (int j = 0; j < 16; ++j) o4[64 * j] = pack4_i8(v[j].x * inv, v[j].y * inv, v[j].z * inv, v[j].w * inv);
            } else {
            u32x2* o8 = (u32x2*)((bf16*)P_HF + (size_t)m * DM) + lane;
#pragma unroll
            for (int j = 0; j < 16; ++j) { const f32x4 gg = ((const f32x4*)gv)[64 * j + lane]; u32x2 w; w.x = cvt_pk_bf16(v[j].x * rstd * gg.x, v[j].y * rstd * gg.y); w.y = cvt_pk_bf16(v[j].z * rstd * gg.z, v[j].w * rstd * gg.w); o8[64 * j] = w; }
            }
        }
    }
    SEAM();

    if (RUN() && EN(9)) { LOCAL_TID();
        pg8::Gemm gm{(const bf16*)P_HF, DM / 2, P_WUPT, NTOK, NUP, DM / 2}; pg8::StaticOrder S; S.init(NTOK, NUP, G, bx);
#if CONV_FUSE
        static_assert(I8_UP && CONV_FUSE, "the all-token FFN stage needs the fused conv epilogue (int8 up GEMM)");
        pg8::EpiConv E{(unsigned char*)P_ACT, P_Y, A->in[I_CW], A->in[I_CB], ws, FP8_DOWN ? S_ACT8 : 1.f}; REP_LOOP_GEMM { int l2_ = lane_id_fresh(); asm volatile("" : "+v"(l2_)); pg8::gemm_phase<pg8::EpiConv, 2>(ldsL, gm, S, E, wave * 64 + l2_); }
#else
        pg8::EpiStoreT<I8_UP != 0, WS_RSHF, WS_CSUP> E{P_Y, NUP, 0, 0, 1.f, ws, 0}; REP_LOOP_GEMM { int l2_ = lane_id_fresh(); asm volatile("" : "+v"(l2_)); pg8::gemm_phase<pg8::EpiStoreT<I8_UP != 0, WS_RSHF, WS_CSUP>, I8_UP ? 2 : 0>(ldsL, gm, S, E, wave * 64 + l2_); }
#endif
    }
    SEAM();

#if CONV_FUSE
    if (RUN() && EN(10)) { LOCAL_TID();
        const float* cw = A->in[I_CW]; const float* cb = A->in[I_CB];
        constexpr int NCB = DFF / 256, NITEM = NCB * (NTOK / 64) * 2;
        for (int it = gw; it < NITEM; it += NGW) {
            const int cbk = it % NCB, be = it / NCB, b = be >> 1, edge = be & 1, c0 = cbk * 256 + lane * 4, t = b * 64 + (edge ? 63 : 0);
            const int posmask = (t < NTOK / 2) ? 4095 : 8191;
            const int colg = (c0 >> 7) * 256 + (c0 & 127);
            const f32x4 wg0 = *(const f32x4*)(cw + c0), wg1 = *(const f32x4*)(cw + NUP + c0), wg2 = *(const f32x4*)(cw + 2 * NUP + c0), bg = *(const f32x4*)(cb + c0);
            const f32x4 wu0 = *(const f32x4*)(cw + DFF + c0), wu1 = *(const f32x4*)(cw + NUP + DFF + c0), wu2 = *(const f32x4*)(cw + 2 * NUP + DFF + c0), bu = *(const f32x4*)(cb + DFF + c0);
            auto ldyb = [&](int blk, int slot, f32x4& yg, f32x4& yu) {
                const bf16* p = P_Y + ((size_t)blk * 4 + slot) * NUP + colg; const u32x2 a = *(const u32x2*)p, bb = *(const u32x2*)(p + 128);
                yg = (f32x4){bf_lo(a.x), bf_hi(a.x), bf_lo(a.y), bf_hi(a.y)}; yu = (f32x4){bf_lo(bb.x), bf_hi(bb.x), bf_lo(bb.y), bf_hi(bb.y)}; };
            const f32x4 z = (f32x4){0.f, 0.f, 0.f, 0.f};
            f32x4 pg = z, pu = z, cg, cu, ng = z, nu = z;
            if (edge == 0) { ldyb(b, 0, cg, cu); ldyb(b, 1, ng, nu); if ((t & posmask) != 0) ldyb(b - 1, 3, pg, pu); }
            else { ldyb(b, 3, cg, cu); ldyb(b, 2, pg, pu); if (((t + 1) & posmask) != 0) ldyb(b + 1, 0, ng, nu); }
            const f32x4 ug = wg0 * pg + wg1 * cg + wg2 * ng + bg, uu = wu0 * pu + wu1 * cu + wu2 * nu + bu;
            float a[4];
#pragma unroll
            for (int j = 0; j < 4; ++j) a[j] = ug[j] * fast_sigmoid(ug[j]) * uu[j];
            if (FP8_DOWN) *(unsigned*)((unsigned char*)P_ACT + (size_t)t * DFF + c0) = pack4_fp8(a[0] * S_ACT8, a[1] * S_ACT8, a[2] * S_ACT8, a[3] * S_ACT8);
            else { u32x2 w; w.x = cvt_pk_bf16(a[0], a[1]); w.y = cvt_pk_bf16(a[2], a[3]); *(u32x2*)(P_ACT + (size_t)t * DFF + c0) = w; }
        }
    }
#else
    if (RUN() && EN(10)) { LOCAL_TID();
        const float* cw = A->in[I_CW]; const float* cb = A->in[I_CB];
        constexpr int RCH = 64, NCB = DFF / 256, NITEM = NCB * (TG / RCH);
        for (int it = gw; it < NITEM; it += NGW) {
            const int cbk = it % NCB, rc = it / NCB, c0 = cbk * 256 + lane * 4, t0 = rc * RCH;
            f32x4 wg0 = *(const f32x4*)(cw + c0), wg1 = *(const f32x4*)(cw + NUP + c0), wg2 = *(const f32x4*)(cw + 2 * NUP + c0), bg = *(const f32x4*)(cb + c0);
            f32x4 wu0 = *(const f32x4*)(cw + DFF + c0), wu1 = *(const f32x4*)(cw + NUP + DFF + c0), wu2 = *(const f32x4*)(cw + 2 * NUP + DFF + c0), bu = *(const f32x4*)(cb + DFF + c0);
            auto ldrow = [&](int t, f32x4& yg, f32x4& yu) {
                const u32x2 a = *(const u32x2*)(P_Y + (size_t)t * NUP + c0), b = *(const u32x2*)(P_Y + (size_t)t * NUP + DFF + c0);
                yg = (f32x4){bf_lo(a.x), bf_hi(a.x), bf_lo(a.y), bf_hi(a.y)}; yu = (f32x4){bf_lo(b.x), bf_hi(b.x), bf_lo(b.y), bf_hi(b.y)}; };
            const f32x4 z = (f32x4){0.f, 0.f, 0.f, 0.f};
            f32x4 pg = z, pu = z, cg, cu, ng, nu;
            if ((t0 & posmask) != 0) ldrow(t0 - 1, pg, pu);
            ldrow(t0, cg, cu);
#pragma unroll 4
            for (int t = t0; t < t0 + RCH; ++t) {
                if (((t + 1) & posmask) != 0) ldrow(t + 1, ng, nu); else { ng = z; nu = z; }
                const f32x4 ug = wg0 * pg + wg1 * cg + wg2 * ng + bg, uu = wu0 * pu + wu1 * cu + wu2 * nu + bu;
                float a[4];
#pragma unroll
                for (int j = 0; j < 4; ++j) a[j] = ug[j] * fast_sigmoid(ug[j]) * uu[j];
                if (FP8_DOWN) *(unsigned*)((unsigned char*)P_ACT + (size_t)t * DFF + c0) = pack4_fp8(a[0] * S_ACT8, a[1] * S_ACT8, a[2] * S_ACT8, a[3] * S_ACT8);
                else { u32x2 w; w.x = cvt_pk_bf16(a[0], a[1]); w.y = cvt_pk_bf16(a[2], a[3]); *(u32x2*)(P_ACT + (size_t)t * DFF + c0) = w; }
                pg = cg; pu = cu; cg = ng; cu = nu;
            }
        }
    }
#endif
    SEAM();

    if (RUN() && EN(11)) { LOCAL_TID();
        pg8::Gemm gm{P_ACT, FP8_DOWN ? DFF / 2 : DFF, P_WDT, NTOK, DM, FP8_DOWN ? DFF / 2 : DFF}; pg8::StaticOrder S; S.init(NTOK, DM, G, bx);
        pg8::EpiResT<false, true> E{P_X1, P_X1, 1 << 30, P_X1, DM, FP8_DOWN ? 1.f / (S_WD * S_ACT8) : 1.f, ws}; { int l2_ = lane_id_fresh(); asm volatile("" : "+v"(l2_)); pg8::gemm_phase<pg8::EpiResT<false, true>, FP8_DOWN ? 1 : 0>(ldsL, gm, S, E, wave * 64 + l2_); }
    }
    SEAM();

    if (RUN() && EN(12)) { LOCAL_TID();
        const float* gv = A->in[I_FNG];
        for (int m = gw; m < NTOK; m += NGW) {
            const u32x2* xr = (const u32x2*)(P_X1 + (size_t)m * DM) + lane; f32x4* orow = (f32x4*)(A->out + (size_t)m * DM) + lane; f32x4 v[16]; float s = 0.f;
#pragma unroll
            for (int j = 0; j < 16; ++j) { const u32x2 w = xr[64 * j]; v[j] = (f32x4){bf_lo(w.x), bf_hi(w.x), bf_lo(w.y), bf_hi(w.y)}; s += (v[j].x * v[j].x + v[j].y * v[j].y) + (v[j].z * v[j].z + v[j].w * v[j].w); }
            const float rstd = 1.0f / sqrtf(wave_sum(s) * (1.f / DM) + EPS);
#pragma unroll
            for (int j = 0; j < 16; ++j) { const f32x4 gg = ((const f32x4*)gv)[64 * j + lane]; orow[64 * j] = v[j] * rstd * gg; }
        }
    }
    SEAM();
#undef RUN
#undef SEAM
}

extern "C" void kernel_launch(void* const* d_in, const int* in_sizes, int n_in, void* d_out, int out_size, void* d_ws, size_t ws_size, hipStream_t stream) {
    static int grid = 0;
    if (grid == 0) {
        if (n_in != 23 || out_size != NTOK * DM || ws_size < WS_END) { fprintf(stderr, "kernel_launch: unexpected shapes: n_in %d out %d ws %zu (need %zu)\n", n_in, out_size, ws_size, (size_t)WS_END); grid = -1; return; }
        int dev = 0, cus = 0, per_cu = 0;
        if (hipGetDevice(&dev) != hipSuccess || hipDeviceGetAttribute(&cus, hipDeviceAttributeMultiprocessorCount, dev) != hipSuccess) { grid = -1; return; }
        if (hipFuncSetAttribute((const void*)enc_fwd, hipFuncAttributeMaxDynamicSharedMemorySize, LDS_BYTES) != hipSuccess) { fprintf(stderr, "kernel_launch: hipFuncSetAttribute failed\n"); grid = -1; return; }
        if (hipOccupancyMaxActiveBlocksPerMultiprocessor(&per_cu, (const void*)enc_fwd, NWAVES * 64, LDS_BYTES) != hipSuccess || per_cu < 1) { fprintf(stderr, "kernel_launch: occupancy query says %d\n", per_cu); per_cu = 1; }
        (void)hipGetLastError();
        grid = cus;
    }
    if (grid < 0) return;
    (void)hipMemsetAsync((char*)d_ws + WS_CTL, 0, CTL_ZERO_BYTES, stream);
    Args a{};
    for (int i = 0; i < 23; ++i) a.in[i] = (const float*)d_in[i];
    a.out = (float*)d_out; a.ws = (unsigned char*)d_ws;
    for (int i = 0; i < 32; ++i) a.invf[i] = powf(10000.0f, -(float)(2 * i) / 64.0f);
#if MK_PER_STEP_LAUNCH
    for (int s = 0; s < NSTEPS; ++s) { a.lo = s; a.hi = s + 1; hipLaunchKernelGGL(enc_fwd, dim3(grid), dim3(NWAVES * 64), LDS_BYTES, stream, a); }
#else
    a.lo = 0; a.hi = NSTEPS;
    hipLaunchKernelGGL(enc_fwd, dim3(grid), dim3(NWAVES * 64), LDS_BYTES, stream, a);
#endif
    const hipError_t le = hipPeekAtLastError();
    if (le != hipSuccess) fprintf(stderr, "kernel_launch: launch failed: %s\n", hipGetErrorName(le));
}
```

```cpp
#include <hip/hip_runtime.h>
#include <cstdio>
#include <cstdint>
#include <cmath>

#ifndef I8_IN
#define I8_IN 1
#endif
#ifndef ATT_CINIT
#define ATT_CINIT 1
#endif
constexpr float CS_DIFF = 0.125f * 1.4426950408889634f;
#ifndef CONV_FUSE
#define CONV_FUSE 1
#endif
#ifndef I8_MID
#define I8_MID 1
#endif
#ifndef I8_UP
#define I8_UP 1
#endif
#ifndef FP8_DOWN
#define FP8_DOWN 1
#endif
constexpr float S_WD = 1024.f, S_ACT8 = 8.f;
#ifndef REP_GEMM
#define REP_GEMM 1
#endif
#ifndef REP_DIFF
#define REP_DIFF 1
#endif
#ifndef REP_MLA
#define REP_MLA 1
#endif
#if REP_GEMM == 1
#define REP_LOOP_GEMM
#else
#define REP_LOOP_GEMM _Pragma("unroll 1") for (int rep = 0; rep < REP_GEMM; ++rep)
#endif
#ifndef MK_PER_STEP_LAUNCH
#define MK_PER_STEP_LAUNCH 0
#endif

typedef unsigned short bf16;
typedef short bf16x8 __attribute__((ext_vector_type(8)));
typedef short s16x4 __attribute__((ext_vector_type(4)));
typedef float f32x4 __attribute__((ext_vector_type(4)));
typedef float f32x2 __attribute__((ext_vector_type(2)));
typedef float f32x16 __attribute__((ext_vector_type(16)));
typedef unsigned u32x4 __attribute__((ext_vector_type(4)));
typedef unsigned u32x2 __attribute__((ext_vector_type(2)));
typedef int i32x4 __attribute__((ext_vector_type(4)));
typedef int i32x8 __attribute__((ext_vector_type(8)));
#define LAS __attribute__((address_space(3)))

__device__ __forceinline__ unsigned cvt_pk_bf16(float lo, float hi) { unsigned r; asm volatile("v_cvt_pk_bf16_f32 %0, %1, %2" : "=v"(r) : "v"(lo), "v"(hi)); return r; }
__device__ __forceinline__ float bf_lo(unsigned w) { return __uint_as_float(w << 16); }
__device__ __forceinline__ float bf_hi(unsigned w) { return __uint_as_float(w & 0xffff0000u); }
__device__ __forceinline__ float clamp448(float x) { return __builtin_fminf(__builtin_fmaxf(x, -448.f), 448.f); }
__device__ __forceinline__ unsigned pack4_fp8(float a, float b, float c, float d) { int w = 0; w = __builtin_amdgcn_cvt_pk_fp8_f32(clamp448(a), clamp448(b), w, false); w = __builtin_amdgcn_cvt_pk_fp8_f32(clamp448(c), clamp448(d), w, true); return (unsigned)w; }
__device__ __forceinline__ unsigned pack4_i8(float a, float b, float c, float d) { const int ia = (int)__builtin_rintf(a), ib = (int)__builtin_rintf(b), ic = (int)__builtin_rintf(c), id = (int)__builtin_rintf(d);
    return (unsigned)(ia & 255) | ((unsigned)(ib & 255) << 8) | ((unsigned)(ic & 255) << 16) | ((unsigned)id << 24); }
__device__ __forceinline__ float fast_sigmoid(float x) { return __builtin_amdgcn_rcpf(1.0f + __builtin_amdgcn_exp2f(-1.4426950408889634f * x)); }

__device__ __forceinline__ int lane_id_fresh() { unsigned ones = ~0u; asm volatile("" : "+s"(ones)); return (int)__builtin_amdgcn_mbcnt_hi(ones, __builtin_amdgcn_mbcnt_lo(ones, 0u)); }

constexpr int DM = 4096, NTOK = 32768, TG = 8192, NGRP = 4;
constexpr int NIN = 16128;
constexpr int C_DQ = 0, C_DK = 2048, C_DV = 4096, C_QLAT = 6144, C_KVLAT = 7168, C_GATE = 7680, C_KPE = 15872;
constexpr int DFF = 11008, NUP = 22016, NQ = 3072, NKV = 4096;
constexpr float EPS = 1e-6f;

constexpr size_t MiB = 1u << 20;
constexpr size_t WS_CTL = 0, CTL_ZERO_BYTES = 1 * MiB;
constexpr size_t WS_COS = 1 * MiB, WS_SIN = 2 * MiB, WS_BIAS = 3 * MiB, WS_LAM = 3 * MiB + 32768;
constexpr size_t WS_CSIN = 3 * MiB + 65536, WS_CSUP = 3 * MiB + 131072, WS_RSH = 3 * MiB + 262144;
constexpr size_t WS_CSQ = 3 * MiB + 320 * 1024, WS_CSKV = 3 * MiB + 336 * 1024, WS_CSA = 3 * MiB + 352 * 1024, WS_CSB = 3 * MiB + 368 * 1024, WS_CSO = 3 * MiB + 384 * 1024;
constexpr size_t WS_RSQL = 3 * MiB + 400 * 1024, WS_RSKVL = 3 * MiB + 432 * 1024, WS_RSA = 3 * MiB + 464 * 1024, WS_RSB = 3 * MiB + 496 * 1024, WS_RSM = 3 * MiB + 528 * 1024;
constexpr size_t EB_IN = I8_IN ? 1 : 2, EB_UP = I8_UP ? 1 : 2, EB_MID = I8_MID ? 1 : 2, EB_DN = FP8_DOWN ? 1 : 2;
constexpr size_t WS_WIN = 4 * MiB, WS_WQ = WS_WIN + (size_t)NIN * DM * EB_IN, WS_WKV = WS_WQ + (size_t)NQ * 1024 * EB_MID, WS_WA = WS_WKV + (size_t)NKV * 512 * EB_MID, WS_WB = WS_WA + (size_t)DM * 2048 * EB_MID,
                 WS_WO = WS_WB + (size_t)DM * 2048 * EB_MID, WS_WUP = WS_WO + (size_t)DM * DM * EB_MID, WS_WD = WS_WUP + (size_t)NUP * DM * EB_UP, WS_WEND = WS_WD + (size_t)DM * DFF * EB_DN;
constexpr size_t WS_ACT = (WS_WEND + MiB - 1) / MiB * MiB;
constexpr size_t WS_P = WS_ACT, WS_Q = WS_P + 252 * MiB, WS_KV = WS_Q + 48 * MiB, WS_AO = WS_KV + 64 * MiB, WS_BO = WS_AO + 32 * MiB, WS_MG = WS_BO + 32 * MiB, WS_STASH = WS_MG + 64 * MiB;
constexpr size_t WS_QL8 = WS_STASH + 32 * MiB, WS_KVL8 = WS_QL8 + 8 * MiB, WS_AO8 = WS_KVL8 + 4 * MiB, WS_BO8 = WS_AO8 + 16 * MiB, WS_MIX_END = WS_BO8 + 16 * MiB;
static_assert(WS_P + (size_t)TG * NIN * 2 <= WS_Q && (size_t)TG * NQ * 2 <= 48 * MiB && (size_t)TG * NKV * 2 <= 64 * MiB && (size_t)TG * DM * 2 <= 64 * MiB, "mixer map");
constexpr size_t WS_Y = WS_ACT, WS_ACTV = WS_Y + (size_t)(NTOK / 64) * 4 * NUP * 2, WS_FFN_END = WS_ACTV + (size_t)NTOK * DFF * EB_DN;
constexpr size_t WS_X1 = ((WS_MIX_END > WS_FFN_END ? WS_MIX_END : WS_FFN_END) + MiB - 1) / MiB * MiB;
constexpr size_t WS_HF = WS_X1 + (size_t)NTOK * DM * 2, WS_MG8 = WS_HF + (size_t)NTOK * DM, WS_END = WS_MG8 + (size_t)NTOK * DM;
static_assert(EB_IN == 1 && EB_UP == 1 && EB_MID == 1, "the all-token row buffers are int8");
constexpr size_t WS_RSHF = 3 * MiB + 576 * 1024, WS_RSMA = 3 * MiB + 704 * 1024;
static_assert(WS_RSM + 32768 <= WS_RSHF && WS_RSMA + (size_t)NTOK * 4 <= 4 * MiB, "scale arrays");

namespace pg8 {
constexpr int BM = 256, BK = 64, HALF = 128, HTB = HALF * BK * 2, STAGE_BYTES = 8 * HTB, NXCD = 8, WGM = 8;
__host__ __device__ __forceinline__ int lds_byte(int r, int c) { const int st = (r >> 4) * 2 + (c >> 5), rr = r & 15, cc = c & 31, ob = rr * 64 + cc * 2; return st * 1024 + (ob ^ (((ob >> 9) & 1) << 5)); }
__host__ __device__ __forceinline__ void stage_rc(int b, int& R, int& C) { const int st = b / 1024, sb = b % 1024, swz = sb ^ (((sb >> 9) & 1) << 5); R = (st >> 1) * 16 + swz / 64; C = (st & 1) * 32 + (swz % 64) / 2; }
__host__ __device__ __forceinline__ int perm32(int rho) { const int n = rho >> 4, i = rho & 15; return 8 * (i >> 2) + 4 * n + (i & 3); }

struct Unit { int pm, pn; };
struct Gemm { const bf16* A; int lda; const bf16* Bt; int M, N, K; };

struct StaticOrder {
    int nM, nN, nwg, G, c;
    __device__ void init(int M, int N, int G_, int c_) { nM = M / BM; nN = N / BM; nwg = nM * nN; G = G_; c = c_; }
    __device__ bool next(int i, Unit& u) const {
        const long L = (long)i * G + c; if (L >= nwg) return false;
        int wgid = (int)L; { const int q = nwg / NXCD, r = nwg % NXCD, xcd = wgid % NXCD, off = wgid / NXCD; wgid = (xcd < r ? xcd * (q + 1) : r * (q + 1) + (xcd - r) * q) + off; }
        const int nig = WGM * nN, gid = wgid / nig, fm = gid * WGM, gsz = (nM - fm) < WGM ? (nM - fm) : WGM;
        u.pm = fm + ((wgid % nig) % gsz); u.pn = (wgid % nig) / gsz; return true;
    }
};

template <int MODE> struct AccSel { typedef f32x4 T; }; template <> struct AccSel<2> { typedef i32x4 T; };
__device__ __forceinline__ f32x4 tof(f32x4 v) { return v; }
__device__ __forceinline__ f32x4 tof(i32x4 v) { return __builtin_convertvector(v, f32x4); }

template <class Epi, int MODE = 0>
__device__ __forceinline__ void gemm_phase(LAS unsigned char* lds, const Gemm g, const StaticOrder& S, const Epi& E, int tid_in) {
    int tid = tid_in; asm volatile("" : "+v"(tid));
    const int wid = __builtin_amdgcn_readfirstlane(tid >> 6), lane = tid & 63, wr = wid >> 2, wc = wid & 3, fr = lane & 15, fq = lane >> 4;
    int K = g.K, lda = g.lda; asm volatile("" : "+s"(K), "+s"(lda));
    const int nt = K / BK;
    unsigned voffA[2], voffB[2];
#pragma unroll
    for (int i = 0; i < 2; ++i) { int R, C; stage_rc(tid * 16 + i * 8192, R, C); const int Rb = (R & ~31) + perm32(R & 31);
        voffA[i] = (unsigned)(R * lda + C) * 2u; voffB[i] = (unsigned)(Rb * K + C) * 2u; }
    const size_t kstep = (size_t)(BK * 2);
    const size_t hstepA = (size_t)HALF * lda * 2, hstepB = (size_t)HALF * K * 2;
    const size_t tstepA = 2 * hstepA, tstepB = 2 * hstepB;
    const unsigned ldsw = (unsigned)wid * 1024u;
    const int aoff = lds_byte(wr * 64 + fr, fq * 8), boff = lds_byte(wc * 32 + fr, fq * 8);
#define PG8_SA(b, h) (((b) * 2 + (h)) * HTB)
#define PG8_SB(b, h) ((4 + (b) * 2 + (h)) * HTB)
#define PG8_STAGE(bufoff, gbase, voff) do { _Pragma("unroll") for (int _i = 0; _i < 2; ++_i) \
        __builtin_amdgcn_global_load_lds((const unsigned*)((const char*)(gbase) + (voff)[_i]), (LAS unsigned*)(lds + (bufoff) + ldsw + _i * 8192), 16, 0, 0); } while (0)
#define PG8_CAT(x, y) __builtin_shufflevector(__builtin_bit_cast(i32x4, x), __builtin_bit_cast(i32x4, y), 0, 1, 2, 3, 4, 5, 6, 7)
#define PG8_LDA(dst, b, h) do { _Pragma("unroll") for (int m = 0; m < 4; ++m) dst[m] = PG8_CAT(*(const LAS bf16x8*)(lds + PG8_SA(b, h) + aoff + m * 2048), *(const LAS bf16x8*)(lds + PG8_SA(b, h) + aoff + m * 2048 + 1024)); } while (0)
#define PG8_LDB(dst, b, h) do { _Pragma("unroll") for (int n = 0; n < 2; ++n) dst[n] = PG8_CAT(*(const LAS bf16x8*)(lds + PG8_SB(b, h) + boff + n * 2048), *(const LAS bf16x8*)(lds + PG8_SB(b, h) + boff + n * 2048 + 1024)); } while (0)
#define PG8_LO4(v) __builtin_shufflevector(v, v, 0, 1, 2, 3)
#define PG8_HI4(v) __builtin_shufflevector(v, v, 4, 5, 6, 7)
#define PG8_LO(v) __builtin_bit_cast(bf16x8, __builtin_shufflevector(v, v, 0, 1, 2, 3))
#define PG8_HI(v) __builtin_bit_cast(bf16x8, __builtin_shufflevector(v, v, 4, 5, 6, 7))
#define PG8_MMA(ai, bj, At, Bt) do { __builtin_amdgcn_s_setprio(1); _Pragma("unroll") for (int m = 0; m < 4; ++m) _Pragma("unroll") for (int n = 0; n < 2; ++n) { \
        if constexpr (F8) asm volatile("v_mfma_f32_16x16x128_f8f6f4 %0, %1, %2, %0" : "+v"(acc[ai][bj][m][n]) : "v"(Bt[n]), "v"(At[m]));   \
        else if constexpr (MODE == 2) { acc[ai][bj][m][n] = __builtin_amdgcn_mfma_i32_16x16x64_i8(PG8_LO4(Bt[n]), PG8_LO4(At[m]), acc[ai][bj][m][n], 0, 0, 0); \
               acc[ai][bj][m][n] = __builtin_amdgcn_mfma_i32_16x16x64_i8(PG8_HI4(Bt[n]), PG8_HI4(At[m]), acc[ai][bj][m][n], 0, 0, 0); } \
        else { acc[ai][bj][m][n] = __builtin_amdgcn_mfma_f32_16x16x32_bf16(PG8_LO(Bt[n]), PG8_LO(At[m]), acc[ai][bj][m][n], 0, 0, 0); \
               acc[ai][bj][m][n] = __builtin_amdgcn_mfma_f32_16x16x32_bf16(PG8_HI(Bt[n]), PG8_HI(At[m]), acc[ai][bj][m][n], 0, 0, 0); } } __builtin_amdgcn_s_setprio(0); } while (0)
#define PG8_WAIT_V(n) asm volatile("s_waitcnt vmcnt(" #n ")" ::: "memory")
#define PG8_WAIT_L(n) asm volatile("s_waitcnt lgkmcnt(" #n ")" ::: "memory")
#define PG8_BAR __builtin_amdgcn_s_barrier()
#define PG8_SCHED __builtin_amdgcn_sched_barrier(0)
    Unit cur, nxt; int ui = 0;
    if (!S.next(0, cur)) return;
    constexpr bool F8 = (MODE == 1); typedef typename AccSel<MODE>::T AccT; AccT acc[2][2][4][2];
#pragma unroll
    for (int a = 0; a < 2; ++a)
#pragma unroll
        for (int b = 0; b < 2; ++b)
#pragma unroll
            for (int m = 0; m < 4; ++m)
#pragma unroll
                for (int n = 0; n < 2; ++n) acc[a][b][m][n] = AccT{};
    i32x8 At[4], B0[2], B1[2];
    const char* cA = (const char*)g.A + (size_t)cur.pm * tstepA; const char* cB = (const char*)g.Bt + (size_t)cur.pn * tstepB;
    PG8_STAGE(PG8_SB(0, 0), cB, voffB); PG8_STAGE(PG8_SB(0, 1), cB + hstepB, voffB); PG8_STAGE(PG8_SA(0, 0), cA, voffA); PG8_STAGE(PG8_SA(0, 1), cA + hstepA, voffA);
    if (wr == 1) PG8_BAR;
    PG8_WAIT_V(2); PG8_BAR;
    PG8_STAGE(PG8_SB(1, 0), cB + kstep, voffB); PG8_STAGE(PG8_SA(1, 0), cA + kstep, voffA); PG8_STAGE(PG8_SB(1, 1), cB + hstepB + kstep, voffB);
    PG8_WAIT_V(6); PG8_BAR;
    for (;;) {
        const bool has_next = S.next(ui + 1, nxt);
        const char* nA = has_next ? (const char*)g.A + (size_t)nxt.pm * tstepA : cA; const char* nB = has_next ? (const char*)g.Bt + (size_t)nxt.pn * tstepB : cB;
        for (int t = 0; t < nt; t += 2) {
            const bool last = (t == nt - 2);
            const char* a1 = cA + (size_t)(t + 1) * kstep;
            const char* a2 = last ? nA : cA + (size_t)(t + 2) * kstep; const char* b2 = last ? nB : cB + (size_t)(t + 2) * kstep;
            const char* a3 = a2 + kstep; const char* b3 = b2 + kstep;
            PG8_LDB(B0, 0, 0); PG8_LDB(B1, 0, 1); PG8_SCHED; PG8_LDA(At, 0, 0); PG8_STAGE(PG8_SA(1, 1), a1 + hstepA, voffA);
            PG8_WAIT_V(8); PG8_WAIT_L(0); PG8_BAR; PG8_MMA(0, 0, At, B0); PG8_MMA(0, 1, At, B1); PG8_BAR; PG8_SCHED;
            PG8_LDA(At, 0, 1); PG8_STAGE(PG8_SB(0, 0), b2, voffB); PG8_STAGE(PG8_SB(0, 1), b2 + hstepB, voffB); PG8_STAGE(PG8_SA(0, 0), a2, voffA);
            PG8_WAIT_V(8); PG8_WAIT_L(0); PG8_BAR; PG8_MMA(1, 0, At, B0); PG8_MMA(1, 1, At, B1); PG8_BAR; PG8_SCHED;
            PG8_LDB(B0, 1, 0); PG8_LDB(B1, 1, 1); PG8_SCHED; PG8_LDA(At, 1, 0); PG8_STAGE(PG8_SA(0, 1), a2 + hstepA, voffA);
            PG8_WAIT_V(8); PG8_WAIT_L(0); PG8_BAR; PG8_MMA(0, 0, At, B0); PG8_MMA(0, 1, At, B1); PG8_BAR; PG8_SCHED;
            PG8_LDA(At, 1, 1); PG8_STAGE(PG8_SB(1, 0), b3, voffB); PG8_STAGE(PG8_SB(1, 1), b3 + hstepB, voffB); PG8_STAGE(PG8_SA(1, 0), a3, voffA);
            PG8_WAIT_V(8); PG8_WAIT_L(0); PG8_BAR; PG8_MMA(1, 0, At, B0); PG8_MMA(1, 1, At, B1); PG8_BAR; PG8_SCHED;
        }
        if (wr == 0) PG8_BAR;
        if constexpr (F8) asm volatile("s_nop 15\n\ts_nop 15" ::: "memory");
        { int l3_ = lane_id_fresh(); asm volatile("" : "+v"(l3_)); E(acc, cur, wr, wc, l3_ & 15, l3_ >> 4); }
        if (!has_next) break;
#pragma unroll
        for (int a = 0; a < 2; ++a)
#pragma unroll
            for (int b = 0; b < 2; ++b)
#pragma unroll
                for (int m = 0; m < 4; ++m)
#pragma unroll
                    for (int n = 0; n < 2; ++n) acc[a][b][m][n] = AccT{};
        cur = nxt; cA = nA; cB = nB; ++ui;
        if (wr == 1) PG8_BAR;
    }
    PG8_WAIT_V(0);
    PG8_BAR;
#undef PG8_SA
#undef PG8_SB
#undef PG8_STAGE
#undef PG8_LDA
#undef PG8_LDB
#undef PG8_MMA
#undef PG8_CAT
#undef PG8_LO
#undef PG8_LO4
#undef PG8_HI4
#undef PG8_HI
#undef PG8_WAIT_V
#undef PG8_WAIT_L
#undef PG8_BAR
#undef PG8_SCHED
}

template <bool SC, size_t RSOFF = 0, size_t CSOFF = 0> struct EpiStoreT {
    bf16* O; int ldc; int sig_lo, sig_hi; float scale; const unsigned char* wsb; int rsrow;
    template <class AccT> __device__ __forceinline__ void operator()(const AccT (&acc)[2][2][4][2], const Unit& u, int wr, int wc, int fr, int fq) const {
        const bool sig = (u.pn >= sig_lo && u.pn < sig_hi);
        const int row0 = u.pm * BM + wr * 64 + fr, col0 = u.pn * BM + wc * 32 + 8 * fq;
        const float* rs = (const float*)(wsb + RSOFF) + rsrow; const float* cs = (const float*)(wsb + CSOFF);
        const float tsc = (u.pn < 8) ? scale : 1.f;
        f32x4 cv[2][2];
#pragma unroll
        for (int bj = 0; bj < 2; ++bj) { if constexpr (SC) { cv[bj][0] = *(const f32x4*)(cs + col0 + bj * HALF) * tsc; cv[bj][1] = *(const f32x4*)(cs + col0 + bj * HALF + 4) * tsc; } else { cv[bj][0] = (f32x4){tsc, tsc, tsc, tsc}; cv[bj][1] = cv[bj][0]; } }
#pragma unroll
        for (int ai = 0; ai < 2; ++ai)
#pragma unroll
            for (int m = 0; m < 4; ++m) { bf16* rowp = O + (size_t)(row0 + ai * HALF + m * 16) * ldc + col0; float rsv = 1.f; if constexpr (SC) rsv = rs[row0 + ai * HALF + m * 16];
#pragma unroll
                for (int bj = 0; bj < 2; ++bj) { f32x4 v0 = tof(acc[ai][bj][m][0]) * (cv[bj][0] * rsv), v1 = tof(acc[ai][bj][m][1]) * (cv[bj][1] * rsv);
                    if (sig) {
#pragma unroll
                        for (int j = 0; j < 4; ++j) { v0[j] = fast_sigmoid(v0[j]); v1[j] = fast_sigmoid(v1[j]); } }
                    u32x4 w; w.x = cvt_pk_bf16(v0[0], v0[1]); w.y = cvt_pk_bf16(v0[2], v0[3]); w.z = cvt_pk_bf16(v1[0], v1[1]); w.w = cvt_pk_bf16(v1[2], v1[3]);
                    *(u32x4*)(rowp + bj * HALF) = w; }
                asm volatile("" ::: "memory"); }
    }
};
template <bool SC> struct EpiQT {
    bf16* O; int ldc; const unsigned char* wsb; int posmask;
    template <class AccT> __device__ __forceinline__ void operator()(const AccT (&acc)[2][2][4][2], const Unit& u, int wr, int wc, int fr, int fq) const {
        const bool rope = (u.pn >= 8);
        const int row0 = u.pm * BM + wr * 64 + fr, col0 = u.pn * BM + wc * 32 + 8 * fq;
        const float* cosT = (const float*)(wsb + WS_COS); const float* sinT = (const float*)(wsb + WS_SIN); const float* rs = (const float*)(wsb + WS_RSQL); const float* cs = (const float*)(wsb + WS_CSQ);
        f32x4 cv[2][2];
#pragma unroll
        for (int bj = 0; bj < 2; ++bj) { if constexpr (SC) { cv[bj][0] = *(const f32x4*)(cs + col0 + bj * HALF); cv[bj][1] = *(const f32x4*)(cs + col0 + bj * HALF + 4); } else { cv[bj][0] = (f32x4){1.f, 1.f, 1.f, 1.f}; cv[bj][1] = cv[bj][0]; } }
#pragma unroll
        for (int ai = 0; ai < 2; ++ai)
#pragma unroll
            for (int m = 0; m < 4; ++m) { const int row = row0 + ai * HALF + m * 16; bf16* rowp = O + (size_t)row * ldc + col0; const int pos = row & posmask; float rsv = 1.f; if constexpr (SC) rsv = rs[row];
#pragma unroll
                for (int bj = 0; bj < 2; ++bj) { f32x4 v0 = tof(acc[ai][bj][m][0]) * (cv[bj][0] * rsv), v1 = tof(acc[ai][bj][m][1]) * (cv[bj][1] * rsv);
                    if (rope) { const int i0 = (((col0 + bj * HALF) & 63) >> 1);
                        const f32x4 c = *(const f32x4*)(cosT + (size_t)pos * 32 + i0), s = *(const f32x4*)(sinT + (size_t)pos * 32 + i0);
                        f32x4 a, b;
                        a[0] = v0[0] * c[0] - v0[1] * s[0]; a[1] = v0[0] * s[0] + v0[1] * c[0]; a[2] = v0[2] * c[1] - v0[3] * s[1]; a[3] = v0[2] * s[1] + v0[3] * c[1];
                        b[0] = v1[0] * c[2] - v1[1] * s[2]; b[1] = v1[0] * s[2] + v1[1] * c[2]; b[2] = v1[2] * c[3] - v1[3] * s[3]; b[3] = v1[2] * s[3] + v1[3] * c[3];
                        v0 = a; v1 = b; }
                    u32x4 w; w.x = cvt_pk_bf16(v0[0], v0[1]); w.y = cvt_pk_bf16(v0[2], v0[3]); w.z = cvt_pk_bf16(v1[0], v1[1]); w.w = cvt_pk_bf16(v1[2], v1[3]);
                    *(u32x4*)(rowp + bj * HALF) = w; } }
    }
};
template <bool SC> struct EpiGateAT {
    bf16* part; int ldp; const bf16* gate; int ldg; const unsigned char* wsb;
    template <class AccT> __device__ __forceinline__ void operator()(const AccT (&acc)[2][2][4][2], const Unit& u, int wr, int wc, int fr, int fq) const {
        const int row0 = u.pm * BM + wr * 64 + fr, col0 = u.pn * BM + wc * 32 + 8 * fq;
        const float* rs = (const float*)(wsb + WS_RSA); const float* cs = (const float*)(wsb + WS_CSA);
        f32x4 cv[2][2];
#pragma unroll
        for (int bj = 0; bj < 2; ++bj) { if constexpr (SC) { cv[bj][0] = *(const f32x4*)(cs + col0 + bj * HALF); cv[bj][1] = *(const f32x4*)(cs + col0 + bj * HALF + 4); } else { cv[bj][0] = (f32x4){1.f, 1.f, 1.f, 1.f}; cv[bj][1] = cv[bj][0]; } }
#pragma unroll
        for (int ai = 0; ai < 2; ++ai) {
            u32x4 gw[4][2]; float rsv[4];
#pragma unroll
            for (int m = 0; m < 4; ++m) { const size_t row = (size_t)(row0 + ai * HALF + m * 16); rsv[m] = 1.f; if constexpr (SC) rsv[m] = rs[row];
#pragma unroll
                for (int bj = 0; bj < 2; ++bj) gw[m][bj] = *(const u32x4*)(gate + row * ldg + col0 + bj * HALF); }
#pragma unroll
            for (int m = 0; m < 4; ++m) { const size_t row = (size_t)(row0 + ai * HALF + m * 16);
#pragma unroll
                for (int bj = 0; bj < 2; ++bj) { const f32x4 v0 = tof(acc[ai][bj][m][0]) * (cv[bj][0] * rsv[m]), v1 = tof(acc[ai][bj][m][1]) * (cv[bj][1] * rsv[m]); const u32x4 g = gw[m][bj];
                    u32x4 w; w.x = cvt_pk_bf16(v0[0] * bf_lo(g.x), v0[1] * bf_hi(g.x)); w.y = cvt_pk_bf16(v0[2] * bf_lo(g.y), v0[3] * bf_hi(g.y)); w.z = cvt_pk_bf16(v1[0] * bf_lo(g.z), v1[1] * bf_hi(g.z)); w.w = cvt_pk_bf16(v1[2] * bf_lo(g.w), v1[3] * bf_hi(g.w));
                    *(u32x4*)(part + row * ldp + col0 + bj * HALF) = w; } }
            asm volatile("" ::: "memory");
        }
    }
};
template <bool SC> struct EpiGateBT {
    const bf16* part; int ldp; const bf16* gate; int ldg; bf16* O; int ldc; const unsigned char* wsb;
    template <class AccT> __device__ __forceinline__ void operator()(const AccT (&acc)[2][2][4][2], const Unit& u, int wr, int wc, int fr, int fq) const {
        const int row0 = u.pm * BM + wr * 64 + fr, col0 = u.pn * BM + wc * 32 + 8 * fq;
        const float* rs = (const float*)(wsb + WS_RSB); const float* cs = (const float*)(wsb + WS_CSB);
        f32x4 cv[2][2];
#pragma unroll
        for (int bj = 0; bj < 2; ++bj) { if constexpr (SC) { cv[bj][0] = *(const f32x4*)(cs + col0 + bj * HALF); cv[bj][1] = *(const f32x4*)(cs + col0 + bj * HALF + 4); } else { cv[bj][0] = (f32x4){1.f, 1.f, 1.f, 1.f}; cv[bj][1] = cv[bj][0]; } }
#pragma unroll
        for (int ai = 0; ai < 2; ++ai) {
            u32x4 gw[4][2], pw[4][2]; float rsv[4];
#pragma unroll
            for (int m = 0; m < 4; ++m) { const size_t row = (size_t)(row0 + ai * HALF + m * 16); rsv[m] = 1.f; if constexpr (SC) rsv[m] = rs[row];
#pragma unroll
                for (int bj = 0; bj < 2; ++bj) { gw[m][bj] = *(const u32x4*)(gate + row * ldg + col0 + bj * HALF); pw[m][bj] = *(const u32x4*)(part + row * ldp + col0 + bj * HALF); } }
#pragma unroll
            for (int m = 0; m < 4; ++m) { const size_t row = (size_t)(row0 + ai * HALF + m * 16);
#pragma unroll
                for (int bj = 0; bj < 2; ++bj) { const f32x4 v0 = tof(acc[ai][bj][m][0]) * (cv[bj][0] * rsv[m]), v1 = tof(acc[ai][bj][m][1]) * (cv[bj][1] * rsv[m]); const u32x4 g = gw[m][bj], p = pw[m][bj];
                    u32x4 w; w.x = cvt_pk_bf16(bf_lo(p.x) + v0[0] * bf_lo(g.x), bf_hi(p.x) + v0[1] * bf_hi(g.x)); w.y = cvt_pk_bf16(bf_lo(p.y) + v0[2] * bf_lo(g.y), bf_hi(p.y) + v0[3] * bf_hi(g.y));
                    w.z = cvt_pk_bf16(bf_lo(p.z) + v1[0] * bf_lo(g.z), bf_hi(p.z) + v1[1] * bf_hi(g.z)); w.w = cvt_pk_bf16(bf_lo(p.w) + v1[2] * bf_lo(g.w), bf_hi(p.w) + v1[3] * bf_hi(g.w));
                    *(u32x4*)(O + row * ldc + col0 + bj * HALF) = w; } }
            asm volatile("" ::: "memory");
        }
    }
};
template <bool SC, bool SRCB> struct EpiResT {
    const void* src; const void* src2; int split_pm; bf16* dst; int ld; float scale; const unsigned char* wsb;
    template <class AccT> __device__ __forceinline__ void operator()(const AccT (&acc)[2][2][4][2], const Unit& u, int wr, int wc, int fr, int fq) const {
        const int row0 = u.pm * BM + wr * 64 + fr, col0 = u.pn * BM + wc * 32 + 8 * fq;
        const float* rs = (const float*)(wsb + WS_RSMA); const float* cs = (const float*)(wsb + WS_CSO);
        const char* sbase = (u.pm < split_pm) ? (const char*)src : (const char*)src2 - (size_t)split_pm * BM * ld * (SRCB ? 2 : 4);
        f32x4 cv[2][2];
#pragma unroll
        for (int bj = 0; bj < 2; ++bj) { if constexpr (SC) { cv[bj][0] = *(const f32x4*)(cs + col0 + bj * HALF); cv[bj][1] = *(const f32x4*)(cs + col0 + bj * HALF + 4); } else { cv[bj][0] = (f32x4){scale, scale, scale, scale}; cv[bj][1] = cv[bj][0]; } }
#pragma unroll
        for (int ai = 0; ai < 2; ++ai)
#pragma unroll
            for (int mh = 0; mh < 2; ++mh) {
                f32x4 sv[2][2][2]; float rsv[2];
#pragma unroll
                for (int mm = 0; mm < 2; ++mm) { const int m = 2 * mh + mm; const size_t off = (size_t)(row0 + ai * HALF + m * 16) * ld + col0; rsv[mm] = 1.f; if constexpr (SC) rsv[mm] = rs[row0 + ai * HALF + m * 16];
#pragma unroll
                    for (int bj = 0; bj < 2; ++bj) {
                        if constexpr (SRCB) { const u32x4 w = *(const u32x4*)((const bf16*)sbase + off + bj * HALF); sv[mm][bj][0] = (f32x4){bf_lo(w.x), bf_hi(w.x), bf_lo(w.y), bf_hi(w.y)}; sv[mm][bj][1] = (f32x4){bf_lo(w.z), bf_hi(w.z), bf_lo(w.w), bf_hi(w.w)}; }
                        else { const float* sp = (const float*)sbase + off + bj * HALF; sv[mm][bj][0] = *(const f32x4*)sp; sv[mm][bj][1] = *(const f32x4*)(sp + 4); } } }
#pragma unroll
                for (int mm = 0; mm < 2; ++mm) { const int m = 2 * mh + mm; const size_t off = (size_t)(row0 + ai * HALF + m * 16) * ld + col0;
#pragma unroll
                    for (int bj = 0; bj < 2; ++bj) { const f32x4 o0 = sv[mm][bj][0] + tof(acc[ai][bj][m][0]) * (cv[bj][0] * rsv[mm]), o1 = sv[mm][bj][1] + tof(acc[ai][bj][m][1]) * (cv[bj][1] * rsv[mm]);
                        u32x4 w; w.x = cvt_pk_bf16(o0[0], o0[1]); w.y = cvt_pk_bf16(o0[2], o0[3]); w.z = cvt_pk_bf16(o1[0], o1[1]); w.w = cvt_pk_bf16(o1[2], o1[3]); *(u32x4*)(dst + off + bj * HALF) = w; } }
                asm volatile("" ::: "memory");
            }
    }
};

__device__ __forceinline__ float dpp_from_prev_lane(float v) { return __builtin_bit_cast(float, __builtin_amdgcn_update_dpp(0, __builtin_bit_cast(int, v), 0x121, 0xF, 0xF, true)); }
__device__ __forceinline__ float dpp_from_next_lane(float v) { return __builtin_bit_cast(float, __builtin_amdgcn_update_dpp(0, __builtin_bit_cast(int, v), 0x12F, 0xF, 0xF, true)); }
struct EpiConv {
    unsigned char* act; bf16* yb; const float* cw; const float* cb; const unsigned char* wsb; float oscale;
    template <class AccT> __device__ __forceinline__ void operator()(const AccT (&acc)[2][2][4][2], const Unit& u, int wr, int wc, int fr, int fq) const {
        const float* rs = (const float*)(wsb + WS_RSHF); const float* cs = (const float*)(wsb + WS_CSUP);
#pragma unroll
        for (int n = 0; n < 2; ++n) {
            const int ch0 = wc * 32 + 8 * fq + 4 * n, cg = u.pn * 128 + ch0, colg = u.pn * BM + ch0;
            const f32x4 csg = *(const f32x4*)(cs + colg), csu = *(const f32x4*)(cs + colg + HALF), bg = *(const f32x4*)(cb + cg), bu = *(const f32x4*)(cb + DFF + cg);
            f32x4 wg[3], wu[3];
#pragma unroll
            for (int t = 0; t < 3; ++t) { wg[t] = *(const f32x4*)(cw + t * NUP + cg); wu[t] = *(const f32x4*)(cw + t * NUP + DFF + cg); }
#pragma unroll
            for (int ai = 0; ai < 2; ++ai) {
                const int rowb = u.pm * BM + ai * HALF + wr * 64;
                f32x4 yg[4], yu[4];
#pragma unroll
                for (int m = 0; m < 4; ++m) { const float rsv = rs[rowb + 16 * m + fr]; yg[m] = tof(acc[ai][0][m][n]) * (csg * rsv); yu[m] = tof(acc[ai][1][m][n]) * (csu * rsv); }
                if (fr < 2 || fr >= 14) { const bool lo = fr < 2; bf16* yr = yb + ((size_t)(rowb >> 6) * 4 + (lo ? fr : fr - 12)) * NUP + colg;
                    const f32x4 a0 = lo ? yg[0] : yg[3], b0 = lo ? yu[0] : yu[3];
                    u32x2 w; w.x = cvt_pk_bf16(a0[0], a0[1]); w.y = cvt_pk_bf16(a0[2], a0[3]); *(u32x2*)yr = w;
                    w.x = cvt_pk_bf16(b0[0], b0[1]); w.y = cvt_pk_bf16(b0[2], b0[3]); *(u32x2*)(yr + HALF) = w; }
#pragma unroll
                for (int m = 0; m < 4; ++m) {
                    float o[4];
#pragma unroll
                    for (int e = 0; e < 4; ++e) {
                        const float gc = yg[m][e], uc = yu[m][e];
                        const float gsp = (m > 0 && fr == 15) ? yg[m > 0 ? m - 1 : 0][e] : gc, usp = (m > 0 && fr == 15) ? yu[m > 0 ? m - 1 : 0][e] : uc;
                        const float gsn = (m < 3 && fr == 0) ? yg[m < 3 ? m + 1 : 3][e] : gc, usn = (m < 3 && fr == 0) ? yu[m < 3 ? m + 1 : 3][e] : uc;
                        const float gp = dpp_from_prev_lane(gsp), up = dpp_from_prev_lane(usp), gn = dpp_from_next_lane(gsn), un = dpp_from_next_lane(usn);
                        const float ug = wg[0][e] * gp + wg[1][e] * gc + wg[2][e] * gn + bg[e];
                        const float uu = wu[0][e] * up + wu[1][e] * uc + wu[2][e] * un + bu[e];
                        o[e] = ug * fast_sigmoid(ug) * uu * oscale; }
                    const bool edge = (m == 0 && fr == 0) || (m == 3 && fr == 15);
                    if (!edge) { const size_t row = (size_t)(rowb + 16 * m + fr);
                        if (FP8_DOWN) *(unsigned*)(act + row * DFF + cg) = pack4_fp8(o[0], o[1], o[2], o[3]);
                        else { u32x2 w; w.x = cvt_pk_bf16(o[0], o[1]); w.y = cvt_pk_bf16(o[2], o[3]); *(u32x2*)((bf16*)act + row * DFF + cg) = w; } }
                }
                asm volatile("" ::: "memory");
            }
        }
    }
};
}

namespace att {
constexpr int OFF_V = 0, SHM_V = 16384, OFF_K = 32768, KROW = 144  , SHM_KP = 64 * KROW, OFF_WS = 32768 + 2 * 3 * SHM_KP, OFF_TBL = OFF_WS + 2048, OFF_QR = OFF_TBL + 2064  , LDS_END = OFF_QR + 256 * KROW;
#define SBAR() __builtin_amdgcn_sched_barrier(0)
__device__ __forceinline__ int crow(int r, int hi) { return (r & 3) + 8 * (r >> 2) + 4 * hi; }
__device__ __forceinline__ int kswz(int row, int colB) { return row * KROW + colB; }
__device__ __forceinline__ int v_st(int k, int c) { const int kk = (k & ~0xC) | ((k & 4) << 1) | ((k & 8) >> 1); return ((kk >> 3) * 4 + (c >> 5)) * 512 + ((kk & 7) * 32 + (c & 31)) * 2; }
__device__ __forceinline__ int v_rd_base(int lane) { return ((lane & 3) << 3) | (((lane >> 2) & 3) << 6) | (((lane >> 4) & 1) << 5) | (((lane >> 5) & 1) << 8); }
constexpr int v_rd_off(int d0, int ks, int half) { return d0 * 512 + ks * 4096 + half * 2048; }
template <int OFF> __device__ __forceinline__ s16x4 tr_read(int vb) { s16x4 r; asm volatile("ds_read_b64_tr_b16 %0, %1 offset:%2" : "=&v"(r) : "v"(vb), "i"(OFF) : "memory"); return r; }
template <int D0> __device__ __forceinline__ void pv_one(f32x16& od, int vb, bf16x8 pa0, bf16x8 pa1, bf16x8 pa2, bf16x8 pa3) {
    const s16x4 l0 = tr_read<v_rd_off(D0, 0, 0)>(vb), h0 = tr_read<v_rd_off(D0, 0, 1)>(vb), l1 = tr_read<v_rd_off(D0, 1, 0)>(vb), h1 = tr_read<v_rd_off(D0, 1, 1)>(vb);
    const s16x4 l2 = tr_read<v_rd_off(D0, 2, 0)>(vb), h2 = tr_read<v_rd_off(D0, 2, 1)>(vb), l3 = tr_read<v_rd_off(D0, 3, 0)>(vb), h3 = tr_read<v_rd_off(D0, 3, 1)>(vb);
    asm volatile("s_waitcnt lgkmcnt(0)" ::: "memory"); SBAR();
#define PK(L, H) (bf16x8){L[0], L[1], L[2], L[3], H[0], H[1], H[2], H[3]}
    od = __builtin_amdgcn_mfma_f32_32x32x16_bf16(pa0, PK(l0, h0), od, 0, 0, 0);
    od = __builtin_amdgcn_mfma_f32_32x32x16_bf16(pa1, PK(l1, h1), od, 0, 0, 0);
    od = __builtin_amdgcn_mfma_f32_32x32x16_bf16(pa2, PK(l2, h2), od, 0, 0, 0);
    od = __builtin_amdgcn_mfma_f32_32x32x16_bf16(pa3, PK(l3, h3), od, 0, 0, 0);
#undef PK
}
__device__ __forceinline__ void pv_d0(f32x16* o, int vb, bf16x8 pa0, bf16x8 pa1, bf16x8 pa2, bf16x8 pa3) {
    pv_one<0>(o[0], vb, pa0, pa1, pa2, pa3); pv_one<1>(o[1], vb, pa0, pa1, pa2, pa3); pv_one<2>(o[2], vb, pa0, pa1, pa2, pa3); pv_one<3>(o[3], vb, pa0, pa1, pa2, pa3);
}
__device__ __forceinline__ float fma_s(float a, float s_uniform, float c) { float d; asm("v_fma_f32 %0, %1, %2, %3" : "=v"(d) : "v"(a), "s"(s_uniform), "v"(c)); return d; }
constexpr float THR2 = 8.0f * 1.4426950408889634f;
template <bool BIAS>
__device__ __forceinline__ void partialSM(f32x16& p0, f32x16& p1, float& m_reg, float& mn, float& alpha, float Cs, bool near, float bconst, int relbase, int hi, const LAS float* tbl) {
    float pmax;
    if (BIAS && near) {
#pragma unroll
        for (int r = 0; r < 16; ++r) { const int k = relbase + crow(r, hi);
            const int i0 = min(max(k, 0), 256), i1 = min(max(k + 32, 0), 256);
            p0[r] = fma_s(p0[r], Cs, tbl[i0]); p1[r] = fma_s(p1[r], Cs, tbl[i1]); }
        pmax = p0[0];
#pragma unroll
        for (int r = 1; r < 16; ++r) pmax = fmaxf(pmax, p0[r]);
#pragma unroll
        for (int r = 0; r < 16; ++r) pmax = fmaxf(pmax, p1[r]);
        { auto rr = __builtin_amdgcn_permlane32_swap(__float_as_uint(pmax), __float_as_uint(pmax), false, false); pmax = fmaxf(__uint_as_float(rr[0]), __uint_as_float(rr[1])); }
        if (__builtin_expect(__all(pmax - m_reg <= THR2), 1)) { mn = m_reg; alpha = 1.f; }
        else { mn = fmaxf(m_reg, pmax); alpha = __builtin_amdgcn_exp2f(m_reg - mn); m_reg = mn; }
#pragma unroll
        for (int r = 0; r < 16; ++r) { p0[r] = p0[r] - mn; p1[r] = p1[r] - mn; }
    } else {
        pmax = p0[0];
#pragma unroll
        for (int r = 1; r < 16; ++r) pmax = fmaxf(pmax, p0[r]);
#pragma unroll
        for (int r = 0; r < 16; ++r) pmax = fmaxf(pmax, p1[r]);
        { auto rr = __builtin_amdgcn_permlane32_swap(__float_as_uint(pmax), __float_as_uint(pmax), false, false); pmax = fmaxf(__uint_as_float(rr[0]), __uint_as_float(rr[1])); }
        pmax = fmaf(pmax, Cs, bconst);
        if (__builtin_expect(__all(pmax - m_reg <= THR2), 1)) { mn = m_reg; alpha = 1.f; }
        else { mn = fmaxf(m_reg, pmax); alpha = __builtin_amdgcn_exp2f(m_reg - mn); m_reg = mn; }
        const float off = bconst - mn;
#pragma unroll
        for (int r = 0; r < 16; ++r) { p0[r] = fma_s(p0[r], Cs, off); p1[r] = fma_s(p1[r], Cs, off); }
    }
#pragma unroll
    for (int r = 0; r < 16; ++r) p0[r] = __builtin_amdgcn_exp2f(p0[r]);
}
__device__ __forceinline__ void partialSM_ci(f32x16& p0, f32x16& p1, float& m_reg, float& alpha, f32x16& csp, bool first, bool near, float bcur, int relbase, int hi, const LAS float* tbl) {
    if (near) {
        const LAS float* tb = tbl + relbase + 4 * hi;
#pragma unroll
        for (int r = 0; r < 16; ++r) { p0[r] += tb[(r & 3) + 8 * (r >> 2)]; p1[r] += tb[32 + (r & 3) + 8 * (r >> 2)]; }
    }
    float pmax = p0[0];
#pragma unroll
    for (int r = 1; r < 16; ++r) pmax = fmaxf(pmax, p0[r]);
#pragma unroll
    for (int r = 0; r < 16; ++r) pmax = fmaxf(pmax, p1[r]);
    { auto rr = __builtin_amdgcn_permlane32_swap(__float_as_uint(pmax), __float_as_uint(pmax), false, false); pmax = fmaxf(__uint_as_float(rr[0]), __uint_as_float(rr[1])); }
    if (__builtin_expect(!first && __all(pmax <= THR2), 1)) { alpha = 1.f; }
    else { const float d = first ? pmax : fmaxf(pmax, 0.f); alpha = __builtin_amdgcn_exp2f(-d); m_reg += d;
#pragma unroll
        for (int r = 0; r < 16; ++r) { p0[r] -= d; p1[r] -= d; csp[r] -= d; } }
#pragma unroll
    for (int r = 0; r < 16; ++r) p0[r] = __builtin_amdgcn_exp2f(p0[r]);
}
__device__ __forceinline__ void finishSM(f32x16& p0, f32x16& p1, float alpha, float& l_reg, bf16x8& pa0, bf16x8& pa1, bf16x8& pa2, bf16x8& pa3) {
#pragma unroll
    for (int r = 0; r < 16; ++r) p1[r] = __builtin_amdgcn_exp2f(p1[r]);
    float ps = 0;
#pragma unroll
    for (int r = 0; r < 16; ++r) ps += p0[r];
#pragma unroll
    for (int r = 0; r < 16; ++r) ps += p1[r];
    { auto rr = __builtin_amdgcn_permlane32_swap(__float_as_uint(ps), __float_as_uint(ps), false, false); ps = __uint_as_float(rr[0]) + __uint_as_float(rr[1]); }
    l_reg = l_reg * alpha + ps;
#define PK4(P, BASE, OUT) do { unsigned a0 = cvt_pk_bf16(P[BASE + 0], P[BASE + 1]), a1 = cvt_pk_bf16(P[BASE + 2], P[BASE + 3]);   \
    unsigned b0 = cvt_pk_bf16(P[BASE + 4], P[BASE + 5]), b1 = cvt_pk_bf16(P[BASE + 6], P[BASE + 7]);                              \
    auto r0 = __builtin_amdgcn_permlane32_swap(a0, b0, false, false); auto r1 = __builtin_amdgcn_permlane32_swap(a1, b1, false, false); \
    u32x4 w = {r0[0], r1[0], r0[1], r1[1]}; OUT = *reinterpret_cast<bf16x8*>(&w); } while (0)
    PK4(p0, 0, pa0); PK4(p0, 8, pa1); PK4(p1, 0, pa2); PK4(p1, 8, pa3);
#undef PK4
}
template <int NP>
__device__ __forceinline__ void qkt(f32x16& p0, f32x16& p1, const LAS char* Ks, const bf16x8* qr, const LAS char* qrl, int r32, int hi, const f32x16& cinit) {
    p0 = cinit; p1 = cinit;
#pragma unroll
    for (int p = 0; p < NP; ++p)
#pragma unroll
        for (int d0 = 0; d0 < 4; ++d0) { const int cb = d0 * 32 + hi * 16;
            bf16x8 b0 = *(const LAS bf16x8*)(Ks + p * SHM_KP + kswz(r32, cb));
            bf16x8 b1 = *(const LAS bf16x8*)(Ks + p * SHM_KP + kswz(32 + r32, cb));
            const bf16x8 qf = (NP == 3 && p == 2) ? *(const LAS bf16x8*)(qrl + d0 * 32) : qr[p * 4 + d0];
            p0 = __builtin_amdgcn_mfma_f32_32x32x16_bf16(b0, qf, p0, 0, 0, 0);
            p1 = __builtin_amdgcn_mfma_f32_32x32x16_bf16(b1, qf, p1, 0, 0, 0); }
}
struct Ptrs { const bf16* q[3]; const bf16* k[3]; const bf16* v; };
struct StrDiff { static constexpr int LDQ = NIN, LDK = NIN, LDK2 = NIN, LDV = NIN; };
struct StrMla { static constexpr int LDQ = NQ, LDK = NKV, LDK2 = NIN, LDV = NKV; };
template <int NP, bool BIAS, int SDEPTH, class STR>
__device__ __forceinline__ void attn_body(const Ptrs& P, int seq, int qpos0, float Cs, LAS char* lds, f32x16 (&o)[4], int tid_in) {
    int tid = tid_in; asm volatile("" : "+v"(tid));
    const int wid = __builtin_amdgcn_readfirstlane(tid >> 6), lane = tid & 63, r32 = lane & 31, hi = lane >> 5;
    LAS char* V_lds = lds + OFF_V; LAS char* K_lds = lds + OFF_K;
    LAS float* wsl = (LAS float*)(lds + OFF_WS) + wid * 64; LAS float* li_l = wsl; LAS float* al_l = wsl + 32;
    const LAS float* tbl = (const LAS float*)(lds + OFF_TBL);
    constexpr int KB = NP * SHM_KP;
    constexpr bool CI = BIAS && (ATT_CINIT != 0);
    float m_reg = CI ? 0.f : -1e30f, l_reg = 0;
#pragma unroll
    for (int d = 0; d < 4; ++d) o[d] = f32x16{};
    constexpr int NPR = (NP == 3) ? 2 : NP;
    bf16x8 qr[NPR * 4];
#pragma unroll
    for (int p = 0; p < NPR; ++p)
#pragma unroll
        for (int d0 = 0; d0 < 4; ++d0) qr[p * 4 + d0] = *reinterpret_cast<const bf16x8*>(P.q[p] + (long)(wid * 32 + r32) * STR::LDQ + hi * 8 + d0 * 16);
    LAS char* qrl = lds + OFF_QR + (wid * 32 + r32) * KROW + hi * 16;
    if constexpr (NP == 3) {
#pragma unroll
        for (int d0 = 0; d0 < 4; ++d0) *(LAS bf16x8*)(qrl + d0 * 32) = *reinterpret_cast<const bf16x8*>(P.q[2] + (long)(wid * 32 + r32) * STR::LDQ + hi * 8 + d0 * 16);
    }
    const int kr = tid >> 3, kc = tid & 7, kst = kswz(kr, kc * 16);
    const int sr = tid >> 4, sc = (tid & 15) * 8, vst0 = v_st(sr, sc), vst1 = v_st(32 + sr, sc);
    const int vb0 = (int)(uintptr_t)V_lds + v_rd_base(lane);
    const int qlo = qpos0 + wid * 32;
    const float bL = BIAS ? tbl[0] : 0.f, bR = BIAS ? tbl[CI ? 512 : 256] : 0.f;
    f32x16 csp = f32x16{}; float bcur = bL;
    if constexpr (CI) {
#pragma unroll
        for (int r = 0; r < 16; ++r) csp[r] = bL; }
    struct { bf16x8 vs0, vs1, ks[NP]; } st_[SDEPTH];
#define SLOAD(i, k0) do { st_[i].vs0 = *reinterpret_cast<const bf16x8*>(P.v + (long)((k0) + sr) * STR::LDV + sc); st_[i].vs1 = *reinterpret_cast<const bf16x8*>(P.v + (long)((k0) + 32 + sr) * STR::LDV + sc); \
    _Pragma("unroll") for (int p_ = 0; p_ < NP; ++p_) st_[i].ks[p_] = *reinterpret_cast<const bf16x8*>(P.k[p_] + (long)((k0) + kr) * (p_ == 2 ? STR::LDK2 : STR::LDK) + kc * 8); } while (0)
#define SWRITE(b, i) do { *(LAS bf16x8*)(V_lds + (b) * SHM_V + vst0) = st_[i].vs0; *(LAS bf16x8*)(V_lds + (b) * SHM_V + vst1) = st_[i].vs1; \
    _Pragma("unroll") for (int p_ = 0; p_ < NP; ++p_) *(LAS bf16x8*)(K_lds + (b) * KB + p_ * SHM_KP + kst) = st_[i].ks[p_]; } while (0)
#define SWAIT() do { if constexpr (SDEPTH == 2) { if constexpr (NP == 1) asm volatile("s_waitcnt vmcnt(3)" ::: "memory"); else asm volatile("s_waitcnt vmcnt(5)" ::: "memory"); } else asm volatile("s_waitcnt vmcnt(0)" ::: "memory"); } while (0)
#define RESC(a) do { if (__any((a) < 1.f)) { if (hi == 0) al_l[r32] = (a); asm volatile("s_waitcnt lgkmcnt(0)" ::: "memory"); \
    _Pragma("unroll") for (int d = 0; d < 4; ++d) _Pragma("unroll") for (int r = 0; r < 16; ++r) o[d][r] *= al_l[crow(r, hi)]; } } while (0)
#define TILEB(j, nearv, bcv, rbv) const int _rh##j = (j) * 64 + 63 - qlo, _rl##j = (j) * 64 - (qlo + 31); \
    const bool nearv = BIAS && (_rh##j > -128) && (_rl##j < 128); const float bcv = (_rh##j <= -128) ? bL : bR; const int rbv = (j) * 64 - (qlo + r32) + (CI ? 256 : 128)
#define CLS(nearv, bcv) do { if constexpr (CI) { const float _bt = (nearv) ? 0.f : (bcv); if (_bt != bcur) { const float _dl = _bt - bcur; _Pragma("unroll") for (int r = 0; r < 16; ++r) csp[r] += _dl; bcur = _bt; } } } while (0)
#define PSM(P0, P1, MN, AL, first, nearv, bcv, rbv) do { if constexpr (CI) { partialSM_ci(P0, P1, m_reg, AL, csp, first, nearv, bcur, rbv, hi, tbl); MN = 0.f; } \
        else partialSM<BIAS>(P0, P1, m_reg, MN, AL, Cs, nearv, bcv, rbv, hi, tbl); } while (0)
    f32x16 pA0, pA1, pB0, pB1; float mnA, mnB, alA, alB; bf16x8 pa0, pa1, pa2, pa3; const int NT = seq / 64;
    constexpr int SE = 0, SO = SDEPTH - 1;
    SLOAD(SE, 0); asm volatile("s_waitcnt vmcnt(0)" ::: "memory"); SWRITE(0, SE); __syncthreads();
    { const int jj = 0; TILEB(jj, nr, bc, rb); CLS(nr, bc); qkt<NP>(pA0, pA1, K_lds, qr, qrl, r32, hi, csp); PSM(pA0, pA1, mnA, alA, true, nr, bc, rb); }
    SLOAD(SO, 64); if constexpr (SDEPTH == 2) { if (2 < NT) SLOAD(SE, 128); }
    SWAIT(); SWRITE(1, SO); __syncthreads();
    for (int j = 1; j + 1 < NT; j += 2) {
        TILEB(j, nrB, bcB, rbB); CLS(nrB, bcB);
        SBAR(); qkt<NP>(pB0, pB1, K_lds + KB, qr, qrl, r32, hi, csp);
        finishSM(pA0, pA1, alA, l_reg, pa0, pa1, pa2, pa3); SBAR();
        SLOAD(SO, (j + SDEPTH) * 64); SBAR();
        pv_d0(o, vb0, pa0, pa1, pa2, pa3);
        PSM(pB0, pB1, mnB, alB, false, nrB, bcB, rbB);
        __syncthreads(); SWAIT(); SWRITE(0, SE);
        RESC(alB); __syncthreads();
        const int j1 = j + 1; TILEB(j1, nrA, bcA, rbA); CLS(nrA, bcA);
        SBAR(); qkt<NP>(pA0, pA1, K_lds, qr, qrl, r32, hi, csp);
        finishSM(pB0, pB1, alB, l_reg, pa0, pa1, pa2, pa3); SBAR();
        if (SDEPTH == 1 || j + 3 < NT) SLOAD(SE, (j + 1 + SDEPTH) * 64); SBAR();
        pv_d0(o, vb0 + SHM_V, pa0, pa1, pa2, pa3);
        PSM(pA0, pA1, mnA, alA, false, nrA, bcA, rbA);
        __syncthreads(); SWAIT(); SWRITE(1, SO);
        RESC(alA); __syncthreads();
    }
    const int jl = NT - 1; TILEB(jl, nrL, bcL, rbL); CLS(nrL, bcL);
    SBAR(); qkt<NP>(pB0, pB1, K_lds + KB, qr, qrl, r32, hi, csp);
    finishSM(pA0, pA1, alA, l_reg, pa0, pa1, pa2, pa3); SBAR();
    pv_d0(o, vb0, pa0, pa1, pa2, pa3);
    PSM(pB0, pB1, mnB, alB, false, nrL, bcL, rbL);
    __syncthreads(); RESC(alB);
    finishSM(pB0, pB1, alB, l_reg, pa0, pa1, pa2, pa3); SBAR();
    pv_d0(o, vb0 + SHM_V, pa0, pa1, pa2, pa3);
    if (hi == 0) li_l[r32] = l_reg; asm volatile("s_waitcnt lgkmcnt(0)" ::: "memory");
#pragma unroll
    for (int r = 0; r < 16; ++r) { const float rl = __builtin_amdgcn_rcpf(li_l[crow(r, hi)]);
#pragma unroll
        for (int d = 0; d < 4; ++d) o[d][r] *= rl; }
    __syncthreads();
#undef SLOAD
#undef SWRITE
#undef SWAIT
#undef RESC
#undef TILEB
#undef CLS
#undef PSM
}
}

constexpr int NWAVES = 8;
constexpr int CW_BAR = 4096;
constexpr int RING_BYTES = 131072, MISC_OFF = RING_BYTES + 320, LDS_BYTES = 147456;
static_assert(att::LDS_END <= RING_BYTES, "attention LDS");

#define XB_TMO      128
#define XB_XCNT(j)  (256  + 64 * (j))
#define XB_XSUB(j)  (1280 + 64 * (j))
#define XB_XGEN(j)  (2304 + 64 * (j))
#define XB_TOP      3328
#define XB_TOPGEN   3392
#define XCD_BAR_WORDS 3456
#define XB_SPIN_CAP (1u << 21)
__device__ __forceinline__ unsigned xb_ld(unsigned* p)              { return __hip_atomic_load(p, __ATOMIC_RELAXED, __HIP_MEMORY_SCOPE_AGENT); }
__device__ __forceinline__ unsigned xb_add(unsigned* p, unsigned v) { return __hip_atomic_fetch_add(p, v, __ATOMIC_RELAXED, __HIP_MEMORY_SCOPE_AGENT); }
__device__ __forceinline__ unsigned xb_xcc_id() { return (unsigned)__builtin_amdgcn_s_getreg((3 << 11) | 20) & 0xFu; }
#define XB_SPIN(cond, bar) do { unsigned _sp = 0; while (cond) { __builtin_amdgcn_s_sleep(1); \
    if ((++_sp & 255u) == 0u) { if (xb_ld(&(bar)[XB_TMO])) break; if (_sp > XB_SPIN_CAP) { atomicAdd(&(bar)[XB_TMO], 1u); break; } } } } while (0)
struct XcdBarrier { unsigned* bar; unsigned x; volatile LAS unsigned* st; };
__device__ __forceinline__ XcdBarrier xcd_barrier_post(unsigned* bar, volatile LAS unsigned* st, bool leader) {
    XcdBarrier b; b.bar = bar; b.x = xb_xcc_id(); b.st = st;
    if (leader) (void)xb_add(&bar[XB_XCNT(b.x)], 1u);
    return b;
}
__device__ __forceinline__ void xcd_barrier_complete(unsigned* bar, unsigned x, unsigned& nloc, unsigned& nx) {
    const unsigned G = gridDim.x * gridDim.y * gridDim.z;
    unsigned sum, cnt, mine, sp = 0u;
    for (;;) {
        sum = 0u; cnt = 0u; mine = 0u;
#pragma unroll
        for (unsigned j = 0; j < 16; ++j) { const unsigned c = xb_ld(&bar[XB_XCNT(j)]); sum += c; cnt += (c > 0u) ? 1u : 0u; mine = (j == x) ? c : mine; }
        if (sum == G) break;
        __builtin_amdgcn_s_sleep(1);
        if ((++sp & 255u) == 0u) { if (xb_ld(&bar[XB_TMO])) break; if (sp > XB_SPIN_CAP) { atomicAdd(&bar[XB_TMO], 1u); break; } }
    }
    nloc = mine > 0u ? mine : 1u; nx = cnt > 0u ? cnt : 1u;
}
__device__ __forceinline__ void xcd_barrier(const XcdBarrier& b, bool leader) {
    asm volatile("s_waitcnt vmcnt(0)" ::: "memory");
    __syncthreads();
    if (leader) {
        unsigned* bar = b.bar;
        __builtin_amdgcn_s_waitcnt(0);
        unsigned nloc = b.st[0], nx = b.st[1];
        if (nloc == 0u) { xcd_barrier_complete(bar, b.x, nloc, nx); b.st[0] = nloc; b.st[1] = nx; }
        const unsigned old = xb_add(&bar[XB_XSUB(b.x)], 1u);
        const unsigned gen = old / nloc;
        if (old + 1u == (gen + 1u) * nloc) {
            __builtin_amdgcn_fence(__ATOMIC_RELEASE, "agent");
            asm volatile("s_waitcnt vmcnt(0)" ::: "memory");
            const unsigned og = xb_add(&bar[XB_TOP], 1u);
            const unsigned tg = og / nx;
            if (og + 1u == (tg + 1u) * nx) xb_add(&bar[XB_TOPGEN], 1u);
            else XB_SPIN(xb_ld(&bar[XB_TOPGEN]) == tg, bar);
            __builtin_amdgcn_fence(__ATOMIC_ACQUIRE, "agent");
            xb_add(&bar[XB_XGEN(b.x)], 1u);
            asm volatile("s_waitcnt vmcnt(0)" ::: "memory");
        } else {
            XB_SPIN(xb_ld(&bar[XB_XGEN(b.x)]) == gen, bar);
            __builtin_amdgcn_fence(__ATOMIC_ACQUIRE, "agent");
            asm volatile("s_waitcnt vmcnt(0)" ::: "memory");
        }
    }
    __syncthreads();
}

#define LDS_WAIT() asm volatile("s_waitcnt lgkmcnt(0)" ::: "memory")
template <int X> __device__ __forceinline__ float swz_xor(float v) { return __int_as_float(__builtin_amdgcn_ds_swizzle(__float_as_int(v), (X << 10) | 0x1f)); }
__device__ __forceinline__ float half_sum(float v) { v += swz_xor<1>(v); v += swz_xor<2>(v); v += swz_xor<4>(v); v += swz_xor<8>(v); v += swz_xor<16>(v); return v; }
__device__ __forceinline__ float wave_max(float v) {
    v = __builtin_fmaxf(v, swz_xor<1>(v)); v = __builtin_fmaxf(v, swz_xor<2>(v)); v = __builtin_fmaxf(v, swz_xor<4>(v)); v = __builtin_fmaxf(v, swz_xor<8>(v)); v = __builtin_fmaxf(v, swz_xor<16>(v));
    auto rr = __builtin_amdgcn_permlane32_swap(__float_as_uint(v), __float_as_uint(v), false, false);
    return __builtin_fmaxf(__uint_as_float(rr[0]), __uint_as_float(rr[1]));
}
__device__ __forceinline__ float wave_sum(float v) {
    v = half_sum(v);
    auto rr = __builtin_amdgcn_permlane32_swap(__float_as_uint(v), __float_as_uint(v), false, false);
    return __uint_as_float(rr[0]) + __uint_as_float(rr[1]);
}

constexpr int NWAVES_ = 8;
template <int MODE, class SrcFn>
__device__ __forceinline__ void convert_strip(const float* W, int K, int N, unsigned char* WT, float* cs, int n0, float fscale, LAS float* lmax, int wave, int lane, SrcFn src) {
    const int rg = lane >> 3, cq = lane & 7, nchunk = K >> 7;
    int sc[4];
#pragma unroll
    for (int j = 0; j < 4; ++j) sc[j] = src(n0 + 4 * cq + j);
    const bool contig = __all(sc[0] >= 0 && (sc[0] & 3) == 0 && sc[1] == sc[0] + 1 && sc[2] == sc[0] + 2 && sc[3] == sc[0] + 3);
    auto ldrow = [&](int row) -> f32x4 {
        if (contig) return *(const f32x4*)(W + (size_t)row * N + sc[0]);
        f32x4 v;
#pragma unroll
        for (int j = 0; j < 4; ++j) v[j] = sc[j] >= 0 ? W[(size_t)row * N + sc[j]] : 0.f;
        return v; };
    f32x4 inv = (f32x4){fscale, fscale, fscale, fscale};
    if constexpr (MODE == 2) {
        f32x4 mx = (f32x4){0.f, 0.f, 0.f, 0.f};
        for (int c = wave; c < nchunk; c += NWAVES_) { f32x4 v[16];
#pragma unroll
            for (int i = 0; i < 16; ++i) v[i] = ldrow(c * 128 + 16 * rg + i);
#pragma unroll
            for (int i = 0; i < 16; ++i)
#pragma unroll
                for (int j = 0; j < 4; ++j) mx[j] = __builtin_fmaxf(mx[j], __builtin_fabsf(v[i][j])); }
#pragma unroll
        for (int j = 0; j < 4; ++j) { float m = mx[j]; m = __builtin_fmaxf(m, swz_xor<8>(m)); m = __builtin_fmaxf(m, swz_xor<16>(m));
            auto rr = __builtin_amdgcn_permlane32_swap(__float_as_uint(m), __float_as_uint(m), false, false); mx[j] = __builtin_fmaxf(__uint_as_float(rr[0]), __uint_as_float(rr[1])); }
        __syncthreads();
        if (lane < 8) *(LAS f32x4*)(lmax + wave * 32 + 4 * lane) = mx;
        __syncthreads();
        f32x4 cm = *(const LAS f32x4*)(lmax + 4 * cq);
#pragma unroll
        for (int w = 1; w < NWAVES_; ++w) { const f32x4 o = *(const LAS f32x4*)(lmax + w * 32 + 4 * cq);
#pragma unroll
            for (int j = 0; j < 4; ++j) cm[j] = __builtin_fmaxf(cm[j], o[j]); }
#pragma unroll
        for (int j = 0; j < 4; ++j) inv[j] = cm[j] > 0.f ? 127.f / cm[j] : 0.f;
        if (wave == 0 && lane < 8) *(f32x4*)(cs + n0 + 4 * lane) = cm * (1.f / 127.f);
    }
    constexpr int EB = (MODE == 0) ? 2 : 1; const size_t rowb = (size_t)K * EB;
    for (int c = wave; c < nchunk; c += NWAVES_) { f32x4 v[16];
#pragma unroll
        for (int i = 0; i < 16; ++i) v[i] = ldrow(c * 128 + 16 * rg + i) * inv;
#pragma unroll
        for (int j = 0; j < 4; ++j) { unsigned char* dst = WT + (size_t)(n0 + 4 * cq + j) * rowb + (size_t)(c * 128 + 16 * rg) * EB;
            if constexpr (MODE == 2) { u32x4 o; o.x = pack4_i8(v[0][j], v[1][j], v[2][j], v[3][j]); o.y = pack4_i8(v[4][j], v[5][j], v[6][j], v[7][j]); o.z = pack4_i8(v[8][j], v[9][j], v[10][j], v[11][j]); o.w = pack4_i8(v[12][j], v[13][j], v[14][j], v[15][j]); *(u32x4*)dst = o; }
            else if constexpr (MODE == 1) { u32x4 o; o.x = pack4_fp8(v[0][j], v[1][j], v[2][j], v[3][j]); o.y = pack4_fp8(v[4][j], v[5][j], v[6][j], v[7][j]); o.z = pack4_fp8(v[8][j], v[9][j], v[10][j], v[11][j]); o.w = pack4_fp8(v[12][j], v[13][j], v[14][j], v[15][j]); *(u32x4*)dst = o; }
            else { u32x4 o; o.x = cvt_pk_bf16(v[0][j], v[1][j]); o.y = cvt_pk_bf16(v[2][j], v[3][j]); o.z = cvt_pk_bf16(v[4][j], v[5][j]); o.w = cvt_pk_bf16(v[6][j], v[7][j]); *(u32x4*)dst = o;
                   o.x = cvt_pk_bf16(v[8][j], v[9][j]); o.y = cvt_pk_bf16(v[10][j], v[11][j]); o.z = cvt_pk_bf16(v[12][j], v[13][j]); o.w = cvt_pk_bf16(v[14][j], v[15][j]); *(u32x4*)(dst + 16) = o; } }
    }
}
__device__ __forceinline__ int t5_bucket(int rel) {
    const int ret = rel > 0 ? 16 : 0; const int n = rel < 0 ? -rel : rel;
    if (n < 8) return ret + n;
    int large = 2 + (31 - __builtin_clz((unsigned)(n * n)));
    large = large < 15 ? large : 15;
    return ret + large;
}
__device__ __forceinline__ void sincos_f32arg(float ang, float& c, float& s) {
    const double a = (double)ang; const double kq = __builtin_rint(a * 0.63661977236758134);
    double r = __builtin_fma(-kq, 1.5707963267948966, a); r = __builtin_fma(-kq, 6.123233995736766e-17, r);
    const int q = ((int)kq) & 3; const double r2 = r * r;
    const double sp = r * (1.0 + r2 * (-1.0 / 6 + r2 * (1.0 / 120 + r2 * (-1.0 / 5040 + r2 * (1.0 / 362880 + r2 * (-1.0 / 39916800))))));
    const double cp = 1.0 + r2 * (-0.5 + r2 * (1.0 / 24 + r2 * (-1.0 / 720 + r2 * (1.0 / 40320 + r2 * (-1.0 / 3628800 + r2 * (1.0 / 479001600))))));
    const double sv = (q == 0) ? sp : (q == 1) ? cp : (q == 2) ? -sp : -cp;
    const double cv = (q == 0) ? cp : (q == 1) ? -sp : (q == 2) ? -cp : sp;
    c = (float)cv; s = (float)sv;
}

struct Args { const float* in[23]; float* out; unsigned char* ws; float invf[32]; int lo, hi; };
typedef const __attribute__((address_space(4))) Args* ArgsP;

enum { I_XP = 0, I_XS, I_RELB, I_FNG, I_RAG, I_WIN, I_LQ1, I_LK1, I_LQ2, I_LK2, I_SUBG, I_QNG, I_WQUP, I_KVNG, I_WKVUP, I_WA, I_WB, I_WO, I_RFG, I_WUP, I_CW, I_CB, I_WD };

#define P_WINT ((bf16*)(ws + WS_WIN))
#define P_WQT ((bf16*)(ws + WS_WQ))
#define P_WKVT ((bf16*)(ws + WS_WKV))
#define P_WAT ((bf16*)(ws + WS_WA))
#define P_WBT ((bf16*)(ws + WS_WB))
#define P_WOT ((bf16*)(ws + WS_WO))
#define P_WUPT ((bf16*)(ws + WS_WUP))
#define P_WDT ((bf16*)(ws + WS_WD))
#define P_COS ((float*)(ws + WS_COS))
#define P_SIN ((float*)(ws + WS_SIN))
#define P_BIAS2 ((float*)(ws + WS_BIAS))
#define P_LAM ((float*)(ws + WS_LAM))
#define P_CSIN ((float*)(ws + WS_CSIN))
#define P_CSUP ((float*)(ws + WS_CSUP))
#define P_RSH ((float*)(ws + WS_RSH))
#define P_QL8 ((unsigned char*)(ws + WS_QL8))
#define P_KVL8 ((unsigned char*)(ws + WS_KVL8))
#define P_AO8 ((unsigned char*)(ws + WS_AO8))
#define P_BO8 ((unsigned char*)(ws + WS_BO8))
#define P_MG8 ((unsigned char*)(ws + WS_MG8))
#define P_X1 ((bf16*)(ws + WS_X1))
#define P_HF ((unsigned char*)(ws + WS_HF))
#define P_RSHF ((float*)(ws + WS_RSHF))
#define P_P ((bf16*)(ws + WS_P))
#define P_Q ((bf16*)(ws + WS_Q))
#define P_KV ((bf16*)(ws + WS_KV))
#define P_AO ((bf16*)(ws + WS_AO))
#define P_BO ((bf16*)(ws + WS_BO))
#define P_MG ((bf16*)(ws + WS_MG))
#define P_STASH ((float*)(ws + WS_STASH))
#define P_Y ((bf16*)(ws + WS_Y))
#define P_ACT ((bf16*)(ws + WS_ACTV))
#define XG() ((g < 2) ? A->in[I_XP] + (size_t)g * TG * DM : A->in[I_XS] + (size_t)(g - 2) * TG * DM)
#define OG() (A->out + (size_t)g * TG * DM)
constexpr int NSTEP_PER_GROUP = 7, NSTEPS = 1 + NGRP * NSTEP_PER_GROUP + 6;
static_assert(I8_MID, "step program written for the int8 mixer path");

__global__ void __launch_bounds__(NWAVES * 64, 2) enc_fwd(Args args) {
    extern __shared__ __attribute__((aligned(16))) unsigned char lds[];
    LAS unsigned char* ldsL = (LAS unsigned char*)lds;
    volatile LAS unsigned* MISC = (volatile LAS unsigned*)(ldsL + MISC_OFF);
    const int wave = __builtin_amdgcn_readfirstlane((int)threadIdx.x >> 6);
    const int G = gridDim.x; const int bx = blockIdx.x; const int vcu0 = (G % 8 == 0) ? (bx % 8) * (G / 8) + bx / 8 : bx;
    unsigned char* ws = args.ws;
    unsigned* ctl = (unsigned*)(ws + WS_CTL);
    { const int tid0 = wave * 64 + lane_id_fresh(); for (int u = tid0; u < (LDS_BYTES - RING_BYTES) / 4; u += NWAVES * 64) ((LAS unsigned*)(ldsL + RING_BYTES))[u] = 0u; }
    __syncthreads();
    XcdBarrier bar; bar.bar = ctl + CW_BAR; bar.x = 0; bar.st = nullptr;
#if !MK_PER_STEP_LAUNCH
    bar = xcd_barrier_post(ctl + CW_BAR, MISC + 8, (wave * 64 + lane_id_fresh()) == 0);
#endif
    const int lo = args.lo, hi = args.hi;
    int step = 0;
#ifndef EN_MASK
#define EN_MASK 0xFFFFFF
#endif
#define EN(k) (((EN_MASK) >> (k)) & 1)
#define RUN() (step >= lo && step < hi)
#define LOCAL_TID() ArgsP A = (ArgsP)__builtin_amdgcn_kernarg_segment_ptr(); asm volatile("" : "+s"(A)); unsigned char* const ws = A->ws; (void)ws; int lane_ = lane_id_fresh(); asm volatile("" : "+v"(lane_)); const int lane = lane_; const int tid = wave * 64 + lane; (void)tid; int gw = gw0, vcu = vcu0; asm volatile("" : "+s"(gw), "+s"(vcu)); (void)gw; (void)vcu
#if MK_PER_STEP_LAUNCH
#define SEAM() do { ++step; } while (0)
#else
#define SEAM() do { if (RUN() && step + 1 < hi) xcd_barrier(bar, (wave * 64 + lane_id_fresh()) == 0); ++step; } while (0)
#endif
    const int gw0 = vcu0 * NWAVES + wave, NGW = G * NWAVES;

    if (RUN() && EN(0)) { LOCAL_TID();
        LAS float* lmax = (LAS float*)ldsL;
        auto ident = [](int n) -> int { return n; };
        auto srcIn = [](int n) -> int { if (n < C_GATE) return n; if (n < C_KPE) return n + 64; if (n < C_KPE + 64) { const int j = n - C_KPE; return 7680 + ((j & 1) ? 32 + (j >> 1) : (j >> 1)); } return -1; };
        auto srcQ = [](int n) -> int { if (n < 2048) return (n >> 7) * 192 + (n & 127); const int j = n - 2048, hh = j >> 6, jj = j & 63; return hh * 192 + 128 + ((jj & 1) ? 32 + (jj >> 1) : (jj >> 1)); };
        auto srcUp = [](int n) -> int { return CONV_FUSE ? ((n & 128) ? DFF : 0) + (n >> 8) * 128 + (n & 127) : n; };
        constexpr int T0 = DM / 32, T1 = T0 + NIN / 32, T2 = T1 + NUP / 32, T3 = T2 + DM / 32, T4 = T3 + DM / 32, T5 = T4 + DM / 32, T6 = T5 + NQ / 32, T7 = T6 + NKV / 32;
        for (int s = vcu; s < T7; s += G) {
            if (s < T0) { const int n0 = 32 * s;
                if (FP8_DOWN) convert_strip<1>(A->in[I_WD], DFF, DM, (unsigned char*)P_WDT, nullptr, n0, S_WD, lmax, wave, lane, ident); else convert_strip<0>(A->in[I_WD], DFF, DM, (unsigned char*)P_WDT, nullptr, n0, 1.f, lmax, wave, lane, ident); }
            else if (s < T1) { const int n0 = 32 * (s - T0);
                if (I8_IN) convert_strip<2>(A->in[I_WIN], DM, 15936, (unsigned char*)P_WINT, P_CSIN, n0, 1.f, lmax, wave, lane, srcIn); else convert_strip<0>(A->in[I_WIN], DM, 15936, (unsigned char*)P_WINT, nullptr, n0, 1.f, lmax, wave, lane, srcIn); }
            else if (s < T2) { const int n0 = 32 * (s - T1);
                if (I8_UP) convert_strip<2>(A->in[I_WUP], DM, NUP, (unsigned char*)P_WUPT, P_CSUP, n0, 1.f, lmax, wave, lane, srcUp); else convert_strip<0>(A->in[I_WUP], DM, NUP, (unsigned char*)P_WUPT, nullptr, n0, 1.f, lmax, wave, lane, srcUp); }
            else if (s < T3) { const int n0 = 32 * (s - T2);
                if (I8_MID) convert_strip<2>(A->in[I_WO], DM, DM, (unsigned char*)P_WOT, (float*)(ws + WS_CSO), n0, 1.f, lmax, wave, lane, ident); else convert_strip<0>(A->in[I_WO], DM, DM, (unsigned char*)P_WOT, nullptr, n0, 1.f, lmax, wave, lane, ident); }
            else if (s < T4) { const int n0 = 32 * (s - T3);
                if (I8_MID) convert_strip<2>(A->in[I_WA], 2048, DM, (unsigned char*)P_WAT, (float*)(ws + WS_CSA), n0, 1.f, lmax, wave, lane, ident); else convert_strip<0>(A->in[I_WA], 2048, DM, (unsigned char*)P_WAT, nullptr, n0, 1.f, lmax, wave, lane, ident); }
            else if (s < T5) { const int n0 = 32 * (s - T4);
                if (I8_MID) convert_strip<2>(A->in[I_WB], 2048, DM, (unsigned char*)P_WBT, (float*)(ws + WS_CSB), n0, 1.f, lmax, wave, lane, ident); else convert_strip<0>(A->in[I_WB], 2048, DM, (unsigned char*)P_WBT, nullptr, n0, 1.f, lmax, wave, lane, ident); }
            else if (s < T6) { const int n0 = 32 * (s - T5);
                if (I8_MID) convert_strip<2>(A->in[I_WQUP], 1024, NQ, (unsigned char*)P_WQT, (float*)(ws + WS_CSQ), n0, 1.f, lmax, wave, lane, srcQ); else convert_strip<0>(A->in[I_WQUP], 1024, NQ, (unsigned char*)P_WQT, nullptr, n0, 1.f, lmax, wave, lane, srcQ); }
            else { const int n0 = 32 * (s - T6);
                if (I8_MID) convert_strip<2>(A->in[I_WKVUP], 512, NKV, (unsigned char*)P_WKVT, (float*)(ws + WS_CSKV), n0, 1.f, lmax, wave, lane, ident); else convert_strip<0>(A->in[I_WKVUP], 512, NKV, (unsigned char*)P_WKVT, nullptr, n0, 1.f, lmax, wave, lane, ident); }
        }
        for (int i = bx * (NWAVES * 64) + tid; i < 8192 * 32; i += G * NWAVES * 64) { const int pos = i >> 5, k = i & 31; float c, s; sincos_f32arg((float)pos * A->invf[k], c, s); P_COS[i] = c; P_SIN[i] = s; }
        if (bx == 0) {
            for (int i = tid; i < 16 * 257; i += NWAVES * 64) { const int h = i / 257, j = i % 257; P_BIAS2[h * 260 + j] = A->in[I_RELB][t5_bucket(j - 128) * 16 + h] * 1.4426950408889634f; }
            if (wave == 0) { const float a = wave_sum(A->in[I_LQ1][lane] * A->in[I_LK1][lane]), b = wave_sum(A->in[I_LQ2][lane] * A->in[I_LK2][lane]);
                if (lane == 0) P_LAM[0] = expf(a) - expf(b) + 0.2f; }
        }
    }

    if (RUN() && EN(1)) { LOCAL_TID();
        const float* gv = A->in[I_RAG];
        for (int m = gw; m < NTOK; m += NGW) {
            const f32x4* xr = (const f32x4*)((m < NTOK / 2 ? A->in[I_XP] + (size_t)m * DM : A->in[I_XS] + (size_t)(m - NTOK / 2) * DM)) + lane; f32x4 v[16]; float s = 0.f;
#pragma unroll
            for (int j = 0; j < 16; ++j) { v[j] = xr[64 * j]; s += (v[j].x * v[j].x + v[j].y * v[j].y) + (v[j].z * v[j].z + v[j].w * v[j].w); }
            const float rstd = 1.0f / sqrtf(wave_sum(s) * (1.f / DM) + EPS);
            if (I8_IN) { float mx = 0.f;
#pragma unroll
                for (int j = 0; j < 16; ++j) { const f32x4 gg = ((const f32x4*)gv)[64 * j + lane]; v[j] = v[j] * rstd * gg; mx = __builtin_fmaxf(__builtin_fmaxf(mx, __builtin_fmaxf(__builtin_fabsf(v[j].x), __builtin_fabsf(v[j].y))), __builtin_fmaxf(__builtin_fabsf(v[j].z), __builtin_fabsf(v[j].w))); }
                mx = wave_max(mx); const float inv = mx > 0.f ? 127.f / mx : 0.f; if (lane == 0) P_RSHF[m] = mx * (1.f / 127.f);
                unsigned* o4 = (unsigned*)(P_HF + (size_t)m * DM) + lane;
#pragma unroll
                for (int j = 0; j < 16; ++j) o4[64 * j] = pack4_i8(v[j].x * inv, v[j].y * inv, v[j].z * inv, v[j].w * inv);
            } else {
            u32x2* o8 = (u32x2*)((bf16*)P_HF + (size_t)m * DM) + lane;
#pragma unroll
            for (int j = 0; j < 16; ++j) { const f32x4 gg = ((const f32x4*)gv)[64 * j + lane]; u32x2 w; w.x = cvt_pk_bf16(v[j].x * rstd * gg.x, v[j].y * rstd * gg.y); w.y = cvt_pk_bf16(v[j].z * rstd * gg.z, v[j].w * rstd * gg.w); o8[64 * j] = w; }
            }
        }
    }
    SEAM();

    for (int g = 0; g < NGRP; ++g) {
        const int seqlen = (g < 2) ? 4096 : 8192, posmask = seqlen - 1;

        if (RUN() && EN(2)) { LOCAL_TID();
            pg8::Gemm gm{(const bf16*)(P_HF + (size_t)g * TG * DM), DM / 2, P_WINT, TG, NIN, DM / 2}; pg8::StaticOrder S; S.init(TG, NIN, G, bx);
            pg8::EpiStoreT<I8_IN != 0, WS_RSHF, WS_CSIN> E{P_P, NIN, C_GATE / 256, C_KPE / 256, ATT_CINIT ? CS_DIFF : 1.f, ws, g * TG};
            REP_LOOP_GEMM { int l2_ = lane_id_fresh(); asm volatile("" : "+v"(l2_)); pg8::gemm_phase<pg8::EpiStoreT<I8_IN != 0, WS_RSHF, WS_CSIN>, I8_IN ? 2 : 0>(ldsL, gm, S, E, wave * 64 + l2_); }
        }
        SEAM();

        if (RUN() && EN(3)) { LOCAL_TID();
            const float* gq = A->in[I_QNG]; const float* gkv = A->in[I_KVNG];
            for (int m = gw; m < TG; m += NGW) {
                bf16* prow = P_P + (size_t)m * NIN;
                { u32x4 a = *(const u32x4*)(prow + C_QLAT + lane * 8), b = *(const u32x4*)(prow + C_QLAT + 512 + lane * 8);
                  float x[16] = {bf_lo(a.x), bf_hi(a.x), bf_lo(a.y), bf_hi(a.y), bf_lo(a.z), bf_hi(a.z), bf_lo(a.w), bf_hi(a.w), bf_lo(b.x), bf_hi(b.x), bf_lo(b.y), bf_hi(b.y), bf_lo(b.z), bf_hi(b.z), bf_lo(b.w), bf_hi(b.w)};
                  float s = 0.f;
#pragma unroll
                  for (int j = 0; j < 16; ++j) s += x[j] * x[j];
                  const float rstd = 1.0f / sqrtf(wave_sum(s) * (1.f / 1024) + EPS);
                  const f32x4 g0 = *(const f32x4*)(gq + lane * 8), g1 = *(const f32x4*)(gq + lane * 8 + 4), g2 = *(const f32x4*)(gq + 512 + lane * 8), g3 = *(const f32x4*)(gq + 512 + lane * 8 + 4);
                  u32x4 oa, ob;
                  oa.x = cvt_pk_bf16(x[0] * rstd * g0.x, x[1] * rstd * g0.y); oa.y = cvt_pk_bf16(x[2] * rstd * g0.z, x[3] * rstd * g0.w); oa.z = cvt_pk_bf16(x[4] * rstd * g1.x, x[5] * rstd * g1.y); oa.w = cvt_pk_bf16(x[6] * rstd * g1.z, x[7] * rstd * g1.w);
                  ob.x = cvt_pk_bf16(x[8] * rstd * g2.x, x[9] * rstd * g2.y); ob.y = cvt_pk_bf16(x[10] * rstd * g2.z, x[11] * rstd * g2.w); ob.z = cvt_pk_bf16(x[12] * rstd * g3.x, x[13] * rstd * g3.y); ob.w = cvt_pk_bf16(x[14] * rstd * g3.z, x[15] * rstd * g3.w);
                  if (I8_MID) { float y[16]; float mx = 0.f; const float gg[16] = {g0.x, g0.y, g0.z, g0.w, g1.x, g1.y, g1.z, g1.w, g2.x, g2.y, g2.z, g2.w, g3.x, g3.y, g3.z, g3.w};
#pragma unroll
                      for (int j = 0; j < 16; ++j) { y[j] = x[j] * rstd * gg[j]; mx = __builtin_fmaxf(mx, __builtin_fabsf(y[j])); }
                      mx = wave_max(mx); const float inv = mx > 0.f ? 127.f / mx : 0.f; if (lane == 0) ((float*)(ws + WS_RSQL))[m] = mx * (1.f / 127.f);
                      u32x2 q0, q1; q0.x = pack4_i8(y[0] * inv, y[1] * inv, y[2] * inv, y[3] * inv); q0.y = pack4_i8(y[4] * inv, y[5] * inv, y[6] * inv, y[7] * inv);
                      q1.x = pack4_i8(y[8] * inv, y[9] * inv, y[10] * inv, y[11] * inv); q1.y = pack4_i8(y[12] * inv, y[13] * inv, y[14] * inv, y[15] * inv);
                      *(u32x2*)(P_QL8 + (size_t)m * 1024 + lane * 8) = q0; *(u32x2*)(P_QL8 + (size_t)m * 1024 + 512 + lane * 8) = q1;
                  } else { *(u32x4*)(prow + C_QLAT + lane * 8) = oa; *(u32x4*)(prow + C_QLAT + 512 + lane * 8) = ob; } }
                { u32x4 a = *(const u32x4*)(prow + C_KVLAT + lane * 8);
                  float x[8] = {bf_lo(a.x), bf_hi(a.x), bf_lo(a.y), bf_hi(a.y), bf_lo(a.z), bf_hi(a.z), bf_lo(a.w), bf_hi(a.w)};
                  float s = 0.f;
#pragma unroll
                  for (int j = 0; j < 8; ++j) s += x[j] * x[j];
                  const float rstd = 1.0f / sqrtf(wave_sum(s) * (1.f / 512) + EPS);
                  const f32x4 g0 = *(const f32x4*)(gkv + lane * 8), g1 = *(const f32x4*)(gkv + lane * 8 + 4);
                  u32x4 oa;
                  oa.x = cvt_pk_bf16(x[0] * rstd * g0.x, x[1] * rstd * g0.y); oa.y = cvt_pk_bf16(x[2] * rstd * g0.z, x[3] * rstd * g0.w); oa.z = cvt_pk_bf16(x[4] * rstd * g1.x, x[5] * rstd * g1.y); oa.w = cvt_pk_bf16(x[6] * rstd * g1.z, x[7] * rstd * g1.w);
                  if (I8_MID) { float y[8]; float mx = 0.f; const float gg[8] = {g0.x, g0.y, g0.z, g0.w, g1.x, g1.y, g1.z, g1.w};
#pragma unroll
                      for (int j = 0; j < 8; ++j) { y[j] = x[j] * rstd * gg[j]; mx = __builtin_fmaxf(mx, __builtin_fabsf(y[j])); }
                      mx = wave_max(mx); const float inv = mx > 0.f ? 127.f / mx : 0.f; if (lane == 0) ((float*)(ws + WS_RSKVL))[m] = mx * (1.f / 127.f);
                      u32x2 q0; q0.x = pack4_i8(y[0] * inv, y[1] * inv, y[2] * inv, y[3] * inv); q0.y = pack4_i8(y[4] * inv, y[5] * inv, y[6] * inv, y[7] * inv);
                      *(u32x2*)(P_KVL8 + (size_t)m * 512 + lane * 8) = q0;
                  } else *(u32x4*)(prow + C_KVLAT + lane * 8) = oa; }
                if (lane < 32) { const int pos = m & posmask; unsigned w = *(const unsigned*)(prow + C_KPE + 2 * lane); const float x1 = bf_lo(w), x2 = bf_hi(w);
                  const float c = P_COS[pos * 32 + lane], s = P_SIN[pos * 32 + lane];
                  *(unsigned*)(prow + C_KPE + 2 * lane) = cvt_pk_bf16(x1 * c - x2 * s, x1 * s + x2 * c); }
            }
        }
        SEAM();

        if (RUN() && EN(4)) { LOCAL_TID();
            if (EN(18)) { pg8::Gemm gm{I8_MID ? (const bf16*)P_QL8 : P_P + C_QLAT, I8_MID ? 512 : NIN, P_WQT, TG, NQ, I8_MID ? 512 : 1024}; pg8::StaticOrder S; S.init(TG, NQ, G, bx);
              pg8::EpiQT<I8_MID != 0> E{P_Q, NQ, ws, posmask}; REP_LOOP_GEMM { int l2_ = lane_id_fresh(); asm volatile("" : "+v"(l2_)); pg8::gemm_phase<pg8::EpiQT<I8_MID != 0>, I8_MID ? 2 : 0>(ldsL, gm, S, E, wave * 64 + l2_); } }
            if (EN(19)) { pg8::Gemm gm{I8_MID ? (const bf16*)P_KVL8 : P_P + C_KVLAT, I8_MID ? 256 : NIN, P_WKVT, TG, NKV, I8_MID ? 256 : 512}; pg8::StaticOrder S; S.init(TG, NKV, G, bx);
              pg8::EpiStoreT<I8_MID != 0, WS_RSKVL, WS_CSKV> E{P_KV, NKV, 0, 0, 1.f, ws, 0}; REP_LOOP_GEMM { int l2_ = lane_id_fresh(); asm volatile("" : "+v"(l2_)); pg8::gemm_phase<pg8::EpiStoreT<I8_MID != 0, WS_RSKVL, WS_CSKV>, I8_MID ? 2 : 0>(ldsL, gm, S, E, wave * 64 + l2_); } }
        }
        SEAM();

        if (RUN() && EN(5)) { LOCAL_TID();
            const int wid = wave;
            const float lam = P_LAM[0];
            _Pragma("unroll 1") for (int ph = 0; ph < 2; ++ph) {
            const bool do_diff = (((vcu >> 5) ^ ph) & 1) == 0;
            if (do_diff) { if (EN(16)) _Pragma("unroll 1") for (int rep = 0; rep < REP_DIFF; ++rep) for (int u = vcu; u < 512; u += G) { const int tid = wave * 64 + lane_id_fresh();
                const int head = u >> 5, rb = u & 31, row0 = rb * 256, kbase = (seqlen == 4096) ? (rb >> 4) * 4096 : 0, qpos0 = row0 - kbase;
                __syncthreads();
                if (ATT_CINIT) { for (int i = tid; i < 513; i += NWAVES * 64) { const int rel = min(max(i - 256, -128), 128); ((float*)(lds + att::OFF_TBL))[i] = P_BIAS2[head * 260 + rel + 128]; } }
                else if (tid < 257) ((float*)(lds + att::OFF_TBL))[tid] = P_BIAS2[head * 260 + tid];
                __syncthreads();
#pragma unroll 1
                for (int c = 0; c < 2; ++c) {
                    att::Ptrs P;
                    P.q[0] = P_P + (size_t)row0 * NIN + C_DQ + head * 128 + c * 64; P.q[1] = P.q[0]; P.q[2] = P.q[0];
                    P.k[0] = P_P + (size_t)kbase * NIN + C_DK + head * 128 + c * 64; P.k[1] = P.k[0]; P.k[2] = P.k[0];
                    P.v = P_P + (size_t)kbase * NIN + C_DV + head * 128;
                    f32x16 o[4];
                    att::attn_body<1, true, 2, att::StrDiff>(P, seqlen, qpos0, 0.125f * 1.4426950408889634f, (LAS char*)ldsL, o, tid);
                    int tid_e = tid; asm volatile("" : "+v"(tid_e));
                    const int r32 = tid_e & 31, hh = (tid_e >> 5) & 1;
                    f32x4* myst = (f32x4*)(P_STASH + ((size_t)bx * 512 + tid_e) * 64);
                    if (c == 0) {
#pragma unroll
                        for (int d = 0; d < 4; ++d)
#pragma unroll
                            for (int r4 = 0; r4 < 4; ++r4) myst[d * 4 + r4] = (f32x4){o[d][4 * r4], o[d][4 * r4 + 1], o[d][4 * r4 + 2], o[d][4 * r4 + 3]};
                    } else {
                        float ss[16];
#pragma unroll
                        for (int r = 0; r < 16; ++r) ss[r] = 0.f;
#pragma unroll
                        for (int d = 0; d < 4; ++d)
#pragma unroll
                            for (int r4 = 0; r4 < 4; ++r4) { const f32x4 s0 = myst[d * 4 + r4];
#pragma unroll
                                for (int j = 0; j < 4; ++j) { const float a = s0[j] - lam * o[d][4 * r4 + j]; o[d][4 * r4 + j] = a; ss[4 * r4 + j] += a * a; } }
#pragma unroll
                        for (int r = 0; r < 16; ++r) ss[r] = 0.8f / sqrtf(half_sum(ss[r]) * (1.f / 128) + EPS);
                        const float* sg = A->in[I_SUBG];
                        float gsub[4];
#pragma unroll
                        for (int d = 0; d < 4; ++d) gsub[d] = sg[d * 32 + r32];
#pragma unroll
                        for (int r = 0; r < 16; ++r) { bf16* orow = P_AO + (size_t)(row0 + wid * 32 + att::crow(r, hh)) * 2048 + head * 128 + r32;
#pragma unroll
                            for (int d = 0; d < 4; ++d) orow[d * 32] = (bf16)(cvt_pk_bf16(o[d][r] * ss[r] * gsub[d], 0.f) & 0xffffu); }
                    }
                }
            }
            } else { if (EN(17)) _Pragma("unroll 1") for (int rep = 0; rep < REP_MLA; ++rep) for (int u = vcu; u < 512; u += G) { const int tid = wave * 64 + lane_id_fresh();
                const int head = u >> 5, rb = u & 31, row0 = rb * 256, kbase = (seqlen == 4096) ? (rb >> 4) * 4096 : 0;
                att::Ptrs P;
                P.q[0] = P_Q + (size_t)row0 * NQ + head * 128; P.q[1] = P.q[0] + 64; P.q[2] = P_Q + (size_t)row0 * NQ + 2048 + head * 64;
                P.k[0] = P_KV + (size_t)kbase * NKV + head * 256; P.k[1] = P.k[0] + 64; P.k[2] = P_P + (size_t)kbase * NIN + C_KPE;
                P.v = P_KV + (size_t)kbase * NKV + head * 256 + 128;
                f32x16 o[4];
                att::attn_body<3, false, 1, att::StrMla>(P, seqlen, 0, 0.07216878364870323f * 1.4426950408889634f, (LAS char*)ldsL, o, tid);
                int tid_e = tid; asm volatile("" : "+v"(tid_e));
                const int r32 = tid_e & 31, hh = (tid_e >> 5) & 1;
#pragma unroll
                for (int r = 0; r < 16; ++r) { bf16* orow = P_BO + (size_t)(row0 + wid * 32 + att::crow(r, hh)) * 2048 + head * 128 + r32;
#pragma unroll
                    for (int d = 0; d < 4; ++d) orow[d * 32] = (bf16)(cvt_pk_bf16(o[d][r], 0.f) & 0xffffu); }
            }
            } }
        }
        SEAM();

#if I8_MID
        if (RUN()) { LOCAL_TID();
            for (int m = gw; m < 2 * TG; m += NGW) { const int row = m >> 1; const bool isB = m & 1;
                const bf16* srow = (isB ? P_BO : P_AO) + (size_t)row * 2048 + lane * 8; u32x4 a[4]; float mx = 0.f;
#pragma unroll
                for (int j = 0; j < 4; ++j) { a[j] = *(const u32x4*)(srow + 512 * j);
                    mx = __builtin_fmaxf(mx, __builtin_fmaxf(__builtin_fmaxf(__builtin_fmaxf(__builtin_fabsf(bf_lo(a[j].x)), __builtin_fabsf(bf_hi(a[j].x))), __builtin_fmaxf(__builtin_fabsf(bf_lo(a[j].y)), __builtin_fabsf(bf_hi(a[j].y)))),
                                                      __builtin_fmaxf(__builtin_fmaxf(__builtin_fabsf(bf_lo(a[j].z)), __builtin_fabsf(bf_hi(a[j].z))), __builtin_fmaxf(__builtin_fabsf(bf_lo(a[j].w)), __builtin_fabsf(bf_hi(a[j].w)))))); }
                mx = wave_max(mx); const float inv = mx > 0.f ? 127.f / mx : 0.f; if (lane == 0) ((float*)(ws + (isB ? WS_RSB : WS_RSA)))[row] = mx * (1.f / 127.f);
                unsigned char* drow = (isB ? P_BO8 : P_AO8) + (size_t)row * 2048 + lane * 8;
#pragma unroll
                for (int j = 0; j < 4; ++j) { u32x2 q; q.x = pack4_i8(bf_lo(a[j].x) * inv, bf_hi(a[j].x) * inv, bf_lo(a[j].y) * inv, bf_hi(a[j].y) * inv); q.y = pack4_i8(bf_lo(a[j].z) * inv, bf_hi(a[j].z) * inv, bf_lo(a[j].w) * inv, bf_hi(a[j].w) * inv); *(u32x2*)(drow + 512 * j) = q; }
            }
        }
        SEAM();
#endif

        if (RUN() && EN(6)) { LOCAL_TID();
            if (EN(20)) { pg8::Gemm gm{I8_MID ? (const bf16*)P_AO8 : P_AO, I8_MID ? 1024 : 2048, P_WAT, TG, DM, I8_MID ? 1024 : 2048}; pg8::StaticOrder S; S.init(TG, DM, G, bx);
              pg8::EpiGateAT<I8_MID != 0> E{P_MG, DM, P_P + C_GATE, NIN, ws}; REP_LOOP_GEMM { int l2_ = lane_id_fresh(); asm volatile("" : "+v"(l2_)); pg8::gemm_phase<pg8::EpiGateAT<I8_MID != 0>, I8_MID ? 2 : 0>(ldsL, gm, S, E, wave * 64 + l2_); } }
            if (EN(21)) { pg8::Gemm gm{I8_MID ? (const bf16*)P_BO8 : P_BO, I8_MID ? 1024 : 2048, P_WBT, TG, DM, I8_MID ? 1024 : 2048}; pg8::StaticOrder S; S.init(TG, DM, G, bx);
              pg8::EpiGateBT<I8_MID != 0> E{P_MG, DM, P_P + C_GATE + DM, NIN, P_MG, DM, ws}; REP_LOOP_GEMM { int l2_ = lane_id_fresh(); asm volatile("" : "+v"(l2_)); pg8::gemm_phase<pg8::EpiGateBT<I8_MID != 0>, I8_MID ? 2 : 0>(ldsL, gm, S, E, wave * 64 + l2_); } }
        }
        SEAM();

#if I8_MID
        if (RUN()) { LOCAL_TID();
            for (int m = gw; m < TG; m += NGW) {
                const bf16* srow = P_MG + (size_t)m * DM + lane * 8; u32x4 a[8]; float mx = 0.f;
#pragma unroll
                for (int j = 0; j < 8; ++j) { a[j] = *(const u32x4*)(srow + 512 * j);
                    mx = __builtin_fmaxf(mx, __builtin_fmaxf(__builtin_fmaxf(__builtin_fmaxf(__builtin_fabsf(bf_lo(a[j].x)), __builtin_fabsf(bf_hi(a[j].x))), __builtin_fmaxf(__builtin_fabsf(bf_lo(a[j].y)), __builtin_fabsf(bf_hi(a[j].y)))),
                                                      __builtin_fmaxf(__builtin_fmaxf(__builtin_fabsf(bf_lo(a[j].z)), __builtin_fabsf(bf_hi(a[j].z))), __builtin_fmaxf(__builtin_fabsf(bf_lo(a[j].w)), __builtin_fabsf(bf_hi(a[j].w)))))); }
                mx = wave_max(mx); const float inv = mx > 0.f ? 127.f / mx : 0.f; if (lane == 0) ((float*)(ws + WS_RSMA))[g * TG + m] = mx * (1.f / 127.f);
                unsigned char* drow = P_MG8 + (size_t)(g * TG + m) * DM + lane * 8;
#pragma unroll
                for (int j = 0; j < 8; ++j) { u32x2 q; q.x = pack4_i8(bf_lo(a[j].x) * inv, bf_hi(a[j].x) * inv, bf_lo(a[j].y) * inv, bf_hi(a[j].y) * inv); q.y = pack4_i8(bf_lo(a[j].z) * inv, bf_hi(a[j].z) * inv, bf_lo(a[j].w) * inv, bf_hi(a[j].w) * inv); *(u32x2*)(drow + 512 * j) = q; }
            }
        }
        SEAM();
#endif

    }

    if (RUN() && EN(7)) { LOCAL_TID();
        pg8::Gemm gm{(const bf16*)P_MG8, DM / 2, P_WOT, NTOK, DM, DM / 2}; pg8::StaticOrder S; S.init(NTOK, DM, G, bx);
        pg8::EpiResT<I8_MID != 0, false> E{A->in[I_XP], A->in[I_XS], NTOK / 2 / 256, P_X1, DM, 1.f, ws}; REP_LOOP_GEMM { int l2_ = lane_id_fresh(); asm volatile("" : "+v"(l2_)); pg8::gemm_phase<pg8::EpiResT<I8_MID != 0, false>, I8_MID ? 2 : 0>(ldsL, gm, S, E, wave * 64 + l2_); }
    }
    SEAM();

    if (RUN() && EN(8)) { LOCAL_TID();
        const float* gv = A->in[I_RFG];
        for (int m = gw; m < NTOK; m += NGW) {
            const u32x2* xr = (const u32x2*)(P_X1 + (size_t)m * DM) + lane; f32x4 v[16]; float s = 0.f;
#pragma unroll
            for (int j = 0; j < 16; ++j) { const u32x2 w = xr[64 * j]; v[j] = (f32x4){bf_lo(w.x), bf_hi(w.x), bf_lo(w.y), bf_hi(w.y)}; s += (v[j].x * v[j].x + v[j].y * v[j].y) + (v[j].z * v[j].z + v[j].w * v[j].w); }
            const float rstd = 1.0f / sqrtf(wave_sum(s) * (1.f / DM) + EPS);
            if (I8_UP) { float mx = 0.f;
#pragma unroll
                for (int j = 0; j < 16; ++j) { const f32x4 gg = ((const f32x4*)gv)[64 * j + lane]; v[j] = v[j] * rstd * gg; mx = __builtin_fmaxf(__builtin_fmaxf(mx, __builtin_fmaxf(__builtin_fabsf(v[j].x), __builtin_fabsf(v[j].y))), __builtin_fmaxf(__builtin_fabsf(v[j].z), __builtin_fabsf(v[j].w))); }
                mx = wave_max(mx); const float inv = mx > 0.f ? 127.f / mx : 0.f; if (lane == 0) P_RSHF[m] = mx * (1.f / 127.f);
                unsigned* o4 = (unsigned*)(P_HF + (size_t)m * DM) + lane;
#pragma unroll
                for (int j = 0; j < 16; ++j) o4[64 * j] = pack4_i8(v[j].x * inv, v[j].y * inv, v[j].z * inv, v[j].w * inv);
            } else {
            u32x2* o8 = (u32x2*)((bf16*)P_HF + (size_t)m * DM) + lane;
#pragma unroll
            for (int j = 0; j < 16; ++j) { const f32x4 gg = ((const f32x4*)gv)[64 * j + lane]; u32x2 w; w.x = cvt_pk_bf16(v[j].x * rstd * gg.x, v[j].y * rstd * gg.y); w.y = cvt_pk_bf16(v[j].z * rstd * gg.z, v[j].w * rstd * gg.w); o8[64 * j] = w; }
            }
        }
    }
    SEAM();

    if (RUN() && EN(9)) { LOCAL_TID();
        pg8::Gemm gm{(const bf16*)P_HF, DM / 2, P_WUPT, NTOK, NUP, DM / 2}; pg8::StaticOrder S; S.init(NTOK, NUP, G, bx);
#if CONV_FUSE
        static_assert(I8_UP && CONV_FUSE, "the all-token FFN stage needs the fused conv epilogue (int8 up GEMM)");
        pg8::EpiConv E{(unsigned char*)P_ACT, P_Y, A->in[I_CW], A->in[I_CB], ws, FP8_DOWN ? S_ACT8 : 1.f}; REP_LOOP_GEMM { int l2_ = lane_id_fresh(); asm volatile("" : "+v"(l2_)); pg8::gemm_phase<pg8::EpiConv, 2>(ldsL, gm, S, E, wave * 64 + l2_); }
#else
        pg8::EpiStoreT<I8_UP != 0, WS_RSHF, WS_CSUP> E{P_Y, NUP, 0, 0, 1.f, ws, 0}; REP_LOOP_GEMM { int l2_ = lane_id_fresh(); asm volatile("" : "+v"(l2_)); pg8::gemm_phase<pg8::EpiStoreT<I8_UP != 0, WS_RSHF, WS_CSUP>, I8_UP ? 2 : 0>(ldsL, gm, S, E, wave * 64 + l2_); }
#endif
    }
    SEAM();

#if CONV_FUSE
    if (RUN() && EN(10)) { LOCAL_TID();
        const float* cw = A->in[I_CW]; const float* cb = A->in[I_CB];
        constexpr int NCB = DFF / 256, NITEM = NCB * (NTOK / 64) * 2;
        for (int it = gw; it < NITEM; it += NGW) {
            const int cbk = it % NCB, be = it / NCB, b = be >> 1, edge = be & 1, c0 = cbk * 256 + lane * 4, t = b * 64 + (edge ? 63 : 0);
            const int posmask = (t < NTOK / 2) ? 4095 : 8191;
            const int colg = (c0 >> 7) * 256 + (c0 & 127);
            const f32x4 wg0 = *(const f32x4*)(cw + c0), wg1 = *(const f32x4*)(cw + NUP + c0), wg2 = *(const f32x4*)(cw + 2 * NUP + c0), bg = *(const f32x4*)(cb + c0);
            const f32x4 wu0 = *(const f32x4*)(cw + DFF + c0), wu1 = *(const f32x4*)(cw + NUP + DFF + c0), wu2 = *(const f32x4*)(cw + 2 * NUP + DFF + c0), bu = *(const f32x4*)(cb + DFF + c0);
            auto ldyb = [&](int blk, int slot, f32x4& yg, f32x4& yu) {
                const bf16* p = P_Y + ((size_t)blk * 4 + slot) * NUP + colg; const u32x2 a = *(const u32x2*)p, bb = *(const u32x2*)(p + 128);
                yg = (f32x4){bf_lo(a.x), bf_hi(a.x), bf_lo(a.y), bf_hi(a.y)}; yu = (f32x4){bf_lo(bb.x), bf_hi(bb.x), bf_lo(bb.y), bf_hi(bb.y)}; };
            const f32x4 z = (f32x4){0.f, 0.f, 0.f, 0.f};
            f32x4 pg = z, pu = z, cg, cu, ng = z, nu = z;
            if (edge == 0) { ldyb(b, 0, cg, cu); ldyb(b, 1, ng, nu); if ((t & posmask) != 0) ldyb(b - 1, 3, pg, pu); }
            else { ldyb(b, 3, cg, cu); ldyb(b, 2, pg, pu); if (((t + 1) & posmask) != 0) ldyb(b + 1, 0, ng, nu); }
            const f32x4 ug = wg0 * pg + wg1 * cg + wg2 * ng + bg, uu = wu0 * pu + wu1 * cu + wu2 * nu + bu;
            float a[4];
#pragma unroll
            for (int j = 0; j < 4; ++j) a[j] = ug[j] * fast_sigmoid(ug[j]) * uu[j];
            if (FP8_DOWN) *(unsigned*)((unsigned char*)P_ACT + (size_t)t * DFF + c0) = pack4_fp8(a[0] * S_ACT8, a[1] * S_ACT8, a[2] * S_ACT8, a[3] * S_ACT8);
            else { u32x2 w; w.x = cvt_pk_bf16(a[0], a[1]); w.y = cvt_pk_bf16(a[2], a[3]); *(u32x2*)(P_ACT + (size_t)t * DFF + c0) = w; }
        }
    }
#else
    if (RUN() && EN(10)) { LOCAL_TID();
        const float* cw = A->in[I_CW]; const float* cb = A->in[I_CB];
        constexpr int RCH = 64, NCB = DFF / 256, NITEM = NCB * (TG / RCH);
        for (int it = gw; it < NITEM; it += NGW) {
            const int cbk = it % NCB, rc = it / NCB, c0 = cbk * 256 + lane * 4, t0 = rc * RCH;
            f32x4 wg0 = *(const f32x4*)(cw + c0), wg1 = *(const f32x4*)(cw + NUP + c0), wg2 = *(const f32x4*)(cw + 2 * NUP + c0), bg = *(const f32x4*)(cb + c0);
            f32x4 wu0 = *(const f32x4*)(cw + DFF + c0), wu1 = *(const f32x4*)(cw + NUP + DFF + c0), wu2 = *(const f32x4*)(cw + 2 * NUP + DFF + c0), bu = *(const f32x4*)(cb + DFF + c0);
            auto ldrow = [&](int t, f32x4& yg, f32x4& yu) {
                const u32x2 a = *(const u32x2*)(P_Y + (size_t)t * NUP + c0), b = *(const u32x2*)(P_Y + (size_t)t * NUP + DFF + c0);
                yg = (f32x4){bf_lo(a.x), bf_hi(a.x), bf_lo(a.y), bf_hi(a.y)}; yu = (f32x4){bf_lo(b.x), bf_hi(b.x), bf_lo(b.y), bf_hi(b.y)}; };
            const f32x4 z = (f32x4){0.f, 0.f, 0.f, 0.f};
            f32x4 pg = z, pu = z, cg, cu, ng, nu;
            if ((t0 & posmask) != 0) ldrow(t0 - 1, pg, pu);
            ldrow(t0, cg, cu);
#pragma unroll 4
            for (int t = t0; t < t0 + RCH; ++t) {
                if (((t + 1) & posmask) != 0) ldrow(t + 1, ng, nu); else { ng = z; nu = z; }
                const f32x4 ug = wg0 * pg + wg1 * cg + wg2 * ng + bg, uu = wu0 * pu + wu1 * cu + wu2 * nu + bu;
                float a[4];
#pragma unroll
                for (int j = 0; j < 4; ++j) a[j] = ug[j] * fast_sigmoid(ug[j]) * uu[j];
                if (FP8_DOWN) *(unsigned*)((unsigned char*)P_ACT + (size_t)t * DFF + c0) = pack4_fp8(a[0] * S_ACT8, a[1] * S_ACT8, a[2] * S_ACT8, a[3] * S_ACT8);
                else { u32x2 w; w.x = cvt_pk_bf16(a[0], a[1]); w.y = cvt_pk_bf16(a[2], a[3]); *(u32x2*)(P_ACT + (size_t)t * DFF + c0) = w; }
                pg = cg; pu = cu; cg = ng; cu = nu;
            }
        }
    }
#endif
    SEAM();

    if (RUN() && EN(11)) { LOCAL_TID();
        pg8::Gemm gm{P_ACT, FP8_DOWN ? DFF / 2 : DFF, P_WDT, NTOK, DM, FP8_DOWN ? DFF / 2 : DFF}; pg8::StaticOrder S; S.init(NTOK, DM, G, bx);
        pg8::EpiResT<false, true> E{P_X1, P_X1, 1 << 30, P_X1, DM, FP8_DOWN ? 1.f / (S_WD * S_ACT8) : 1.f, ws}; { int l2_ = lane_id_fresh(); asm volatile("" : "+v"(l2_)); pg8::gemm_phase<pg8::EpiResT<false, true>, FP8_DOWN ? 1 : 0>(ldsL, gm, S, E, wave * 64 + l2_); }
    }
    SEAM();

    if (RUN() && EN(12)) { LOCAL_TID();
        const float* gv = A->in[I_FNG];
        for (int m = gw; m < NTOK; m += NGW) {
            const u32x2* xr = (const u32x2*)(P_X1 + (size_t)m * DM) + lane; f32x4* orow = (f32x4*)(A->out + (size_t)m * DM) + lane; f32x4 v[16]; float s = 0.f;
#pragma unroll
            for (int j = 0; j < 16; ++j) { const u32x2 w = xr[64 * j]; v[j] = (f32x4){bf_lo(w.x), bf_hi(w.x), bf_lo(w.y), bf_hi(w.y)}; s += (v[j].x * v[j].x + v[j].y * v[j].y) + (v[j].z * v[j].z + v[j].w * v[j].w); }
            const float rstd = 1.0f / sqrtf(wave_sum(s) * (1.f / DM) + EPS);
#pragma unroll
            for (int j = 0; j < 16; ++j) { const f32x4 gg = ((const f32x4*)gv)[64 * j + lane]; orow[64 * j] = v[j] * rstd * gg; }
        }
    }
    SEAM();
#undef RUN
#undef SEAM
}

extern "C" void kernel_launch(void* const* d_in, const int* in_sizes, int n_in, void* d_out, int out_size, void* d_ws, size_t ws_size, hipStream_t stream) {
    static int grid = 0;
    if (grid == 0) {
        if (n_in != 23 || out_size != NTOK * DM || ws_size < WS_END) { fprintf(stderr, "kernel_launch: unexpected shapes: n_in %d out %d ws %zu (need %zu)\n", n_in, out_size, ws_size, (size_t)WS_END); grid = -1; return; }
        int dev = 0, cus = 0, per_cu = 0;
        if (hipGetDevice(&dev) != hipSuccess || hipDeviceGetAttribute(&cus, hipDeviceAttributeMultiprocessorCount, dev) != hipSuccess) { grid = -1; return; }
        if (hipFuncSetAttribute((const void*)enc_fwd, hipFuncAttributeMaxDynamicSharedMemorySize, LDS_BYTES) != hipSuccess) { fprintf(stderr, "kernel_launch: hipFuncSetAttribute failed\n"); grid = -1; return; }
        if (hipOccupancyMaxActiveBlocksPerMultiprocessor(&per_cu, (const void*)enc_fwd, NWAVES * 64, LDS_BYTES) != hipSuccess || per_cu < 1) { fprintf(stderr, "kernel_launch: occupancy query says %d\n", per_cu); per_cu = 1; }
        (void)hipGetLastError();
        grid = cus;
    }
    if (grid < 0) return;
    (void)hipMemsetAsync((char*)d_ws + WS_CTL, 0, CTL_ZERO_BYTES, stream);
    Args a{};
    for (int i = 0; i < 23; ++i) a.in[i] = (const float*)d_in[i];
    a.out = (float*)d_out; a.ws = (unsigned char*)d_ws;
    for (int i = 0; i < 32; ++i) a.invf[i] = powf(10000.0f, -(float)(2 * i) / 64.0f);
#if MK_PER_STEP_LAUNCH
    for (int s = 0; s < NSTEPS; ++s) { a.lo = s; a.hi = s + 1; hipLaunchKernelGGL(enc_fwd, dim3(grid), dim3(NWAVES * 64), LDS_BYTES, stream, a); }
#else
    a.lo = 0; a.hi = NSTEPS;
    hipLaunchKernelGGL(enc_fwd, dim3(grid), dim3(NWAVES * 64), LDS_BYTES, stream, a);
#endif
    const hipError_t le = hipPeekAtLastError();
    if (le != hipSuccess) fprintf(stderr, "kernel_launch: launch failed: %s\n", hipGetErrorName(le));
}
```

```cpp
#include <hip/hip_runtime.h>
#include <cstdio>
#include <cstdint>
#include <cmath>

#ifndef I8_IN
#define I8_IN 1
#endif
#ifndef ATT_CINIT
#define ATT_CINIT 1
#endif
constexpr float CS_DIFF = 0.125f * 1.4426950408889634f;
#ifndef CONV_FUSE
#define CONV_FUSE 1
#endif
#ifndef I8_MID
#define I8_MID 1
#endif
#ifndef I8_UP
#define I8_UP 1
#endif
#ifndef FP8_DOWN
#define FP8_DOWN 1
#endif
constexpr float S_WD = 1024.f, S_ACT8 = 8.f;
#ifndef REP_GEMM
#define REP_GEMM 1
#endif
#ifndef REP_DIFF
#define REP_DIFF 1
#endif
#ifndef REP_MLA
#define REP_MLA 1
#endif
#if REP_GEMM == 1
#define REP_LOOP_GEMM
#else
#define REP_LOOP_GEMM _Pragma("unroll 1") for (int rep = 0; rep < REP_GEMM; ++rep)
#endif
#ifndef MK_PER_STEP_LAUNCH
#define MK_PER_STEP_LAUNCH 0
#endif

typedef unsigned short bf16;
typedef short bf16x8 __attribute__((ext_vector_type(8)));
typedef short s16x4 __attribute__((ext_vector_type(4)));
typedef float f32x4 __attribute__((ext_vector_type(4)));
typedef float f32x2 __attribute__((ext_vector_type(2)));
typedef float f32x16 __attribute__((ext_vector_type(16)));
typedef unsigned u32x4 __attribute__((ext_vector_type(4)));
typedef unsigned u32x2 __attribute__((ext_vector_type(2)));
typedef int i32x4 __attribute__((ext_vector_type(4)));
typedef int i32x8 __attribute__((ext_vector_type(8)));
#define LAS __attribute__((address_space(3)))

__device__ __forceinline__ unsigned cvt_pk_bf16(float lo, float hi) { unsigned r; asm volatile("v_cvt_pk_bf16_f32 %0, %1, %2" : "=v"(r) : "v"(lo), "v"(hi)); return r; }
__device__ __forceinline__ float bf_lo(unsigned w) { return __uint_as_float(w << 16); }
__device__ __forceinline__ float bf_hi(unsigned w) { return __uint_as_float(w & 0xffff0000u); }
__device__ __forceinline__ float clamp448(float x) { return __builtin_fminf(__builtin_fmaxf(x, -448.f), 448.f); }
__device__ __forceinline__ unsigned pack4_fp8(float a, float b, float c, float d) { int w = 0; w = __builtin_amdgcn_cvt_pk_fp8_f32(clamp448(a), clamp448(b), w, false); w = __builtin_amdgcn_cvt_pk_fp8_f32(clamp448(c), clamp448(d), w, true); return (unsigned)w; }
__device__ __forceinline__ unsigned pack4_i8(float a, float b, float c, float d) { const int ia = (int)__builtin_rintf(a), ib = (int)__builtin_rintf(b), ic = (int)__builtin_rintf(c), id = (int)__builtin_rintf(d);
    return (unsigned)(ia & 255) | ((unsigned)(ib & 255) << 8) | ((unsigned)(ic & 255) << 16) | ((unsigned)id << 24); }
__device__ __forceinline__ float fast_sigmoid(float x) { return __builtin_amdgcn_rcpf(1.0f + __builtin_amdgcn_exp2f(-1.4426950408889634f * x)); }

__device__ __forceinline__ int lane_id_fresh() { unsigned ones = ~0u; asm volatile("" : "+s"(ones)); return (int)__builtin_amdgcn_mbcnt_hi(ones, __builtin_amdgcn_mbcnt_lo(ones, 0u)); }

constexpr int DM = 4096, NTOK = 32768, TG = 8192, NGRP = 4;
constexpr int NIN = 16128;
constexpr int C_DQ = 0, C_DK = 2048, C_DV = 4096, C_QLAT = 6144, C_KVLAT = 7168, C_GATE = 7680, C_KPE = 15872;
constexpr int DFF = 11008, NUP = 22016, NQ = 3072, NKV = 4096;
constexpr float EPS = 1e-6f;

constexpr size_t MiB = 1u << 20;
constexpr size_t WS_CTL = 0, CTL_ZERO_BYTES = 1 * MiB;
constexpr size_t WS_COS = 1 * MiB, WS_SIN = 2 * MiB, WS_BIAS = 3 * MiB, WS_LAM = 3 * MiB + 32768;
constexpr size_t WS_CSIN = 3 * MiB + 65536, WS_CSUP = 3 * MiB + 131072, WS_RSH = 3 * MiB + 262144;
constexpr size_t WS_CSQ = 3 * MiB + 320 * 1024, WS_CSKV = 3 * MiB + 336 * 1024, WS_CSA = 3 * MiB + 352 * 1024, WS_CSB = 3 * MiB + 368 * 1024, WS_CSO = 3 * MiB + 384 * 1024;
constexpr size_t WS_RSQL = 3 * MiB + 400 * 1024, WS_RSKVL = 3 * MiB + 432 * 1024, WS_RSA = 3 * MiB + 464 * 1024, WS_RSB = 3 * MiB + 496 * 1024, WS_RSM = 3 * MiB + 528 * 1024;
constexpr size_t EB_IN = I8_IN ? 1 : 2, EB_UP = I8_UP ? 1 : 2, EB_MID = I8_MID ? 1 : 2, EB_DN = FP8_DOWN ? 1 : 2;
constexpr size_t WS_WIN = 4 * MiB, WS_WQ = WS_WIN + (size_t)NIN * DM * EB_IN, WS_WKV = WS_WQ + (size_t)NQ * 1024 * EB_MID, WS_WA = WS_WKV + (size_t)NKV * 512 * EB_MID, WS_WB = WS_WA + (size_t)DM * 2048 * EB_MID,
                 WS_WO = WS_WB + (size_t)DM * 2048 * EB_MID, WS_WUP = WS_WO + (size_t)DM * DM * EB_MID, WS_WD = WS_WUP + (size_t)NUP * DM * EB_UP, WS_WEND = WS_WD + (size_t)DM * DFF * EB_DN;
constexpr size_t WS_ACT = (WS_WEND + MiB - 1) / MiB * MiB;
constexpr size_t WS_P = WS_ACT, WS_Q = WS_P + 252 * MiB, WS_KV = WS_Q + 48 * MiB, WS_AO = WS_KV + 64 * MiB, WS_BO = WS_AO + 32 * MiB, WS_MG = WS_BO + 32 * MiB, WS_STASH = WS_MG + 64 * MiB;
constexpr size_t WS_QL8 = WS_STASH + 32 * MiB, WS_KVL8 = WS_QL8 + 8 * MiB, WS_AO8 = WS_KVL8 + 4 * MiB, WS_BO8 = WS_AO8 + 16 * MiB, WS_MIX_END = WS_BO8 + 16 * MiB;
static_assert(WS_P + (size_t)TG * NIN * 2 <= WS_Q && (size_t)TG * NQ * 2 <= 48 * MiB && (size_t)TG * NKV * 2 <= 64 * MiB && (size_t)TG * DM * 2 <= 64 * MiB, "mixer map");
constexpr size_t WS_Y = WS_ACT, WS_ACTV = WS_Y + (size_t)(NTOK / 64) * 4 * NUP * 2, WS_FFN_END = WS_ACTV + (size_t)NTOK * DFF * EB_DN;
constexpr size_t WS_X1 = ((WS_MIX_END > WS_FFN_END ? WS_MIX_END : WS_FFN_END) + MiB - 1) / MiB * MiB;
constexpr size_t WS_HF = WS_X1 + (size_t)NTOK * DM * 2, WS_MG8 = WS_HF + (size_t)NTOK * DM, WS_END = WS_MG8 + (size_t)NTOK * DM;
static_assert(EB_IN == 1 && EB_UP == 1 && EB_MID == 1, "the all-token row buffers are int8");
constexpr size_t WS_RSHF = 3 * MiB + 576 * 1024, WS_RSMA = 3 * MiB + 704 * 1024;
static_assert(WS_RSM + 32768 <= WS_RSHF && WS_RSMA + (size_t)NTOK * 4 <= 4 * MiB, "scale arrays");

namespace pg8 {
constexpr int BM = 256, BK = 64, HALF = 128, HTB = HALF * BK * 2, STAGE_BYTES = 8 * HTB, NXCD = 8, WGM = 8;
__host__ __device__ __forceinline__ int lds_byte(int r, int c) { const int st = (r >> 4) * 2 + (c >> 5), rr = r & 15, cc = c & 31, ob = rr * 64 + cc * 2; return st * 1024 + (ob ^ (((ob >> 9) & 1) << 5)); }
__host__ __device__ __forceinline__ void stage_rc(int b, int& R, int& C) { const int st = b / 1024, sb = b % 1024, swz = sb ^ (((sb >> 9) & 1) << 5); R = (st >> 1) * 16 + swz / 64; C = (st & 1) * 32 + (swz % 64) / 2; }
__host__ __device__ __forceinline__ int perm32(int rho) { const int n = rho >> 4, i = rho & 15; return 8 * (i >> 2) + 4 * n + (i & 3); }

struct Unit { int pm, pn; };
struct Gemm { const bf16* A; int lda; const bf16* Bt; int M, N, K; };

struct StaticOrder {
    int nM, nN, nwg, G, c;
    __device__ void init(int M, int N, int G_, int c_) { nM = M / BM; nN = N / BM; nwg = nM * nN; G = G_; c = c_; }
    __device__ bool next(int i, Unit& u) const {
        const long L = (long)i * G + c; if (L >= nwg) return false;
        int wgid = (int)L; { const int q = nwg / NXCD, r = nwg % NXCD, xcd = wgid % NXCD, off = wgid / NXCD; wgid = (xcd < r ? xcd * (q + 1) : r * (q + 1) + (xcd - r) * q) + off; }
        const int nig = WGM * nN, gid = wgid / nig, fm = gid * WGM, gsz = (nM - fm) < WGM ? (nM - fm) : WGM;
        u.pm = fm + ((wgid % nig) % gsz); u.pn = (wgid % nig) / gsz; return true;
    }
};

template <int MODE> struct AccSel { typedef f32x4 T; }; template <> struct AccSel<2> { typedef i32x4 T; };
__device__ __forceinline__ f32x4 tof(f32x4 v) { return v; }
__device__ __forceinline__ f32x4 tof(i32x4 v) { return __builtin_convertvector(v, f32x4); }

template <class Epi, int MODE = 0>
__device__ __forceinline__ void gemm_phase(LAS unsigned char* lds, const Gemm g, const StaticOrder& S, const Epi& E, int tid_in) {
    int tid = tid_in; asm volatile("" : "+v"(tid));
    const int wid = __builtin_amdgcn_readfirstlane(tid >> 6), lane = tid & 63, wr = wid >> 2, wc = wid & 3, fr = lane & 15, fq = lane >> 4;
    int K = g.K, lda = g.lda; asm volatile("" : "+s"(K), "+s"(lda));
    const int nt = K / BK;
    unsigned voffA[2], voffB[2];
#pragma unroll
    for (int i = 0; i < 2; ++i) { int R, C; stage_rc(tid * 16 + i * 8192, R, C); const int Rb = (R & ~31) + perm32(R & 31);
        voffA[i] = (unsigned)(R * lda + C) * 2u; voffB[i] = (unsigned)(Rb * K + C) * 2u; }
    const size_t kstep = (size_t)(BK * 2);
    const size_t hstepA = (size_t)HALF * lda * 2, hstepB = (size_t)HALF * K * 2;
    const size_t tstepA = 2 * hstepA, tstepB = 2 * hstepB;
    const unsigned ldsw = (unsigned)wid * 1024u;
    const int aoff = lds_byte(wr * 64 + fr, fq * 8), boff = lds_byte(wc * 32 + fr, fq * 8);
#define PG8_SA(b, h) (((b) * 2 + (h)) * HTB)
#define PG8_SB(b, h) ((4 + (b) * 2 + (h)) * HTB)
#define PG8_STAGE(bufoff, gbase, voff) do { _Pragma("unroll") for (int _i = 0; _i < 2; ++_i) \
        __builtin_amdgcn_global_load_lds((const unsigned*)((const char*)(gbase) + (voff)[_i]), (LAS unsigned*)(lds + (bufoff) + ldsw + _i * 8192), 16, 0, 0); } while (0)
#define PG8_CAT(x, y) __builtin_shufflevector(__builtin_bit_cast(i32x4, x), __builtin_bit_cast(i32x4, y), 0, 1, 2, 3, 4, 5, 6, 7)
#define PG8_LDA(dst, b, h) do { _Pragma("unroll") for (int m = 0; m < 4; ++m) dst[m] = PG8_CAT(*(const LAS bf16x8*)(lds + PG8_SA(b, h) + aoff + m * 2048), *(const LAS bf16x8*)(lds + PG8_SA(b, h) + aoff + m * 2048 + 1024)); } while (0)
#define PG8_LDB(dst, b, h) do { _Pragma("unroll") for (int n = 0; n < 2; ++n) dst[n] = PG8_CAT(*(const LAS bf16x8*)(lds + PG8_SB(b, h) + boff + n * 2048), *(const LAS bf16x8*)(lds + PG8_SB(b, h) + boff + n * 2048 + 1024)); } while (0)
#define PG8_LO4(v) __builtin_shufflevector(v, v, 0, 1, 2, 3)
#define PG8_HI4(v) __builtin_shufflevector(v, v, 4, 5, 6, 7)
#define PG8_LO(v) __builtin_bit_cast(bf16x8, __builtin_shufflevector(v, v, 0, 1, 2, 3))
#define PG8_HI(v) __builtin_bit_cast(bf16x8, __builtin_shufflevector(v, v, 4, 5, 6, 7))
#define PG8_MMA(ai, bj, At, Bt) do { __builtin_amdgcn_s_setprio(1); _Pragma("unroll") for (int m = 0; m < 4; ++m) _Pragma("unroll") for (int n = 0; n < 2; ++n) { \
        if constexpr (F8) asm volatile("v_mfma_f32_16x16x128_f8f6f4 %0, %1, %2, %0" : "+v"(acc[ai][bj][m][n]) : "v"(Bt[n]), "v"(At[m]));   \
        else if constexpr (MODE == 2) { acc[ai][bj][m][n] = __builtin_amdgcn_mfma_i32_16x16x64_i8(PG8_LO4(Bt[n]), PG8_LO4(At[m]), acc[ai][bj][m][n], 0, 0, 0); \
               acc[ai][bj][m][n] = __builtin_amdgcn_mfma_i32_16x16x64_i8(PG8_HI4(Bt[n]), PG8_HI4(At[m]), acc[ai][bj][m][n], 0, 0, 0); } \
        else { acc[ai][bj][m][n] = __builtin_amdgcn_mfma_f32_16x16x32_bf16(PG8_LO(Bt[n]), PG8_LO(At[m]), acc[ai][bj][m][n], 0, 0, 0); \
               acc[ai][bj][m][n] = __builtin_amdgcn_mfma_f32_16x16x32_bf16(PG8_HI(Bt[n]), PG8_HI(At[m]), acc[ai][bj][m][n], 0, 0, 0); } } __builtin_amdgcn_s_setprio(0); } while (0)
#define PG8_WAIT_V(n) asm volatile("s_waitcnt vmcnt(" #n ")" ::: "memory")
#define PG8_WAIT_L(n) asm volatile("s_waitcnt lgkmcnt(" #n ")" ::: "memory")
#define PG8_BAR __builtin_amdgcn_s_barrier()
#define PG8_SCHED __builtin_amdgcn_sched_barrier(0)
    Unit cur, nxt; int ui = 0;
    if (!S.next(0, cur)) return;
    constexpr bool F8 = (MODE == 1); typedef typename AccSel<MODE>::T AccT; AccT acc[2][2][4][2];
#pragma unroll
    for (int a = 0; a < 2; ++a)
#pragma unroll
        for (int b = 0; b < 2; ++b)
#pragma unroll
            for (int m = 0; m < 4; ++m)
#pragma unroll
                for (int n = 0; n < 2; ++n) acc[a][b][m][n] = AccT{};
    i32x8 At[4], B0[2], B1[2];
    const char* cA = (const char*)g.A + (size_t)cur.pm * tstepA; const char* cB = (const char*)g.Bt + (size_t)cur.pn * tstepB;
    PG8_STAGE(PG8_SB(0, 0), cB, voffB); PG8_STAGE(PG8_SB(0, 1), cB + hstepB, voffB); PG8_STAGE(PG8_SA(0, 0), cA, voffA); PG8_STAGE(PG8_SA(0, 1), cA + hstepA, voffA);
    if (wr == 1) PG8_BAR;
    PG8_WAIT_V(2); PG8_BAR;
    PG8_STAGE(PG8_SB(1, 0), cB + kstep, voffB); PG8_STAGE(PG8_SA(1, 0), cA + kstep, voffA); PG8_STAGE(PG8_SB(1, 1), cB + hstepB + kstep, voffB);
    PG8_WAIT_V(6); PG8_BAR;
    for (;;) {
        const bool has_next = S.next(ui + 1, nxt);
        const char* nA = has_next ? (const char*)g.A + (size_t)nxt.pm * tstepA : cA; const char* nB = has_next ? (const char*)g.Bt + (size_t)nxt.pn * tstepB : cB;
        for (int t = 0; t < nt; t += 2) {
            const bool last = (t == nt - 2);
            const char* a1 = cA + (size_t)(t + 1) * kstep;
            const char* a2 = last ? nA : cA + (size_t)(t + 2) * kstep; const char* b2 = last ? nB : cB + (size_t)(t + 2) * kstep;
            const char* a3 = a2 + kstep; const char* b3 = b2 + kstep;
            PG8_LDB(B0, 0, 0); PG8_LDB(B1, 0, 1); PG8_SCHED; PG8_LDA(At, 0, 0); PG8_STAGE(PG8_SA(1, 1), a1 + hstepA, voffA);
            PG8_WAIT_V(8); PG8_WAIT_L(0); PG8_BAR; PG8_MMA(0, 0, At, B0); PG8_MMA(0, 1, At, B1); PG8_BAR; PG8_SCHED;
            PG8_LDA(At, 0, 1); PG8_STAGE(PG8_SB(0, 0), b2, voffB); PG8_STAGE(PG8_SB(0, 1), b2 + hstepB, voffB); PG8_STAGE(PG8_SA(0, 0), a2, voffA);
            PG8_WAIT_V(8); PG8_WAIT_L(0); PG8_BAR; PG8_MMA(1, 0, At, B0); PG8_MMA(1, 1, At, B1); PG8_BAR; PG8_SCHED;
            PG8_LDB(B0, 1, 0); PG8_LDB(B1, 1, 1); PG8_SCHED; PG8_LDA(At, 1, 0); PG8_STAGE(PG8_SA(0, 1), a2 + hstepA, voffA);
            PG8_WAIT_V(8); PG8_WAIT_L(0); PG8_BAR; PG8_MMA(0, 0, At, B0); PG8_MMA(0, 1, At, B1); PG8_BAR; PG8_SCHED;
            PG8_LDA(At, 1, 1); PG8_STAGE(PG8_SB(1, 0), b3, voffB); PG8_STAGE(PG8_SB(1, 1), b3 + hstepB, voffB); PG8_STAGE(PG8_SA(1, 0), a3, voffA);
            PG8_WAIT_V(8); PG8_WAIT_L(0); PG8_BAR; PG8_MMA(1, 0, At, B0); PG8_MMA(1, 1, At, B1); PG8_BAR; PG8_SCHED;
        }
        if (wr == 0) PG8_BAR;
        if constexpr (F8) asm volatile("s_nop 15\n\ts_nop 15" ::: "memory");
        { int l3_ = lane_id_fresh(); asm volatile("" : "+v"(l3_)); E(acc, cur, wr, wc, l3_ & 15, l3_ >> 4); }
        if (!has_next) break;
#pragma unroll
        for (int a = 0; a < 2; ++a)
#pragma unroll
            for (int b = 0; b < 2; ++b)
#pragma unroll
                for (int m = 0; m < 4; ++m)
#pragma unroll
                    for (int n = 0; n < 2; ++n) acc[a][b][m][n] = AccT{};
        cur = nxt; cA = nA; cB = nB; ++ui;
        if (wr == 1) PG8_BAR;
    }
    PG8_WAIT_V(0);
    PG8_BAR;
#undef PG8_SA
#undef PG8_SB
#undef PG8_STAGE
#undef PG8_LDA
#undef PG8_LDB
#undef PG8_MMA
#undef PG8_CAT
#undef PG8_LO
#undef PG8_LO4
#undef PG8_HI4
#undef PG8_HI
#undef PG8_WAIT_V
#undef PG8_WAIT_L
#undef PG8_BAR
#undef PG8_SCHED
}

template <bool SC, size_t RSOFF = 0, size_t CSOFF = 0> struct EpiStoreT {
    bf16* O; int ldc; int sig_lo, sig_hi; float scale; const unsigned char* wsb; int rsrow;
    template <class AccT> __device__ __forceinline__ void operator()(const AccT (&acc)[2][2][4][2], const Unit& u, int wr, int wc, int fr, int fq) const {
        const bool sig = (u.pn >= sig_lo && u.pn < sig_hi);
        const int row0 = u.pm * BM + wr * 64 + fr, col0 = u.pn * BM + wc * 32 + 8 * fq;
        const float* rs = (const float*)(wsb + RSOFF) + rsrow; const float* cs = (const float*)(wsb + CSOFF);
        const float tsc = (u.pn < 8) ? scale : 1.f;
        f32x4 cv[2][2];
#pragma unroll
        for (int bj = 0; bj < 2; ++bj) { if constexpr (SC) { cv[bj][0] = *(const f32x4*)(cs + col0 + bj * HALF) * tsc; cv[bj][1] = *(const f32x4*)(cs + col0 + bj * HALF + 4) * tsc; } else { cv[bj][0] = (f32x4){tsc, tsc, tsc, tsc}; cv[bj][1] = cv[bj][0]; } }
#pragma unroll
        for (int ai = 0; ai < 2; ++ai)
#pragma unroll
            for (int m = 0; m < 4; ++m) { bf16* rowp = O + (size_t)(row0 + ai * HALF + m * 16) * ldc + col0; float rsv = 1.f; if constexpr (SC) rsv = rs[row0 + ai * HALF + m * 16];
#pragma unroll
                for (int bj = 0; bj < 2; ++bj) { f32x4 v0 = tof(acc[ai][bj][m][0]) * (cv[bj][0] * rsv), v1 = tof(acc[ai][bj][m][1]) * (cv[bj][1] * rsv);
                    if (sig) {
#pragma unroll
                        for (int j = 0; j < 4; ++j) { v0[j] = fast_sigmoid(v0[j]); v1[j] = fast_sigmoid(v1[j]); } }
                    u32x4 w; w.x = cvt_pk_bf16(v0[0], v0[1]); w.y = cvt_pk_bf16(v0[2], v0[3]); w.z = cvt_pk_bf16(v1[0], v1[1]); w.w = cvt_pk_bf16(v1[2], v1[3]);
                    *(u32x4*)(rowp + bj * HALF) = w; }
                asm volatile("" ::: "memory"); }
    }
};
template <bool SC> struct EpiQT {
    bf16* O; int ldc; const unsigned char* wsb; int posmask;
    template <class AccT> __device__ __forceinline__ void operator()(const AccT (&acc)[2][2][4][2], const Unit& u, int wr, int wc, int fr, int fq) const {
        const bool rope = (u.pn >= 8);
        const int row0 = u.pm * BM + wr * 64 + fr, col0 = u.pn * BM + wc * 32 + 8 * fq;
        const float* cosT = (const float*)(wsb + WS_COS); const float* sinT = (const float*)(wsb + WS_SIN); const float* rs = (const float*)(wsb + WS_RSQL); const float* cs = (const float*)(wsb + WS_CSQ);
        f32x4 cv[2][2];
#pragma unroll
        for (int bj = 0; bj < 2; ++bj) { if constexpr (SC) { cv[bj][0] = *(const f32x4*)(cs + col0 + bj * HALF); cv[bj][1] = *(const f32x4*)(cs + col0 + bj * HALF + 4); } else { cv[bj][0] = (f32x4){1.f, 1.f, 1.f, 1.f}; cv[bj][1] = cv[bj][0]; } }
#pragma unroll
        for (int ai = 0; ai < 2; ++ai)
#pragma unroll
            for (int m = 0; m < 4; ++m) { const int row = row0 + ai * HALF + m * 16; bf16* rowp = O + (size_t)row * ldc + col0; const int pos = row & posmask; float rsv = 1.f; if constexpr (SC) rsv = rs[row];
#pragma unroll
                for (int bj = 0; bj < 2; ++bj) { f32x4 v0 = tof(acc[ai][bj][m][0]) * (cv[bj][0] * rsv), v1 = tof(acc[ai][bj][m][1]) * (cv[bj][1] * rsv);
                    if (rope) { const int i0 = (((col0 + bj * HALF) & 63) >> 1);
                        const f32x4 c = *(const f32x4*)(cosT + (size_t)pos * 32 + i0), s = *(const f32x4*)(sinT + (size_t)pos * 32 + i0);
                        f32x4 a, b;
                        a[0] = v0[0] * c[0] - v0[1] * s[0]; a[1] = v0[0] * s[0] + v0[1] * c[0]; a[2] = v0[2] * c[1] - v0[3] * s[1]; a[3] = v0[2] * s[1] + v0[3] * c[1];
                        b[0] = v1[0] * c[2] - v1[1] * s[2]; b[1] = v1[0] * s[2] + v1[1] * c[2]; b[2] = v1[2] * c[3] - v1[3] * s[3]; b[3] = v1[2] * s[3] + v1[3] * c[3];
                        v0 = a; v1 = b; }
                    u32x4 w; w.x = cvt_pk_bf16(v0[0], v0[1]); w.y = cvt_pk_bf16(v0[2], v0[3]); w.z = cvt_pk_bf16(v1[0], v1[1]); w.w = cvt_pk_bf16(v1[2], v1[3]);
                    *(u32x4*)(rowp + bj * HALF) = w; } }
    }
};
template <bool SC> struct EpiGateAT {
    bf16* part; int ldp; const bf16* gate; int ldg; const unsigned char* wsb;
    template <class AccT> __device__ __forceinline__ void operator()(const AccT (&acc)[2][2][4][2], const Unit& u, int wr, int wc, int fr, int fq) const {
        const int row0 = u.pm * BM + wr * 64 + fr, col0 = u.pn * BM + wc * 32 + 8 * fq;
        const float* rs = (const float*)(wsb + WS_RSA); const float* cs = (const float*)(wsb + WS_CSA);
        f32x4 cv[2][2];
#pragma unroll
        for (int bj = 0; bj < 2; ++bj) { if constexpr (SC) { cv[bj][0] = *(const f32x4*)(cs + col0 + bj * HALF); cv[bj][1] = *(const f32x4*)(cs + col0 + bj * HALF + 4); } else { cv[bj][0] = (f32x4){1.f, 1.f, 1.f, 1.f}; cv[bj][1] = cv[bj][0]; } }
#pragma unroll
        for (int ai = 0; ai < 2; ++ai) {
            u32x4 gw[4][2]; float rsv[4];
#pragma unroll
            for (int m = 0; m < 4; ++m) { const size_t row = (size_t)(row0 + ai * HALF + m * 16); rsv[m] = 1.f; if constexpr (SC) rsv[m] = rs[row];
#pragma unroll
                for (int bj = 0; bj < 2; ++bj) gw[m][bj] = *(const u32x4*)(gate + row * ldg + col0 + bj * HALF); }
#pragma unroll
            for (int m = 0; m < 4; ++m) { const size_t row = (size_t)(row0 + ai * HALF + m * 16);
#pragma unroll
                for (int bj = 0; bj < 2; ++bj) { const f32x4 v0 = tof(acc[ai][bj][m][0]) * (cv[bj][0] * rsv[m]), v1 = tof(acc[ai][bj][m][1]) * (cv[bj][1] * rsv[m]); const u32x4 g = gw[m][bj];
                    u32x4 w; w.x = cvt_pk_bf16(v0[0] * bf_lo(g.x), v0[1] * bf_hi(g.x)); w.y = cvt_pk_bf16(v0[2] * bf_lo(g.y), v0[3] * bf_hi(g.y)); w.z = cvt_pk_bf16(v1[0] * bf_lo(g.z), v1[1] * bf_hi(g.z)); w.w = cvt_pk_bf16(v1[2] * bf_lo(g.w), v1[3] * bf_hi(g.w));
                    *(u32x4*)(part + row * ldp + col0 + bj * HALF) = w; } }
            asm volatile("" ::: "memory");
        }
    }
};
template <bool SC> struct EpiGateBT {
    const bf16* part; int ldp; const bf16* gate; int ldg; bf16* O; int ldc; const unsigned char* wsb;
    template <class AccT> __device__ __forceinline__ void operator()(const AccT (&acc)[2][2][4][2], const Unit& u, int wr, int wc, int fr, int fq) const {
        const int row0 = u.pm * BM + wr * 64 + fr, col0 = u.pn * BM + wc * 32 + 8 * fq;
        const float* rs = (const float*)(wsb + WS_RSB); const float* cs = (const float*)(wsb + WS_CSB);
        f32x4 cv[2][2];
#pragma unroll
        for (int bj = 0; bj < 2; ++bj) { if constexpr (SC) { cv[bj][0] = *(const f32x4*)(cs + col0 + bj * HALF); cv[bj][1] = *(const f32x4*)(cs + col0 + bj * HALF + 4); } else { cv[bj][0] = (f32x4){1.f, 1.f, 1.f, 1.f}; cv[bj][1] = cv[bj][0]; } }
#pragma unroll
        for (int ai = 0; ai < 2; ++ai) {
            u32x4 gw[4][2], pw[4][2]; float rsv[4];
#pragma unroll
            for (int m = 0; m < 4; ++m) { const size_t row = (size_t)(row0 + ai * HALF + m * 16); rsv[m] = 1.f; if constexpr (SC) rsv[m] = rs[row];
#pragma unroll
                for (int bj = 0; bj < 2; ++bj) { gw[m][bj] = *(const u32x4*)(gate + row * ldg + col0 + bj * HALF); pw[m][bj] = *(const u32x4*)(part + row * ldp + col0 + bj * HALF); } }
#pragma unroll
            for (int m = 0; m < 4; ++m) { const size_t row = (size_t)(row0 + ai * HALF + m * 16);
#pragma unroll
                for (int bj = 0; bj < 2; ++bj) { const f32x4 v0 = tof(acc[ai][bj][m][0]) * (cv[bj][0] * rsv[m]), v1 = tof(acc[ai][bj][m][1]) * (cv[bj][1] * rsv[m]); const u32x4 g = gw[m][bj], p = pw[m][bj];
                    u32x4 w; w.x = cvt_pk_bf16(bf_lo(p.x) + v0[0] * bf_lo(g.x), bf_hi(p.x) + v0[1] * bf_hi(g.x)); w.y = cvt_pk_bf16(bf_lo(p.y) + v0[2] * bf_lo(g.y), bf_hi(p.y) + v0[3] * bf_hi(g.y));
                    w.z = cvt_pk_bf16(bf_lo(p.z) + v1[0] * bf_lo(g.z), bf_hi(p.z) + v1[1] * bf_hi(g.z)); w.w = cvt_pk_bf16(bf_lo(p.w) + v1[2] * bf_lo(g.w), bf_hi(p.w) + v1[3] * bf_hi(g.w));
                    *(u32x4*)(O + row * ldc + col0 + bj * HALF) = w; } }
            asm volatile("" ::: "memory");
        }
    }
};
template <bool SC, bool SRCB> struct EpiResT {
    const void* src; const void* src2; int split_pm; bf16* dst; int ld; float scale; const unsigned char* wsb;
    template <class AccT> __device__ __forceinline__ void operator()(const AccT (&acc)[2][2][4][2], const Unit& u, int wr, int wc, int fr, int fq) const {
        const int row0 = u.pm * BM + wr * 64 + fr, col0 = u.pn * BM + wc * 32 + 8 * fq;
        const float* rs = (const float*)(wsb + WS_RSMA); const float* cs = (const float*)(wsb + WS_CSO);
        const char* sbase = (u.pm < split_pm) ? (const char*)src : (const char*)src2 - (size_t)split_pm * BM * ld * (SRCB ? 2 : 4);
        f32x4 cv[2][2];
#pragma unroll
        for (int bj = 0; bj < 2; ++bj) { if constexpr (SC) { cv[bj][0] = *(const f32x4*)(cs + col0 + bj * HALF); cv[bj][1] = *(const f32x4*)(cs + col0 + bj * HALF + 4); } else { cv[bj][0] = (f32x4){scale, scale, scale, scale}; cv[bj][1] = cv[bj][0]; } }
#pragma unroll
        for (int ai = 0; ai < 2; ++ai)
#pragma unroll
            for (int mh = 0; mh < 2; ++mh) {
                f32x4 sv[2][2][2]; float rsv[2];
#pragma unroll
                for (int mm = 0; mm < 2; ++mm) { const int m = 2 * mh + mm; const size_t off = (size_t)(row0 + ai * HALF + m * 16) * ld + col0; rsv[mm] = 1.f; if constexpr (SC) rsv[mm] = rs[row0 + ai * HALF + m * 16];
#pragma unroll
                    for (int bj = 0; bj < 2; ++bj) {
                        if constexpr (SRCB) { const u32x4 w = *(const u32x4*)((const bf16*)sbase + off + bj * HALF); sv[mm][bj][0] = (f32x4){bf_lo(w.x), bf_hi(w.x), bf_lo(w.y), bf_hi(w.y)}; sv[mm][bj][1] = (f32x4){bf_lo(w.z), bf_hi(w.z), bf_lo(w.w), bf_hi(w.w)}; }
                        else { const float* sp = (const float*)sbase + off + bj * HALF; sv[mm][bj][0] = *(const f32x4*)sp; sv[mm][bj][1] = *(const f32x4*)(sp + 4); } } }
#pragma unroll
                for (int mm = 0; mm < 2; ++mm) { const int m = 2 * mh + mm; const size_t off = (size_t)(row0 + ai * HALF + m * 16) * ld + col0;
#pragma unroll
                    for (int bj = 0; bj < 2; ++bj) { const f32x4 o0 = sv[mm][bj][0] + tof(acc[ai][bj][m][0]) * (cv[bj][0] * rsv[mm]), o1 = sv[mm][bj][1] + tof(acc[ai][bj][m][1]) * (cv[bj][1] * rsv[mm]);
                        u32x4 w; w.x = cvt_pk_bf16(o0[0], o0[1]); w.y = cvt_pk_bf16(o0[2], o0[3]); w.z = cvt_pk_bf16(o1[0], o1[1]); w.w = cvt_pk_bf16(o1[2], o1[3]); *(u32x4*)(dst + off + bj * HALF) = w; } }
                asm volatile("" ::: "memory");
            }
    }
};

__device__ __forceinline__ float dpp_from_prev_lane(float v) { return __builtin_bit_cast(float, __builtin_amdgcn_update_dpp(0, __builtin_bit_cast(int, v), 0x121, 0xF, 0xF, true)); }
__device__ __forceinline__ float dpp_from_next_lane(float v) { return __builtin_bit_cast(float, __builtin_amdgcn_update_dpp(0, __builtin_bit_cast(int, v), 0x12F, 0xF, 0xF, true)); }
struct EpiConv {
    unsigned char* act; bf16* yb; const float* cw; const float* cb; const unsigned char* wsb; float oscale;
    template <class AccT> __device__ __forceinline__ void operator()(const AccT (&acc)[2][2][4][2], const Unit& u, int wr, int wc, int fr, int fq) const {
        const float* rs = (const float*)(wsb + WS_RSHF); const float* cs = (const float*)(wsb + WS_CSUP);
#pragma unroll
        for (int n = 0; n < 2; ++n) {
            const int ch0 = wc * 32 + 8 * fq + 4 * n, cg = u.pn * 128 + ch0, colg = u.pn * BM + ch0;
            const f32x4 csg = *(const f32x4*)(cs + colg), csu = *(const f32x4*)(cs + colg + HALF), bg = *(const f32x4*)(cb + cg), bu = *(const f32x4*)(cb + DFF + cg);
            f32x4 wg[3], wu[3];
#pragma unroll
            for (int t = 0; t < 3; ++t) { wg[t] = *(const f32x4*)(cw + t * NUP + cg); wu[t] = *(const f32x4*)(cw + t * NUP + DFF + cg); }
#pragma unroll
            for (int ai = 0; ai < 2; ++ai) {
                const int rowb = u.pm * BM + ai * HALF + wr * 64;
                f32x4 yg[4], yu[4];
#pragma unroll
                for (int m = 0; m < 4; ++m) { const float rsv = rs[rowb + 16 * m + fr]; yg[m] = tof(acc[ai][0][m][n]) * (csg * rsv); yu[m] = tof(acc[ai][1][m][n]) * (csu * rsv); }
                if (fr < 2 || fr >= 14) { const bool lo = fr < 2; bf16* yr = yb + ((size_t)(rowb >> 6) * 4 + (lo ? fr : fr - 12)) * NUP + colg;
                    const f32x4 a0 = lo ? yg[0] : yg[3], b0 = lo ? yu[0] : yu[3];
                    u32x2 w; w.x = cvt_pk_bf16(a0[0], a0[1]); w.y = cvt_pk_bf16(a0[2], a0[3]); *(u32x2*)yr = w;
                    w.x = cvt_pk_bf16(b0[0], b0[1]); w.y = cvt_pk_bf16(b0[2], b0[3]); *(u32x2*)(yr + HALF) = w; }
#pragma unroll
                for (int m = 0; m < 4; ++m) {
                    float o[4];
#pragma unroll
                    for (int e = 0; e < 4; ++e) {
                        const float gc = yg[m][e], uc = yu[m][e];
                        const float gsp = (m > 0 && fr == 15) ? yg[m > 0 ? m - 1 : 0][e] : gc, usp = (m > 0 && fr == 15) ? yu[m > 0 ? m - 1 : 0][e] : uc;
                        const float gsn = (m < 3 && fr == 0) ? yg[m < 3 ? m + 1 : 3][e] : gc, usn = (m < 3 && fr == 0) ? yu[m < 3 ? m + 1 : 3][e] : uc;
                        const float gp = dpp_from_prev_lane(gsp), up = dpp_from_prev_lane(usp), gn = dpp_from_next_lane(gsn), un = dpp_from_next_lane(usn);
                        const float ug = wg[0][e] * gp + wg[1][e] * gc + wg[2][e] * gn + bg[e];
                        const float uu = wu[0][e] * up + wu[1][e] * uc + wu[2][e] * un + bu[e];
                        o[e] = ug * fast_sigmoid(ug) * uu * oscale; }
                    const bool edge = (m == 0 && fr == 0) || (m == 3 && fr == 15);
                    if (!edge) { const size_t row = (size_t)(rowb + 16 * m + fr);
                        if (FP8_DOWN) *(unsigned*)(act + row * DFF + cg) = pack4_fp8(o[0], o[1], o[2], o[3]);
                        else { u32x2 w; w.x = cvt_pk_bf16(o[0], o[1]); w.y = cvt_pk_bf16(o[2], o[3]); *(u32x2*)((bf16*)act + row * DFF + cg) = w; } }
                }
                asm volatile("" ::: "memory");
            }
        }
    }
};
}

namespace att {
constexpr int OFF_V = 0, SHM_V = 16384, OFF_K = 32768, KROW = 144  , SHM_KP = 64 * KROW, OFF_WS = 32768 + 2 * 3 * SHM_KP, OFF_TBL = OFF_WS + 2048, OFF_QR = OFF_TBL + 2064  , LDS_END = OFF_QR + 256 * KROW;
#define SBAR() __builtin_amdgcn_sched_barrier(0)
__device__ __forceinline__ int crow(int r, int hi) { return (r & 3) + 8 * (r >> 2) + 4 * hi; }
__device__ __forceinline__ int kswz(int row, int colB) { return row * KROW + colB; }
__device__ __forceinline__ int v_st(int k, int c) { const int kk = (k & ~0xC) | ((k & 4) << 1) | ((k & 8) >> 1); return ((kk >> 3) * 4 + (c >> 5)) * 512 + ((kk & 7) * 32 + (c & 31)) * 2; }
__device__ __forceinline__ int v_rd_base(int lane) { return ((lane & 3) << 3) | (((lane >> 2) & 3) << 6) | (((lane >> 4) & 1) << 5) | (((lane >> 5) & 1) << 8); }
constexpr int v_rd_off(int d0, int ks, int half) { return d0 * 512 + ks * 4096 + half * 2048; }
template <int OFF> __device__ __forceinline__ s16x4 tr_read(int vb) { s16x4 r; asm volatile("ds_read_b64_tr_b16 %0, %1 offset:%2" : "=&v"(r) : "v"(vb), "i"(OFF) : "memory"); return r; }
template <int D0> __device__ __forceinline__ void pv_one(f32x16& od, int vb, bf16x8 pa0, bf16x8 pa1, bf16x8 pa2, bf16x8 pa3) {
    const s16x4 l0 = tr_read<v_rd_off(D0, 0, 0)>(vb), h0 = tr_read<v_rd_off(D0, 0, 1)>(vb), l1 = tr_read<v_rd_off(D0, 1, 0)>(vb), h1 = tr_read<v_rd_off(D0, 1, 1)>(vb);
    const s16x4 l2 = tr_read<v_rd_off(D0, 2, 0)>(vb), h2 = tr_read<v_rd_off(D0, 2, 1)>(vb), l3 = tr_read<v_rd_off(D0, 3, 0)>(vb), h3 = tr_read<v_rd_off(D0, 3, 1)>(vb);
    asm volatile("s_waitcnt lgkmcnt(0)" ::: "memory"); SBAR();
#define PK(L, H) (bf16x8){L[0], L[1], L[2], L[3], H[0], H[1], H[2], H[3]}
    od = __builtin_amdgcn_mfma_f32_32x32x16_bf16(pa0, PK(l0, h0), od, 0, 0, 0);
    od = __builtin_amdgcn_mfma_f32_32x32x16_bf16(pa1, PK(l1, h1), od, 0, 0, 0);
    od = __builtin_amdgcn_mfma_f32_32x32x16_bf16(pa2, PK(l2, h2), od, 0, 0, 0);
    od = __builtin_amdgcn_mfma_f32_32x32x16_bf16(pa3, PK(l3, h3), od, 0, 0, 0);
#undef PK
}
__device__ __forceinline__ void pv_d0(f32x16* o, int vb, bf16x8 pa0, bf16x8 pa1, bf16x8 pa2, bf16x8 pa3) {
    pv_one<0>(o[0], vb, pa0, pa1, pa2, pa3); pv_one<1>(o[1], vb, pa0, pa1, pa2, pa3); pv_one<2>(o[2], vb, pa0, pa1, pa2, pa3); pv_one<3>(o[3], vb, pa0, pa1, pa2, pa3);
}
__device__ __forceinline__ float fma_s(float a, float s_uniform, float c) { float d; asm("v_fma_f32 %0, %1, %2, %3" : "=v"(d) : "v"(a), "s"(s_uniform), "v"(c)); return d; }
constexpr float THR2 = 8.0f * 1.4426950408889634f;
template <bool BIAS>
__device__ __forceinline__ void partialSM(f32x16& p0, f32x16& p1, float& m_reg, float& mn, float& alpha, float Cs, bool near, float bconst, int relbase, int hi, const LAS float* tbl) {
    float pmax;
    if (BIAS && near) {
#pragma unroll
        for (int r = 0; r < 16; ++r) { const int k = relbase + crow(r, hi);
            const int i0 = min(max(k, 0), 256), i1 = min(max(k + 32, 0), 256);
            p0[r] = fma_s(p0[r], Cs, tbl[i0]); p1[r] = fma_s(p1[r], Cs, tbl[i1]); }
        pmax = p0[0];
#pragma unroll
        for (int r = 1; r < 16; ++r) pmax = fmaxf(pmax, p0[r]);
#pragma unroll
        for (int r = 0; r < 16; ++r) pmax = fmaxf(pmax, p1[r]);
        { auto rr = __builtin_amdgcn_permlane32_swap(__float_as_uint(pmax), __float_as_uint(pmax), false, false); pmax = fmaxf(__uint_as_float(rr[0]), __uint_as_float(rr[1])); }
        if (__builtin_expect(__all(pmax - m_reg <= THR2), 1)) { mn = m_reg; alpha = 1.f; }
        else { mn = fmaxf(m_reg, pmax); alpha = __builtin_amdgcn_exp2f(m_reg - mn); m_reg = mn; }
#pragma unroll
        for (int r = 0; r < 16; ++r) { p0[r] = p0[r] - mn; p1[r] = p1[r] - mn; }
    } else {
        pmax = p0[0];
#pragma unroll
        for (int r = 1; r < 16; ++r) pmax = fmaxf(pmax, p0[r]);
#pragma unroll
        for (int r = 0; r < 16; ++r) pmax = fmaxf(pmax, p1[r]);
        { auto rr = __builtin_amdgcn_permlane32_swap(__float_as_uint(pmax), __float_as_uint(pmax), false, false); pmax = fmaxf(__uint_as_float(rr[0]), __uint_as_float(rr[1])); }
        pmax = fmaf(pmax, Cs, bconst);
        if (__builtin_expect(__all(pmax - m_reg <= THR2), 1)) { mn = m_reg; alpha = 1.f; }
        else { mn = fmaxf(m_reg, pmax); alpha = __builtin_amdgcn_exp2f(m_reg - mn); m_reg = mn; }
        const float off = bconst - mn;
#pragma unroll
        for (int r = 0; r < 16; ++r) { p0[r] = fma_s(p0[r], Cs, off); p1[r] = fma_s(p1[r], Cs, off); }
    }
#pragma unroll
    for (int r = 0; r < 16; ++r) p0[r] = __builtin_amdgcn_exp2f(p0[r]);
}
__device__ __forceinline__ void partialSM_ci(f32x16& p0, f32x16& p1, float& m_reg, float& alpha, f32x16& csp, bool first, bool near, float bcur, int relbase, int hi, const LAS float* tbl) {
    if (near) {
        const LAS float* tb = tbl + relbase + 4 * hi;
#pragma unroll
        for (int r = 0; r < 16; ++r) { p0[r] += tb[(r & 3) + 8 * (r >> 2)]; p1[r] += tb[32 + (r & 3) + 8 * (r >> 2)]; }
    }
    float pmax = p0[0];
#pragma unroll
    for (int r = 1; r < 16; ++r) pmax = fmaxf(pmax, p0[r]);
#pragma unroll
    for (int r = 0; r < 16; ++r) pmax = fmaxf(pmax, p1[r]);
    { auto rr = __builtin_amdgcn_permlane32_swap(__float_as_uint(pmax), __float_as_uint(pmax), false, false); pmax = fmaxf(__uint_as_float(rr[0]), __uint_as_float(rr[1])); }
    if (__builtin_expect(!first && __all(pmax <= THR2), 1)) { alpha = 1.f; }
    else { const float d = first ? pmax : fmaxf(pmax, 0.f); alpha = __builtin_amdgcn_exp2f(-d); m_reg += d;
#pragma unroll
        for (int r = 0; r < 16; ++r) { p0[r] -= d; p1[r] -= d; csp[r] -= d; } }
#pragma unroll
    for (int r = 0; r < 16; ++r) p0[r] = __builtin_amdgcn_exp2f(p0[r]);
}
__device__ __forceinline__ void finishSM(f32x16& p0, f32x16& p1, float alpha, float& l_reg, bf16x8& pa0, bf16x8& pa1, bf16x8& pa2, bf16x8& pa3) {
#pragma unroll
    for (int r = 0; r < 16; ++r) p1[r] = __builtin_amdgcn_exp2f(p1[r]);
    float ps = 0;
#pragma unroll
    for (int r = 0; r < 16; ++r) ps += p0[r];
#pragma unroll
    for (int r = 0; r < 16; ++r) ps += p1[r];
    { auto rr = __builtin_amdgcn_permlane32_swap(__float_as_uint(ps), __float_as_uint(ps), false, false); ps = __uint_as_float(rr[0]) + __uint_as_float(rr[1]); }
    l_reg = l_reg * alpha + ps;
#define PK4(P, BASE, OUT) do { unsigned a0 = cvt_pk_bf16(P[BASE + 0], P[BASE + 1]), a1 = cvt_pk_bf16(P[BASE + 2], P[BASE + 3]);   \
    unsigned b0 = cvt_pk_bf16(P[BASE + 4], P[BASE + 5]), b1 = cvt_pk_bf16(P[BASE + 6], P[BASE + 7]);                              \
    auto r0 = __builtin_amdgcn_permlane32_swap(a0, b0, false, false); auto r1 = __builtin_amdgcn_permlane32_swap(a1, b1, false, false); \
    u32x4 w = {r0[0], r1[0], r0[1], r1[1]}; OUT = *reinterpret_cast<bf16x8*>(&w); } while (0)
    PK4(p0, 0, pa0); PK4(p0, 8, pa1); PK4(p1, 0, pa2); PK4(p1, 8, pa3);
#undef PK4
}
template <int NP>
__device__ __forceinline__ void qkt(f32x16& p0, f32x16& p1, const LAS char* Ks, const bf16x8* qr, const LAS char* qrl, int r32, int hi, const f32x16& cinit) {
    p0 = cinit; p1 = cinit;
#pragma unroll
    for (int p = 0; p < NP; ++p)
#pragma unroll
        for (int d0 = 0; d0 < 4; ++d0) { const int cb = d0 * 32 + hi * 16;
            bf16x8 b0 = *(const LAS bf16x8*)(Ks + p * SHM_KP + kswz(r32, cb));
            bf16x8 b1 = *(const LAS bf16x8*)(Ks + p * SHM_KP + kswz(32 + r32, cb));
            const bf16x8 qf = (NP == 3 && p == 2) ? *(const LAS bf16x8*)(qrl + d0 * 32) : qr[p * 4 + d0];
            p0 = __builtin_amdgcn_mfma_f32_32x32x16_bf16(b0, qf, p0, 0, 0, 0);
            p1 = __builtin_amdgcn_mfma_f32_32x32x16_bf16(b1, qf, p1, 0, 0, 0); }
}
struct Ptrs { const bf16* q[3]; const bf16* k[3]; const bf16* v; };
struct StrDiff { static constexpr int LDQ = NIN, LDK = NIN, LDK2 = NIN, LDV = NIN; };
struct StrMla { static constexpr int LDQ = NQ, LDK = NKV, LDK2 = NIN, LDV = NKV; };
template <int NP, bool BIAS, int SDEPTH, class STR>
__device__ __forceinline__ void attn_body(const Ptrs& P, int seq, int qpos0, float Cs, LAS char* lds, f32x16 (&o)[4], int tid_in) {
    int tid = tid_in; asm volatile("" : "+v"(tid));
    const int wid = __builtin_amdgcn_readfirstlane(tid >> 6), lane = tid & 63, r32 = lane & 31, hi = lane >> 5;
    LAS char* V_lds = lds + OFF_V; LAS char* K_lds = lds + OFF_K;
    LAS float* wsl = (LAS float*)(lds + OFF_WS) + wid * 64; LAS float* li_l = wsl; LAS float* al_l = wsl + 32;
    const LAS float* tbl = (const LAS float*)(lds + OFF_TBL);
    constexpr int KB = NP * SHM_KP;
    constexpr bool CI = BIAS && (ATT_CINIT != 0);
    float m_reg = CI ? 0.f : -1e30f, l_reg = 0;
#pragma unroll
    for (int d = 0; d < 4; ++d) o[d] = f32x16{};
    constexpr int NPR = (NP == 3) ? 2 : NP;
    bf16x8 qr[NPR * 4];
#pragma unroll
    for (int p = 0; p < NPR; ++p)
#pragma unroll
        for (int d0 = 0; d0 < 4; ++d0) qr[p * 4 + d0] = *reinterpret_cast<const bf16x8*>(P.q[p] + (long)(wid * 32 + r32) * STR::LDQ + hi * 8 + d0 * 16);
    LAS char* qrl = lds + OFF_QR + (wid * 32 + r32) * KROW + hi * 16;
    if constexpr (NP == 3) {
#pragma unroll
        for (int d0 = 0; d0 < 4; ++d0) *(LAS bf16x8*)(qrl + d0 * 32) = *reinterpret_cast<const bf16x8*>(P.q[2] + (long)(wid * 32 + r32) * STR::LDQ + hi * 8 + d0 * 16);
    }
    const int kr = tid >> 3, kc = tid & 7, kst = kswz(kr, kc * 16);
    const int sr = tid >> 4, sc = (tid & 15) * 8, vst0 = v_st(sr, sc), vst1 = v_st(32 + sr, sc);
    const int vb0 = (int)(uintptr_t)V_lds + v_rd_base(lane);
    const int qlo = qpos0 + wid * 32;
    const float bL = BIAS ? tbl[0] : 0.f, bR = BIAS ? tbl[CI ? 512 : 256] : 0.f;
    f32x16 csp = f32x16{}; float bcur = bL;
    if constexpr (CI) {
#pragma unroll
        for (int r = 0; r < 16; ++r) csp[r] = bL; }
    struct { bf16x8 vs0, vs1, ks[NP]; } st_[SDEPTH];
#define SLOAD(i, k0) do { st_[i].vs0 = *reinterpret_cast<const bf16x8*>(P.v + (long)((k0) + sr) * STR::LDV + sc); st_[i].vs1 = *reinterpret_cast<const bf16x8*>(P.v + (long)((k0) + 32 + sr) * STR::LDV + sc); \
    _Pragma("unroll") for (int p_ = 0; p_ < NP; ++p_) st_[i].ks[p_] = *reinterpret_cast<const bf16x8*>(P.k[p_] + (long)((k0) + kr) * (p_ == 2 ? STR::LDK2 : STR::LDK) + kc * 8); } while (0)
#define SWRITE(b, i) do { *(LAS bf16x8*)(V_lds + (b) * SHM_V + vst0) = st_[i].vs0; *(LAS bf16x8*)(V_lds + (b) * SHM_V + vst1) = st_[i].vs1; \
    _Pragma("unroll") for (int p_ = 0; p_ < NP; ++p_) *(LAS bf16x8*)(K_lds + (b) * KB + p_ * SHM_KP + kst) = st_[i].ks[p_]; } while (0)
#define SWAIT() do { if constexpr (SDEPTH == 2) { if constexpr (NP == 1) asm volatile("s_waitcnt vmcnt(3)" ::: "memory"); else asm volatile("s_waitcnt vmcnt(5)" ::: "memory"); } else asm volatile("s_waitcnt vmcnt(0)" ::: "memory"); } while (0)
#define RESC(a) do { if (__any((a) < 1.f)) { if (hi == 0) al_l[r32] = (a); asm volatile("s_waitcnt lgkmcnt(0)" ::: "memory"); \
    _Pragma("unroll") for (int d = 0; d < 4; ++d) _Pragma("unroll") for (int r = 0; r < 16; ++r) o[d][r] *= al_l[crow(r, hi)]; } } while (0)
#define TILEB(j, nearv, bcv, rbv) const int _rh##j = (j) * 64 + 63 - qlo, _rl##j = (j) * 64 - (qlo + 31); \
    const bool nearv = BIAS && (_rh##j > -128) && (_rl##j < 128); const float bcv = (_rh##j <= -128) ? bL : bR; const int rbv = (j) * 64 - (qlo + r32) + (CI ? 256 : 128)
#define CLS(nearv, bcv) do { if constexpr (CI) { const float _bt = (nearv) ? 0.f : (bcv); if (_bt != bcur) { const float _dl = _bt - bcur; _Pragma("unroll") for (int r = 0; r < 16; ++r) csp[r] += _dl; bcur = _bt; } } } while (0)
#define PSM(P0, P1, MN, AL, first, nearv, bcv, rbv) do { if constexpr (CI) { partialSM_ci(P0, P1, m_reg, AL, csp, first, nearv, bcur, rbv, hi, tbl); MN = 0.f; } \
        else partialSM<BIAS>(P0, P1, m_reg, MN, AL, Cs, nearv, bcv, rbv, hi, tbl); } while (0)
    f32x16 pA0, pA1, pB0, pB1; float mnA, mnB, alA, alB; bf16x8 pa0, pa1, pa2, pa3; const int NT = seq / 64;
    constexpr int SE = 0, SO = SDEPTH - 1;
    SLOAD(SE, 0); asm volatile("s_waitcnt vmcnt(0)" ::: "memory"); SWRITE(0, SE); __syncthreads();
    { const int jj = 0; TILEB(jj, nr, bc, rb); CLS(nr, bc); qkt<NP>(pA0, pA1, K_lds, qr, qrl, r32, hi, csp); PSM(pA0, pA1, mnA, alA, true, nr, bc, rb); }
    SLOAD(SO, 64); if constexpr (SDEPTH == 2) { if (2 < NT) SLOAD(SE, 128); }
    SWAIT(); SWRITE(1, SO); __syncthreads();
    for (int j = 1; j + 1 < NT; j += 2) {
        TILEB(j, nrB, bcB, rbB); CLS(nrB, bcB);
        SBAR(); qkt<NP>(pB0, pB1, K_lds + KB, qr, qrl, r32, hi, csp);
        finishSM(pA0, pA1, alA, l_reg, pa0, pa1, pa2, pa3); SBAR();
        SLOAD(SO, (j + SDEPTH) * 64); SBAR();
        pv_d0(o, vb0, pa0, pa1, pa2, pa3);
        PSM(pB0, pB1, mnB, alB, false, nrB, bcB, rbB);
        __syncthreads(); SWAIT(); SWRITE(0, SE);
        RESC(alB); __syncthreads();
        const int j1 = j + 1; TILEB(j1, nrA, bcA, rbA); CLS(nrA, bcA);
        SBAR(); qkt<NP>(pA0, pA1, K_lds, qr, qrl, r32, hi, csp);
        finishSM(pB0, pB1, alB, l_reg, pa0, pa1, pa2, pa3); SBAR();
        if (SDEPTH == 1 || j + 3 < NT) SLOAD(SE, (j + 1 + SDEPTH) * 64); SBAR();
        pv_d0(o, vb0 + SHM_V, pa0, pa1, pa2, pa3);
        PSM(pA0, pA1, mnA, alA, false, nrA, bcA, rbA);
        __syncthreads(); SWAIT(); SWRITE(1, SO);
        RESC(alA); __syncthreads();
    }
    const int jl = NT - 1; TILEB(jl, nrL, bcL, rbL); CLS(nrL, bcL);
    SBAR(); qkt<NP>(pB0, pB1, K_lds + KB, qr, qrl, r32, hi, csp);
    finishSM(pA0, pA1, alA, l_reg, pa0, pa1, pa2, pa3); SBAR();
    pv_d0(o, vb0, pa0, pa1, pa2, pa3);
    PSM(pB0, pB1, mnB, alB, false, nrL, bcL, rbL);
    __syncthreads(); RESC(alB);
    finishSM(pB0, pB1, alB, l_reg, pa0, pa1, pa2, pa3); SBAR();
    pv_d0(o, vb0 + SHM_V, pa0, pa1, pa2, pa3);
    if (hi == 0) li_l[r32] = l_reg; asm volatile("s_waitcnt lgkmcnt(0)" ::: "memory");
#pragma unroll
    for (int r = 0; r < 16; ++r) { const float rl = __builtin_amdgcn_rcpf(li_l[crow(r, hi)]);
#pragma unroll
        for (int d = 0; d < 4; ++d) o[d][r] *= rl; }
    __syncthreads();
#undef SLOAD
#undef SWRITE
#undef SWAIT
#undef RESC
#undef TILEB
#undef CLS
#undef PSM
}
}

constexpr int NWAVES = 8;
constexpr int CW_BAR = 4096;
constexpr int RING_BYTES = 131072, MISC_OFF = RING_BYTES + 320, LDS_BYTES = 147456;
static_assert(att::LDS_END <= RING_BYTES, "attention LDS");

#define XB_TMO      128
#define XB_XCNT(j)  (256  + 64 * (j))
#define XB_XSUB(j)  (1280 + 64 * (j))
#define XB_XGEN(j)  (2304 + 64 * (j))
#define XB_TOP      3328
#define XB_TOPGEN   3392
#define XCD_BAR_WORDS 3456
#define XB_SPIN_CAP (1u << 21)
__device__ __forceinline__ unsigned xb_ld(unsigned* p)              { return __hip_atomic_load(p, __ATOMIC_RELAXED, __HIP_MEMORY_SCOPE_AGENT); }
__device__ __forceinline__ unsigned xb_add(unsigned* p, unsigned v) { return __hip_atomic_fetch_add(p, v, __ATOMIC_RELAXED, __HIP_MEMORY_SCOPE_AGENT); }
__device__ __forceinline__ unsigned xb_xcc_id() { return (unsigned)__builtin_amdgcn_s_getreg((3 << 11) | 20) & 0xFu; }
#define XB_SPIN(cond, bar) do { unsigned _sp = 0; while (cond) { __builtin_amdgcn_s_sleep(1); \
    if ((++_sp & 255u) == 0u) { if (xb_ld(&(bar)[XB_TMO])) break; if (_sp > XB_SPIN_CAP) { atomicAdd(&(bar)[XB_TMO], 1u); break; } } } } while (0)
struct XcdBarrier { unsigned* bar; unsigned x; volatile LAS unsigned* st; };
__device__ __forceinline__ XcdBarrier xcd_barrier_post(unsigned* bar, volatile LAS unsigned* st, bool leader) {
    XcdBarrier b; b.bar = bar; b.x = xb_xcc_id(); b.st = st;
    if (leader) (void)xb_add(&bar[XB_XCNT(b.x)], 1u);
    return b;
}
__device__ __forceinline__ void xcd_barrier_complete(unsigned* bar, unsigned x, unsigned& nloc, unsigned& nx) {
    const unsigned G = gridDim.x * gridDim.y * gridDim.z;
    unsigned sum, cnt, mine, sp = 0u;
    for (;;) {
        sum = 0u; cnt = 0u; mine = 0u;
#pragma unroll
        for (unsigned j = 0; j < 16; ++j) { const unsigned c = xb_ld(&bar[XB_XCNT(j)]); sum += c; cnt += (c > 0u) ? 1u : 0u; mine = (j == x) ? c : mine; }
        if (sum == G) break;
        __builtin_amdgcn_s_sleep(1);
        if ((++sp & 255u) == 0u) { if (xb_ld(&bar[XB_TMO])) break; if (sp > XB_SPIN_CAP) { atomicAdd(&bar[XB_TMO], 1u); break; } }
    }
    nloc = mine > 0u ? mine : 1u; nx = cnt > 0u ? cnt : 1u;
}
__device__ __forceinline__ void xcd_barrier(const XcdBarrier& b, bool leader) {
    asm volatile("s_waitcnt vmcnt(0)" ::: "memory");
    __syncthreads();
    if (leader) {
        unsigned* bar = b.bar;
        __builtin_amdgcn_s_waitcnt(0);
        unsigned nloc = b.st[0], nx = b.st[1];
        if (nloc == 0u) { xcd_barrier_complete(bar, b.x, nloc, nx); b.st[0] = nloc; b.st[1] = nx; }
        const unsigned old = xb_add(&bar[XB_XSUB(b.x)], 1u);
        const unsigned gen = old / nloc;
        if (old + 1u == (gen + 1u) * nloc) {
            __builtin_amdgcn_fence(__ATOMIC_RELEASE, "agent");
            asm volatile("s_waitcnt vmcnt(0)" ::: "memory");
            const unsigned og = xb_add(&bar[XB_TOP], 1u);
            const unsigned tg = og / nx;
            if (og + 1u == (tg + 1u) * nx) xb_add(&bar[XB_TOPGEN], 1u);
            else XB_SPIN(xb_ld(&bar[XB_TOPGEN]) == tg, bar);
            __builtin_amdgcn_fence(__ATOMIC_ACQUIRE, "agent");
            xb_add(&bar[XB_XGEN(b.x)], 1u);
            asm volatile("s_waitcnt vmcnt(0)" ::: "memory");
        } else {
            XB_SPIN(xb_ld(&bar[XB_XGEN(b.x)]) == gen, bar);
            __builtin_amdgcn_fence(__ATOMIC_ACQUIRE, "agent");
            asm volatile("s_waitcnt vmcnt(0)" ::: "memory");
        }
    }
    __syncthreads();
}

#define LDS_WAIT() asm volatile("s_waitcnt lgkmcnt(0)" ::: "memory")
template <int X> __device__ __forceinline__ float swz_xor(float v) { return __int_as_float(__builtin_amdgcn_ds_swizzle(__float_as_int(v), (X << 10) | 0x1f)); }
__device__ __forceinline__ float half_sum(float v) { v += swz_xor<1>(v); v += swz_xor<2>(v); v += swz_xor<4>(v); v += swz_xor<8>(v); v += swz_xor<16>(v); return v; }
__device__ __forceinline__ float wave_max(float v) {
    v = __builtin_fmaxf(v, swz_xor<1>(v)); v = __builtin_fmaxf(v, swz_xor<2>(v)); v = __builtin_fmaxf(v, swz_xor<4>(v)); v = __builtin_fmaxf(v, swz_xor<8>(v)); v = __builtin_fmaxf(v, swz_xor<16>(v));
    auto rr = __builtin_amdgcn_permlane32_swap(__float_as_uint(v), __float_as_uint(v), false, false);
    return __builtin_fmaxf(__uint_as_float(rr[0]), __uint_as_float(rr[1]));
}
__device__ __forceinline__ float wave_sum(float v) {
    v = half_sum(v);
    auto rr = __builtin_amdgcn_permlane32_swap(__float_as_uint(v), __float_as_uint(v), false, false);
    return __uint_as_float(rr[0]) + __uint_as_float(rr[1]);
}

__device__ __forceinline__ void wave_sum_max(float& s, float& mx) {
    s += swz_xor<1>(s); mx = __builtin_fmaxf(mx, swz_xor<1>(mx)); s += swz_xor<2>(s); mx = __builtin_fmaxf(mx, swz_xor<2>(mx)); s += swz_xor<4>(s); mx = __builtin_fmaxf(mx, swz_xor<4>(mx));
    s += swz_xor<8>(s); mx = __builtin_fmaxf(mx, swz_xor<8>(mx)); s += swz_xor<16>(s); mx = __builtin_fmaxf(mx, swz_xor<16>(mx));
    auto rs = __builtin_amdgcn_permlane32_swap(__float_as_uint(s), __float_as_uint(s), false, false); auto rm = __builtin_amdgcn_permlane32_swap(__float_as_uint(mx), __float_as_uint(mx), false, false);
    s = __uint_as_float(rs[0]) + __uint_as_float(rs[1]); mx = __builtin_fmaxf(__uint_as_float(rm[0]), __uint_as_float(rm[1]));
}
__device__ __forceinline__ void norm_quant_row(f32x4 (&t)[16], float ss, unsigned char* drow, float* rsp, int lane) {
    float mx = 0.f;
#pragma unroll
    for (int j = 0; j < 16; ++j) mx = __builtin_fmaxf(__builtin_fmaxf(mx, __builtin_fmaxf(__builtin_fabsf(t[j].x), __builtin_fabsf(t[j].y))), __builtin_fmaxf(__builtin_fabsf(t[j].z), __builtin_fabsf(t[j].w)));
    wave_sum_max(ss, mx);
    const float rstd = 1.0f / sqrtf(ss * (1.f / DM) + EPS); mx *= rstd;
    const float q = mx > 0.f ? rstd * (127.f / mx) : 0.f; if (lane == 0) *rsp = mx * (1.f / 127.f);
#pragma unroll
    for (int j = 0; j < 8; ++j) { u32x2 w; w.x = pack4_i8(t[2 * j].x * q, t[2 * j].y * q, t[2 * j].z * q, t[2 * j].w * q); w.y = pack4_i8(t[2 * j + 1].x * q, t[2 * j + 1].y * q, t[2 * j + 1].z * q, t[2 * j + 1].w * q);
        *(u32x2*)(drow + j * 512 + lane * 8) = w; }
}
constexpr int NWAVES_ = 8;
template <int MODE, class SrcFn>
__device__ __forceinline__ void convert_strip(const float* W, int K, int N, unsigned char* WT, float* cs, int n0, float fscale, LAS float* lmax, int wave, int lane, SrcFn src) {
    const int rg = lane >> 3, cq = lane & 7, nchunk = K >> 7;
    int sc[4];
#pragma unroll
    for (int j = 0; j < 4; ++j) sc[j] = src(n0 + 4 * cq + j);
    const bool contig = __all(sc[0] >= 0 && (sc[0] & 3) == 0 && sc[1] == sc[0] + 1 && sc[2] == sc[0] + 2 && sc[3] == sc[0] + 3);
    auto ldrow = [&](int row) -> f32x4 {
        if (contig) return *(const f32x4*)(W + (size_t)row * N + sc[0]);
        f32x4 v;
#pragma unroll
        for (int j = 0; j < 4; ++j) v[j] = sc[j] >= 0 ? W[(size_t)row * N + sc[j]] : 0.f;
        return v; };
    f32x4 inv = (f32x4){fscale, fscale, fscale, fscale};
    if constexpr (MODE == 2) {
        f32x4 mx = (f32x4){0.f, 0.f, 0.f, 0.f};
        for (int c = wave; c < nchunk; c += NWAVES_) { f32x4 v[16];
#pragma unroll
            for (int i = 0; i < 16; ++i) v[i] = ldrow(c * 128 + 16 * rg + i);
#pragma unroll
            for (int i = 0; i < 16; ++i)
#pragma unroll
                for (int j = 0; j < 4; ++j) mx[j] = __builtin_fmaxf(mx[j], __builtin_fabsf(v[i][j])); }
#pragma unroll
        for (int j = 0; j < 4; ++j) { float m = mx[j]; m = __builtin_fmaxf(m, swz_xor<8>(m)); m = __builtin_fmaxf(m, swz_xor<16>(m));
            auto rr = __builtin_amdgcn_permlane32_swap(__float_as_uint(m), __float_as_uint(m), false, false); mx[j] = __builtin_fmaxf(__uint_as_float(rr[0]), __uint_as_float(rr[1])); }
        __syncthreads();
        if (lane < 8) *(LAS f32x4*)(lmax + wave * 32 + 4 * lane) = mx;
        __syncthreads();
        f32x4 cm = *(const LAS f32x4*)(lmax + 4 * cq);
#pragma unroll
        for (int w = 1; w < NWAVES_; ++w) { const f32x4 o = *(const LAS f32x4*)(lmax + w * 32 + 4 * cq);
#pragma unroll
            for (int j = 0; j < 4; ++j) cm[j] = __builtin_fmaxf(cm[j], o[j]); }
#pragma unroll
        for (int j = 0; j < 4; ++j) inv[j] = cm[j] > 0.f ? 127.f / cm[j] : 0.f;
        if (wave == 0 && lane < 8) *(f32x4*)(cs + n0 + 4 * lane) = cm * (1.f / 127.f);
    }
    constexpr int EB = (MODE == 0) ? 2 : 1; const size_t rowb = (size_t)K * EB;
    for (int c = wave; c < nchunk; c += NWAVES_) { f32x4 v[16];
#pragma unroll
        for (int i = 0; i < 16; ++i) v[i] = ldrow(c * 128 + 16 * rg + i) * inv;
#pragma unroll
        for (int j = 0; j < 4; ++j) { unsigned char* dst = WT + (size_t)(n0 + 4 * cq + j) * rowb + (size_t)(c * 128 + 16 * rg) * EB;
            if constexpr (MODE == 2) { u32x4 o; o.x = pack4_i8(v[0][j], v[1][j], v[2][j], v[3][j]); o.y = pack4_i8(v[4][j], v[5][j], v[6][j], v[7][j]); o.z = pack4_i8(v[8][j], v[9][j], v[10][j], v[11][j]); o.w = pack4_i8(v[12][j], v[13][j], v[14][j], v[15][j]); *(u32x4*)dst = o; }
            else if constexpr (MODE == 1) { u32x4 o; o.x = pack4_fp8(v[0][j], v[1][j], v[2][j], v[3][j]); o.y = pack4_fp8(v[4][j], v[5][j], v[6][j], v[7][j]); o.z = pack4_fp8(v[8][j], v[9][j], v[10][j], v[11][j]); o.w = pack4_fp8(v[12][j], v[13][j], v[14][j], v[15][j]); *(u32x4*)dst = o; }
            else { u32x4 o; o.x = cvt_pk_bf16(v[0][j], v[1][j]); o.y = cvt_pk_bf16(v[2][j], v[3][j]); o.z = cvt_pk_bf16(v[4][j], v[5][j]); o.w = cvt_pk_bf16(v[6][j], v[7][j]); *(u32x4*)dst = o;
                   o.x = cvt_pk_bf16(v[8][j], v[9][j]); o.y = cvt_pk_bf16(v[10][j], v[11][j]); o.z = cvt_pk_bf16(v[12][j], v[13][j]); o.w = cvt_pk_bf16(v[14][j], v[15][j]); *(u32x4*)(dst + 16) = o; } }
    }
}
__device__ __forceinline__ int t5_bucket(int rel) {
    const int ret = rel > 0 ? 16 : 0; const int n = rel < 0 ? -rel : rel;
    if (n < 8) return ret + n;
    int large = 2 + (31 - __builtin_clz((unsigned)(n * n)));
    large = large < 15 ? large : 15;
    return ret + large;
}
__device__ __forceinline__ void sincos_f32arg(float ang, float& c, float& s) {
    const double a = (double)ang; const double kq = __builtin_rint(a * 0.63661977236758134);
    double r = __builtin_fma(-kq, 1.5707963267948966, a); r = __builtin_fma(-kq, 6.123233995736766e-17, r);
    const int q = ((int)kq) & 3; const double r2 = r * r;
    const double sp = r * (1.0 + r2 * (-1.0 / 6 + r2 * (1.0 / 120 + r2 * (-1.0 / 5040 + r2 * (1.0 / 362880 + r2 * (-1.0 / 39916800))))));
    const double cp = 1.0 + r2 * (-0.5 + r2 * (1.0 / 24 + r2 * (-1.0 / 720 + r2 * (1.0 / 40320 + r2 * (-1.0 / 3628800 + r2 * (1.0 / 479001600))))));
    const double sv = (q == 0) ? sp : (q == 1) ? cp : (q == 2) ? -sp : -cp;
    const double cv = (q == 0) ? cp : (q == 1) ? -sp : (q == 2) ? -cp : sp;
    c = (float)cv; s = (float)sv;
}

struct Args { const float* in[23]; float* out; unsigned char* ws; float invf[32]; int lo, hi; };
typedef const __attribute__((address_space(4))) Args* ArgsP;

enum { I_XP = 0, I_XS, I_RELB, I_FNG, I_RAG, I_WIN, I_LQ1, I_LK1, I_LQ2, I_LK2, I_SUBG, I_QNG, I_WQUP, I_KVNG, I_WKVUP, I_WA, I_WB, I_WO, I_RFG, I_WUP, I_CW, I_CB, I_WD };

#define P_WINT ((bf16*)(ws + WS_WIN))
#define P_WQT ((bf16*)(ws + WS_WQ))
#define P_WKVT ((bf16*)(ws + WS_WKV))
#define P_WAT ((bf16*)(ws + WS_WA))
#define P_WBT ((bf16*)(ws + WS_WB))
#define P_WOT ((bf16*)(ws + WS_WO))
#define P_WUPT ((bf16*)(ws + WS_WUP))
#define P_WDT ((bf16*)(ws + WS_WD))
#define P_COS ((float*)(ws + WS_COS))
#define P_SIN ((float*)(ws + WS_SIN))
#define P_BIAS2 ((float*)(ws + WS_BIAS))
#define P_LAM ((float*)(ws + WS_LAM))
#define P_CSIN ((float*)(ws + WS_CSIN))
#define P_CSUP ((float*)(ws + WS_CSUP))
#define P_RSH ((float*)(ws + WS_RSH))
#define P_QL8 ((unsigned char*)(ws + WS_QL8))
#define P_KVL8 ((unsigned char*)(ws + WS_KVL8))
#define P_AO8 ((unsigned char*)(ws + WS_AO8))
#define P_BO8 ((unsigned char*)(ws + WS_BO8))
#define P_MG8 ((unsigned char*)(ws + WS_MG8))
#define P_X1 ((bf16*)(ws + WS_X1))
#define P_HF ((unsigned char*)(ws + WS_HF))
#define P_RSHF ((float*)(ws + WS_RSHF))
#define P_P ((bf16*)(ws + WS_P))
#define P_Q ((bf16*)(ws + WS_Q))
#define P_KV ((bf16*)(ws + WS_KV))
#define P_AO ((bf16*)(ws + WS_AO))
#define P_BO ((bf16*)(ws + WS_BO))
#define P_MG ((bf16*)(ws + WS_MG))
#define P_STASH ((float*)(ws + WS_STASH))
#define P_Y ((bf16*)(ws + WS_Y))
#define P_ACT ((bf16*)(ws + WS_ACTV))
#define XG() ((g < 2) ? A->in[I_XP] + (size_t)g * TG * DM : A->in[I_XS] + (size_t)(g - 2) * TG * DM)
#define OG() (A->out + (size_t)g * TG * DM)
constexpr int NSTEP_PER_GROUP = 7, NSTEPS = 1 + NGRP * NSTEP_PER_GROUP + 6;
static_assert(I8_MID, "step program written for the int8 mixer path");

__global__ void __launch_bounds__(NWAVES * 64, 2) enc_fwd(Args args) {
    extern __shared__ __attribute__((aligned(16))) unsigned char lds[];
    LAS unsigned char* ldsL = (LAS unsigned char*)lds;
    volatile LAS unsigned* MISC = (volatile LAS unsigned*)(ldsL + MISC_OFF);
    const int wave = __builtin_amdgcn_readfirstlane((int)threadIdx.x >> 6);
    const int G = gridDim.x; const int bx = blockIdx.x; const int vcu0 = (G % 8 == 0) ? (bx % 8) * (G / 8) + bx / 8 : bx;
    unsigned char* ws = args.ws;
    unsigned* ctl = (unsigned*)(ws + WS_CTL);
    { const int tid0 = wave * 64 + lane_id_fresh(); for (int u = tid0; u < (LDS_BYTES - RING_BYTES) / 4; u += NWAVES * 64) ((LAS unsigned*)(ldsL + RING_BYTES))[u] = 0u; }
    __syncthreads();
    XcdBarrier bar; bar.bar = ctl + CW_BAR; bar.x = 0; bar.st = nullptr;
#if !MK_PER_STEP_LAUNCH
    bar = xcd_barrier_post(ctl + CW_BAR, MISC + 8, (wave * 64 + lane_id_fresh()) == 0);
#endif
    const int lo = args.lo, hi = args.hi;
    int step = 0;
#ifndef EN_MASK
#define EN_MASK 0xFFFFFF
#endif
#define EN(k) (((EN_MASK) >> (k)) & 1)
#define RUN() (step >= lo && step < hi)
#define LOCAL_TID() ArgsP A = (ArgsP)__builtin_amdgcn_kernarg_segment_ptr(); asm volatile("" : "+s"(A)); unsigned char* const ws = A->ws; (void)ws; int lane_ = lane_id_fresh(); asm volatile("" : "+v"(lane_)); const int lane = lane_; const int tid = wave * 64 + lane; (void)tid; int gw = gw0, vcu = vcu0; asm volatile("" : "+s"(gw), "+s"(vcu)); (void)gw; (void)vcu
#if MK_PER_STEP_LAUNCH
#define SEAM() do { ++step; } while (0)
#else
#define SEAM() do { if (RUN() && step + 1 < hi) xcd_barrier(bar, (wave * 64 + lane_id_fresh()) == 0); ++step; } while (0)
#endif
    const int gw0 = vcu0 * NWAVES + wave, NGW = G * NWAVES;

    if (RUN() && EN(0)) { LOCAL_TID();
        LAS float* lmax = (LAS float*)ldsL;
        auto ident = [](int n) -> int { return n; };
        auto srcIn = [](int n) -> int { if (n < C_GATE) return n; if (n < C_KPE) return n + 64; if (n < C_KPE + 64) { const int j = n - C_KPE; return 7680 + ((j & 1) ? 32 + (j >> 1) : (j >> 1)); } return -1; };
        auto srcQ = [](int n) -> int { if (n < 2048) return (n >> 7) * 192 + (n & 127); const int j = n - 2048, hh = j >> 6, jj = j & 63; return hh * 192 + 128 + ((jj & 1) ? 32 + (jj >> 1) : (jj >> 1)); };
        auto srcUp = [](int n) -> int { return CONV_FUSE ? ((n & 128) ? DFF : 0) + (n >> 8) * 128 + (n & 127) : n; };
        constexpr int T0 = DM / 32, T1 = T0 + NIN / 32, T2 = T1 + NUP / 32, T3 = T2 + DM / 32, T4 = T3 + DM / 32, T5 = T4 + DM / 32, T6 = T5 + NQ / 32, T7 = T6 + NKV / 32;
        for (int s = vcu; s < T7; s += G) {
            if (s < T0) { const int n0 = 32 * s;
                if (FP8_DOWN) convert_strip<1>(A->in[I_WD], DFF, DM, (unsigned char*)P_WDT, nullptr, n0, S_WD, lmax, wave, lane, ident); else convert_strip<0>(A->in[I_WD], DFF, DM, (unsigned char*)P_WDT, nullptr, n0, 1.f, lmax, wave, lane, ident); }
            else if (s < T1) { const int n0 = 32 * (s - T0);
                if (I8_IN) convert_strip<2>(A->in[I_WIN], DM, 15936, (unsigned char*)P_WINT, P_CSIN, n0, 1.f, lmax, wave, lane, srcIn); else convert_strip<0>(A->in[I_WIN], DM, 15936, (unsigned char*)P_WINT, nullptr, n0, 1.f, lmax, wave, lane, srcIn); }
            else if (s < T2) { const int n0 = 32 * (s - T1);
                if (I8_UP) convert_strip<2>(A->in[I_WUP], DM, NUP, (unsigned char*)P_WUPT, P_CSUP, n0, 1.f, lmax, wave, lane, srcUp); else convert_strip<0>(A->in[I_WUP], DM, NUP, (unsigned char*)P_WUPT, nullptr, n0, 1.f, lmax, wave, lane, srcUp); }
            else if (s < T3) { const int n0 = 32 * (s - T2);
                if (I8_MID) convert_strip<2>(A->in[I_WO], DM, DM, (unsigned char*)P_WOT, (float*)(ws + WS_CSO), n0, 1.f, lmax, wave, lane, ident); else convert_strip<0>(A->in[I_WO], DM, DM, (unsigned char*)P_WOT, nullptr, n0, 1.f, lmax, wave, lane, ident); }
            else if (s < T4) { const int n0 = 32 * (s - T3);
                if (I8_MID) convert_strip<2>(A->in[I_WA], 2048, DM, (unsigned char*)P_WAT, (float*)(ws + WS_CSA), n0, 1.f, lmax, wave, lane, ident); else convert_strip<0>(A->in[I_WA], 2048, DM, (unsigned char*)P_WAT, nullptr, n0, 1.f, lmax, wave, lane, ident); }
            else if (s < T5) { const int n0 = 32 * (s - T4);
                if (I8_MID) convert_strip<2>(A->in[I_WB], 2048, DM, (unsigned char*)P_WBT, (float*)(ws + WS_CSB), n0, 1.f, lmax, wave, lane, ident); else convert_strip<0>(A->in[I_WB], 2048, DM, (unsigned char*)P_WBT, nullptr, n0, 1.f, lmax, wave, lane, ident); }
            else if (s < T6) { const int n0 = 32 * (s - T5);
                if (I8_MID) convert_strip<2>(A->in[I_WQUP], 1024, NQ, (unsigned char*)P_WQT, (float*)(ws + WS_CSQ), n0, 1.f, lmax, wave, lane, srcQ); else convert_strip<0>(A->in[I_WQUP], 1024, NQ, (unsigned char*)P_WQT, nullptr, n0, 1.f, lmax, wave, lane, srcQ); }
            else { const int n0 = 32 * (s - T6);
                if (I8_MID) convert_strip<2>(A->in[I_WKVUP], 512, NKV, (unsigned char*)P_WKVT, (float*)(ws + WS_CSKV), n0, 1.f, lmax, wave, lane, ident); else convert_strip<0>(A->in[I_WKVUP], 512, NKV, (unsigned char*)P_WKVT, nullptr, n0, 1.f, lmax, wave, lane, ident); }
        }
        for (int i = bx * (NWAVES * 64) + tid; i < 8192 * 32; i += G * NWAVES * 64) { const int pos = i >> 5, k = i & 31; float c, s; sincos_f32arg((float)pos * A->invf[k], c, s); P_COS[i] = c; P_SIN[i] = s; }
        if (bx == 0) {
            for (int i = tid; i < 16 * 257; i += NWAVES * 64) { const int h = i / 257, j = i % 257; P_BIAS2[h * 260 + j] = A->in[I_RELB][t5_bucket(j - 128) * 16 + h] * 1.4426950408889634f; }
            if (wave == 0) { const float a = wave_sum(A->in[I_LQ1][lane] * A->in[I_LK1][lane]), b = wave_sum(A->in[I_LQ2][lane] * A->in[I_LK2][lane]);
                if (lane == 0) P_LAM[0] = expf(a) - expf(b) + 0.2f; }
        }
    }

    if (RUN() && EN(1)) { LOCAL_TID();
        static_assert(I8_IN, "norm1 writes int8 rows");
        f32x4 gg[16];
#pragma unroll
        for (int j = 0; j < 8; ++j) { gg[2 * j] = *(const f32x4*)(A->in[I_RAG] + j * 512 + lane * 8); gg[2 * j + 1] = *(const f32x4*)(A->in[I_RAG] + j * 512 + lane * 8 + 4); }
        for (int m = gw; m < NTOK; m += 2 * NGW) {
            const int m2 = m + NGW; const bool has2 = m2 < NTOK;
            const float* r1 = (m < NTOK / 2 ? A->in[I_XP] + (size_t)m * DM : A->in[I_XS] + (size_t)(m - NTOK / 2) * DM) + lane * 8;
            const float* r2 = (m2 < NTOK / 2 ? A->in[I_XP] + (size_t)m2 * DM : A->in[I_XS] + (size_t)((has2 ? m2 : m) - NTOK / 2) * DM) + lane * 8;
            f32x4 a[16], b[16];
#pragma unroll
            for (int j = 0; j < 8; ++j) { a[2 * j] = *(const f32x4*)(r1 + j * 512); a[2 * j + 1] = *(const f32x4*)(r1 + j * 512 + 4); }
            if (has2) {
#pragma unroll
                for (int j = 0; j < 8; ++j) { b[2 * j] = *(const f32x4*)(r2 + j * 512); b[2 * j + 1] = *(const f32x4*)(r2 + j * 512 + 4); } }
            { float ss = 0.f;
#pragma unroll
              for (int j = 0; j < 16; ++j) { ss += (a[j].x * a[j].x + a[j].y * a[j].y) + (a[j].z * a[j].z + a[j].w * a[j].w); a[j] = a[j] * gg[j]; }
              norm_quant_row(a, ss, P_HF + (size_t)m * DM, P_RSHF + m, lane); }
            if (has2) { float ss = 0.f;
#pragma unroll
              for (int j = 0; j < 16; ++j) { ss += (b[j].x * b[j].x + b[j].y * b[j].y) + (b[j].z * b[j].z + b[j].w * b[j].w); b[j] = b[j] * gg[j]; }
              norm_quant_row(b, ss, P_HF + (size_t)m2 * DM, P_RSHF + m2, lane); }
        }
    }
    SEAM();

    for (int g = 0; g < NGRP; ++g) {
        const int seqlen = (g < 2) ? 4096 : 8192, posmask = seqlen - 1;

        if (RUN() && EN(2)) { LOCAL_TID();
            pg8::Gemm gm{(const bf16*)(P_HF + (size_t)g * TG * DM), DM / 2, P_WINT, TG, NIN, DM / 2}; pg8::StaticOrder S; S.init(TG, NIN, G, bx);
            pg8::EpiStoreT<I8_IN != 0, WS_RSHF, WS_CSIN> E{P_P, NIN, C_GATE / 256, C_KPE / 256, ATT_CINIT ? CS_DIFF : 1.f, ws, g * TG};
            REP_LOOP_GEMM { int l2_ = lane_id_fresh(); asm volatile("" : "+v"(l2_)); pg8::gemm_phase<pg8::EpiStoreT<I8_IN != 0, WS_RSHF, WS_CSIN>, I8_IN ? 2 : 0>(ldsL, gm, S, E, wave * 64 + l2_); }
        }
        SEAM();

        if (RUN() && EN(3)) { LOCAL_TID();
            const float* gq = A->in[I_QNG]; const float* gkv = A->in[I_KVNG];
            for (int m = gw; m < TG; m += NGW) {
                bf16* prow = P_P + (size_t)m * NIN;
                { u32x4 a = *(const u32x4*)(prow + C_QLAT + lane * 8), b = *(const u32x4*)(prow + C_QLAT + 512 + lane * 8);
                  float x[16] = {bf_lo(a.x), bf_hi(a.x), bf_lo(a.y), bf_hi(a.y), bf_lo(a.z), bf_hi(a.z), bf_lo(a.w), bf_hi(a.w), bf_lo(b.x), bf_hi(b.x), bf_lo(b.y), bf_hi(b.y), bf_lo(b.z), bf_hi(b.z), bf_lo(b.w), bf_hi(b.w)};
                  float s = 0.f;
#pragma unroll
                  for (int j = 0; j < 16; ++j) s += x[j] * x[j];
                  const float rstd = 1.0f / sqrtf(wave_sum(s) * (1.f / 1024) + EPS);
                  const f32x4 g0 = *(const f32x4*)(gq + lane * 8), g1 = *(const f32x4*)(gq + lane * 8 + 4), g2 = *(const f32x4*)(gq + 512 + lane * 8), g3 = *(const f32x4*)(gq + 512 + lane * 8 + 4);
                  u32x4 oa, ob;
                  oa.x = cvt_pk_bf16(x[0] * rstd * g0.x, x[1] * rstd * g0.y); oa.y = cvt_pk_bf16(x[2] * rstd * g0.z, x[3] * rstd * g0.w); oa.z = cvt_pk_bf16(x[4] * rstd * g1.x, x[5] * rstd * g1.y); oa.w = cvt_pk_bf16(x[6] * rstd * g1.z, x[7] * rstd * g1.w);
                  ob.x = cvt_pk_bf16(x[8] * rstd * g2.x, x[9] * rstd * g2.y); ob.y = cvt_pk_bf16(x[10] * rstd * g2.z, x[11] * rstd * g2.w); ob.z = cvt_pk_bf16(x[12] * rstd * g3.x, x[13] * rstd * g3.y); ob.w = cvt_pk_bf16(x[14] * rstd * g3.z, x[15] * rstd * g3.w);
                  if (I8_MID) { float y[16]; float mx = 0.f; const float gg[16] = {g0.x, g0.y, g0.z, g0.w, g1.x, g1.y, g1.z, g1.w, g2.x, g2.y, g2.z, g2.w, g3.x, g3.y, g3.z, g3.w};
#pragma unroll
                      for (int j = 0; j < 16; ++j) { y[j] = x[j] * rstd * gg[j]; mx = __builtin_fmaxf(mx, __builtin_fabsf(y[j])); }
                      mx = wave_max(mx); const float inv = mx > 0.f ? 127.f / mx : 0.f; if (lane == 0) ((float*)(ws + WS_RSQL))[m] = mx * (1.f / 127.f);
                      u32x2 q0, q1; q0.x = pack4_i8(y[0] * inv, y[1] * inv, y[2] * inv, y[3] * inv); q0.y = pack4_i8(y[4] * inv, y[5] * inv, y[6] * inv, y[7] * inv);
                      q1.x = pack4_i8(y[8] * inv, y[9] * inv, y[10] * inv, y[11] * inv); q1.y = pack4_i8(y[12] * inv, y[13] * inv, y[14] * inv, y[15] * inv);
                      *(u32x2*)(P_QL8 + (size_t)m * 1024 + lane * 8) = q0; *(u32x2*)(P_QL8 + (size_t)m * 1024 + 512 + lane * 8) = q1;
                  } else { *(u32x4*)(prow + C_QLAT + lane * 8) = oa; *(u32x4*)(prow + C_QLAT + 512 + lane * 8) = ob; } }
                { u32x4 a = *(const u32x4*)(prow + C_KVLAT + lane * 8);
                  float x[8] = {bf_lo(a.x), bf_hi(a.x), bf_lo(a.y), bf_hi(a.y), bf_lo(a.z), bf_hi(a.z), bf_lo(a.w), bf_hi(a.w)};
                  float s = 0.f;
#pragma unroll
                  for (int j = 0; j < 8; ++j) s += x[j] * x[j];
                  const float rstd = 1.0f / sqrtf(wave_sum(s) * (1.f / 512) + EPS);
                  const f32x4 g0 = *(const f32x4*)(gkv + lane * 8), g1 = *(const f32x4*)(gkv + lane * 8 + 4);
                  u32x4 oa;
                  oa.x = cvt_pk_bf16(x[0] * rstd * g0.x, x[1] * rstd * g0.y); oa.y = cvt_pk_bf16(x[2] * rstd * g0.z, x[3] * rstd * g0.w); oa.z = cvt_pk_bf16(x[4] * rstd * g1.x, x[5] * rstd * g1.y); oa.w = cvt_pk_bf16(x[6] * rstd * g1.z, x[7] * rstd * g1.w);
                  if (I8_MID) { float y[8]; float mx = 0.f; const float gg[8] = {g0.x, g0.y, g0.z, g0.w, g1.x, g1.y, g1.z, g1.w};
#pragma unroll
                      for (int j = 0; j < 8; ++j) { y[j] = x[j] * rstd * gg[j]; mx = __builtin_fmaxf(mx, __builtin_fabsf(y[j])); }
                      mx = wave_max(mx); const float inv = mx > 0.f ? 127.f / mx : 0.f; if (lane == 0) ((float*)(ws + WS_RSKVL))[m] = mx * (1.f / 127.f);
                      u32x2 q0; q0.x = pack4_i8(y[0] * inv, y[1] * inv, y[2] * inv, y[3] * inv); q0.y = pack4_i8(y[4] * inv, y[5] * inv, y[6] * inv, y[7] * inv);
                      *(u32x2*)(P_KVL8 + (size_t)m * 512 + lane * 8) = q0;
                  } else *(u32x4*)(prow + C_KVLAT + lane * 8) = oa; }
                if (lane < 32) { const int pos = m & posmask; unsigned w = *(const unsigned*)(prow + C_KPE + 2 * lane); const float x1 = bf_lo(w), x2 = bf_hi(w);
                  const float c = P_COS[pos * 32 + lane], s = P_SIN[pos * 32 + lane];
                  *(unsigned*)(prow + C_KPE + 2 * lane) = cvt_pk_bf16(x1 * c - x2 * s, x1 * s + x2 * c); }
            }
        }
        SEAM();

        if (RUN() && EN(4)) { LOCAL_TID();
            if (EN(18)) { pg8::Gemm gm{I8_MID ? (const bf16*)P_QL8 : P_P + C_QLAT, I8_MID ? 512 : NIN, P_WQT, TG, NQ, I8_MID ? 512 : 1024}; pg8::StaticOrder S; S.init(TG, NQ, G, bx);
              pg8::EpiQT<I8_MID != 0> E{P_Q, NQ, ws, posmask}; REP_LOOP_GEMM { int l2_ = lane_id_fresh(); asm volatile("" : "+v"(l2_)); pg8::gemm_phase<pg8::EpiQT<I8_MID != 0>, I8_MID ? 2 : 0>(ldsL, gm, S, E, wave * 64 + l2_); } }
            if (EN(19)) { pg8::Gemm gm{I8_MID ? (const bf16*)P_KVL8 : P_P + C_KVLAT, I8_MID ? 256 : NIN, P_WKVT, TG, NKV, I8_MID ? 256 : 512}; pg8::StaticOrder S; S.init(TG, NKV, G, bx);
              pg8::EpiStoreT<I8_MID != 0, WS_RSKVL, WS_CSKV> E{P_KV, NKV, 0, 0, 1.f, ws, 0}; REP_LOOP_GEMM { int l2_ = lane_id_fresh(); asm volatile("" : "+v"(l2_)); pg8::gemm_phase<pg8::EpiStoreT<I8_MID != 0, WS_RSKVL, WS_CSKV>, I8_MID ? 2 : 0>(ldsL, gm, S, E, wave * 64 + l2_); } }
        }
        SEAM();

        if (RUN() && EN(5)) { LOCAL_TID();
            const int wid = wave;
            const float lam = P_LAM[0];
            _Pragma("unroll 1") for (int ph = 0; ph < 2; ++ph) {
            const bool do_diff = (((vcu >> 5) ^ ph) & 1) == 0;
            if (do_diff) { if (EN(16)) _Pragma("unroll 1") for (int rep = 0; rep < REP_DIFF; ++rep) for (int u = vcu; u < 512; u += G) { const int tid = wave * 64 + lane_id_fresh();
                const int head = u >> 5, rb = u & 31, row0 = rb * 256, kbase = (seqlen == 4096) ? (rb >> 4) * 4096 : 0, qpos0 = row0 - kbase;
                __syncthreads();
                if (ATT_CINIT) { for (int i = tid; i < 513; i += NWAVES * 64) { const int rel = min(max(i - 256, -128), 128); ((float*)(lds + att::OFF_TBL))[i] = P_BIAS2[head * 260 + rel + 128]; } }
                else if (tid < 257) ((float*)(lds + att::OFF_TBL))[tid] = P_BIAS2[head * 260 + tid];
                __syncthreads();
#pragma unroll 1
                for (int c = 0; c < 2; ++c) {
                    att::Ptrs P;
                    P.q[0] = P_P + (size_t)row0 * NIN + C_DQ + head * 128 + c * 64; P.q[1] = P.q[0]; P.q[2] = P.q[0];
                    P.k[0] = P_P + (size_t)kbase * NIN + C_DK + head * 128 + c * 64; P.k[1] = P.k[0]; P.k[2] = P.k[0];
                    P.v = P_P + (size_t)kbase * NIN + C_DV + head * 128;
                    f32x16 o[4];
                    att::attn_body<1, true, 2, att::StrDiff>(P, seqlen, qpos0, 0.125f * 1.4426950408889634f, (LAS char*)ldsL, o, tid);
                    int tid_e = tid; asm volatile("" : "+v"(tid_e));
                    const int r32 = tid_e & 31, hh = (tid_e >> 5) & 1;
                    f32x4* myst = (f32x4*)(P_STASH + ((size_t)bx * 512 + tid_e) * 64);
                    if (c == 0) {
#pragma unroll
                        for (int d = 0; d < 4; ++d)
#pragma unroll
                            for (int r4 = 0; r4 < 4; ++r4) myst[d * 4 + r4] = (f32x4){o[d][4 * r4], o[d][4 * r4 + 1], o[d][4 * r4 + 2], o[d][4 * r4 + 3]};
                    } else {
                        float ss[16];
#pragma unroll
                        for (int r = 0; r < 16; ++r) ss[r] = 0.f;
#pragma unroll
                        for (int d = 0; d < 4; ++d)
#pragma unroll
                            for (int r4 = 0; r4 < 4; ++r4) { const f32x4 s0 = myst[d * 4 + r4];
#pragma unroll
                                for (int j = 0; j < 4; ++j) { const float a = s0[j] - lam * o[d][4 * r4 + j]; o[d][4 * r4 + j] = a; ss[4 * r4 + j] += a * a; } }
#pragma unroll
                        for (int r = 0; r < 16; ++r) ss[r] = 0.8f / sqrtf(half_sum(ss[r]) * (1.f / 128) + EPS);
                        const float* sg = A->in[I_SUBG];
                        float gsub[4];
#pragma unroll
                        for (int d = 0; d < 4; ++d) gsub[d] = sg[d * 32 + r32];
#pragma unroll
                        for (int r = 0; r < 16; ++r) { bf16* orow = P_AO + (size_t)(row0 + wid * 32 + att::crow(r, hh)) * 2048 + head * 128 + r32;
#pragma unroll
                            for (int d = 0; d < 4; ++d) orow[d * 32] = (bf16)(cvt_pk_bf16(o[d][r] * ss[r] * gsub[d], 0.f) & 0xffffu); }
                    }
                }
            }
            } else { if (EN(17)) _Pragma("unroll 1") for (int rep = 0; rep < REP_MLA; ++rep) for (int u = vcu; u < 512; u += G) { const int tid = wave * 64 + lane_id_fresh();
                const int head = u >> 5, rb = u & 31, row0 = rb * 256, kbase = (seqlen == 4096) ? (rb >> 4) * 4096 : 0;
                att::Ptrs P;
                P.q[0] = P_Q + (size_t)row0 * NQ + head * 128; P.q[1] = P.q[0] + 64; P.q[2] = P_Q + (size_t)row0 * NQ + 2048 + head * 64;
                P.k[0] = P_KV + (size_t)kbase * NKV + head * 256; P.k[1] = P.k[0] + 64; P.k[2] = P_P + (size_t)kbase * NIN + C_KPE;
                P.v = P_KV + (size_t)kbase * NKV + head * 256 + 128;
                f32x16 o[4];
                att::attn_body<3, false, 1, att::StrMla>(P, seqlen, 0, 0.07216878364870323f * 1.4426950408889634f, (LAS char*)ldsL, o, tid);
                int tid_e = tid; asm volatile("" : "+v"(tid_e));
                const int r32 = tid_e & 31, hh = (tid_e >> 5) & 1;
#pragma unroll
                for (int r = 0; r < 16; ++r) { bf16* orow = P_BO + (size_t)(row0 + wid * 32 + att::crow(r, hh)) * 2048 + head * 128 + r32;
#pragma unroll
                    for (int d = 0; d < 4; ++d) orow[d * 32] = (bf16)(cvt_pk_bf16(o[d][r], 0.f) & 0xffffu); }
            }
            } }
        }
        SEAM();

#if I8_MID
        if (RUN()) { LOCAL_TID();
            for (int m = gw; m < 2 * TG; m += NGW) { const int row = m >> 1; const bool isB = m & 1;
                const bf16* srow = (isB ? P_BO : P_AO) + (size_t)row * 2048 + lane * 8; u32x4 a[4]; float mx = 0.f;
#pragma unroll
                for (int j = 0; j < 4; ++j) { a[j] = *(const u32x4*)(srow + 512 * j);
                    mx = __builtin_fmaxf(mx, __builtin_fmaxf(__builtin_fmaxf(__builtin_fmaxf(__builtin_fabsf(bf_lo(a[j].x)), __builtin_fabsf(bf_hi(a[j].x))), __builtin_fmaxf(__builtin_fabsf(bf_lo(a[j].y)), __builtin_fabsf(bf_hi(a[j].y)))),
                                                      __builtin_fmaxf(__builtin_fmaxf(__builtin_fabsf(bf_lo(a[j].z)), __builtin_fabsf(bf_hi(a[j].z))), __builtin_fmaxf(__builtin_fabsf(bf_lo(a[j].w)), __builtin_fabsf(bf_hi(a[j].w)))))); }
                mx = wave_max(mx); const float inv = mx > 0.f ? 127.f / mx : 0.f; if (lane == 0) ((float*)(ws + (isB ? WS_RSB : WS_RSA)))[row] = mx * (1.f / 127.f);
                unsigned char* drow = (isB ? P_BO8 : P_AO8) + (size_t)row * 2048 + lane * 8;
#pragma unroll
                for (int j = 0; j < 4; ++j) { u32x2 q; q.x = pack4_i8(bf_lo(a[j].x) * inv, bf_hi(a[j].x) * inv, bf_lo(a[j].y) * inv, bf_hi(a[j].y) * inv); q.y = pack4_i8(bf_lo(a[j].z) * inv, bf_hi(a[j].z) * inv, bf_lo(a[j].w) * inv, bf_hi(a[j].w) * inv); *(u32x2*)(drow + 512 * j) = q; }
            }
        }
        SEAM();
#endif

        if (RUN() && EN(6)) { LOCAL_TID();
            if (EN(20)) { pg8::Gemm gm{I8_MID ? (const bf16*)P_AO8 : P_AO, I8_MID ? 1024 : 2048, P_WAT, TG, DM, I8_MID ? 1024 : 2048}; pg8::StaticOrder S; S.init(TG, DM, G, bx);
              pg8::EpiGateAT<I8_MID != 0> E{P_MG, DM, P_P + C_GATE, NIN, ws}; REP_LOOP_GEMM { int l2_ = lane_id_fresh(); asm volatile("" : "+v"(l2_)); pg8::gemm_phase<pg8::EpiGateAT<I8_MID != 0>, I8_MID ? 2 : 0>(ldsL, gm, S, E, wave * 64 + l2_); } }
            if (EN(21)) { pg8::Gemm gm{I8_MID ? (const bf16*)P_BO8 : P_BO, I8_MID ? 1024 : 2048, P_WBT, TG, DM, I8_MID ? 1024 : 2048}; pg8::StaticOrder S; S.init(TG, DM, G, bx);
              pg8::EpiGateBT<I8_MID != 0> E{P_MG, DM, P_P + C_GATE + DM, NIN, P_MG, DM, ws}; REP_LOOP_GEMM { int l2_ = lane_id_fresh(); asm volatile("" : "+v"(l2_)); pg8::gemm_phase<pg8::EpiGateBT<I8_MID != 0>, I8_MID ? 2 : 0>(ldsL, gm, S, E, wave * 64 + l2_); } }
        }
        SEAM();

#if I8_MID
        if (RUN()) { LOCAL_TID();
            for (int m = gw; m < TG; m += NGW) {
                const bf16* srow = P_MG + (size_t)m * DM + lane * 8; u32x4 a[8]; float mx = 0.f;
#pragma unroll
                for (int j = 0; j < 8; ++j) { a[j] = *(const u32x4*)(srow + 512 * j);
                    mx = __builtin_fmaxf(mx, __builtin_fmaxf(__builtin_fmaxf(__builtin_fmaxf(__builtin_fabsf(bf_lo(a[j].x)), __builtin_fabsf(bf_hi(a[j].x))), __builtin_fmaxf(__builtin_fabsf(bf_lo(a[j].y)), __builtin_fabsf(bf_hi(a[j].y)))),
                                                      __builtin_fmaxf(__builtin_fmaxf(__builtin_fabsf(bf_lo(a[j].z)), __builtin_fabsf(bf_hi(a[j].z))), __builtin_fmaxf(__builtin_fabsf(bf_lo(a[j].w)), __builtin_fabsf(bf_hi(a[j].w)))))); }
                mx = wave_max(mx); const float inv = mx > 0.f ? 127.f / mx : 0.f; if (lane == 0) ((float*)(ws + WS_RSMA))[g * TG + m] = mx * (1.f / 127.f);
                unsigned char* drow = P_MG8 + (size_t)(g * TG + m) * DM + lane * 8;
#pragma unroll
                for (int j = 0; j < 8; ++j) { u32x2 q; q.x = pack4_i8(bf_lo(a[j].x) * inv, bf_hi(a[j].x) * inv, bf_lo(a[j].y) * inv, bf_hi(a[j].y) * inv); q.y = pack4_i8(bf_lo(a[j].z) * inv, bf_hi(a[j].z) * inv, bf_lo(a[j].w) * inv, bf_hi(a[j].w) * inv); *(u32x2*)(drow + 512 * j) = q; }
            }
        }
        SEAM();
#endif

    }

    if (RUN() && EN(7)) { LOCAL_TID();
        pg8::Gemm gm{(const bf16*)P_MG8, DM / 2, P_WOT, NTOK, DM, DM / 2}; pg8::StaticOrder S; S.init(NTOK, DM, G, bx);
        pg8::EpiResT<I8_MID != 0, false> E{A->in[I_XP], A->in[I_XS], NTOK / 2 / 256, P_X1, DM, 1.f, ws}; REP_LOOP_GEMM { int l2_ = lane_id_fresh(); asm volatile("" : "+v"(l2_)); pg8::gemm_phase<pg8::EpiResT<I8_MID != 0, false>, I8_MID ? 2 : 0>(ldsL, gm, S, E, wave * 64 + l2_); }
    }
    SEAM();

    if (RUN() && EN(8)) { LOCAL_TID();
        static_assert(I8_UP, "norm2 writes int8 rows");
        f32x4 gg[16];
#pragma unroll
        for (int j = 0; j < 8; ++j) { gg[2 * j] = *(const f32x4*)(A->in[I_RFG] + j * 512 + lane * 8); gg[2 * j + 1] = *(const f32x4*)(A->in[I_RFG] + j * 512 + lane * 8 + 4); }
        for (int m = gw; m < NTOK; m += 2 * NGW) {
            const int m2 = m + NGW; const bool has2 = m2 < NTOK;
            const bf16* r1 = P_X1 + (size_t)m * DM + lane * 8; const bf16* r2 = P_X1 + (size_t)(has2 ? m2 : m) * DM + lane * 8;
            u32x4 wa[8], wb[8];
#pragma unroll
            for (int j = 0; j < 8; ++j) wa[j] = *(const u32x4*)(r1 + j * 512);
            if (has2) {
#pragma unroll
                for (int j = 0; j < 8; ++j) wb[j] = *(const u32x4*)(r2 + j * 512); }
            { f32x4 t[16]; float ss = 0.f;
#pragma unroll
              for (int j = 0; j < 8; ++j) { t[2 * j] = (f32x4){bf_lo(wa[j].x), bf_hi(wa[j].x), bf_lo(wa[j].y), bf_hi(wa[j].y)}; t[2 * j + 1] = (f32x4){bf_lo(wa[j].z), bf_hi(wa[j].z), bf_lo(wa[j].w), bf_hi(wa[j].w)}; }
#pragma unroll
              for (int j = 0; j < 16; ++j) { ss += (t[j].x * t[j].x + t[j].y * t[j].y) + (t[j].z * t[j].z + t[j].w * t[j].w); t[j] = t[j] * gg[j]; }
              norm_quant_row(t, ss, P_HF + (size_t)m * DM, P_RSHF + m, lane); }
            if (has2) { f32x4 t[16]; float ss = 0.f;
#pragma unroll
              for (int j = 0; j < 8; ++j) { t[2 * j] = (f32x4){bf_lo(wb[j].x), bf_hi(wb[j].x), bf_lo(wb[j].y), bf_hi(wb[j].y)}; t[2 * j + 1] = (f32x4){bf_lo(wb[j].z), bf_hi(wb[j].z), bf_lo(wb[j].w), bf_hi(wb[j].w)}; }
#pragma unroll
              for (int j = 0; j < 16; ++j) { ss += (t[j].x * t[j].x + t[j].y * t[j].y) + (t[j].z * t[j].z + t[j].w * t[j].w); t[j] = t[j] * gg[j]; }
              norm_quant_row(t, ss, P_HF + (size_t)m2 * DM, P_RSHF + m2, lane); }
        }
    }
    SEAM();

    if (RUN() && EN(9)) { LOCAL_TID();
        pg8::Gemm gm{(const bf16*)P_HF, DM / 2, P_WUPT, NTOK, NUP, DM / 2}; pg8::StaticOrder S; S.init(NTOK, NUP, G, bx);
#if CONV_FUSE
        static_assert(I8_UP && CONV_FUSE, "the all-token FFN stage needs the fused conv epilogue (int8 up GEMM)");
        pg8::EpiConv E{(unsigned char*)P_ACT, P_Y, A->in[I_CW], A->in[I_CB], ws, FP8_DOWN ? S_ACT8 : 1.f}; REP_LOOP_GEMM { int l2_ = lane_id_fresh(); asm volatile("" : "+v"(l2_)); pg8::gemm_phase<pg8::EpiConv, 2>(ldsL, gm, S, E, wave * 64 + l2_); }
#else
        pg8::EpiStoreT<I8_UP != 0, WS_RSHF, WS_CSUP> E{P_Y, NUP, 0, 0, 1.f, ws, 0}; REP_LOOP_GEMM { int l2_ = lane_id_fresh(); asm volatile("" : "+v"(l2_)); pg8::gemm_phase<pg8::EpiStoreT<I8_UP != 0, WS_RSHF, WS_CSUP>, I8_UP ? 2 : 0>(ldsL, gm, S, E, wave * 64 + l2_); }
#endif
    }
    SEAM();

#if CONV_FUSE
    if (RUN() && EN(10)) { LOCAL_TID();
        const float* cw = A->in[I_CW]; const float* cb = A->in[I_CB];
        constexpr int NCB = DFF / 256, NITEM = NCB * (NTOK / 64) * 2;
        for (int it = gw; it < NITEM; it += NGW) {
            const int cbk = it % NCB, be = it / NCB, b = be >> 1, edge = be & 1, c0 = cbk * 256 + lane * 4, t = b * 64 + (edge ? 63 : 0);
            const int posmask = (t < NTOK / 2) ? 4095 : 8191;
            const int colg = (c0 >> 7) * 256 + (c0 & 127);
            const f32x4 wg0 = *(const f32x4*)(cw + c0), wg1 = *(const f32x4*)(cw + NUP + c0), wg2 = *(const f32x4*)(cw + 2 * NUP + c0), bg = *(const f32x4*)(cb + c0);
            const f32x4 wu0 = *(const f32x4*)(cw + DFF + c0), wu1 = *(const f32x4*)(cw + NUP + DFF + c0), wu2 = *(const f32x4*)(cw + 2 * NUP + DFF + c0), bu = *(const f32x4*)(cb + DFF + c0);
            auto ldyb = [&](int blk, int slot, f32x4& yg, f32x4& yu) {
                const bf16* p = P_Y + ((size_t)blk * 4 + slot) * NUP + colg; const u32x2 a = *(const u32x2*)p, bb = *(const u32x2*)(p + 128);
                yg = (f32x4){bf_lo(a.x), bf_hi(a.x), bf_lo(a.y), bf_hi(a.y)}; yu = (f32x4){bf_lo(bb.x), bf_hi(bb.x), bf_lo(bb.y), bf_hi(bb.y)}; };
            const f32x4 z = (f32x4){0.f, 0.f, 0.f, 0.f};
            f32x4 pg = z, pu = z, cg, cu, ng = z, nu = z;
            if (edge == 0) { ldyb(b, 0, cg, cu); ldyb(b, 1, ng, nu); if ((t & posmask) != 0) ldyb(b - 1, 3, pg, pu); }
            else { ldyb(b, 3, cg, cu); ldyb(b, 2, pg, pu); if (((t + 1) & posmask) != 0) ldyb(b + 1, 0, ng, nu); }
            const f32x4 ug = wg0 * pg + wg1 * cg + wg2 * ng + bg, uu = wu0 * pu + wu1 * cu + wu2 * nu + bu;
            float a[4];
#pragma unroll
            for (int j = 0; j < 4; ++j) a[j] = ug[j] * fast_sigmoid(ug[j]) * uu[j];
            if (FP8_DOWN) *(unsigned*)((unsigned char*)P_ACT + (size_t)t * DFF + c0) = pack4_fp8(a[0] * S_ACT8, a[1] * S_ACT8, a[2] * S_ACT8, a[3] * S_ACT8);
            else { u32x2 w; w.x = cvt_pk_bf16(a[0], a[1]); w.y = cvt_pk_bf16(a[2], a[3]); *(u32x2*)(P_ACT + (size_t)t * DFF + c0) = w; }
        }
    }
#else
    if (RUN() && EN(10)) { LOCAL_TID();
        const float* cw = A->in[I_CW]; const float* cb = A->in[I_CB];
        constexpr int RCH = 64, NCB = DFF / 256, NITEM = NCB * (TG / RCH);
        for (int it = gw; it < NITEM; it += NGW) {
            const int cbk = it % NCB, rc = it / NCB, c0 = cbk * 256 + lane * 4, t0 = rc * RCH;
            f32x4 wg0 = *(const f32x4*)(cw + c0), wg1 = *(const f32x4*)(cw + NUP + c0), wg2 = *(const f32x4*)(cw + 2 * NUP + c0), bg = *(const f32x4*)(cb + c0);
            f32x4 wu0 = *(const f32x4*)(cw + DFF + c0), wu1 = *(const f32x4*)(cw + NUP + DFF + c0), wu2 = *(const f32x4*)(cw + 2 * NUP + DFF + c0), bu = *(const f32x4*)(cb + DFF + c0);
            auto ldrow = [&](int t, f32x4& yg, f32x4& yu) {
                const u32x2 a = *(const u32x2*)(P_Y + (size_t)t * NUP + c0), b = *(const u32x2*)(P_Y + (size_t)t * NUP + DFF + c0);
                yg = (f32x4){bf_lo(a.x), bf_hi(a.x), bf_lo(a.y), bf_hi(a.y)}; yu = (f32x4){bf_lo(b.x), bf_hi(b.x), bf_lo(b.y), bf_hi(b.y)}; };
            const f32x4 z = (f32x4){0.f, 0.f, 0.f, 0.f};
            f32x4 pg = z, pu = z, cg, cu, ng, nu;
            if ((t0 & posmask) != 0) ldrow(t0 - 1, pg, pu);
            ldrow(t0, cg, cu);
#pragma unroll 4
            for (int t = t0; t < t0 + RCH; ++t) {
                if (((t + 1) & posmask) != 0) ldrow(t + 1, ng, nu); else { ng = z; nu = z; }
                const f32x4 ug = wg0 * pg + wg1 * cg + wg2 * ng + bg, uu = wu0 * pu + wu1 * cu + wu2 * nu + bu;
                float a[4];
#pragma unroll
                for (int j = 0; j < 4; ++j) a[j] = ug[j] * fast_sigmoid(ug[j]) * uu[j];
                if (FP8_DOWN) *(unsigned*)((unsigned char*)P_ACT + (size_t)t * DFF + c0) = pack4_fp8(a[0] * S_ACT8, a[1] * S_ACT8, a[2] * S_ACT8, a[3] * S_ACT8);
                else { u32x2 w; w.x = cvt_pk_bf16(a[0], a[1]); w.y = cvt_pk_bf16(a[2], a[3]); *(u32x2*)(P_ACT + (size_t)t * DFF + c0) = w; }
                pg = cg; pu = cu; cg = ng; cu = nu;
            }
        }
    }
#endif
    SEAM();

    if (RUN() && EN(11)) { LOCAL_TID();
        pg8::Gemm gm{P_ACT, FP8_DOWN ? DFF / 2 : DFF, P_WDT, NTOK, DM, FP8_DOWN ? DFF / 2 : DFF}; pg8::StaticOrder S; S.init(NTOK, DM, G, bx);
        pg8::EpiResT<false, true> E{P_X1, P_X1, 1 << 30, P_X1, DM, FP8_DOWN ? 1.f / (S_WD * S_ACT8) : 1.f, ws}; { int l2_ = lane_id_fresh(); asm volatile("" : "+v"(l2_)); pg8::gemm_phase<pg8::EpiResT<false, true>, FP8_DOWN ? 1 : 0>(ldsL, gm, S, E, wave * 64 + l2_); }
    }
    SEAM();

    if (RUN() && EN(12)) { LOCAL_TID();
        f32x4 gg[16];
#pragma unroll
        for (int j = 0; j < 8; ++j) { gg[2 * j] = *(const f32x4*)(A->in[I_FNG] + j * 512 + lane * 8); gg[2 * j + 1] = *(const f32x4*)(A->in[I_FNG] + j * 512 + lane * 8 + 4); }
        for (int m = gw; m < NTOK; m += 2 * NGW) {
            const int m2 = m + NGW; const bool has2 = m2 < NTOK;
            const bf16* r1 = P_X1 + (size_t)m * DM + lane * 8; const bf16* r2 = P_X1 + (size_t)(has2 ? m2 : m) * DM + lane * 8;
            u32x4 wa[8], wb[8];
#pragma unroll
            for (int j = 0; j < 8; ++j) wa[j] = *(const u32x4*)(r1 + j * 512);
            if (has2) {
#pragma unroll
                for (int j = 0; j < 8; ++j) wb[j] = *(const u32x4*)(r2 + j * 512); }
            { f32x4 t[16]; float ss = 0.f;
#pragma unroll
              for (int j = 0; j < 8; ++j) { t[2 * j] = (f32x4){bf_lo(wa[j].x), bf_hi(wa[j].x), bf_lo(wa[j].y), bf_hi(wa[j].y)}; t[2 * j + 1] = (f32x4){bf_lo(wa[j].z), bf_hi(wa[j].z), bf_lo(wa[j].w), bf_hi(wa[j].w)}; }
#pragma unroll
              for (int j = 0; j < 16; ++j) ss += (t[j].x * t[j].x + t[j].y * t[j].y) + (t[j].z * t[j].z + t[j].w * t[j].w);
              const float rstd = 1.0f / sqrtf(wave_sum(ss) * (1.f / DM) + EPS); float* orow = A->out + (size_t)m * DM + lane * 8;
#pragma unroll
              for (int j = 0; j < 8; ++j) { *(f32x4*)(orow + j * 512) = t[2 * j] * rstd * gg[2 * j]; *(f32x4*)(orow + j * 512 + 4) = t[2 * j + 1] * rstd * gg[2 * j + 1]; } }
            if (has2) { f32x4 t[16]; float ss = 0.f;
#pragma unroll
              for (int j = 0; j < 8; ++j) { t[2 * j] = (f32x4){bf_lo(wb[j].x), bf_hi(wb[j].x), bf_lo(wb[j].y), bf_hi(wb[j].y)}; t[2 * j + 1] = (f32x4){bf_lo(wb[j].z), bf_hi(wb[j].z), bf_lo(wb[j].w), bf_hi(wb[j].w)}; }
#pragma unroll
              for (int j = 0; j < 16; ++j) ss += (t[j].x * t[j].x + t[j].y * t[j].y) + (t[j].z * t[j].z + t[j].w * t[j].w);
              const float rstd = 1.0f / sqrtf(wave_sum(ss) * (1.f / DM) + EPS); float* orow = A->out + (size_t)m2 * DM + lane * 8;
#pragma unroll
              for (int j = 0; j < 8; ++j) { *(f32x4*)(orow + j * 512) = t[2 * j] * rstd * gg[2 * j]; *(f32x4*)(orow + j * 512 + 4) = t[2 * j + 1] * rstd * gg[2 * j + 1]; } }
        }
    }
    SEAM();
#undef RUN
#undef SEAM
}

extern "C" void kernel_launch(void* const* d_in, const int* in_sizes, int n_in, void* d_out, int out_size, void* d_ws, size_t ws_size, hipStream_t stream) {
    static int grid = 0;
    if (grid == 0) {
        if (n_in != 23 || out_size != NTOK * DM || ws_size < WS_END) { fprintf(stderr, "kernel_launch: unexpected shapes: n_in %d out %d ws %zu (need %zu)\n", n_in, out_size, ws_size, (size_t)WS_END); grid = -1; return; }
        int dev = 0, cus = 0, per_cu = 0;
        if (hipGetDevice(&dev) != hipSuccess || hipDeviceGetAttribute(&cus, hipDeviceAttributeMultiprocessorCount, dev) != hipSuccess) { grid = -1; return; }
        if (hipFuncSetAttribute((const void*)enc_fwd, hipFuncAttributeMaxDynamicSharedMemorySize, LDS_BYTES) != hipSuccess) { fprintf(stderr, "kernel_launch: hipFuncSetAttribute failed\n"); grid = -1; return; }
        if (hipOccupancyMaxActiveBlocksPerMultiprocessor(&per_cu, (const void*)enc_fwd, NWAVES * 64, LDS_BYTES) != hipSuccess || per_cu < 1) { fprintf(stderr, "kernel_launch: occupancy query says %d\n", per_cu); per_cu = 1; }
        (void)hipGetLastError();
        grid = cus;
    }
    if (grid < 0) return;
    (void)hipMemsetAsync((char*)d_ws + WS_CTL, 0, CTL_ZERO_BYTES, stream);
    Args a{};
    for (int i = 0; i < 23; ++i) a.in[i] = (const float*)d_in[i];
    a.out = (float*)d_out; a.ws = (unsigned char*)d_ws;
    for (int i = 0; i < 32; ++i) a.invf[i] = powf(10000.0f, -(float)(2 * i) / 64.0f);
#if MK_PER_STEP_LAUNCH
    for (int s = 0; s < NSTEPS; ++s) { a.lo = s; a.hi = s + 1; hipLaunchKernelGGL(enc_fwd, dim3(grid), dim3(NWAVES * 64), LDS_BYTES, stream, a); }
#else
    a.lo = 0; a.hi = NSTEPS;
    hipLaunchKernelGGL(enc_fwd, dim3(grid), dim3(NWAVES * 64), LDS_BYTES, stream, a);
#endif
    const hipError_t le = hipPeekAtLastError();
    if (le != hipSuccess) fprintf(stderr, "kernel_launch: launch failed: %s\n", hipGetErrorName(le));
}
```
